# Optimizing an MI355X kernel written in HIP

```python
import jax, jax.numpy as jnp
from jax import lax
import numpy as np

D_MODEL = 1024
BATCH = 32
SEQ = 256
DEPTH = 2
DEC_BATCH = 4
DEC_SEQ = 1024
PAST_LEN = 512

GRID_W = 64
N_MIXERS = 2
N_ATTN_LAYERS = (DEPTH + 1) // 2
N_GMLP_LAYERS = DEPTH // 2
N_HEADS = 16
HEAD_DIM = D_MODEL // N_HEADS
NA_ROWS = 8
NA_COLS = 16
Q_BLOCK = 128
CHUNK = 128
GMLP_WIDTH = 2 * D_MODEL
GMLP_GROUPS = 16
GMLP_GROUP_DIM = GMLP_WIDTH // GMLP_GROUPS
FFN_DIM = 2816
CONV_W = 3
EPS = 1e-6

kernel_name = 'hybrid_natten_gmlp_diffusion_step'


def rmsnorm(x, g):
    xf = x.astype(jnp.float32)
    y = xf * lax.rsqrt(jnp.mean(xf * xf, axis=-1, keepdims=True) + EPS)
    return (y * g.astype(jnp.float32)).astype(x.dtype)


def layernorm(x, g):
    xf = x.astype(jnp.float32)
    xc = xf - jnp.mean(xf, axis=-1, keepdims=True)
    y = xc * lax.rsqrt(jnp.mean(xc * xc, axis=-1, keepdims=True) + EPS)
    return (y * g.astype(jnp.float32)).astype(x.dtype)


def adaln(cond, w_ada, b_ada):
    mod = jax.nn.silu(cond) @ w_ada + b_ada
    return jnp.split(mod[:, None, :], 6, axis=-1)


def modulate(h, shift, scale):
    return h * (1 + scale) + shift


def qkv_proj(h, w_qkv):
    B, T, _ = h.shape
    qkv = (h @ w_qkv).reshape(B, T, 3, N_HEADS, HEAD_DIM)
    qkv = jnp.transpose(qkv, (2, 0, 3, 1, 4))
    return qkv[0], qkv[1], qkv[2]


def merge_heads(o):
    B, H, T, Dh = o.shape
    return jnp.transpose(o, (0, 2, 1, 3)).reshape(B, T, H * Dh)


def context_attention(q, k, v):
    B, H, S, Dh = q.shape
    nb = S // Q_BLOCK
    scale = HEAD_DIM ** -0.5
    qb = jnp.moveaxis(q.reshape(B, H, nb, Q_BLOCK, Dh), 2, 0)

    def block(qi):
        s = jnp.einsum('bhqd,bhkd->bhqk', qi, k).astype(jnp.float32) * scale
        p = jax.nn.softmax(s, axis=-1).astype(v.dtype)
        return jnp.einsum('bhqk,bhkd->bhqd', p, v)

    o = lax.map(block, qb)
    return jnp.moveaxis(o, 0, 2).reshape(B, H, S, Dh)


def neighbourhood_attention(q, k, v, k_ctx, v_ctx, rpb):
    B, H, T, Dh = q.shape
    rows = T // GRID_W
    kh = min(NA_ROWS, rows)
    n_win = kh * NA_COLS
    scale = HEAD_DIM ** -0.5
    qg = q.reshape(B, H, rows, GRID_W, Dh)
    kg = k.reshape(B, H, rows, GRID_W, Dh)
    vg = v.reshape(B, H, rows, GRID_W, Dh)
    r_idx = jnp.arange(rows)
    row_start = jnp.clip(r_idx - kh // 2, 0, rows - kh)
    cols = jnp.arange(GRID_W)
    col_start = jnp.clip(cols - NA_COLS // 2, 0, GRID_W - NA_COLS)
    col_idx = col_start[:, None] + jnp.arange(NA_COLS)[None, :]
    col_off = col_idx - cols[:, None] + (NA_COLS - 1)

    def row_block(args):
        q_r, r, rs = args
        k_blk = lax.dynamic_slice_in_dim(kg, rs, kh, axis=2)
        v_blk = lax.dynamic_slice_in_dim(vg, rs, kh, axis=2)
        k_win = k_blk[:, :, :, col_idx, :]
        v_win = v_blk[:, :, :, col_idx, :]
        row_off = rs + jnp.arange(kh) - r + (NA_ROWS - 1)
        bias = jnp.transpose(rpb[:, row_off][:, :, col_off], (0, 2, 1, 3))
        s_win = (jnp.einsum('bhqd,bhiqjd->bhqij', q_r, k_win).astype(jnp.float32) * scale
                 + bias.astype(jnp.float32)).reshape(B, H, GRID_W, n_win)
        s_ctx = jnp.einsum('bhqd,bhcd->bhqc', q_r, k_ctx).astype(jnp.float32) * scale
        p = jax.nn.softmax(jnp.concatenate([s_win, s_ctx], axis=-1), axis=-1).astype(v.dtype)
        p_win = p[..., :n_win].reshape(B, H, GRID_W, kh, NA_COLS)
        p_ctx = p[..., n_win:]
        return (jnp.einsum('bhqij,bhiqjd->bhqd', p_win, v_win)
                + jnp.einsum('bhqc,bhcd->bhqd', p_ctx, v_ctx))

    o = lax.map(row_block, (jnp.moveaxis(qg, 2, 0), r_idx, row_start))
    return jnp.moveaxis(o, 0, 2).reshape(B, H, T, Dh)


def chunk_gmlp(h, w_in, g_v, w_s, b_s, w_out):
    B, T, _ = h.shape
    nc = T // CHUNK
    z = jax.nn.gelu(h @ w_in)
    u, vv = jnp.split(z, 2, axis=-1)
    vv = layernorm(vv, g_v).reshape(B, nc, CHUNK, GMLP_GROUPS, GMLP_GROUP_DIM)
    mixed = jnp.einsum('gpq,bnqgc->bnpgc', w_s, vv) + jnp.transpose(b_s)[:, :, None]
    return (u * mixed.reshape(B, T, GMLP_WIDTH)) @ w_out


def conv_ffn(h, w_up, w_conv, b_conv, w_down):
    T = h.shape[1]
    a = h @ w_up
    pad = CONV_W // 2
    ap = jnp.pad(a, ((0, 0), (pad, pad), (0, 0)))
    a = sum(ap[:, j:j + T] * w_conv[j] for j in range(CONV_W)) + b_conv
    g, val = jnp.split(a, 2, axis=-1)
    return (jax.nn.silu(g) * val) @ w_down


def setup_inputs(seed: int = 0) -> dict:
    key = jax.random.key(seed)
    ks = jax.random.split(key, 24)
    D, E, F, G = D_MODEL, GMLP_WIDTH, FFN_DIM, GMLP_GROUPS
    nrm = jax.random.normal
    return {
        'x_prompt': nrm(ks[0], (BATCH, SEQ, D), jnp.float32),
        'x_sample': nrm(ks[1], (DEC_BATCH, DEC_SEQ, D), jnp.float32),
        'cache_k': nrm(ks[2], (DEC_BATCH, N_ATTN_LAYERS, N_HEADS, PAST_LEN, HEAD_DIM), jnp.float32),
        'cache_v': nrm(ks[3], (DEC_BATCH, N_ATTN_LAYERS, N_HEADS, PAST_LEN, HEAD_DIM), jnp.float32),
        'c': nrm(ks[4], (DEC_BATCH, D), jnp.float32),
        'c_ctx': nrm(ks[5], (D,), jnp.float32),
        'w_ada': nrm(ks[6], (DEPTH, D, 6 * D), jnp.float32) * D ** -0.5,
        'b_ada': nrm(ks[7], (DEPTH, 6 * D), jnp.float32) * 0.01,
        'norm_mix_g': 1.0 + 0.02 * nrm(ks[8], (DEPTH, D), jnp.float32),
        'norm_ffn_g': 1.0 + 0.02 * nrm(ks[9], (DEPTH, D), jnp.float32),
        'norm_final_g': 1.0 + 0.02 * nrm(ks[10], (D,), jnp.float32),
        'w_qkv': nrm(ks[11], (N_ATTN_LAYERS, D, 3 * D), jnp.float32) * D ** -0.5,
        'w_attn_out': nrm(ks[12], (N_ATTN_LAYERS, D, D), jnp.float32) * D ** -0.5,
        'rpb': 0.2 * nrm(ks[13], (N_ATTN_LAYERS, N_HEADS, 2 * NA_ROWS - 1, 2 * NA_COLS - 1), jnp.float32),
        'w_gmlp_in': nrm(ks[14], (N_GMLP_LAYERS, D, 2 * E), jnp.float32) * D ** -0.5,
        'g_gmlp_v': 1.0 + 0.02 * nrm(ks[15], (N_GMLP_LAYERS, E), jnp.float32),
        'w_spatial': nrm(ks[16], (N_GMLP_LAYERS, G, CHUNK, CHUNK), jnp.float32) * CHUNK ** -0.5,
        'b_spatial': 1.0 + 0.01 * nrm(ks[17], (N_GMLP_LAYERS, G, CHUNK), jnp.float32),
        'w_gmlp_out': nrm(ks[18], (N_GMLP_LAYERS, E, D), jnp.float32) * E ** -0.5,
        'w_ffn_up': nrm(ks[19], (DEPTH, D, 2 * F), jnp.float32) * D ** -0.5,
        'w_ffn_conv': nrm(ks[20], (DEPTH, CONV_W, 2 * F), jnp.float32) * CONV_W ** -0.5,
        'b_ffn_conv': 0.01 * nrm(ks[21], (DEPTH, 2 * F), jnp.float32),
        'w_ffn_down': nrm(ks[22], (DEPTH, F, D), jnp.float32) * F ** -0.5,
    }


def reference(x_prompt, x_sample, cache_k, cache_v, c, c_ctx, w_ada, b_ada, norm_mix_g,
              norm_ffn_g, norm_final_g, w_qkv, w_attn_out, rpb, w_gmlp_in, g_gmlp_v,
              w_spatial, b_spatial, w_gmlp_out, w_ffn_up, w_ffn_conv, b_ffn_conv, w_ffn_down):
    x = x_prompt
    ks_new, vs_new = [], []
    for l in range(DEPTH):
        sm, cm, gm, sf, cf, gf = adaln(c_ctx[None, :], w_ada[l], b_ada[l])
        h = modulate(rmsnorm(x, norm_mix_g[l]), sm, cm)
        j = l // N_MIXERS
        if l % N_MIXERS == 0:
            q, k, v = qkv_proj(h, w_qkv[j])
            mix = merge_heads(context_attention(q, k, v)) @ w_attn_out[j]
            ks_new.append(k)
            vs_new.append(v)
        else:
            mix = chunk_gmlp(h, w_gmlp_in[j], g_gmlp_v[j], w_spatial[j], b_spatial[j], w_gmlp_out[j])
        x = x + gm * mix
        h = modulate(rmsnorm(x, norm_ffn_g[l]), sf, cf)
        x = x + gf * conv_ffn(h, w_ffn_up[l], w_ffn_conv[l], b_ffn_conv[l], w_ffn_down[l])
    y_prompt = rmsnorm(x, norm_final_g)
    state_k = jnp.stack(ks_new, axis=1)
    state_v = jnp.stack(vs_new, axis=1)

    x = x_sample
    for l in range(DEPTH):
        sm, cm, gm, sf, cf, gf = adaln(c, w_ada[l], b_ada[l])
        h = modulate(rmsnorm(x, norm_mix_g[l]), sm, cm)
        j = l // N_MIXERS
        if l % N_MIXERS == 0:
            q, k, v = qkv_proj(h, w_qkv[j])
            o = neighbourhood_attention(q, k, v, cache_k[:, j], cache_v[:, j], rpb[j])
            mix = merge_heads(o) @ w_attn_out[j]
        else:
            mix = chunk_gmlp(h, w_gmlp_in[j], g_gmlp_v[j], w_spatial[j], b_spatial[j], w_gmlp_out[j])
        x = x + gm * mix
        h = modulate(rmsnorm(x, norm_ffn_g[l]), sf, cf)
        x = x + gf * conv_ffn(h, w_ffn_up[l], w_ffn_conv[l], b_ffn_conv[l], w_ffn_down[l])
    y_sample = rmsnorm(x, norm_final_g)

    return (y_prompt, y_sample, state_k, state_v)
```

```cpp
#include <hip/hip_runtime.h>
#include <cstdio>
#include <cstdint>

#ifndef MK_MULTI_LAUNCH
#define MK_MULTI_LAUNCH 0
#endif

#define GAS __attribute__((address_space(1)))
#define LAS __attribute__((address_space(3)))
typedef unsigned short bf16;
typedef short bf16x8 __attribute__((ext_vector_type(8)));
typedef float f32x4 __attribute__((ext_vector_type(4)));
typedef float f32x2 __attribute__((ext_vector_type(2)));
typedef unsigned u32x4 __attribute__((ext_vector_type(4)));
typedef unsigned u32x2 __attribute__((ext_vector_type(2)));
typedef GAS unsigned gu32;

constexpr int D = 1024, NCTX = 8192, NLAT = 4096, MT = 12288, NH = 16, HD = 64, FF = 2816, FF2 = 5632, GE = 2048, GE2 = 4096, NQKV = 3072;
constexpr int SEQ_C = 256, SEQ_L = 1024, PAST = 512;
constexpr float EPS = 1e-6f, LOG2E = 1.4426950408889634f, C2 = 0.125f * 1.4426950408889634f;
constexpr int NWAVES = 8;

constexpr size_t MiB = 1u << 20;
constexpr size_t WS_CTL = 0, CTL_ZERO_BYTES = 1 * MiB;
constexpr size_t WS_MOD = 512 * 1024;
constexpr size_t WS_SW = 1 * MiB;
constexpr size_t WS_RS = 2 * MiB;
constexpr size_t WS_LNP = 3 * MiB;
constexpr size_t WS_WQKV = 4 * MiB, WS_WO = 10 * MiB, WS_WIN = 12 * MiB, WS_WOUT = 20 * MiB, WS_WUP = 24 * MiB, WS_WDN = 46 * MiB;
constexpr size_t WUP_BYTES = 11 * MiB, WDN_BYTES = (size_t)1024 * 2816 * 2;
constexpr size_t WS_CK = 58 * MiB, WS_CV = 62 * MiB;
constexpr size_t WS_AN = 66 * MiB;
constexpr size_t WS_BIG = 90 * MiB;
constexpr size_t WS_Q = WS_BIG, WS_K = WS_BIG + 24 * MiB, WS_V = WS_BIG + 48 * MiB;
constexpr size_t WS_M = WS_BIG, WS_ARAW = WS_BIG + 66 * MiB;
constexpr size_t WS_U = WS_BIG, WS_VV = WS_BIG + 48 * MiB;
constexpr size_t WS_END = 256 * MiB;
static_assert(WS_ARAW + (size_t)4096 * 5632 * 2 <= WS_END && WS_WDN + 2 * WDN_BYTES <= WS_CK && WS_VV + 48 * MiB <= WS_END, "ws map");
constexpr int SW_QKV = 0, SW_UP0 = 5 * NQKV, SW_IN = SW_UP0 + 5 * FF2, SW_UP1 = SW_IN + 5 * GE2;
constexpr int CW_TMO = 0, CW_CODE = 1, CW_BAR = 4096;

#define RLX_AGENT __ATOMIC_RELAXED, __HIP_MEMORY_SCOPE_AGENT
#define LDS_WAIT() asm volatile("s_waitcnt lgkmcnt(0)" ::: "memory")
#define VM_WAIT() asm volatile("s_waitcnt vmcnt(0)" ::: "memory")
__device__ __forceinline__ unsigned cvt_pk_bf16(float lo, float hi) { unsigned r; asm volatile("v_cvt_pk_bf16_f32 %0, %1, %2" : "=v"(r) : "v"(lo), "v"(hi)); return r; }
__device__ __forceinline__ float bf2f(unsigned short u) { return __uint_as_float((unsigned)u << 16); }
__device__ __forceinline__ float bflo(unsigned w) { return __uint_as_float(w << 16); }
__device__ __forceinline__ float bfhi(unsigned w) { return __uint_as_float(w & 0xffff0000u); }
__device__ __forceinline__ u32x4 pack8(f32x4 a, f32x4 b) { u32x4 w; w.x = cvt_pk_bf16(a[0], a[1]); w.y = cvt_pk_bf16(a[2], a[3]); w.z = cvt_pk_bf16(b[0], b[1]); w.w = cvt_pk_bf16(b[2], b[3]); return w; }
__device__ __forceinline__ float wave_sum(float v) {
#pragma unroll
    for (int o = 1; o < 64; o <<= 1) v += __shfl_xor(v, o);
    return v;
}
__device__ __forceinline__ float silu_f(float x) { return x / (1.f + __builtin_amdgcn_exp2f(-x * LOG2E)); }
__device__ __forceinline__ float gelu_tanh_f(float x) { const float u = 1.5957691216057308f * (x + 0.044715f * x * x * x); return x / (1.f + __builtin_amdgcn_exp2f(-u * LOG2E)); }
__device__ __forceinline__ int ci_of(int row) { return row < NCTX ? 0 : 1 + ((row - NCTX) >> 10); }

#define XB_TMO      128
#define XB_XCNT(j)  (256  + 64 * (j))
#define XB_XSUB(j)  (1280 + 64 * (j))
#define XB_XGEN(j)  (2304 + 64 * (j))
#define XB_TOP      3328
#define XB_TOPGEN   3392
#define XCD_BAR_WORDS 3456
#define XB_SPIN_CAP (1u << 18)
__device__ __forceinline__ unsigned xb_ld(unsigned* p)              { return __hip_atomic_load(p, __ATOMIC_RELAXED, __HIP_MEMORY_SCOPE_AGENT); }
__device__ __forceinline__ unsigned xb_add(unsigned* p, unsigned v) { return __hip_atomic_fetch_add(p, v, __ATOMIC_RELAXED, __HIP_MEMORY_SCOPE_AGENT); }
__device__ __forceinline__ unsigned xb_xcc_id() { return (unsigned)__builtin_amdgcn_s_getreg((3 << 11) | 20) & 0xFu; }
#define XB_SPIN(cond, bar) do { unsigned _sp = 0; while (cond) { __builtin_amdgcn_s_sleep(1); \
    if ((++_sp & 255u) == 0u) { if (xb_ld(&(bar)[XB_TMO])) break; if (_sp > XB_SPIN_CAP) { atomicAdd(&(bar)[XB_TMO], 1u); break; } } } } while (0)
struct XcdBarrier { unsigned* bar; unsigned x; volatile LAS unsigned* st; };
__device__ __forceinline__ XcdBarrier xcd_barrier_post(unsigned* bar, volatile LAS unsigned* st) {
    XcdBarrier b; b.bar = bar; b.x = xb_xcc_id(); b.st = st;
    if (threadIdx.x == 0) (void)xb_add(&bar[XB_XCNT(b.x)], 1u);
    return b;
}
__device__ __forceinline__ void xcd_barrier_complete(unsigned* bar, unsigned x, unsigned& nloc, unsigned& nx) {
    const unsigned G = gridDim.x * gridDim.y * gridDim.z;
    unsigned sum, cnt, mine, sp = 0u;
    for (;;) {
        sum = 0u; cnt = 0u; mine = 0u;
#pragma unroll
        for (unsigned j = 0; j < 16; ++j) { const unsigned c = xb_ld(&bar[XB_XCNT(j)]); sum += c; cnt += (c > 0u) ? 1u : 0u; mine = (j == x) ? c : mine; }
        if (sum == G) break;
        __builtin_amdgcn_s_sleep(1);
        if ((++sp & 255u) == 0u) { if (xb_ld(&bar[XB_TMO])) break; if (sp > XB_SPIN_CAP) { atomicAdd(&bar[XB_TMO], 1u); break; } }
    }
    nloc = mine > 0u ? mine : 1u; nx = cnt > 0u ? cnt : 1u;
}
__device__ __forceinline__ void xcd_barrier(const XcdBarrier& b) {
    asm volatile("s_waitcnt vmcnt(0)" ::: "memory");
    __syncthreads();
    if (threadIdx.x == 0) {
        unsigned* bar = b.bar;
        __builtin_amdgcn_s_waitcnt(0);
        unsigned nloc = b.st[0], nx = b.st[1];
        if (nloc == 0u) { xcd_barrier_complete(bar, b.x, nloc, nx); b.st[0] = nloc; b.st[1] = nx; }
        const unsigned old = xb_add(&bar[XB_XSUB(b.x)], 1u);
        const unsigned gen = old / nloc;
        if (old + 1u == (gen + 1u) * nloc) {
            __builtin_amdgcn_fence(__ATOMIC_RELEASE, "agent");
            asm volatile("s_waitcnt vmcnt(0)" ::: "memory");
            const unsigned og = xb_add(&bar[XB_TOP], 1u);
            const unsigned tg = og / nx;
            if (og + 1u == (tg + 1u) * nx) xb_add(&bar[XB_TOPGEN], 1u);
            else XB_SPIN(xb_ld(&bar[XB_TOPGEN]) == tg, bar);
            __builtin_amdgcn_fence(__ATOMIC_ACQUIRE, "agent");
            xb_add(&bar[XB_XGEN(b.x)], 1u);
            asm volatile("s_waitcnt vmcnt(0)" ::: "memory");
        } else {
            XB_SPIN(xb_ld(&bar[XB_XGEN(b.x)]) == gen, bar);
            __builtin_amdgcn_fence(__ATOMIC_ACQUIRE, "agent");
            asm volatile("s_waitcnt vmcnt(0)" ::: "memory");
        }
    }
    __syncthreads();
}

constexpr int RING_OFF = 0, RING_BYTES = 131072;
constexpr int LDSCTL_OFF = RING_BYTES, MISC_OFF = LDSCTL_OFF + 320;
constexpr int LDS_BYTES = 147456;

struct Frame {
    LAS unsigned char* lds;
    volatile LAS unsigned* MISC;
    int tid, lane, wave, G, bid;
};
struct Args { const float* in[23]; float* out; unsigned char* ws; int lo, hi; };
__device__ __forceinline__ const float* inp(const Args& a, int i) { asm volatile("" : "+s"(i)); return a.in[i]; }
__device__ __forceinline__ unsigned char* wsb(const Args& a) { unsigned char* p = a.ws; asm volatile("" : "+s"(p)); return p; }
__device__ __forceinline__ float* outb(const Args& a) { float* p = a.out; asm volatile("" : "+s"(p)); return p; }
enum InIdx { I_XP = 0, I_XS, I_CK, I_CV, I_C, I_CCTX, I_WADA, I_BADA, I_NMIX, I_NFFN, I_NFIN, I_WQKV, I_WO, I_RPB, I_WIN, I_GV, I_WSP, I_BSP, I_WOUT, I_WUP, I_WCONV, I_BCONV, I_WDN };

__device__ __forceinline__ int upmap(int n) { return n < FF ? ((n >> 7) << 8) + (n & 127) : (((n - FF) >> 7) << 8) + 128 + ((n - FF) & 127); }
__device__ __forceinline__ void p0_transpose_item(const float* W, int K, int N, bf16* WT, bool upperm, LAS float* scr, int item, int lane) {
    const int nblk = N / 32, kb = item / nblk, nb = item % nblk, k0 = 64 * kb, n0 = 32 * nb;
    const int nm0 = upperm ? upmap(n0) : n0;
#pragma unroll 8
    for (int i = 0; i < 32; ++i) { const int kk = 2 * i + (lane >> 5); scr[kk * 33 + (lane & 31)] = W[(size_t)(k0 + kk) * N + n0 + (lane & 31)]; }
    LDS_WAIT(); asm volatile("" ::: "memory");
    const int c = lane & 7;
#pragma unroll
    for (int j = 0; j < 4; ++j) { const int n = (lane >> 3) + 8 * j; const LAS float* s = scr + (8 * c) * 33 + n;
        u32x4 o; o.x = cvt_pk_bf16(s[0 * 33], s[1 * 33]); o.y = cvt_pk_bf16(s[2 * 33], s[3 * 33]); o.z = cvt_pk_bf16(s[4 * 33], s[5 * 33]); o.w = cvt_pk_bf16(s[6 * 33], s[7 * 33]);
        *(u32x4*)(WT + (size_t)(nm0 + n) * K + k0 + 8 * c) = o; }
    LDS_WAIT(); asm volatile("" ::: "memory");
}
__device__ __forceinline__ void p0_adaln_item(const Args& args, int item, int lane) {
    const float* w_ada = inp(args, I_WADA); const float* c_ctx = inp(args, I_CCTX); const float* cc = inp(args, I_C);
    float* MOD = (float*)(wsb(args) + WS_MOD);
    const int jb = item % 24, kc = (item / 24) % 16, l = item / 384;
    const int j = jb * 256 + lane * 4;
    const float* W = w_ada + ((size_t)l * D + (size_t)kc * 64) * 6144 + j;
    f32x4 acc[5];
#pragma unroll
    for (int q = 0; q < 5; ++q) acc[q] = (f32x4){0.f, 0.f, 0.f, 0.f};
    for (int i = 0; i < 64; ++i) {
        const f32x4 w = *(const f32x4*)(W + (size_t)i * 6144);
        const int k = kc * 64 + i;
        acc[0] += silu_f(c_ctx[k]) * w;
#pragma unroll
        for (int b = 0; b < 4; ++b) acc[1 + b] += silu_f(cc[b * D + k]) * w;
    }
    if (kc == 0) { const f32x4 bv = *(const f32x4*)(inp(args, I_BADA) + l * 6144 + j);
#pragma unroll
        for (int q = 0; q < 5; ++q) acc[q] += bv; }
#pragma unroll
    for (int q = 0; q < 5; ++q)
#pragma unroll
        for (int e = 0; e < 4; ++e) atomicAdd(MOD + (size_t)(l * 5 + q) * 6144 + j + e, acc[q][e]);
}
__device__ __forceinline__ void p0_cache_item(const Args& args, int item, int lane) {
    const int which = item >> 11, r = item & 2047, cg = r & 31, h = (r >> 5) & 15, b = r >> 9;
    const float* src = inp(args, which ? I_CV : I_CK); bf16* dst = (bf16*)(wsb(args) + (which ? WS_CV : WS_CK));
    const int c = cg * 16 + (lane >> 2), dq = (lane & 3) * 16;
    const f32x4* s = (const f32x4*)(src + (((size_t)b * NH + h) * PAST + c) * HD + dq);
    const f32x4 a0 = s[0], a1 = s[1], a2 = s[2], a3 = s[3];
    bf16* d = dst + ((size_t)b * PAST + c) * D + h * HD + dq;
    *(u32x4*)d = pack8(a0, a1); *(u32x4*)(d + 8) = pack8(a2, a3);
}
__device__ __forceinline__ void p0_prologue(const Frame& F, const Args& args) {
    LAS float* scr = (LAS float*)(F.lds + RING_OFF + F.wave * 16384);
    const int gw = F.bid * NWAVES + F.wave, NGW = F.G * NWAVES;
    constexpr int N_ADA = 768, N_CACHE = 4096;
    constexpr int N_QKV = (D / 64) * (NQKV / 32), N_O = (D / 64) * (D / 32), N_IN = (D / 64) * (GE2 / 32), N_OUT = (GE / 64) * (D / 32), N_UP = (D / 64) * (FF2 / 32), N_DN = (FF / 64) * (D / 32);
    constexpr int NITEMS = N_ADA + N_CACHE + N_QKV + N_O + N_IN + N_OUT + 2 * N_UP + 2 * N_DN;
    for (int it = gw; it < NITEMS; it += NGW) {
        int r = it;
        if (r < N_ADA) { p0_adaln_item(args, r, F.lane); continue; } r -= N_ADA;
        if (r < N_CACHE) { p0_cache_item(args, r, F.lane); continue; } r -= N_CACHE;
        unsigned char* ws = wsb(args);
        if (r < N_QKV) { p0_transpose_item(inp(args, I_WQKV), D, NQKV, (bf16*)(ws + WS_WQKV), false, scr, r, F.lane); continue; } r -= N_QKV;
        if (r < N_O) { p0_transpose_item(inp(args, I_WO), D, D, (bf16*)(ws + WS_WO), false, scr, r, F.lane); continue; } r -= N_O;
        if (r < N_IN) { p0_transpose_item(inp(args, I_WIN), D, GE2, (bf16*)(ws + WS_WIN), false, scr, r, F.lane); continue; } r -= N_IN;
        if (r < N_OUT) { p0_transpose_item(inp(args, I_WOUT), GE, D, (bf16*)(ws + WS_WOUT), false, scr, r, F.lane); continue; } r -= N_OUT;
        if (r < 2 * N_UP) { const int l = r / N_UP; p0_transpose_item(inp(args, I_WUP) + (size_t)l * D * FF2, D, FF2, (bf16*)(ws + WS_WUP) + (size_t)l * FF2 * D, true, scr, r % N_UP, F.lane); continue; } r -= 2 * N_UP;
        { const int l = r / N_DN; p0_transpose_item(inp(args, I_WDN) + (size_t)l * FF * D, FF, D, (bf16*)(ws + WS_WDN) + (size_t)l * D * FF, false, scr, r % N_DN, F.lane); }
    }
}

__device__ __forceinline__ void p1_rows(const Frame& F, const Args& args) {
    const int gw = F.bid * NWAVES + F.wave, NGW = F.G * NWAVES, lane = F.lane;
    const float* xp = inp(args, I_XP); const float* xs = inp(args, I_XS); const float* gmix = inp(args, I_NMIX);
    unsigned char* ws = wsb(args);
    const float* MOD = (const float*)(ws + WS_MOD); float* RS = (float*)(ws + WS_RS); bf16* AN = (bf16*)(ws + WS_AN);
    for (int m = gw; m < MT; m += NGW) {
        const float* xr = (m < NCTX) ? xp + (size_t)m * D : xs + (size_t)(m - NCTX) * D;
        const int ci = ci_of(m);
        f32x4 v[4]; float s = 0.f;
#pragma unroll
        for (int j = 0; j < 4; ++j) { v[j] = ((const f32x4*)xr)[lane + 64 * j]; s += (v[j].x * v[j].x + v[j].y * v[j].y) + (v[j].z * v[j].z + v[j].w * v[j].w); }
        s = wave_sum(s);
        if (lane == 0) *(f32x4*)(RS + (size_t)m * 4) = (f32x4){s, 0.f, 0.f, 0.f};
        const float* sc = MOD + (size_t)ci * 6144 + 1024;
#pragma unroll
        for (int j = 0; j < 4; ++j) { const int col = 4 * lane + 256 * j;
            const f32x4 g = *(const f32x4*)(gmix + col), cs = *(const f32x4*)(sc + col);
            const f32x4 o = v[j] * g * (1.f + cs);
            u32x2 w; w.x = cvt_pk_bf16(o[0], o[1]); w.y = cvt_pk_bf16(o[2], o[3]);
            *(u32x2*)(AN + (size_t)m * D + col) = w; }
    }
}
__device__ __forceinline__ void p1_sw_stage(const Frame& F, const bf16* WT, int N, const float* shift  , float* out) {
    const int gw = F.bid * NWAVES + F.wave, NGW = F.G * NWAVES, lane = F.lane;
    float sh[5][16];
#pragma unroll
    for (int q = 0; q < 5; ++q)
#pragma unroll
        for (int e = 0; e < 16; ++e) sh[q][e] = shift[(size_t)q * 6144 + lane * 16 + e];
    for (int n = gw; n < N; n += NGW) {
        const u32x4* wp = (const u32x4*)(WT + (size_t)n * D + lane * 16);
        const u32x4 w0 = wp[0], w1 = wp[1];
        float wv[16];
        wv[0] = bflo(w0.x); wv[1] = bfhi(w0.x); wv[2] = bflo(w0.y); wv[3] = bfhi(w0.y); wv[4] = bflo(w0.z); wv[5] = bfhi(w0.z); wv[6] = bflo(w0.w); wv[7] = bfhi(w0.w);
        wv[8] = bflo(w1.x); wv[9] = bfhi(w1.x); wv[10] = bflo(w1.y); wv[11] = bfhi(w1.y); wv[12] = bflo(w1.z); wv[13] = bfhi(w1.z); wv[14] = bflo(w1.w); wv[15] = bfhi(w1.w);
#pragma unroll
        for (int q = 0; q < 5; ++q) { float s = 0.f;
#pragma unroll
            for (int e = 0; e < 16; ++e) s += sh[q][e] * wv[e];
            s = wave_sum(s);
            if (lane == 0) out[(size_t)q * N + n] = s; }
    }
}

template <class Epi>
__device__ __forceinline__ void gemm_simple(const Frame& F, const bf16* A, const bf16* Bt, int row0, int Mrows, int N, int K, const Epi& E) {
    const int gw = F.bid * NWAVES + F.wave, NGW = F.G * NWAVES, lane = F.lane, fr = lane & 15, fq = lane >> 4;
    const int tn = N / 64, ntile = (Mrows / 64) * tn;
    for (int t = gw; t < ntile; t += NGW) {
        const int m0 = row0 + (t / tn) * 64, n0 = (t % tn) * 64;
        f32x4 acc[4][4];
#pragma unroll
        for (int i = 0; i < 4; ++i)
#pragma unroll
            for (int j = 0; j < 4; ++j) acc[i][j] = (f32x4){0.f, 0.f, 0.f, 0.f};
        const bf16* ap = A + (size_t)(m0 + fr) * K + fq * 8;
        const bf16* bp = Bt + (size_t)(n0 + 8 * (fr >> 2) + (fr & 3)) * K + fq * 8;
        for (int k0 = 0; k0 < K; k0 += 32) {
            bf16x8 a[4], b[4];
#pragma unroll
            for (int mi = 0; mi < 4; ++mi) a[mi] = *(const bf16x8*)(ap + (size_t)(16 * mi) * K + k0);
#pragma unroll
            for (int nj = 0; nj < 4; ++nj) b[nj] = *(const bf16x8*)(bp + (size_t)(32 * (nj >> 1) + 4 * (nj & 1)) * K + k0);
#pragma unroll
            for (int mi = 0; mi < 4; ++mi)
#pragma unroll
                for (int nj = 0; nj < 4; ++nj) acc[mi][nj] = __builtin_amdgcn_mfma_f32_16x16x32_bf16(b[nj], a[mi], acc[mi][nj], 0, 0, 0);
        }
#pragma unroll
        for (int mi = 0; mi < 4; ++mi)
#pragma unroll
            for (int p = 0; p < 2; ++p) E.apply(m0 + 16 * mi + fr, n0 + 32 * p + 8 * fq, acc[mi][2 * p], acc[mi][2 * p + 1]);
    }
}

struct RowLin {
    const float* RS; const float* SW; int N;
    __device__ __forceinline__ void lin(int row, int col, f32x4& v0, f32x4& v1) const {
        const f32x4 p = *(const f32x4*)(RS + (size_t)row * 4);
        const float r = __builtin_amdgcn_rsqf(((p.x + p.y) + (p.z + p.w)) * (1.f / D) + EPS);
        const float* s = SW + (size_t)ci_of(row) * N + col;
        v0 = v0 * r + *(const f32x4*)s; v1 = v1 * r + *(const f32x4*)(s + 4);
    }
};
struct EpiQKV {
    RowLin L; bf16 *Q, *K, *V; float *sk, *sv;
    __device__ __forceinline__ void apply(int row, int col, f32x4 v0, f32x4 v1) const {
        L.lin(row, col, v0, v1);
        const int which = col >> 10, cc = col & 1023;
        if (which == 0) { *(u32x4*)(Q + (size_t)row * D + cc) = pack8(v0 * C2, v1 * C2); }
        else { bf16* dst = which == 1 ? K : V; *(u32x4*)(dst + (size_t)row * D + cc) = pack8(v0, v1);
            if (row < NCTX) { float* st = which == 1 ? sk : sv; const int b = row >> 8, t = row & 255, h = cc >> 6, d = cc & 63;
                float* p = st + (((size_t)b * NH + h) * SEQ_C + t) * HD + d; *(f32x4*)p = v0; *(f32x4*)(p + 4) = v1; } }
    }
};
struct EpiRes {
    const float *base_c, *base_l; float* Xout; const float* gate; bf16* AN; const float* gn; const float* scn;
    __device__ __forceinline__ void apply(int row, int col, f32x4 v0, f32x4 v1) const {
        const int ci = ci_of(row);
        const float* bp = (row < NCTX ? base_c + (size_t)row * D : base_l + (size_t)(row - NCTX) * D) + col;
        const float* gp = gate + (size_t)ci * 6144 + col;
        const f32x4 x0 = *(const f32x4*)bp + *(const f32x4*)gp * v0, x1 = *(const f32x4*)(bp + 4) + *(const f32x4*)(gp + 4) * v1;
        float* xo = Xout + (size_t)row * D + col; *(f32x4*)xo = x0; *(f32x4*)(xo + 4) = x1;
        if (AN) { const float* sp = scn + (size_t)ci * 6144 + col;
            const f32x4 a0 = x0 * *(const f32x4*)(gn + col) * (1.f + *(const f32x4*)sp), a1 = x1 * *(const f32x4*)(gn + col + 4) * (1.f + *(const f32x4*)(sp + 4));
            *(u32x4*)(AN + (size_t)row * D + col) = pack8(a0, a1); }
    }
};
struct EpiUpRaw {
    RowLin L; bf16* A; int row0;
    __device__ __forceinline__ void apply(int row, int col, f32x4 v0, f32x4 v1) const { L.lin(row, col, v0, v1); *(u32x4*)(A + (size_t)(row - row0) * FF2 + col) = pack8(v0, v1); }
};
struct EpiIn {
    RowLin L; bf16 *U, *VV;
    __device__ __forceinline__ void apply(int row, int col, f32x4 v0, f32x4 v1) const {
        L.lin(row, col, v0, v1);
#pragma unroll
        for (int e = 0; e < 4; ++e) { v0[e] = gelu_tanh_f(v0[e]); v1[e] = gelu_tanh_f(v1[e]); }
        bf16* dst = col < GE ? U + (size_t)row * GE + col : VV + (size_t)row * GE + (col - GE);
        *(u32x4*)dst = pack8(v0, v1);
    }
};

__device__ __forceinline__ void pass_rs(const Frame& F, const float* X, float* RSst) {
    const int gw = F.bid * NWAVES + F.wave, NGW = F.G * NWAVES, lane = F.lane;
    for (int m = gw; m < MT; m += NGW) { float s = 0.f;
#pragma unroll
        for (int j = 0; j < 4; ++j) { const f32x4 v = ((const f32x4*)(X + (size_t)m * D))[lane + 64 * j]; s += (v.x * v.x + v.y * v.y) + (v.z * v.z + v.w * v.w); }
        s = wave_sum(s);
        if (lane == 0) *(f32x4*)(RSst + (size_t)m * 4) = (f32x4){s, 0.f, 0.f, 0.f}; }
}
__device__ __forceinline__ void pass_final(const Frame& F, float* X, const float* gfin) {
    const int gw = F.bid * NWAVES + F.wave, NGW = F.G * NWAVES, lane = F.lane;
    for (int m = gw; m < MT; m += NGW) { f32x4 v[4]; float s = 0.f; f32x4* xr = (f32x4*)(X + (size_t)m * D);
#pragma unroll
        for (int j = 0; j < 4; ++j) { v[j] = xr[lane + 64 * j]; s += (v[j].x * v[j].x + v[j].y * v[j].y) + (v[j].z * v[j].z + v[j].w * v[j].w); }
        const float r = __builtin_amdgcn_rsqf(wave_sum(s) * (1.f / D) + EPS);
#pragma unroll
        for (int j = 0; j < 4; ++j) xr[lane + 64 * j] = v[j] * r * ((const f32x4*)gfin)[lane + 64 * j]; }
}
__device__ __forceinline__ void pass_lnstats(const Frame& F, const bf16* VV, float* LNP) {
    const int gw = F.bid * NWAVES + F.wave, NGW = F.G * NWAVES, lane = F.lane;
    for (int m = gw; m < MT; m += NGW) { float s = 0.f, q = 0.f;
#pragma unroll
        for (int j = 0; j < 4; ++j) { const u32x4 w = *(const u32x4*)(VV + (size_t)m * GE + lane * 8 + 512 * j);
#pragma unroll
            for (int e = 0; e < 4; ++e) { const float a = bflo(w[e]), b = bfhi(w[e]); s += a + b; q += a * a + b * b; } }
        s = wave_sum(s); q = wave_sum(q);
        if (lane < 8) *(f32x2*)(LNP + (size_t)m * 16 + lane * 2) = lane == 0 ? (f32x2){s, q} : (f32x2){0.f, 0.f}; }
}
__device__ __forceinline__ void pass_conv(const Frame& F, const Args& args, int l, int row0) {
    const int gt = F.bid * (NWAVES * 64) + F.tid, GT = F.G * NWAVES * 64;
    const float* wc = inp(args, I_WCONV) + (size_t)l * 3 * FF2; const float* bc = inp(args, I_BCONV) + (size_t)l * FF2;
    unsigned char* ws = wsb(args); const bf16* ARAW = (const bf16*)(ws + WS_ARAW); bf16* M = (bf16*)(ws + WS_M);
    for (int idx = gt; idx < 4096 * FF; idx += GT) {
        const int tl = idx / FF, j = idx - tl * FF, row = row0 + tl;
        const int pos = row < NCTX ? (row & (SEQ_C - 1)) : ((row - NCTX) & (SEQ_L - 1)), len = row < NCTX ? SEQ_C : SEQ_L;
        const int gc = ((j >> 7) << 8) + (j & 127), vc = gc + 128;
        const bf16* a = ARAW + (size_t)tl * FF2;
        float g = wc[FF2 + j] * bf2f(a[gc]) + bc[j], v = wc[FF2 + FF + j] * bf2f(a[vc]) + bc[FF + j];
        if (pos > 0) { g += wc[j] * bf2f(a[gc - FF2]); v += wc[FF + j] * bf2f(a[vc - FF2]); }
        if (pos < len - 1) { g += wc[2 * FF2 + j] * bf2f(a[gc + FF2]); v += wc[2 * FF2 + FF + j] * bf2f(a[vc + FF2]); }
        const float o = silu_f(g) * v;
        M[(size_t)row * FF + j] = (bf16)(cvt_pk_bf16(o, 0.f) & 0xffffu);
    }
}
__device__ __forceinline__ void pass_mix(const Frame& F, const Args& args) {
    LAS float* st = (LAS float*)(F.lds + RING_OFF);
    unsigned char* ws = wsb(args); const float* LNP = (const float*)(ws + WS_LNP); const bf16* VV = (const bf16*)(ws + WS_VV); bf16* U = (bf16*)(ws + WS_U);
    const float* wsp = inp(args, I_WSP); const float* bsp = inp(args, I_BSP); const float* gvp = inp(args, I_GV);
    for (int it = F.bid; it < 96 * 4; it += F.G) {
        const int chunk = it >> 2, e = (it & 3) * 512 + F.tid, g = e >> 7;
        __syncthreads();
        if (F.tid < 128) { const float* p = LNP + (size_t)(chunk * 128 + F.tid) * 16; float s = 0.f, q = 0.f;
#pragma unroll
            for (int k = 0; k < 8; ++k) { s += p[2 * k]; q += p[2 * k + 1]; }
            const float mean = s * (1.f / GE), var = q * (1.f / GE) - mean * mean;
            st[2 * F.tid] = mean; st[2 * F.tid + 1] = __builtin_amdgcn_rsqf(var + EPS); }
        __syncthreads();
        float vn[128]; const float gv = gvp[e];
#pragma unroll
        for (int q = 0; q < 128; ++q) vn[q] = (bf2f(VV[(size_t)(chunk * 128 + q) * GE + e]) - st[2 * q]) * st[2 * q + 1] * gv;
        const float* wsg = wsp + (size_t)g * 128 * 128;
        for (int p = 0; p < 128; ++p) { float acc = 0.f;
#pragma unroll
            for (int q = 0; q < 128; ++q) acc += wsg[p * 128 + q] * vn[q];
            bf16* up = U + (size_t)(chunk * 128 + p) * GE + e;
            const float o = bf2f(*up) * (acc + bsp[g * 128 + p]);
            *up = (bf16)(cvt_pk_bf16(o, 0.f) & 0xffffu); }
    }
}

__device__ __forceinline__ void attn_key(const bf16* kp, const bf16* vp, float bias, const float (&q)[64], float (&o)[64], float& mx, float& l) {
    float s = bias;
#pragma unroll
    for (int c = 0; c < 8; ++c) { const u32x4 w = *(const u32x4*)(kp + 8 * c);
#pragma unroll
        for (int e = 0; e < 4; ++e) s += q[8 * c + 2 * e] * bflo(w[e]) + q[8 * c + 2 * e + 1] * bfhi(w[e]); }
    const float mn = fmaxf(mx, s), corr = __builtin_amdgcn_exp2f(mx - mn), p = __builtin_amdgcn_exp2f(s - mn);
    l = l * corr + p; mx = mn;
#pragma unroll
    for (int c = 0; c < 8; ++c) { const u32x4 w = *(const u32x4*)(vp + 8 * c);
#pragma unroll
        for (int e = 0; e < 4; ++e) { o[8 * c + 2 * e] = o[8 * c + 2 * e] * corr + p * bflo(w[e]); o[8 * c + 2 * e + 1] = o[8 * c + 2 * e + 1] * corr + p * bfhi(w[e]); } }
}
__device__ __forceinline__ void attn_simple(const Frame& F, const Args& args) {
    const int gt = F.bid * (NWAVES * 64) + F.tid, GT = F.G * NWAVES * 64;
    constexpr int NQ_C = 32 * NH * SEQ_C, NQ_L = 4 * NH * SEQ_L;
    unsigned char* ws = wsb(args);
    bf16* Q = (bf16*)(ws + WS_Q); const bf16* K = (const bf16*)(ws + WS_K); const bf16* V = (const bf16*)(ws + WS_V);
    const bf16* CK = (const bf16*)(ws + WS_CK); const bf16* CV = (const bf16*)(ws + WS_CV); const float* rpb = inp(args, I_RPB);
    for (int idx = gt; idx < NQ_C + NQ_L; idx += GT) {
        const bool lat = idx >= NQ_C;
        int b, h, t, m;
        if (!lat) { t = idx & 255; h = (idx >> 8) & 15; b = idx >> 12; m = b * SEQ_C + t; }
        else { const int i2 = idx - NQ_C; t = i2 & 1023; h = (i2 >> 10) & 15; b = i2 >> 14; m = NCTX + b * SEQ_L + t; }
        float q[64], o[64]; float mx = -INFINITY, l = 0.f;
        bf16* qp = Q + (size_t)m * D + h * HD;
#pragma unroll
        for (int c = 0; c < 8; ++c) { const u32x4 w = *(const u32x4*)(qp + 8 * c);
#pragma unroll
            for (int e = 0; e < 4; ++e) { q[8 * c + 2 * e] = bflo(w[e]); q[8 * c + 2 * e + 1] = bfhi(w[e]); } }
#pragma unroll
        for (int d = 0; d < 64; ++d) o[d] = 0.f;
        if (!lat) {
            const bf16* kb = K + (size_t)(b * SEQ_C) * D + h * HD; const bf16* vb = V + (size_t)(b * SEQ_C) * D + h * HD;
            for (int j = 0; j < SEQ_C; ++j) attn_key(kb + (size_t)j * D, vb + (size_t)j * D, 0.f, q, o, mx, l);
        } else {
            const int r = t >> 6, c = t & 63;
            const int rs = min(max(r - 4, 0), 8), cs = min(max(c - 8, 0), 48);
            const bf16* kb = K + (size_t)(NCTX + b * SEQ_L) * D + h * HD; const bf16* vb = V + (size_t)(NCTX + b * SEQ_L) * D + h * HD;
            for (int ij = 0; ij < 128; ++ij) { const int i = ij >> 4, j = ij & 15; const int tk = (rs + i) * 64 + cs + j;
                const float bias = rpb[(h * 15 + (rs + i - r + 7)) * 31 + (cs + j - c + 15)] * LOG2E;
                attn_key(kb + (size_t)tk * D, vb + (size_t)tk * D, bias, q, o, mx, l); }
            const bf16* ck = CK + (size_t)(b * PAST) * D + h * HD; const bf16* cv = CV + (size_t)(b * PAST) * D + h * HD;
            for (int j = 0; j < PAST; ++j) attn_key(ck + (size_t)j * D, cv + (size_t)j * D, 0.f, q, o, mx, l);
        }
        const float rl = 1.f / l;
#pragma unroll
        for (int c = 0; c < 8; ++c) { u32x4 w;
#pragma unroll
            for (int e = 0; e < 4; ++e) w[e] = cvt_pk_bf16(o[8 * c + 2 * e] * rl, o[8 * c + 2 * e + 1] * rl);
            *(u32x4*)(qp + 8 * c) = w; }
    }
}

enum Steps { S_P0 = 0, S_P1, S_QKV, S_ATT, S_WO, S_RS1, S_UP0  , S_DN0 = 12, S_RS2, S_IN, S_LNS, S_MIX, S_OUT, S_RS3, S_UP1  , S_DN1 = 25, S_FIN, NSTEPS };

__device__ __forceinline__ void run_step(const Frame& F, const Args& args, int s) {
    unsigned char* ws = wsb(args);
    const float* MOD0 = (const float*)(ws + WS_MOD); const float* MOD1 = MOD0 + 5 * 6144;
    float* SW = (float*)(ws + WS_SW);
    float* RS0 = (float*)(ws + WS_RS); float* RS1 = RS0 + (size_t)MT * 4; float* RS2 = RS0 + (size_t)MT * 8; float* RS3 = RS0 + (size_t)MT * 12;
    bf16* AN = (bf16*)(ws + WS_AN);
    if (s == S_P0) p0_prologue(F, args);
    else if (s == S_P1) {
        p1_rows(F, args);
        p1_sw_stage(F, (const bf16*)(ws + WS_WQKV), NQKV, MOD0 + 0, SW + SW_QKV);
        p1_sw_stage(F, (const bf16*)(ws + WS_WUP), FF2, MOD0 + 3072, SW + SW_UP0);
        p1_sw_stage(F, (const bf16*)(ws + WS_WIN), GE2, MOD1 + 0, SW + SW_IN);
        p1_sw_stage(F, (const bf16*)(ws + WS_WUP) + (size_t)FF2 * D, FF2, MOD1 + 3072, SW + SW_UP1);
    }
    else if (s == S_QKV) { float* out = outb(args);
        EpiQKV E{{RS0, SW + SW_QKV, NQKV}, (bf16*)(ws + WS_Q), (bf16*)(ws + WS_K), (bf16*)(ws + WS_V), out + (size_t)MT * D, out + (size_t)MT * D + (size_t)NCTX * D};
        gemm_simple(F, AN, (const bf16*)(ws + WS_WQKV), 0, MT, NQKV, D, E); }
    else if (s == S_ATT) attn_simple(F, args);
    else if (s == S_WO) { float* X = outb(args);
        EpiRes E{inp(args, I_XP), inp(args, I_XS), X, MOD0 + 2048, AN, inp(args, I_NFFN), MOD0 + 4096};
        gemm_simple(F, (const bf16*)(ws + WS_Q), (const bf16*)(ws + WS_WO), 0, MT, D, D, E); }
    else if (s == S_RS1) pass_rs(F, outb(args), RS1);
    else if (s >= S_UP0 && s < S_DN0) { const int c = (s - S_UP0) >> 1;
        if (((s - S_UP0) & 1) == 0) { EpiUpRaw E{{RS1, SW + SW_UP0, FF2}, (bf16*)(ws + WS_ARAW), c * 4096}; gemm_simple(F, AN, (const bf16*)(ws + WS_WUP), c * 4096, 4096, FF2, D, E); }
        else pass_conv(F, args, 0, c * 4096); }
    else if (s == S_DN0) { float* X = outb(args);
        EpiRes E{X, X + (size_t)NCTX * D, X, MOD0 + 5120, AN, inp(args, I_NMIX) + D, MOD1 + 1024};
        gemm_simple(F, (const bf16*)(ws + WS_M), (const bf16*)(ws + WS_WDN), 0, MT, D, FF, E); }
    else if (s == S_RS2) pass_rs(F, outb(args), RS2);
    else if (s == S_IN) { EpiIn E{{RS2, SW + SW_IN, GE2}, (bf16*)(ws + WS_U), (bf16*)(ws + WS_VV)}; gemm_simple(F, AN, (const bf16*)(ws + WS_WIN), 0, MT, GE2, D, E); }
    else if (s == S_LNS) pass_lnstats(F, (const bf16*)(ws + WS_VV), (float*)(ws + WS_LNP));
    else if (s == S_MIX) pass_mix(F, args);
    else if (s == S_OUT) { float* X = outb(args);
        EpiRes E{X, X + (size_t)NCTX * D, X, MOD1 + 2048, AN, inp(args, I_NFFN) + D, MOD1 + 4096};
        gemm_simple(F, (const bf16*)(ws + WS_U), (const bf16*)(ws + WS_WOUT), 0, MT, D, GE, E); }
    else if (s == S_RS3) pass_rs(F, outb(args), RS3);
    else if (s >= S_UP1 && s < S_DN1) { const int c = (s - S_UP1) >> 1;
        if (((s - S_UP1) & 1) == 0) { EpiUpRaw E{{RS3, SW + SW_UP1, FF2}, (bf16*)(ws + WS_ARAW), c * 4096}; gemm_simple(F, AN, (const bf16*)(ws + WS_WUP) + (size_t)FF2 * D, c * 4096, 4096, FF2, D, E); }
        else pass_conv(F, args, 1, c * 4096); }
    else if (s == S_DN1) { float* X = outb(args);
        EpiRes E{X, X + (size_t)NCTX * D, X, MOD1 + 5120, nullptr, nullptr, nullptr};
        gemm_simple(F, (const bf16*)(ws + WS_M), (const bf16*)(ws + WS_WDN) + (size_t)D * FF, 0, MT, D, FF, E); }
    else if (s == S_FIN) pass_final(F, outb(args), inp(args, I_NFIN));
}

__global__ void __launch_bounds__(NWAVES * 64, 2) mk_fwd(Args args) {
    extern __shared__ __attribute__((aligned(16))) unsigned char lds[];
    Frame F;
    F.lds = (LAS unsigned char*)lds;
    F.MISC = (volatile LAS unsigned*)(F.lds + MISC_OFF);
    F.tid = threadIdx.x; F.lane = F.tid & 63; F.wave = __builtin_amdgcn_readfirstlane(F.tid >> 6);
    F.G = gridDim.x; F.bid = blockIdx.x;
    for (int u = F.tid; u < (LDS_BYTES - LDSCTL_OFF) / 4; u += NWAVES * 64) ((LAS unsigned*)(F.lds + LDSCTL_OFF))[u] = 0u;
    __syncthreads();
    XcdBarrier bar; bar.bar = (unsigned*)(args.ws + WS_CTL) + CW_BAR; bar.x = 0; bar.st = nullptr;
    if (args.hi - args.lo > 1) bar = xcd_barrier_post((unsigned*)(args.ws + WS_CTL) + CW_BAR, F.MISC + 8);
    for (int s = args.lo; s < args.hi; ++s) {
        run_step(F, args, s);
        if (s + 1 < args.hi) xcd_barrier(bar);
    }
}

extern "C" void kernel_launch(void* const* d_in, const int* in_sizes, int n_in, void* d_out, int out_size, void* d_ws, size_t ws_size, hipStream_t stream) {
    static int grid = 0;
    if (grid == 0) {
        if (n_in != 23 || ws_size < WS_END) { fprintf(stderr, "kernel_launch: unexpected n_in %d / ws %zu\n", n_in, ws_size); grid = -1; return; }
        int dev = 0, cus = 0, per_cu = 0;
        if (hipGetDevice(&dev) != hipSuccess || hipDeviceGetAttribute(&cus, hipDeviceAttributeMultiprocessorCount, dev) != hipSuccess) { grid = -1; return; }
        if (hipFuncSetAttribute((const void*)mk_fwd, hipFuncAttributeMaxDynamicSharedMemorySize, LDS_BYTES) != hipSuccess) { fprintf(stderr, "kernel_launch: hipFuncSetAttribute failed\n"); grid = -1; return; }
        if (hipOccupancyMaxActiveBlocksPerMultiprocessor(&per_cu, (const void*)mk_fwd, NWAVES * 64, LDS_BYTES) != hipSuccess || per_cu < 1) { fprintf(stderr, "kernel_launch: occupancy query says %d blocks per CU\n", per_cu); per_cu = 1; }
        (void)hipGetLastError();
        grid = cus;
    }
    if (grid < 0) return;
    if (hipMemsetAsync((char*)d_ws + WS_CTL, 0, CTL_ZERO_BYTES, stream) != hipSuccess) { fprintf(stderr, "kernel_launch: memset failed\n"); return; }
    Args a{};
    for (int i = 0; i < 23; ++i) a.in[i] = (const float*)d_in[i];
    a.out = (float*)d_out; a.ws = (unsigned char*)d_ws;
#if MK_MULTI_LAUNCH
    for (int s = 0; s < NSTEPS; ++s) { a.lo = s; a.hi = s + 1; hipLaunchKernelGGL(mk_fwd, dim3(grid), dim3(NWAVES * 64), LDS_BYTES, stream, a); }
#else
    a.lo = 0; a.hi = NSTEPS;
    hipLaunchKernelGGL(mk_fwd, dim3(grid), dim3(NWAVES * 64), LDS_BYTES, stream, a);
#endif
    const hipError_t le = hipPeekAtLastError();
    if (le != hipSuccess) fprintf(stderr, "kernel_launch: launch failed: %s\n", hipGetErrorName(le));
}
```

```cpp
#include <hip/hip_runtime.h>
#include <cstdio>
#include <cstdint>

#ifndef MK_MULTI_LAUNCH
#define MK_MULTI_LAUNCH 0
#endif

#define GAS __attribute__((address_space(1)))
#define LAS __attribute__((address_space(3)))
typedef unsigned short bf16;
typedef short bf16x8 __attribute__((ext_vector_type(8)));
typedef float f32x4 __attribute__((ext_vector_type(4)));
typedef float f32x2 __attribute__((ext_vector_type(2)));
typedef unsigned u32x4 __attribute__((ext_vector_type(4)));
typedef unsigned u32x2 __attribute__((ext_vector_type(2)));
typedef GAS unsigned gu32;

constexpr int D = 1024, NCTX = 8192, NLAT = 4096, MT = 12288, NH = 16, HD = 64, FF = 2816, FF2 = 5632, GE = 2048, GE2 = 4096, NQKV = 3072;
constexpr int SEQ_C = 256, SEQ_L = 1024, PAST = 512;
constexpr float EPS = 1e-6f, LOG2E = 1.4426950408889634f, C2 = 0.125f * 1.4426950408889634f;
constexpr int NWAVES = 8;

constexpr size_t MiB = 1u << 20;
constexpr size_t WS_CTL = 0, CTL_ZERO_BYTES = 1 * MiB;
constexpr size_t WS_MOD = 512 * 1024;
constexpr size_t WS_SW = 1 * MiB;
constexpr size_t WS_RS = 2 * MiB;
constexpr size_t WS_LNP = 3 * MiB;
constexpr size_t WS_WQKV = 4 * MiB, WS_WO = 10 * MiB, WS_WIN = 12 * MiB, WS_WOUT = 20 * MiB, WS_WUP = 24 * MiB, WS_WDN = 46 * MiB;
constexpr size_t WUP_BYTES = 11 * MiB, WDN_BYTES = (size_t)1024 * 2816 * 2;
constexpr size_t WS_CK = 58 * MiB, WS_CV = 62 * MiB;
constexpr size_t WS_AN = 66 * MiB;
constexpr size_t WS_BIG = 90 * MiB;
constexpr size_t WS_Q = WS_BIG, WS_K = WS_BIG + 24 * MiB, WS_V = WS_BIG + 48 * MiB;
constexpr size_t WS_M = WS_BIG, WS_ARAW = WS_BIG + 66 * MiB;
constexpr size_t WS_U = WS_BIG, WS_VV = WS_BIG + 48 * MiB;
constexpr size_t WS_END = 256 * MiB;
static_assert(WS_ARAW + (size_t)4096 * 5632 * 2 <= WS_END && WS_WDN + 2 * WDN_BYTES <= WS_CK && WS_VV + 48 * MiB <= WS_END, "ws map");
constexpr int SW_QKV = 0, SW_UP0 = 5 * NQKV, SW_IN = SW_UP0 + 5 * FF2, SW_UP1 = SW_IN + 5 * GE2;
constexpr int CW_TMO = 0, CW_CODE = 1, CW_BAR = 4096;

#define RLX_AGENT __ATOMIC_RELAXED, __HIP_MEMORY_SCOPE_AGENT
#define LDS_WAIT() asm volatile("s_waitcnt lgkmcnt(0)" ::: "memory")
#define VM_WAIT() asm volatile("s_waitcnt vmcnt(0)" ::: "memory")
__device__ __forceinline__ unsigned cvt_pk_bf16(float lo, float hi) { unsigned r; asm volatile("v_cvt_pk_bf16_f32 %0, %1, %2" : "=v"(r) : "v"(lo), "v"(hi)); return r; }
__device__ __forceinline__ float bf2f(unsigned short u) { return __uint_as_float((unsigned)u << 16); }
__device__ __forceinline__ float bflo(unsigned w) { return __uint_as_float(w << 16); }
__device__ __forceinline__ float bfhi(unsigned w) { return __uint_as_float(w & 0xffff0000u); }
__device__ __forceinline__ u32x4 pack8(f32x4 a, f32x4 b) { u32x4 w; w.x = cvt_pk_bf16(a[0], a[1]); w.y = cvt_pk_bf16(a[2], a[3]); w.z = cvt_pk_bf16(b[0], b[1]); w.w = cvt_pk_bf16(b[2], b[3]); return w; }
__device__ __forceinline__ float wave_sum(float v) {
#pragma unroll
    for (int o = 1; o < 64; o <<= 1) v += __shfl_xor(v, o);
    return v;
}
__device__ __forceinline__ float silu_f(float x) { return x / (1.f + __builtin_amdgcn_exp2f(-x * LOG2E)); }
__device__ __forceinline__ float gelu_tanh_f(float x) { const float u = 1.5957691216057308f * (x + 0.044715f * x * x * x); return x / (1.f + __builtin_amdgcn_exp2f(-u * LOG2E)); }
__device__ __forceinline__ int ci_of(int row) { return row < NCTX ? 0 : 1 + ((row - NCTX) >> 10); }

#define XB_TMO      128
#define XB_XCNT(j)  (256  + 64 * (j))
#define XB_XSUB(j)  (1280 + 64 * (j))
#define XB_XGEN(j)  (2304 + 64 * (j))
#define XB_TOP      3328
#define XB_TOPGEN   3392
#define XCD_BAR_WORDS 3456
#define XB_SPIN_CAP (1u << 18)
__device__ __forceinline__ unsigned xb_ld(unsigned* p)              { return __hip_atomic_load(p, __ATOMIC_RELAXED, __HIP_MEMORY_SCOPE_AGENT); }
__device__ __forceinline__ unsigned xb_add(unsigned* p, unsigned v) { return __hip_atomic_fetch_add(p, v, __ATOMIC_RELAXED, __HIP_MEMORY_SCOPE_AGENT); }
__device__ __forceinline__ unsigned xb_xcc_id() { return (unsigned)__builtin_amdgcn_s_getreg((3 << 11) | 20) & 0xFu; }
#define XB_SPIN(cond, bar) do { unsigned _sp = 0; while (cond) { __builtin_amdgcn_s_sleep(1); \
    if ((++_sp & 255u) == 0u) { if (xb_ld(&(bar)[XB_TMO])) break; if (_sp > XB_SPIN_CAP) { atomicAdd(&(bar)[XB_TMO], 1u); break; } } } } while (0)
struct XcdBarrier { unsigned* bar; unsigned x; volatile LAS unsigned* st; };
__device__ __forceinline__ XcdBarrier xcd_barrier_post(unsigned* bar, volatile LAS unsigned* st) {
    XcdBarrier b; b.bar = bar; b.x = xb_xcc_id(); b.st = st;
    if (threadIdx.x == 0) (void)xb_add(&bar[XB_XCNT(b.x)], 1u);
    return b;
}
__device__ __forceinline__ void xcd_barrier_complete(unsigned* bar, unsigned x, unsigned& nloc, unsigned& nx) {
    const unsigned G = gridDim.x * gridDim.y * gridDim.z;
    unsigned sum, cnt, mine, sp = 0u;
    for (;;) {
        sum = 0u; cnt = 0u; mine = 0u;
#pragma unroll
        for (unsigned j = 0; j < 16; ++j) { const unsigned c = xb_ld(&bar[XB_XCNT(j)]); sum += c; cnt += (c > 0u) ? 1u : 0u; mine = (j == x) ? c : mine; }
        if (sum == G) break;
        __builtin_amdgcn_s_sleep(1);
        if ((++sp & 255u) == 0u) { if (xb_ld(&bar[XB_TMO])) break; if (sp > XB_SPIN_CAP) { atomicAdd(&bar[XB_TMO], 1u); break; } }
    }
    nloc = mine > 0u ? mine : 1u; nx = cnt > 0u ? cnt : 1u;
}
__device__ __forceinline__ void xcd_barrier(const XcdBarrier& b) {
    asm volatile("s_waitcnt vmcnt(0)" ::: "memory");
    __syncthreads();
    if (threadIdx.x == 0) {
        unsigned* bar = b.bar;
        __builtin_amdgcn_s_waitcnt(0);
        unsigned nloc = b.st[0], nx = b.st[1];
        if (nloc == 0u) { xcd_barrier_complete(bar, b.x, nloc, nx); b.st[0] = nloc; b.st[1] = nx; }
        const unsigned old = xb_add(&bar[XB_XSUB(b.x)], 1u);
        const unsigned gen = old / nloc;
        if (old + 1u == (gen + 1u) * nloc) {
            __builtin_amdgcn_fence(__ATOMIC_RELEASE, "agent");
            asm volatile("s_waitcnt vmcnt(0)" ::: "memory");
            const unsigned og = xb_add(&bar[XB_TOP], 1u);
            const unsigned tg = og / nx;
            if (og + 1u == (tg + 1u) * nx) xb_add(&bar[XB_TOPGEN], 1u);
            else XB_SPIN(xb_ld(&bar[XB_TOPGEN]) == tg, bar);
            __builtin_amdgcn_fence(__ATOMIC_ACQUIRE, "agent");
            xb_add(&bar[XB_XGEN(b.x)], 1u);
            asm volatile("s_waitcnt vmcnt(0)" ::: "memory");
        } else {
            XB_SPIN(xb_ld(&bar[XB_XGEN(b.x)]) == gen, bar);
            __builtin_amdgcn_fence(__ATOMIC_ACQUIRE, "agent");
            asm volatile("s_waitcnt vmcnt(0)" ::: "memory");
        }
    }
    __syncthreads();
}

constexpr int RING_OFF = 0, RING_BYTES = 131072;
constexpr int LDSCTL_OFF = RING_BYTES, MISC_OFF = LDSCTL_OFF + 320;
constexpr int LDS_BYTES = 147456;

struct Frame {
    LAS unsigned char* lds;
    volatile LAS unsigned* MISC;
    int tid, lane, wave, G, bid;
};
struct Args { const float* in[23]; float* out; unsigned char* ws; int lo, hi; };
__device__ __forceinline__ const float* inp(const Args& a, int i) { asm volatile("" : "+s"(i)); return a.in[i]; }
__device__ __forceinline__ unsigned char* wsb(const Args& a) { unsigned char* p = a.ws; asm volatile("" : "+s"(p)); return p; }
__device__ __forceinline__ float* outb(const Args& a) { float* p = a.out; asm volatile("" : "+s"(p)); return p; }
enum InIdx { I_XP = 0, I_XS, I_CK, I_CV, I_C, I_CCTX, I_WADA, I_BADA, I_NMIX, I_NFFN, I_NFIN, I_WQKV, I_WO, I_RPB, I_WIN, I_GV, I_WSP, I_BSP, I_WOUT, I_WUP, I_WCONV, I_BCONV, I_WDN };

__device__ __forceinline__ int upmap(int n) { return n < FF ? ((n >> 7) << 8) + (n & 127) : (((n - FF) >> 7) << 8) + 128 + ((n - FF) & 127); }
__device__ __forceinline__ void p0_transpose_item(const float* W, int K, int N, bf16* WT, bool upperm, LAS float* scr, int item, int lane) {
    const int nblk = N / 32, kb = item / nblk, nb = item % nblk, k0 = 64 * kb, n0 = 32 * nb;
    const int nm0 = upperm ? upmap(n0) : n0;
#pragma unroll 8
    for (int i = 0; i < 32; ++i) { const int kk = 2 * i + (lane >> 5); scr[kk * 33 + (lane & 31)] = W[(size_t)(k0 + kk) * N + n0 + (lane & 31)]; }
    LDS_WAIT(); asm volatile("" ::: "memory");
    const int c = lane & 7;
#pragma unroll
    for (int j = 0; j < 4; ++j) { const int n = (lane >> 3) + 8 * j; const LAS float* s = scr + (8 * c) * 33 + n;
        u32x4 o; o.x = cvt_pk_bf16(s[0 * 33], s[1 * 33]); o.y = cvt_pk_bf16(s[2 * 33], s[3 * 33]); o.z = cvt_pk_bf16(s[4 * 33], s[5 * 33]); o.w = cvt_pk_bf16(s[6 * 33], s[7 * 33]);
        *(u32x4*)(WT + (size_t)(nm0 + n) * K + k0 + 8 * c) = o; }
    LDS_WAIT(); asm volatile("" ::: "memory");
}
__device__ __forceinline__ void p0_adaln_item(const Args& args, int item, int lane) {
    const float* w_ada = inp(args, I_WADA); const float* c_ctx = inp(args, I_CCTX); const float* cc = inp(args, I_C);
    float* MOD = (float*)(wsb(args) + WS_MOD);
    const int jb = item % 24, kc = (item / 24) % 16, l = item / 384;
    const int j = jb * 256 + lane * 4;
    const float* W = w_ada + ((size_t)l * D + (size_t)kc * 64) * 6144 + j;
    f32x4 acc[5];
#pragma unroll
    for (int q = 0; q < 5; ++q) acc[q] = (f32x4){0.f, 0.f, 0.f, 0.f};
    for (int i = 0; i < 64; ++i) {
        const f32x4 w = *(const f32x4*)(W + (size_t)i * 6144);
        const int k = kc * 64 + i;
        acc[0] += silu_f(c_ctx[k]) * w;
#pragma unroll
        for (int b = 0; b < 4; ++b) acc[1 + b] += silu_f(cc[b * D + k]) * w;
    }
    if (kc == 0) { const f32x4 bv = *(const f32x4*)(inp(args, I_BADA) + l * 6144 + j);
#pragma unroll
        for (int q = 0; q < 5; ++q) acc[q] += bv; }
#pragma unroll
    for (int q = 0; q < 5; ++q)
#pragma unroll
        for (int e = 0; e < 4; ++e) atomicAdd(MOD + (size_t)(l * 5 + q) * 6144 + j + e, acc[q][e]);
}
__device__ __forceinline__ void p0_cache_item(const Args& args, int item, int lane) {
    const int which = item >> 11, r = item & 2047, cg = r & 31, h = (r >> 5) & 15, b = r >> 9;
    const float* src = inp(args, which ? I_CV : I_CK); bf16* dst = (bf16*)(wsb(args) + (which ? WS_CV : WS_CK));
    const int c = cg * 16 + (lane >> 2), dq = (lane & 3) * 16;
    const f32x4* s = (const f32x4*)(src + (((size_t)b * NH + h) * PAST + c) * HD + dq);
    const f32x4 a0 = s[0], a1 = s[1], a2 = s[2], a3 = s[3];
    bf16* d = dst + ((size_t)b * PAST + c) * D + h * HD + dq;
    *(u32x4*)d = pack8(a0, a1); *(u32x4*)(d + 8) = pack8(a2, a3);
}
__device__ __forceinline__ void p0_prologue(const Frame& F, const Args& args) {
    LAS float* scr = (LAS float*)(F.lds + RING_OFF + F.wave * 16384);
    const int gw = F.bid * NWAVES + F.wave, NGW = F.G * NWAVES;
    constexpr int N_ADA = 768, N_CACHE = 4096;
    constexpr int N_QKV = (D / 64) * (NQKV / 32), N_O = (D / 64) * (D / 32), N_IN = (D / 64) * (GE2 / 32), N_OUT = (GE / 64) * (D / 32), N_UP = (D / 64) * (FF2 / 32), N_DN = (FF / 64) * (D / 32);
    constexpr int NITEMS = N_ADA + N_CACHE + N_QKV + N_O + N_IN + N_OUT + 2 * N_UP + 2 * N_DN;
    for (int it = gw; it < NITEMS; it += NGW) {
        int r = it;
        if (r < N_ADA) { p0_adaln_item(args, r, F.lane); continue; } r -= N_ADA;
        if (r < N_CACHE) { p0_cache_item(args, r, F.lane); continue; } r -= N_CACHE;
        unsigned char* ws = wsb(args);
        if (r < N_QKV) { p0_transpose_item(inp(args, I_WQKV), D, NQKV, (bf16*)(ws + WS_WQKV), false, scr, r, F.lane); continue; } r -= N_QKV;
        if (r < N_O) { p0_transpose_item(inp(args, I_WO), D, D, (bf16*)(ws + WS_WO), false, scr, r, F.lane); continue; } r -= N_O;
        if (r < N_IN) { p0_transpose_item(inp(args, I_WIN), D, GE2, (bf16*)(ws + WS_WIN), false, scr, r, F.lane); continue; } r -= N_IN;
        if (r < N_OUT) { p0_transpose_item(inp(args, I_WOUT), GE, D, (bf16*)(ws + WS_WOUT), false, scr, r, F.lane); continue; } r -= N_OUT;
        if (r < 2 * N_UP) { const int l = r / N_UP; p0_transpose_item(inp(args, I_WUP) + (size_t)l * D * FF2, D, FF2, (bf16*)(ws + WS_WUP) + (size_t)l * FF2 * D, true, scr, r % N_UP, F.lane); continue; } r -= 2 * N_UP;
        { const int l = r / N_DN; p0_transpose_item(inp(args, I_WDN) + (size_t)l * FF * D, FF, D, (bf16*)(ws + WS_WDN) + (size_t)l * D * FF, false, scr, r % N_DN, F.lane); }
    }
}

__device__ __forceinline__ void p1_rows(const Frame& F, const Args& args) {
    const int gw = F.bid * NWAVES + F.wave, NGW = F.G * NWAVES, lane = F.lane;
    const float* xp = inp(args, I_XP); const float* xs = inp(args, I_XS); const float* gmix = inp(args, I_NMIX);
    unsigned char* ws = wsb(args);
    const float* MOD = (const float*)(ws + WS_MOD); float* RS = (float*)(ws + WS_RS); bf16* AN = (bf16*)(ws + WS_AN);
    for (int m = gw; m < MT; m += NGW) {
        const float* xr = (m < NCTX) ? xp + (size_t)m * D : xs + (size_t)(m - NCTX) * D;
        const int ci = ci_of(m);
        f32x4 v[4]; float s = 0.f;
#pragma unroll
        for (int j = 0; j < 4; ++j) { v[j] = ((const f32x4*)xr)[lane + 64 * j]; s += (v[j].x * v[j].x + v[j].y * v[j].y) + (v[j].z * v[j].z + v[j].w * v[j].w); }
        s = wave_sum(s);
        if (lane == 0) *(f32x4*)(RS + (size_t)m * 4) = (f32x4){s, 0.f, 0.f, 0.f};
        const float* sc = MOD + (size_t)ci * 6144 + 1024;
#pragma unroll
        for (int j = 0; j < 4; ++j) { const int col = 4 * lane + 256 * j;
            const f32x4 g = *(const f32x4*)(gmix + col), cs = *(const f32x4*)(sc + col);
            const f32x4 o = v[j] * g * (1.f + cs);
            u32x2 w; w.x = cvt_pk_bf16(o[0], o[1]); w.y = cvt_pk_bf16(o[2], o[3]);
            *(u32x2*)(AN + (size_t)m * D + col) = w; }
    }
}
__device__ __forceinline__ void p1_sw_stage(const Frame& F, const bf16* WT, int N, const float* shift  , float* out) {
    const int gw = F.bid * NWAVES + F.wave, NGW = F.G * NWAVES, lane = F.lane;
    float sh[5][16];
#pragma unroll
    for (int q = 0; q < 5; ++q)
#pragma unroll
        for (int e = 0; e < 16; ++e) sh[q][e] = shift[(size_t)q * 6144 + lane * 16 + e];
    for (int n = gw; n < N; n += NGW) {
        const u32x4* wp = (const u32x4*)(WT + (size_t)n * D + lane * 16);
        const u32x4 w0 = wp[0], w1 = wp[1];
        float wv[16];
        wv[0] = bflo(w0.x); wv[1] = bfhi(w0.x); wv[2] = bflo(w0.y); wv[3] = bfhi(w0.y); wv[4] = bflo(w0.z); wv[5] = bfhi(w0.z); wv[6] = bflo(w0.w); wv[7] = bfhi(w0.w);
        wv[8] = bflo(w1.x); wv[9] = bfhi(w1.x); wv[10] = bflo(w1.y); wv[11] = bfhi(w1.y); wv[12] = bflo(w1.z); wv[13] = bfhi(w1.z); wv[14] = bflo(w1.w); wv[15] = bfhi(w1.w);
#pragma unroll
        for (int q = 0; q < 5; ++q) { float s = 0.f;
#pragma unroll
            for (int e = 0; e < 16; ++e) s += sh[q][e] * wv[e];
            s = wave_sum(s);
            if (lane == 0) out[(size_t)q * N + n] = s; }
    }
}

namespace pg8 {
#define PG8_LAS __attribute__((address_space(3)))
typedef unsigned short bf16_t;
typedef short bf16x8 __attribute__((ext_vector_type(8)));
typedef float f32x4 __attribute__((ext_vector_type(4)));
typedef unsigned u32x4 __attribute__((ext_vector_type(4)));
constexpr int BM = 256, BK = 64, HALF = 128, HTB = HALF * BK * 2  , STAGE_BYTES = 8 * HTB, NXCD = 8, WGM = 8;

__host__ __device__ __forceinline__ int lds_byte(int r, int c) { const int st = (r >> 4) * 2 + (c >> 5), rr = r & 15, cc = c & 31, ob = rr * 64 + cc * 2; return st * 1024 + (ob ^ (((ob >> 9) & 1) << 5)); }
__host__ __device__ __forceinline__ void stage_rc(int b, int& R, int& C) { const int st = b / 1024, sb = b % 1024, swz = sb ^ (((sb >> 9) & 1) << 5); R = (st >> 1) * 16 + swz / 64; C = (st & 1) * 32 + (swz % 64) / 2; }
__host__ __device__ __forceinline__ int perm32(int rho) { const int n = rho >> 4, i = rho & 15; return 8 * (i >> 2) + 4 * n + (i & 3); }

struct Unit { int pm, pn; };
struct Gemm { const bf16_t* A; const bf16_t* Bt; int M, N, K; };

struct StaticOrder {
    int nM, nN, nwg, G, c;
    __host__ __device__ void init(int M, int N, int G_, int c_) { nM = M / BM; nN = N / BM; nwg = nM * nN; G = G_; c = c_; }
    __host__ __device__ bool next(int i, Unit& u) const {
        const long L = (long)i * G + c; if (L >= nwg) return false;
        int wgid = (int)L; { const int q = nwg / NXCD, r = nwg % NXCD, xcd = wgid % NXCD, off = wgid / NXCD; wgid = (xcd < r ? xcd * (q + 1) : r * (q + 1) + (xcd - r) * q) + off; }
        const int nig = WGM * nN, gid = wgid / nig, fm = gid * WGM, gsz = (nM - fm) < WGM ? (nM - fm) : WGM;
        u.pm = fm + ((wgid % nig) % gsz); u.pn = (wgid % nig) / gsz; return true;
    }
    __device__ __forceinline__ void a_ready(const Unit&) const {}
    __device__ __forceinline__ void done(const Unit&) const {}
};

template <class E> struct EpiAdapt {
    static constexpr bool PERM = true, AFTER_DRAIN = false;
    E e; int row0;
    __device__ __forceinline__ void operator()(const f32x4 (&acc)[2][2][4][2], const Unit& u, int wr, int wc, int fr, int fq) const {
        const int rbase = row0 + u.pm * BM + wr * 64 + fr, cbase = u.pn * BM + wc * 32 + 8 * fq;
#pragma unroll
        for (int ai = 0; ai < 2; ++ai)
#pragma unroll
            for (int m = 0; m < 4; ++m)
#pragma unroll
                for (int bj = 0; bj < 2; ++bj) e.apply(rbase + ai * HALF + m * 16, cbase + bj * HALF, acc[ai][bj][m][0], acc[ai][bj][m][1]);
    }
};
template <class Epi, class Sched, bool ALIGN_EPI = false, bool SP2 = false>
__device__ __forceinline__ void gemm_phase(PG8_LAS unsigned char* lds, const Gemm g, const Sched& S, const Epi& E, const int tid) {
    const int wid = __builtin_amdgcn_readfirstlane(tid >> 6), lane = tid & 63, wr = wid >> 2, wc = wid & 3, fr = lane & 15, fq = lane >> 4;
    const int K = g.K, nt = K / BK;
    unsigned voffA[2], voffB[2];
#pragma unroll
    for (int i = 0; i < 2; ++i) { int R, C; stage_rc(tid * 16 + i * 8192, R, C); const int Rb = Epi::PERM ? ((R & ~31) + perm32(R & 31)) : R;
        voffA[i] = (unsigned)(R * K + C) * 2u; voffB[i] = (unsigned)(Rb * K + C) * 2u; }
    const size_t kstep = (size_t)(BK * 2);
    const size_t hstep = (size_t)HALF * K * 2;
    const size_t tstep = 2 * hstep;
    const unsigned ldsw = (unsigned)wid * 1024u;
    const int aoff = lds_byte(wr * 64 + fr, fq * 8), boff = lds_byte(wc * 32 + fr, fq * 8);
#define PG8_SA(b, h) (((b) * 2 + (h)) * HTB)
#define PG8_SB(b, h) ((4 + (b) * 2 + (h)) * HTB)
#define PG8_STAGE(bufoff, gbase, voff) do { _Pragma("unroll") for (int _i = 0; _i < 2; ++_i) \
        __builtin_amdgcn_global_load_lds((const unsigned*)((const char*)(gbase) + (voff)[_i]), (PG8_LAS unsigned*)(lds + (bufoff) + ldsw + _i * 8192), 16, 0, 0); } while (0)
#define PG8_LDA(dst, b, h) do { _Pragma("unroll") for (int m = 0; m < 4; ++m) _Pragma("unroll") for (int k = 0; k < 2; ++k) dst[m][k] = *(const PG8_LAS bf16x8*)(lds + PG8_SA(b, h) + aoff + m * 2048 + k * 1024); } while (0)
#define PG8_LDB(dst, b, h) do { _Pragma("unroll") for (int n = 0; n < 2; ++n) _Pragma("unroll") for (int k = 0; k < 2; ++k) dst[n][k] = *(const PG8_LAS bf16x8*)(lds + PG8_SB(b, h) + boff + n * 2048 + k * 1024); } while (0)
#define PG8_MMA(ai, bj, At, Bt) do { __builtin_amdgcn_s_setprio(1); _Pragma("unroll") for (int m = 0; m < 4; ++m) _Pragma("unroll") for (int n = 0; n < 2; ++n) _Pragma("unroll") for (int k = 0; k < 2; ++k) \
        acc[ai][bj][m][n] = __builtin_amdgcn_mfma_f32_16x16x32_bf16(Bt[n][k], At[m][k], acc[ai][bj][m][n], 0, 0, 0); __builtin_amdgcn_s_setprio(0); } while (0)
#define PG8_WAIT_V(n) asm volatile("s_waitcnt vmcnt(" #n ")" ::: "memory")
#define PG8_WAIT_L(n) asm volatile("s_waitcnt lgkmcnt(" #n ")" ::: "memory")
#define PG8_BAR __builtin_amdgcn_s_barrier()
#define PG8_SCHED __builtin_amdgcn_sched_barrier(0)
    Unit cur, nxt; int ui = 0;
    if (!S.next(0, cur)) return;
    f32x4 acc[2][2][4][2];
#pragma unroll
    for (int a = 0; a < 2; ++a)
#pragma unroll
        for (int b = 0; b < 2; ++b)
#pragma unroll
            for (int m = 0; m < 4; ++m)
#pragma unroll
                for (int n = 0; n < 2; ++n) acc[a][b][m][n] = (f32x4){0.f, 0.f, 0.f, 0.f};
    bf16x8 At[4][2], B0[2][2], B1[2][2];
    const char* cA = (const char*)g.A + (size_t)cur.pm * tstep; const char* cB = (const char*)g.Bt + (size_t)cur.pn * tstep;
    S.a_ready(cur);
    if constexpr (SP2) {
        PG8_STAGE(PG8_SB(0, 0), cB, voffB); PG8_STAGE(PG8_SB(0, 1), cB + hstep, voffB); PG8_STAGE(PG8_SA(0, 0), cA, voffA); PG8_STAGE(PG8_SA(0, 1), cA + hstep, voffA);
        if (wr == 1) PG8_BAR;
        PG8_WAIT_V(2); PG8_BAR;
        PG8_STAGE(PG8_SB(1, 0), cB + kstep, voffB); PG8_STAGE(PG8_SA(1, 0), cA + kstep, voffA); PG8_STAGE(PG8_SB(1, 1), cB + hstep + kstep, voffB);
        PG8_WAIT_V(6); PG8_BAR;
    } else {
        PG8_STAGE(PG8_SB(0, 0), cB, voffB); PG8_STAGE(PG8_SA(0, 0), cA, voffA); PG8_STAGE(PG8_SB(0, 1), cB + hstep, voffB); PG8_STAGE(PG8_SA(0, 1), cA + hstep, voffA);
        if (wr == 1) PG8_BAR;
        PG8_WAIT_V(4); PG8_BAR;
        PG8_STAGE(PG8_SB(1, 0), cB + kstep, voffB); PG8_STAGE(PG8_SA(1, 0), cA + kstep, voffA); PG8_STAGE(PG8_SB(1, 1), cB + hstep + kstep, voffB);
        PG8_WAIT_V(6); PG8_BAR;
    }
    for (;;) {
        const bool has_next = S.next(ui + 1, nxt);
        const char* nA = has_next ? (const char*)g.A + (size_t)nxt.pm * tstep : cA; const char* nB = has_next ? (const char*)g.Bt + (size_t)nxt.pn * tstep : cB;
        for (int t = 0; t < nt; t += 2) {
            const bool last = (t == nt - 2);
            const char* a1 = cA + (size_t)(t + 1) * kstep;
            const char* a2 = last ? nA : cA + (size_t)(t + 2) * kstep; const char* b2 = last ? nB : cB + (size_t)(t + 2) * kstep;
            const char* a3 = a2 + kstep; const char* b3 = b2 + kstep;
            if (last && has_next) S.a_ready(nxt);
            if constexpr (SP2) {
            PG8_LDB(B0, 0, 0); PG8_LDB(B1, 0, 1); PG8_SCHED; PG8_LDA(At, 0, 0); PG8_STAGE(PG8_SA(1, 1), a1 + hstep, voffA);
            PG8_WAIT_V(8); PG8_WAIT_L(0); PG8_BAR; PG8_MMA(0, 0, At, B0); PG8_MMA(0, 1, At, B1); PG8_BAR; PG8_SCHED;
            PG8_LDA(At, 0, 1); PG8_STAGE(PG8_SB(0, 0), b2, voffB); PG8_STAGE(PG8_SB(0, 1), b2 + hstep, voffB); PG8_STAGE(PG8_SA(0, 0), a2, voffA);
            PG8_WAIT_V(8); PG8_WAIT_L(0); PG8_BAR; PG8_MMA(1, 0, At, B0); PG8_MMA(1, 1, At, B1); PG8_BAR; PG8_SCHED;
            PG8_LDB(B0, 1, 0); PG8_LDB(B1, 1, 1); PG8_SCHED; PG8_LDA(At, 1, 0); PG8_STAGE(PG8_SA(0, 1), a2 + hstep, voffA);
            PG8_WAIT_V(8); PG8_WAIT_L(0); PG8_BAR; PG8_MMA(0, 0, At, B0); PG8_MMA(0, 1, At, B1); PG8_BAR; PG8_SCHED;
            PG8_LDA(At, 1, 1); PG8_STAGE(PG8_SB(1, 0), b3, voffB); PG8_STAGE(PG8_SB(1, 1), b3 + hstep, voffB); PG8_STAGE(PG8_SA(1, 0), a3, voffA);
            PG8_WAIT_V(8); PG8_WAIT_L(0); PG8_BAR; PG8_MMA(1, 0, At, B0); PG8_MMA(1, 1, At, B1); PG8_BAR; PG8_SCHED;
            } else {
            PG8_LDB(B0, 0, 0); PG8_SCHED; PG8_LDA(At, 0, 0); PG8_STAGE(PG8_SA(1, 1), a1 + hstep, voffA);
            PG8_WAIT_L(8); PG8_BAR; PG8_WAIT_L(0); PG8_MMA(0, 0, At, B0); PG8_BAR; PG8_SCHED;
            PG8_LDB(B1, 0, 1); PG8_STAGE(PG8_SB(0, 0), b2, voffB);
            PG8_BAR; PG8_WAIT_L(0); PG8_MMA(0, 1, At, B1); PG8_BAR;
            PG8_LDA(At, 0, 1); PG8_STAGE(PG8_SA(0, 0), a2, voffA);
            PG8_BAR; PG8_WAIT_L(0); PG8_MMA(1, 0, At, B0); PG8_BAR; PG8_SCHED;
            PG8_STAGE(PG8_SB(0, 1), b2 + hstep, voffB);
            PG8_WAIT_V(6); PG8_BAR; PG8_MMA(1, 1, At, B1); PG8_BAR;
            PG8_LDB(B0, 1, 0); PG8_SCHED; PG8_LDA(At, 1, 0); PG8_STAGE(PG8_SA(0, 1), a2 + hstep, voffA);
            PG8_WAIT_L(8); PG8_BAR; PG8_WAIT_L(0); PG8_MMA(0, 0, At, B0); PG8_BAR; PG8_SCHED;
            PG8_LDB(B1, 1, 1); PG8_STAGE(PG8_SB(1, 0), b3, voffB);
            PG8_BAR; PG8_WAIT_L(0); PG8_MMA(0, 1, At, B1); PG8_BAR;
            PG8_LDA(At, 1, 1); PG8_STAGE(PG8_SA(1, 0), a3, voffA);
            PG8_BAR; PG8_WAIT_L(0); PG8_MMA(1, 0, At, B0); PG8_BAR; PG8_SCHED;
            PG8_STAGE(PG8_SB(1, 1), b3 + hstep, voffB);
            PG8_WAIT_V(6); PG8_BAR; PG8_MMA(1, 1, At, B1); PG8_BAR;
            }
        }
        if constexpr (ALIGN_EPI) { if (wr == 0) PG8_BAR; }
        if constexpr (!Epi::AFTER_DRAIN) { E(acc, cur, wr, wc, fr, fq); S.done(cur); }
        if (!has_next) break;
#pragma unroll
        for (int a = 0; a < 2; ++a)
#pragma unroll
            for (int b = 0; b < 2; ++b)
#pragma unroll
                for (int m = 0; m < 4; ++m)
#pragma unroll
                    for (int n = 0; n < 2; ++n) acc[a][b][m][n] = (f32x4){0.f, 0.f, 0.f, 0.f};
        cur = nxt; cA = nA; cB = nB; ++ui;
        if constexpr (ALIGN_EPI) { if (wr == 1) PG8_BAR; }
    }
    PG8_WAIT_V(0);
    if constexpr (!ALIGN_EPI) { if (wr == 0) PG8_BAR; }
    PG8_BAR;
    if constexpr (Epi::AFTER_DRAIN) { E.fused(acc, cur, wr, wc, fr, fq, lds, wid, lane); S.done(cur); }
#undef PG8_SA
#undef PG8_SB
#undef PG8_STAGE
#undef PG8_LDA
#undef PG8_LDB
#undef PG8_MMA
#undef PG8_WAIT_V
#undef PG8_WAIT_L
#undef PG8_BAR
#undef PG8_SCHED
}
}

template <class Epi>
__device__ __forceinline__ void gemm_simple(const Frame& F, const bf16* A, const bf16* Bt, int row0, int Mrows, int N, int K, const Epi& E) {
    const int gw = F.bid * NWAVES + F.wave, NGW = F.G * NWAVES, lane = F.lane, fr = lane & 15, fq = lane >> 4;
    const int tn = N / 64, ntile = (Mrows / 64) * tn;
    for (int t = gw; t < ntile; t += NGW) {
        const int m0 = row0 + (t / tn) * 64, n0 = (t % tn) * 64;
        f32x4 acc[4][4];
#pragma unroll
        for (int i = 0; i < 4; ++i)
#pragma unroll
            for (int j = 0; j < 4; ++j) acc[i][j] = (f32x4){0.f, 0.f, 0.f, 0.f};
        const bf16* ap = A + (size_t)(m0 + fr) * K + fq * 8;
        const bf16* bp = Bt + (size_t)(n0 + 8 * (fr >> 2) + (fr & 3)) * K + fq * 8;
        for (int k0 = 0; k0 < K; k0 += 32) {
            bf16x8 a[4], b[4];
#pragma unroll
            for (int mi = 0; mi < 4; ++mi) a[mi] = *(const bf16x8*)(ap + (size_t)(16 * mi) * K + k0);
#pragma unroll
            for (int nj = 0; nj < 4; ++nj) b[nj] = *(const bf16x8*)(bp + (size_t)(32 * (nj >> 1) + 4 * (nj & 1)) * K + k0);
#pragma unroll
            for (int mi = 0; mi < 4; ++mi)
#pragma unroll
                for (int nj = 0; nj < 4; ++nj) acc[mi][nj] = __builtin_amdgcn_mfma_f32_16x16x32_bf16(b[nj], a[mi], acc[mi][nj], 0, 0, 0);
        }
#pragma unroll
        for (int mi = 0; mi < 4; ++mi)
#pragma unroll
            for (int p = 0; p < 2; ++p) E.apply(m0 + 16 * mi + fr, n0 + 32 * p + 8 * fq, acc[mi][2 * p], acc[mi][2 * p + 1]);
    }
}

template <class Epi>
__device__ __forceinline__ void gemm_pg8(const Frame& F, const bf16* A, const bf16* Bt, int row0, int Mrows, int N, int K, const Epi& E) {
    pg8::Gemm g{A + (size_t)row0 * K, Bt, Mrows, N, K}; pg8::StaticOrder S; S.init(Mrows, N, F.G, F.bid);
    pg8::EpiAdapt<Epi> EA{E, row0};
    pg8::gemm_phase<pg8::EpiAdapt<Epi>, pg8::StaticOrder, true, true>(F.lds + RING_OFF, g, S, EA, F.tid);
}

struct RowLin {
    const float* RS; const float* SW; int N;
    __device__ __forceinline__ void lin(int row, int col, f32x4& v0, f32x4& v1) const {
        const f32x4 p = *(const f32x4*)(RS + (size_t)row * 4);
        const float r = __builtin_amdgcn_rsqf(((p.x + p.y) + (p.z + p.w)) * (1.f / D) + EPS);
        const float* s = SW + (size_t)ci_of(row) * N + col;
        v0 = v0 * r + *(const f32x4*)s; v1 = v1 * r + *(const f32x4*)(s + 4);
    }
};
struct EpiQKV {
    RowLin L; bf16 *Q, *K, *V; float *sk, *sv;
    __device__ __forceinline__ void apply(int row, int col, f32x4 v0, f32x4 v1) const {
        L.lin(row, col, v0, v1);
        const int which = col >> 10, cc = col & 1023;
        if (which == 0) { *(u32x4*)(Q + (size_t)row * D + cc) = pack8(v0 * C2, v1 * C2); }
        else { bf16* dst = which == 1 ? K : V; *(u32x4*)(dst + (size_t)row * D + cc) = pack8(v0, v1);
            if (row < NCTX) { float* st = which == 1 ? sk : sv; const int b = row >> 8, t = row & 255, h = cc >> 6, d = cc & 63;
                float* p = st + (((size_t)b * NH + h) * SEQ_C + t) * HD + d; *(f32x4*)p = v0; *(f32x4*)(p + 4) = v1; } }
    }
};
struct EpiRes {
    const float *base_c, *base_l; float* Xout; const float* gate; bf16* AN; const float* gn; const float* scn;
    __device__ __forceinline__ void apply(int row, int col, f32x4 v0, f32x4 v1) const {
        const int ci = ci_of(row);
        const float* bp = (row < NCTX ? base_c + (size_t)row * D : base_l + (size_t)(row - NCTX) * D) + col;
        const float* gp = gate + (size_t)ci * 6144 + col;
        const f32x4 x0 = *(const f32x4*)bp + *(const f32x4*)gp * v0, x1 = *(const f32x4*)(bp + 4) + *(const f32x4*)(gp + 4) * v1;
        float* xo = Xout + (size_t)row * D + col; *(f32x4*)xo = x0; *(f32x4*)(xo + 4) = x1;
        if (AN) { const float* sp = scn + (size_t)ci * 6144 + col;
            const f32x4 a0 = x0 * *(const f32x4*)(gn + col) * (1.f + *(const f32x4*)sp), a1 = x1 * *(const f32x4*)(gn + col + 4) * (1.f + *(const f32x4*)(sp + 4));
            *(u32x4*)(AN + (size_t)row * D + col) = pack8(a0, a1); }
    }
};
struct EpiUpRaw {
    RowLin L; bf16* A; int row0;
    __device__ __forceinline__ void apply(int row, int col, f32x4 v0, f32x4 v1) const { L.lin(row, col, v0, v1); *(u32x4*)(A + (size_t)(row - row0) * FF2 + col) = pack8(v0, v1); }
};
struct EpiIn {
    RowLin L; bf16 *U, *VV;
    __device__ __forceinline__ void apply(int row, int col, f32x4 v0, f32x4 v1) const {
        L.lin(row, col, v0, v1);
#pragma unroll
        for (int e = 0; e < 4; ++e) { v0[e] = gelu_tanh_f(v0[e]); v1[e] = gelu_tanh_f(v1[e]); }
        bf16* dst = col < GE ? U + (size_t)row * GE + col : VV + (size_t)row * GE + (col - GE);
        *(u32x4*)dst = pack8(v0, v1);
    }
};

__device__ __forceinline__ void pass_rs(const Frame& F, const float* X, float* RSst) {
    const int gw = F.bid * NWAVES + F.wave, NGW = F.G * NWAVES, lane = F.lane;
    for (int m = gw; m < MT; m += NGW) { float s = 0.f;
#pragma unroll
        for (int j = 0; j < 4; ++j) { const f32x4 v = ((const f32x4*)(X + (size_t)m * D))[lane + 64 * j]; s += (v.x * v.x + v.y * v.y) + (v.z * v.z + v.w * v.w); }
        s = wave_sum(s);
        if (lane == 0) *(f32x4*)(RSst + (size_t)m * 4) = (f32x4){s, 0.f, 0.f, 0.f}; }
}
__device__ __forceinline__ void pass_final(const Frame& F, float* X, const float* gfin) {
    const int gw = F.bid * NWAVES + F.wave, NGW = F.G * NWAVES, lane = F.lane;
    for (int m = gw; m < MT; m += NGW) { f32x4 v[4]; float s = 0.f; f32x4* xr = (f32x4*)(X + (size_t)m * D);
#pragma unroll
        for (int j = 0; j < 4; ++j) { v[j] = xr[lane + 64 * j]; s += (v[j].x * v[j].x + v[j].y * v[j].y) + (v[j].z * v[j].z + v[j].w * v[j].w); }
        const float r = __builtin_amdgcn_rsqf(wave_sum(s) * (1.f / D) + EPS);
#pragma unroll
        for (int j = 0; j < 4; ++j) xr[lane + 64 * j] = v[j] * r * ((const f32x4*)gfin)[lane + 64 * j]; }
}
__device__ __forceinline__ void pass_lnstats(const Frame& F, const bf16* VV, float* LNP) {
    const int gw = F.bid * NWAVES + F.wave, NGW = F.G * NWAVES, lane = F.lane;
    for (int m = gw; m < MT; m += NGW) { float s = 0.f, q = 0.f;
#pragma unroll
        for (int j = 0; j < 4; ++j) { const u32x4 w = *(const u32x4*)(VV + (size_t)m * GE + lane * 8 + 512 * j);
#pragma unroll
            for (int e = 0; e < 4; ++e) { const float a = bflo(w[e]), b = bfhi(w[e]); s += a + b; q += a * a + b * b; } }
        s = wave_sum(s); q = wave_sum(q);
        if (lane < 8) *(f32x2*)(LNP + (size_t)m * 16 + lane * 2) = lane == 0 ? (f32x2){s, q} : (f32x2){0.f, 0.f}; }
}
__device__ __forceinline__ void pass_conv(const Frame& F, const Args& args, int l, int row0) {
    const int gt = F.bid * (NWAVES * 64) + F.tid, GT = F.G * NWAVES * 64;
    const float* wc = inp(args, I_WCONV) + (size_t)l * 3 * FF2; const float* bc = inp(args, I_BCONV) + (size_t)l * FF2;
    unsigned char* ws = wsb(args); const bf16* ARAW = (const bf16*)(ws + WS_ARAW); bf16* M = (bf16*)(ws + WS_M);
    for (int idx = gt; idx < 4096 * FF; idx += GT) {
        const int tl = idx / FF, j = idx - tl * FF, row = row0 + tl;
        const int pos = row < NCTX ? (row & (SEQ_C - 1)) : ((row - NCTX) & (SEQ_L - 1)), len = row < NCTX ? SEQ_C : SEQ_L;
        const int gc = ((j >> 7) << 8) + (j & 127), vc = gc + 128;
        const bf16* a = ARAW + (size_t)tl * FF2;
        float g = wc[FF2 + j] * bf2f(a[gc]) + bc[j], v = wc[FF2 + FF + j] * bf2f(a[vc]) + bc[FF + j];
        if (pos > 0) { g += wc[j] * bf2f(a[gc - FF2]); v += wc[FF + j] * bf2f(a[vc - FF2]); }
        if (pos < len - 1) { g += wc[2 * FF2 + j] * bf2f(a[gc + FF2]); v += wc[2 * FF2 + FF + j] * bf2f(a[vc + FF2]); }
        const float o = silu_f(g) * v;
        M[(size_t)row * FF + j] = (bf16)(cvt_pk_bf16(o, 0.f) & 0xffffu);
    }
}
__device__ __forceinline__ void pass_mix(const Frame& F, const Args& args) {
    LAS float* st = (LAS float*)(F.lds + RING_OFF);
    unsigned char* ws = wsb(args); const float* LNP = (const float*)(ws + WS_LNP); const bf16* VV = (const bf16*)(ws + WS_VV); bf16* U = (bf16*)(ws + WS_U);
    const float* wsp = inp(args, I_WSP); const float* bsp = inp(args, I_BSP); const float* gvp = inp(args, I_GV);
    for (int it = F.bid; it < 96 * 4; it += F.G) {
        const int chunk = it >> 2, e = (it & 3) * 512 + F.tid, g = e >> 7;
        __syncthreads();
        if (F.tid < 128) { const float* p = LNP + (size_t)(chunk * 128 + F.tid) * 16; float s = 0.f, q = 0.f;
#pragma unroll
            for (int k = 0; k < 8; ++k) { s += p[2 * k]; q += p[2 * k + 1]; }
            const float mean = s * (1.f / GE), var = q * (1.f / GE) - mean * mean;
            st[2 * F.tid] = mean; st[2 * F.tid + 1] = __builtin_amdgcn_rsqf(var + EPS); }
        __syncthreads();
        float vn[128]; const float gv = gvp[e];
#pragma unroll
        for (int q = 0; q < 128; ++q) vn[q] = (bf2f(VV[(size_t)(chunk * 128 + q) * GE + e]) - st[2 * q]) * st[2 * q + 1] * gv;
        const float* wsg = wsp + (size_t)g * 128 * 128;
        for (int p = 0; p < 128; ++p) { float acc = 0.f;
#pragma unroll
            for (int q = 0; q < 128; ++q) acc += wsg[p * 128 + q] * vn[q];
            bf16* up = U + (size_t)(chunk * 128 + p) * GE + e;
            const float o = bf2f(*up) * (acc + bsp[g * 128 + p]);
            *up = (bf16)(cvt_pk_bf16(o, 0.f) & 0xffffu); }
    }
}

__device__ __forceinline__ void attn_key(const bf16* kp, const bf16* vp, float bias, const float (&q)[64], float (&o)[64], float& mx, float& l) {
    float s = bias;
#pragma unroll
    for (int c = 0; c < 8; ++c) { const u32x4 w = *(const u32x4*)(kp + 8 * c);
#pragma unroll
        for (int e = 0; e < 4; ++e) s += q[8 * c + 2 * e] * bflo(w[e]) + q[8 * c + 2 * e + 1] * bfhi(w[e]); }
    const float mn = fmaxf(mx, s), corr = __builtin_amdgcn_exp2f(mx - mn), p = __builtin_amdgcn_exp2f(s - mn);
    l = l * corr + p; mx = mn;
#pragma unroll
    for (int c = 0; c < 8; ++c) { const u32x4 w = *(const u32x4*)(vp + 8 * c);
#pragma unroll
        for (int e = 0; e < 4; ++e) { o[8 * c + 2 * e] = o[8 * c + 2 * e] * corr + p * bflo(w[e]); o[8 * c + 2 * e + 1] = o[8 * c + 2 * e + 1] * corr + p * bfhi(w[e]); } }
}
__device__ __forceinline__ void attn_simple(const Frame& F, const Args& args) {
    const int gt = F.bid * (NWAVES * 64) + F.tid, GT = F.G * NWAVES * 64;
    constexpr int NQ_C = 32 * NH * SEQ_C, NQ_L = 4 * NH * SEQ_L;
    unsigned char* ws = wsb(args);
    bf16* Q = (bf16*)(ws + WS_Q); const bf16* K = (const bf16*)(ws + WS_K); const bf16* V = (const bf16*)(ws + WS_V);
    const bf16* CK = (const bf16*)(ws + WS_CK); const bf16* CV = (const bf16*)(ws + WS_CV); const float* rpb = inp(args, I_RPB);
    for (int idx = gt; idx < NQ_C + NQ_L; idx += GT) {
        const bool lat = idx >= NQ_C;
        int b, h, t, m;
        if (!lat) { t = idx & 255; h = (idx >> 8) & 15; b = idx >> 12; m = b * SEQ_C + t; }
        else { const int i2 = idx - NQ_C; t = i2 & 1023; h = (i2 >> 10) & 15; b = i2 >> 14; m = NCTX + b * SEQ_L + t; }
        float q[64], o[64]; float mx = -INFINITY, l = 0.f;
        bf16* qp = Q + (size_t)m * D + h * HD;
#pragma unroll
        for (int c = 0; c < 8; ++c) { const u32x4 w = *(const u32x4*)(qp + 8 * c);
#pragma unroll
            for (int e = 0; e < 4; ++e) { q[8 * c + 2 * e] = bflo(w[e]); q[8 * c + 2 * e + 1] = bfhi(w[e]); } }
#pragma unroll
        for (int d = 0; d < 64; ++d) o[d] = 0.f;
        if (!lat) {
            const bf16* kb = K + (size_t)(b * SEQ_C) * D + h * HD; const bf16* vb = V + (size_t)(b * SEQ_C) * D + h * HD;
            for (int j = 0; j < SEQ_C; ++j) attn_key(kb + (size_t)j * D, vb + (size_t)j * D, 0.f, q, o, mx, l);
        } else {
            const int r = t >> 6, c = t & 63;
            const int rs = min(max(r - 4, 0), 8), cs = min(max(c - 8, 0), 48);
            const bf16* kb = K + (size_t)(NCTX + b * SEQ_L) * D + h * HD; const bf16* vb = V + (size_t)(NCTX + b * SEQ_L) * D + h * HD;
            for (int ij = 0; ij < 128; ++ij) { const int i = ij >> 4, j = ij & 15; const int tk = (rs + i) * 64 + cs + j;
                const float bias = rpb[(h * 15 + (rs + i - r + 7)) * 31 + (cs + j - c + 15)] * LOG2E;
                attn_key(kb + (size_t)tk * D, vb + (size_t)tk * D, bias, q, o, mx, l); }
            const bf16* ck = CK + (size_t)(b * PAST) * D + h * HD; const bf16* cv = CV + (size_t)(b * PAST) * D + h * HD;
            for (int j = 0; j < PAST; ++j) attn_key(ck + (size_t)j * D, cv + (size_t)j * D, 0.f, q, o, mx, l);
        }
        const float rl = 1.f / l;
#pragma unroll
        for (int c = 0; c < 8; ++c) { u32x4 w;
#pragma unroll
            for (int e = 0; e < 4; ++e) w[e] = cvt_pk_bf16(o[8 * c + 2 * e] * rl, o[8 * c + 2 * e + 1] * rl);
            *(u32x4*)(qp + 8 * c) = w; }
    }
}

enum Steps { S_P0 = 0, S_P1, S_QKV, S_ATT, S_WO, S_RS1, S_UP0  , S_DN0 = 12, S_RS2, S_IN, S_LNS, S_MIX, S_OUT, S_RS3, S_UP1  , S_DN1 = 25, S_FIN, NSTEPS };

#ifndef GEMM
#define GEMM gemm_pg8
#endif
#ifndef STEPMASK
#define STEPMASK 0xffffffffu
#endif
#define ON(s) ((STEPMASK >> (s)) & 1u)
__device__ __forceinline__ void run_step(const Frame& F0, const Args& args, int s) {
    Frame F = F0; asm volatile("" : "+v"(F.tid)); F.lane = F.tid & 63; F.wave = __builtin_amdgcn_readfirstlane(F.tid >> 6);
    unsigned char* ws = wsb(args);
    const float* MOD0 = (const float*)(ws + WS_MOD); const float* MOD1 = MOD0 + 5 * 6144;
    float* SW = (float*)(ws + WS_SW);
    float* RS0 = (float*)(ws + WS_RS); float* RS1 = RS0 + (size_t)MT * 4; float* RS2 = RS0 + (size_t)MT * 8; float* RS3 = RS0 + (size_t)MT * 12;
    bf16* AN = (bf16*)(ws + WS_AN);
    if (ON(S_P0) && s == S_P0) p0_prologue(F, args);
    else if (ON(S_P1) && s == S_P1) {
        p1_rows(F, args);
        p1_sw_stage(F, (const bf16*)(ws + WS_WQKV), NQKV, MOD0 + 0, SW + SW_QKV);
        p1_sw_stage(F, (const bf16*)(ws + WS_WUP), FF2, MOD0 + 3072, SW + SW_UP0);
        p1_sw_stage(F, (const bf16*)(ws + WS_WIN), GE2, MOD1 + 0, SW + SW_IN);
        p1_sw_stage(F, (const bf16*)(ws + WS_WUP) + (size_t)FF2 * D, FF2, MOD1 + 3072, SW + SW_UP1);
    }
    else if (ON(S_QKV) && s == S_QKV) { float* out = outb(args);
        EpiQKV E{{RS0, SW + SW_QKV, NQKV}, (bf16*)(ws + WS_Q), (bf16*)(ws + WS_K), (bf16*)(ws + WS_V), out + (size_t)MT * D, out + (size_t)MT * D + (size_t)NCTX * D};
        GEMM(F, AN, (const bf16*)(ws + WS_WQKV), 0, MT, NQKV, D, E); }
    else if (ON(S_ATT) && s == S_ATT) attn_simple(F, args);
    else if (ON(S_WO) && s == S_WO) { float* X = outb(args);
        EpiRes E{inp(args, I_XP), inp(args, I_XS), X, MOD0 + 2048, AN, inp(args, I_NFFN), MOD0 + 4096};
        GEMM(F, (const bf16*)(ws + WS_Q), (const bf16*)(ws + WS_WO), 0, MT, D, D, E); }
    else if (ON(S_RS1) && s == S_RS1) pass_rs(F, outb(args), RS1);
    else if (ON(S_UP0) && s >= S_UP0 && s < S_DN0) { const int c = (s - S_UP0) >> 1;
        if (((s - S_UP0) & 1) == 0) { EpiUpRaw E{{RS1, SW + SW_UP0, FF2}, (bf16*)(ws + WS_ARAW), c * 4096}; GEMM(F, AN, (const bf16*)(ws + WS_WUP), c * 4096, 4096, FF2, D, E); }
        else pass_conv(F, args, 0, c * 4096); }
    else if (ON(S_DN0) && s == S_DN0) { float* X = outb(args);
        EpiRes E{X, X + (size_t)NCTX * D, X, MOD0 + 5120, AN, inp(args, I_NMIX) + D, MOD1 + 1024};
        GEMM(F, (const bf16*)(ws + WS_M), (const bf16*)(ws + WS_WDN), 0, MT, D, FF, E); }
    else if (ON(S_RS2) && s == S_RS2) pass_rs(F, outb(args), RS2);
    else if (ON(S_IN) && s == S_IN) { EpiIn E{{RS2, SW + SW_IN, GE2}, (bf16*)(ws + WS_U), (bf16*)(ws + WS_VV)}; GEMM(F, AN, (const bf16*)(ws + WS_WIN), 0, MT, GE2, D, E); }
    else if (ON(S_LNS) && s == S_LNS) pass_lnstats(F, (const bf16*)(ws + WS_VV), (float*)(ws + WS_LNP));
    else if (ON(S_MIX) && s == S_MIX) pass_mix(F, args);
    else if (ON(S_OUT) && s == S_OUT) { float* X = outb(args);
        EpiRes E{X, X + (size_t)NCTX * D, X, MOD1 + 2048, AN, inp(args, I_NFFN) + D, MOD1 + 4096};
        GEMM(F, (const bf16*)(ws + WS_U), (const bf16*)(ws + WS_WOUT), 0, MT, D, GE, E); }
    else if (ON(S_RS3) && s == S_RS3) pass_rs(F, outb(args), RS3);
    else if (ON(S_UP1) && s >= S_UP1 && s < S_DN1) { const int c = (s - S_UP1) >> 1;
        if (((s - S_UP1) & 1) == 0) { EpiUpRaw E{{RS3, SW + SW_UP1, FF2}, (bf16*)(ws + WS_ARAW), c * 4096}; GEMM(F, AN, (const bf16*)(ws + WS_WUP) + (size_t)FF2 * D, c * 4096, 4096, FF2, D, E); }
        else pass_conv(F, args, 1, c * 4096); }
    else if (ON(S_DN1) && s == S_DN1) { float* X = outb(args);
        EpiRes E{X, X + (size_t)NCTX * D, X, MOD1 + 5120, nullptr, nullptr, nullptr};
        GEMM(F, (const bf16*)(ws + WS_M), (const bf16*)(ws + WS_WDN) + (size_t)D * FF, 0, MT, D, FF, E); }
    else if (ON(S_FIN) && s == S_FIN) pass_final(F, outb(args), inp(args, I_NFIN));
}

__global__ void __launch_bounds__(NWAVES * 64, 2) mk_fwd(Args args) {
    extern __shared__ __attribute__((aligned(16))) unsigned char lds[];
    Frame F;
    F.lds = (LAS unsigned char*)lds;
    F.MISC = (volatile LAS unsigned*)(F.lds + MISC_OFF);
    F.tid = threadIdx.x; F.lane = F.tid & 63; F.wave = __builtin_amdgcn_readfirstlane(F.tid >> 6);
    F.G = gridDim.x; F.bid = blockIdx.x;
    for (int u = F.tid; u < (LDS_BYTES - LDSCTL_OFF) / 4; u += NWAVES * 64) ((LAS unsigned*)(F.lds + LDSCTL_OFF))[u] = 0u;
    __syncthreads();
    XcdBarrier bar; bar.bar = (unsigned*)(args.ws + WS_CTL) + CW_BAR; bar.x = 0; bar.st = nullptr;
    if (args.hi - args.lo > 1) bar = xcd_barrier_post((unsigned*)(args.ws + WS_CTL) + CW_BAR, F.MISC + 8);
    for (int s = args.lo; s < args.hi; ++s) {
        run_step(F, args, s);
        if (s + 1 < args.hi) xcd_barrier(bar);
    }
}

extern "C" void kernel_launch(void* const* d_in, const int* in_sizes, int n_in, void* d_out, int out_size, void* d_ws, size_t ws_size, hipStream_t stream) {
    static int grid = 0;
    if (grid == 0) {
        if (n_in != 23 || ws_size < WS_END) { fprintf(stderr, "kernel_launch: unexpected n_in %d / ws %zu\n", n_in, ws_size); grid = -1; return; }
        int dev = 0, cus = 0, per_cu = 0;
        if (hipGetDevice(&dev) != hipSuccess || hipDeviceGetAttribute(&cus, hipDeviceAttributeMultiprocessorCount, dev) != hipSuccess) { grid = -1; return; }
        if (hipFuncSetAttribute((const void*)mk_fwd, hipFuncAttributeMaxDynamicSharedMemorySize, LDS_BYTES) != hipSuccess) { fprintf(stderr, "kernel_launch: hipFuncSetAttribute failed\n"); grid = -1; return; }
        if (hipOccupancyMaxActiveBlocksPerMultiprocessor(&per_cu, (const void*)mk_fwd, NWAVES * 64, LDS_BYTES) != hipSuccess || per_cu < 1) { fprintf(stderr, "kernel_launch: occupancy query says %d blocks per CU\n", per_cu); per_cu = 1; }
        (void)hipGetLastError();
        grid = cus;
    }
    if (grid < 0) return;
    if (hipMemsetAsync((char*)d_ws + WS_CTL, 0, CTL_ZERO_BYTES, stream) != hipSuccess) { fprintf(stderr, "kernel_launch: memset failed\n"); return; }
    Args a{};
    for (int i = 0; i < 23; ++i) a.in[i] = (const float*)d_in[i];
    a.out = (float*)d_out; a.ws = (unsigned char*)d_ws;
#if MK_MULTI_LAUNCH
    for (int s = 0; s < NSTEPS; ++s) { a.lo = s; a.hi = s + 1; hipLaunchKernelGGL(mk_fwd, dim3(grid), dim3(NWAVES * 64), LDS_BYTES, stream, a); }
#else
    a.lo = 0; a.hi = NSTEPS;
    hipLaunchKernelGGL(mk_fwd, dim3(grid), dim3(NWAVES * 64), LDS_BYTES, stream, a);
#endif
    const hipError_t le = hipPeekAtLastError();
    if (le != hipSuccess) fprintf(stderr, "kernel_launch: launch failed: %s\n", hipGetErrorName(le));
}
```

```cpp
#include <hip/hip_runtime.h>
#include <cstdio>
#include <cstdint>
#include <type_traits>


#define GAS __attribute__((address_space(1)))
#define LAS __attribute__((address_space(3)))
typedef unsigned short bf16;
typedef short bf16x8 __attribute__((ext_vector_type(8)));
typedef float f32x4 __attribute__((ext_vector_type(4)));
typedef float f32x2 __attribute__((ext_vector_type(2)));
typedef unsigned u32x4 __attribute__((ext_vector_type(4)));
typedef unsigned u32x2 __attribute__((ext_vector_type(2)));
typedef GAS unsigned gu32;

constexpr int D = 1024, NCTX = 8192, NLAT = 4096, MT = 12288, NH = 16, HD = 64, FF = 2816, FF2 = 5632, GE = 2048, GE2 = 4096, NQKV = 3072;
constexpr int SEQ_C = 256, SEQ_L = 1024, PAST = 512;
constexpr float EPS = 1e-6f, LOG2E = 1.4426950408889634f, C2 = 0.125f * 1.4426950408889634f;
constexpr int NWAVES = 8;

constexpr size_t MiB = 1u << 20;
constexpr size_t WS_CTL = 0, CTL_ZERO_BYTES = 1 * MiB + 512 * 1024;
constexpr size_t WS_MOD = 512 * 1024;
constexpr size_t WS_TS = 800 * 1024;
constexpr size_t WS_SW = 1 * MiB;
constexpr size_t WS_HALO = 1 * MiB + 512 * 1024;
constexpr size_t WS_RS = 3 * MiB;
constexpr size_t WS_LNP = 4 * MiB;
constexpr size_t WS_WQKV = 5 * MiB, WS_WO = 11 * MiB, WS_WIN = 13 * MiB, WS_WOUT = 21 * MiB, WS_WUP = 25 * MiB, WS_WDN = 47 * MiB;
constexpr size_t WUP_BYTES = 11 * MiB, WDN_BYTES = (size_t)1024 * 2816 * 2;
constexpr size_t WS_WSB = 58 * MiB;
constexpr size_t WS_CK = 59 * MiB, WS_CV = 63 * MiB;
constexpr size_t WS_AN = 67 * MiB;
constexpr size_t WS_BIG = 91 * MiB;
constexpr size_t WS_Q = WS_BIG, WS_K = WS_BIG + 24 * MiB, WS_V = WS_BIG + 48 * MiB;
constexpr size_t WS_M = WS_BIG, WS_ARAW = WS_BIG + 66 * MiB;
constexpr size_t WS_U = WS_BIG, WS_VV = WS_BIG + 48 * MiB;
constexpr size_t WS_XB = 200 * MiB;
constexpr size_t WS_KC = 224 * MiB, WS_VC = 240 * MiB;
constexpr size_t WS_END = 256 * MiB;
static_assert(WS_HALO + (size_t)16 * 4 * 5632 * 4 <= WS_RS && WS_SW + 5 * (3072 + 5632 + 4096 + 5632) * 4 <= CTL_ZERO_BYTES, "zeroed region / halo");
static_assert(WS_ARAW + (size_t)4096 * 5632 * 2 <= WS_END && WS_WDN + 2 * WDN_BYTES <= WS_CK && WS_VV + 48 * MiB <= WS_END, "ws map");
constexpr int SW_QKV = 0, SW_UP0 = 5 * NQKV, SW_IN = SW_UP0 + 5 * FF2, SW_UP1 = SW_IN + 5 * GE2;
constexpr int CW_TMO = 0, CW_CODE = 1, CW_BAR = 4096;

#define RLX_AGENT __ATOMIC_RELAXED, __HIP_MEMORY_SCOPE_AGENT
#define LDS_WAIT() asm volatile("s_waitcnt lgkmcnt(0)" ::: "memory")
#define VM_WAIT() asm volatile("s_waitcnt vmcnt(0)" ::: "memory")
__device__ __forceinline__ unsigned cvt_pk_bf16(float lo, float hi) { unsigned r; asm volatile("v_cvt_pk_bf16_f32 %0, %1, %2" : "=v"(r) : "v"(lo), "v"(hi)); return r; }
__device__ __forceinline__ float bf2f(unsigned short u) { return __uint_as_float((unsigned)u << 16); }
__device__ __forceinline__ float bflo(unsigned w) { return __uint_as_float(w << 16); }
__device__ __forceinline__ float bfhi(unsigned w) { return __uint_as_float(w & 0xffff0000u); }
__device__ __forceinline__ u32x4 pack8(f32x4 a, f32x4 b) { u32x4 w; w.x = cvt_pk_bf16(a[0], a[1]); w.y = cvt_pk_bf16(a[2], a[3]); w.z = cvt_pk_bf16(b[0], b[1]); w.w = cvt_pk_bf16(b[2], b[3]); return w; }
__device__ __forceinline__ float wave_sum(float v) {
#pragma unroll
    for (int o = 1; o < 64; o <<= 1) v += __shfl_xor(v, o);
    return v;
}
__device__ __forceinline__ float silu_f(float x) { return x * __builtin_amdgcn_rcpf(1.f + __builtin_amdgcn_exp2f(-x * LOG2E)); }
__device__ __forceinline__ float gelu_tanh_f(float x) { const float u = (-1.5957691216057308f * LOG2E) * (x + 0.044715f * x * x * x); return x * __builtin_amdgcn_rcpf(1.f + __builtin_amdgcn_exp2f(u)); }
__device__ __forceinline__ int ci_of(int row) { return row < NCTX ? 0 : 1 + ((row - NCTX) >> 10); }


__device__ __forceinline__ void st4f_wt(float* p, float v) { __hip_atomic_store((unsigned*)p, __float_as_uint(v), __ATOMIC_RELAXED, __HIP_MEMORY_SCOPE_AGENT); }
__device__ __forceinline__ void wave_publish(unsigned* cnt) {
    asm volatile("s_waitcnt vmcnt(0)" ::: "memory");
    if ((threadIdx.x & 63) == 0) __hip_atomic_fetch_add(cnt, 1u, __ATOMIC_RELAXED, __HIP_MEMORY_SCOPE_AGENT);
}
__device__ __forceinline__ void wave_wait_ge(unsigned* cnt, unsigned need, unsigned* tmo) {
    unsigned sp = 0;
    while ((unsigned)__builtin_amdgcn_readfirstlane(__hip_atomic_load(cnt, __ATOMIC_RELAXED, __HIP_MEMORY_SCOPE_AGENT)) < need) {
        __builtin_amdgcn_s_sleep(2);
        if (++sp > (1u << 22)) { if ((threadIdx.x & 63) == 0) __hip_atomic_store(tmo, 1u, __ATOMIC_RELAXED, __HIP_MEMORY_SCOPE_AGENT); break; } }
}
constexpr int CW_CNT = 16384;
#define XB_TMO      128
#define XB_XCNT(j)  (256  + 64 * (j))
#define XB_XSUB(j)  (1280 + 64 * (j))
#define XB_XGEN(j)  (2304 + 64 * (j))
#define XB_TOP      3328
#define XB_TOPGEN   3392
#define XCD_BAR_WORDS 3456
#define XB_SPIN_CAP (1u << 18)
__device__ __forceinline__ unsigned xb_ld(unsigned* p)              { return __hip_atomic_load(p, __ATOMIC_RELAXED, __HIP_MEMORY_SCOPE_AGENT); }
__device__ __forceinline__ unsigned xb_add(unsigned* p, unsigned v) { return __hip_atomic_fetch_add(p, v, __ATOMIC_RELAXED, __HIP_MEMORY_SCOPE_AGENT); }
__device__ __forceinline__ unsigned xb_xcc_id() { return (unsigned)__builtin_amdgcn_s_getreg((3 << 11) | 20) & 0xFu; }
#define XB_SPIN(cond, bar) do { unsigned _sp = 0; while (cond) { __builtin_amdgcn_s_sleep(1); \
    if ((++_sp & 255u) == 0u) { if (xb_ld(&(bar)[XB_TMO])) break; if (_sp > XB_SPIN_CAP) { atomicAdd(&(bar)[XB_TMO], 1u); break; } } } } while (0)
struct XcdBarrier { unsigned* bar; unsigned x; volatile LAS unsigned* st; };
__device__ __forceinline__ XcdBarrier xcd_barrier_post(unsigned* bar, volatile LAS unsigned* st) {
    XcdBarrier b; b.bar = bar; b.x = xb_xcc_id(); b.st = st;
    if (threadIdx.x == 0) (void)xb_add(&bar[XB_XCNT(b.x)], 1u);
    return b;
}
__device__ __forceinline__ void xcd_barrier_complete(unsigned* bar, unsigned x, unsigned& nloc, unsigned& nx) {
    const unsigned G = gridDim.x * gridDim.y * gridDim.z;
    unsigned sum, cnt, mine, sp = 0u;
    for (;;) {
        sum = 0u; cnt = 0u; mine = 0u;
#pragma unroll
        for (unsigned j = 0; j < 16; ++j) { const unsigned c = xb_ld(&bar[XB_XCNT(j)]); sum += c; cnt += (c > 0u) ? 1u : 0u; mine = (j == x) ? c : mine; }
        if (sum == G) break;
        __builtin_amdgcn_s_sleep(1);
        if ((++sp & 255u) == 0u) { if (xb_ld(&bar[XB_TMO])) break; if (sp > XB_SPIN_CAP) { atomicAdd(&bar[XB_TMO], 1u); break; } }
    }
    nloc = mine > 0u ? mine : 1u; nx = cnt > 0u ? cnt : 1u;
}
__device__ __forceinline__ void xcd_barrier(const XcdBarrier& b) {
    asm volatile("s_waitcnt vmcnt(0)" ::: "memory");
    __syncthreads();
    if (threadIdx.x == 0) {
        unsigned* bar = b.bar;
        __builtin_amdgcn_s_waitcnt(0);
        unsigned nloc = b.st[0], nx = b.st[1];
        if (nloc == 0u) { xcd_barrier_complete(bar, b.x, nloc, nx); b.st[0] = nloc; b.st[1] = nx; }
        const unsigned old = xb_add(&bar[XB_XSUB(b.x)], 1u);
        const unsigned gen = old / nloc;
        if (old + 1u == (gen + 1u) * nloc) {
            __builtin_amdgcn_fence(__ATOMIC_RELEASE, "agent");
            asm volatile("s_waitcnt vmcnt(0)" ::: "memory");
            const unsigned og = xb_add(&bar[XB_TOP], 1u);
            const unsigned tg = og / nx;
            if (og + 1u == (tg + 1u) * nx) xb_add(&bar[XB_TOPGEN], 1u);
            else XB_SPIN(xb_ld(&bar[XB_TOPGEN]) == tg, bar);
            __builtin_amdgcn_fence(__ATOMIC_ACQUIRE, "agent");
            xb_add(&bar[XB_XGEN(b.x)], 1u);
            asm volatile("s_waitcnt vmcnt(0)" ::: "memory");
        } else {
            XB_SPIN(xb_ld(&bar[XB_XGEN(b.x)]) == gen, bar);
            __builtin_amdgcn_fence(__ATOMIC_ACQUIRE, "agent");
            asm volatile("s_waitcnt vmcnt(0)" ::: "memory");
        }
    }
    __syncthreads();
}

constexpr int RING_OFF = 0, RING_BYTES = 131072;
constexpr int LDSCTL_OFF = RING_BYTES, MISC_OFF = LDSCTL_OFF + 320;
constexpr int LDS_BYTES = 147456;

struct Frame {
    LAS unsigned char* lds;
    volatile LAS unsigned* MISC;
    int tid, lane, wave, G, bid;
    bool skip_epi;
    float scale;
};
struct Args { const float* in[23]; float* out; unsigned char* ws; int nseq, pad; unsigned char seq[32]; };
#define ASSUME_GLOBAL(p) __builtin_assume(!__builtin_amdgcn_is_shared((const void*)(p)) && !__builtin_amdgcn_is_private((const void*)(p)))
__device__ __forceinline__ const float* inp(const Args& a, int i) { asm volatile("" : "+s"(i)); const float* p = a.in[i]; return (const float*)(const GAS float*)p; }
__device__ __forceinline__ unsigned char* wsb(const Args& a) { unsigned char* p = a.ws; asm volatile("" : "+s"(p)); return (unsigned char*)(GAS unsigned char*)p; }
__device__ __forceinline__ float* outb(const Args& a) { float* p = a.out; asm volatile("" : "+s"(p)); return (float*)(GAS float*)p; }
enum InIdx { I_XP = 0, I_XS, I_CK, I_CV, I_C, I_CCTX, I_WADA, I_BADA, I_NMIX, I_NFFN, I_NFIN, I_WQKV, I_WO, I_RPB, I_WIN, I_GV, I_WSP, I_BSP, I_WOUT, I_WUP, I_WCONV, I_BCONV, I_WDN };


#define G_LD4(p)   (*(const GAS f32x4*)(p))
#define G_LDU4(p)  (*(const GAS u32x4*)(p))
#define G_ST4(p,v) (*(GAS f32x4*)(p) = (v))
#define G_STU4(p,v) (*(GAS u32x4*)(p) = (v))

__device__ __forceinline__ int upmap(int n) { return n < FF ? ((n >> 7) << 8) + (n & 127) : (((n - FF) >> 7) << 8) + 128 + ((n - FF) & 127); }
constexpr int ADA_UNITS = 2 * 24 * 4;
__device__ __forceinline__ void p0_adaln_unit(const Frame& F, const Args& args, int u) {
    const float* w_ada = inp(args, I_WADA); const float* c_ctx = inp(args, I_CCTX); const float* cc = inp(args, I_C);
    float* MOD = (float*)(wsb(args) + WS_MOD);
    const int jb = u % 24, kq = (u / 24) & 3, l = u / 96;
    const int k0 = kq * 256 + F.wave * 32;
    const float* W = w_ada + ((size_t)l * D + k0) * 6144 + jb * 256 + F.lane * 4;
    f32x4 acc[5];
#pragma unroll
    for (int q = 0; q < 5; ++q) acc[q] = (f32x4){0.f, 0.f, 0.f, 0.f};
    for (int i0 = 0; i0 < 32; i0 += 16) {
        f32x4 w[16];
#pragma unroll
        for (int i = 0; i < 16; ++i) w[i] = G_LD4(W + (size_t)(i0 + i) * 6144);
#pragma unroll
        for (int i = 0; i < 16; ++i) { const int k = k0 + i0 + i;
            acc[0] += silu_f(c_ctx[k]) * w[i];
#pragma unroll
            for (int b = 0; b < 4; ++b) acc[1 + b] += silu_f(cc[b * D + k]) * w[i]; }
    }
    LAS f32x4* red = (LAS f32x4*)(F.lds + RING_OFF);
#pragma unroll
    for (int q = 0; q < 5; ++q) red[(F.wave * 5 + q) * 64 + F.lane] = acc[q];
    __syncthreads();
    const LAS float* redf = (const LAS float*)red;
    for (int o = F.tid; o < 5 * 256; o += NWAVES * 64) { const int q = o >> 8, c = o & 255;
        float s = 0.f;
#pragma unroll
        for (int w = 0; w < NWAVES; ++w) s += redf[(w * 5 + q) * 256 + c];
        if (kq == 0) s += inp(args, I_BADA)[l * 6144 + jb * 256 + c];
        atomicAdd(MOD + (size_t)(l * 5 + q) * 6144 + jb * 256 + c, s * F.scale); }
    __syncthreads();
}
constexpr int PI_QKV = (D / 64) * (NQKV / 32), PI_FIRST = PI_QKV;
constexpr int PI_CACHE = 4096, PI_WSP = 512, PI_O = (D / 64) * (D / 32), PI_IN = (D / 64) * (GE2 / 32), PI_OUT = (GE / 64) * (D / 32), PI_UP = (D / 64) * (FF2 / 32), PI_DN = (FF / 64) * (D / 32);
constexpr int PI_SECOND = PI_FIRST + PI_CACHE + PI_WSP + PI_O + PI_UP + PI_DN, PI_ALL = PI_SECOND + PI_UP + PI_DN + PI_IN + PI_OUT;
__device__ __forceinline__ void p0_transpose_seg(const float* W, int K, int N, bf16* WT, bool upperm, LAS float* scr, int it, int end, int stride, int lane) {
    if (it >= end) return;
    const int nblk = N / 32;
    f32x4 v[8];
    { const int k0 = 64 * (it / nblk), n0 = 32 * (it % nblk);
#pragma unroll
      for (int i = 0; i < 8; ++i) v[i] = G_LD4(W + (size_t)(k0 + 8 * i + (lane >> 3)) * N + n0 + 4 * (lane & 7)); }
    for (; it < end; it += stride) {
        const int k0 = 64 * (it / nblk), n0 = 32 * (it % nblk), nm0 = upperm ? upmap(n0) : n0;
#pragma unroll
        for (int i = 0; i < 8; ++i) { LAS float* d = scr + (8 * i + (lane >> 3)) * 33 + 4 * (lane & 7); d[0] = v[i].x; d[1] = v[i].y; d[2] = v[i].z; d[3] = v[i].w; }
        const int itn = it + stride;
        if (itn < end) { const int k1 = 64 * (itn / nblk), n1 = 32 * (itn % nblk);
#pragma unroll
            for (int i = 0; i < 8; ++i) v[i] = G_LD4(W + (size_t)(k1 + 8 * i + (lane >> 3)) * N + n1 + 4 * (lane & 7)); }
        LDS_WAIT(); asm volatile("" ::: "memory");
        const int c = lane & 7;
#pragma unroll
        for (int j = 0; j < 4; ++j) { const int n = (lane >> 3) + 8 * j; const LAS float* s = scr + (8 * c) * 33 + n;
            u32x4 o; o.x = cvt_pk_bf16(s[0 * 33], s[1 * 33]); o.y = cvt_pk_bf16(s[2 * 33], s[3 * 33]); o.z = cvt_pk_bf16(s[4 * 33], s[5 * 33]); o.w = cvt_pk_bf16(s[6 * 33], s[7 * 33]);
            G_STU4(WT + (size_t)(nm0 + n) * K + k0 + 8 * c, o); }
        LDS_WAIT(); asm volatile("" ::: "memory");
    }
}
__device__ __forceinline__ void p0_cache_seg(const Args& args, int it, int end, int stride, int lane) {
    if (it >= end) return;
    f32x4 a[4];
    { const int which = it >> 11, r = it & 2047, cg = r & 31, h = (r >> 5) & 15, b = r >> 9;
      const float* s = inp(args, which ? I_CV : I_CK) + (((size_t)b * NH + h) * PAST + cg * 16 + (lane >> 2)) * HD + (lane & 3) * 16;
#pragma unroll
      for (int i = 0; i < 4; ++i) a[i] = G_LD4(s + 4 * i); }
    for (; it < end; it += stride) {
        const int which = it >> 11, r = it & 2047, cg = r & 31, h = (r >> 5) & 15, b = r >> 9;
        bf16* d = (bf16*)(wsb(args) + (which ? WS_CV : WS_CK)) + ((size_t)b * PAST + cg * 16 + (lane >> 2)) * D + h * HD + (lane & 3) * 16;
        const u32x4 o0 = pack8(a[0], a[1]), o1 = pack8(a[2], a[3]);
        const int itn = it + stride;
        if (itn < end) { const int w1 = itn >> 11, r1 = itn & 2047, cg1 = r1 & 31, h1 = (r1 >> 5) & 15, b1 = r1 >> 9;
            const float* s = inp(args, w1 ? I_CV : I_CK) + (((size_t)b1 * NH + h1) * PAST + cg1 * 16 + (lane >> 2)) * HD + (lane & 3) * 16;
#pragma unroll
            for (int i = 0; i < 4; ++i) a[i] = G_LD4(s + 4 * i); }
        G_STU4(d, o0); G_STU4(d + 8, o1);
    }
}
__device__ __forceinline__ int first_from(int start, int stride, int s0) { return start >= s0 ? start : start + (s0 - start + stride - 1) / stride * stride; }
__device__ __forceinline__ void p0_items(const Frame& F, const Args& args, int lo, int hi, int fw, int nfw) {
    LAS float* scr = (LAS float*)(F.lds + RING_OFF + F.wave * 16384);
    unsigned char* ws = wsb(args);
    int base = 0;
#define P0_SEG(n, s0v, itv, endv) const int s0v = base; base += (n); const int endv = (hi < base ? hi : base) - s0v, itv = first_from(lo + fw, nfw, s0v) - s0v;
    { P0_SEG(PI_QKV, s0, it, end) p0_transpose_seg(inp(args, I_WQKV), D, NQKV, (bf16*)(ws + WS_WQKV), false, scr, it, end, nfw, F.lane); }
    if (hi <= base) return;
    { P0_SEG(PI_CACHE, s0, it, end) p0_cache_seg(args, it, end, nfw, F.lane); }
    { P0_SEG(PI_WSP, s0, it, end) for (int r = it; r < end; r += nfw) { const float* s = inp(args, I_WSP) + (size_t)r * 512 + F.lane * 8; const f32x4 a0 = *(const f32x4*)s, a1 = *(const f32x4*)(s + 4); *(u32x4*)((bf16*)(ws + WS_WSB) + (size_t)r * 512 + F.lane * 8) = pack8(a0, a1); } }
    { P0_SEG(PI_O, s0, it, end) p0_transpose_seg(inp(args, I_WO), D, D, (bf16*)(ws + WS_WO), false, scr, it, end, nfw, F.lane); }
    { P0_SEG(PI_UP, s0, it, end) p0_transpose_seg(inp(args, I_WUP), D, FF2, (bf16*)(ws + WS_WUP), true, scr, it, end, nfw, F.lane); }
    { P0_SEG(PI_DN, s0, it, end) p0_transpose_seg(inp(args, I_WDN), FF, D, (bf16*)(ws + WS_WDN), false, scr, it, end, nfw, F.lane); }
    if (hi <= base) return;
    { P0_SEG(PI_UP, s0, it, end) p0_transpose_seg(inp(args, I_WUP) + (size_t)D * FF2, D, FF2, (bf16*)(ws + WS_WUP) + (size_t)FF2 * D, true, scr, it, end, nfw, F.lane); }
    { P0_SEG(PI_DN, s0, it, end) p0_transpose_seg(inp(args, I_WDN) + (size_t)FF * D, FF, D, (bf16*)(ws + WS_WDN) + (size_t)D * FF, false, scr, it, end, nfw, F.lane); }
    { P0_SEG(PI_IN, s0, it, end) p0_transpose_seg(inp(args, I_WIN), D, GE2, (bf16*)(ws + WS_WIN), false, scr, it, end, nfw, F.lane); }
    { P0_SEG(PI_OUT, s0, it, end) p0_transpose_seg(inp(args, I_WOUT), GE, D, (bf16*)(ws + WS_WOUT), false, scr, it, end, nfw, F.lane); }
#undef P0_SEG
}
constexpr int ST_ITEMS = 2 * 32 * NH * (SEQ_C / 16);
__device__ __forceinline__ void state_items(const Frame& F, const Args& args, int fw, int nfw) {
    unsigned char* ws = wsb(args); float* out = outb(args);
    for (int it = fw; it < ST_ITEMS; it += nfw) {
        const int tg = it & 15, h = (it >> 4) & 15, b = (it >> 8) & 31, which = it >> 13;
        const bf16* src = (const bf16*)(ws + (which ? WS_VC : WS_KC)) + (size_t)(b * SEQ_C + tg * 16 + (F.lane >> 2)) * D + h * HD + (F.lane & 3) * 16;
        const u32x4 w0 = G_LDU4(src), w1 = G_LDU4(src + 8);
        float* dst = out + (size_t)MT * D + (size_t)which * NCTX * D + (((size_t)b * NH + h) * SEQ_C + tg * 16 + (F.lane >> 2)) * HD + (F.lane & 3) * 16;
        f32x4 o0, o1, o2, o3;
        o0.x = bflo(w0.x); o0.y = bfhi(w0.x); o0.z = bflo(w0.y); o0.w = bfhi(w0.y); o1.x = bflo(w0.z); o1.y = bfhi(w0.z); o1.z = bflo(w0.w); o1.w = bfhi(w0.w);
        o2.x = bflo(w1.x); o2.y = bfhi(w1.x); o2.z = bflo(w1.y); o2.w = bfhi(w1.y); o3.x = bflo(w1.z); o3.y = bfhi(w1.z); o3.z = bflo(w1.w); o3.w = bfhi(w1.w);
        G_ST4(dst, o0); G_ST4(dst + 4, o1); G_ST4(dst + 8, o2); G_ST4(dst + 12, o3);
    }
}
__device__ __forceinline__ bool filler_slot(const Frame& F, int nunits, int& fw, int& nfw) {
    const int rem = nunits % F.G, first = rem, nblk = F.G - rem;
    if (F.bid < first) return false;
    fw = (F.bid - first) * NWAVES + F.wave; nfw = nblk * NWAVES; return true;
}

constexpr int SWI_QKV_C = NQKV / 16;
__device__ __forceinline__ void p1_rows(const Frame& F, const Args& args) {
    const int gw = F.bid * NWAVES + F.wave, NGW = F.G * NWAVES, lane = F.lane;
    const float* xp = inp(args, I_XP); const float* xs = inp(args, I_XS); const float* gmix = inp(args, I_NMIX);
    unsigned char* ws = wsb(args);
    const float* MOD = (const float*)(ws + WS_MOD); float* RS = (float*)(ws + WS_RS); bf16* AN = (bf16*)(ws + WS_AN);
    const int nshort = NGW > 2 * SWI_QKV_C ? SWI_QKV_C : 0; const bool busy = gw < nshort;
    int m = busy ? gw : 3 * nshort + (gw - nshort); const int mstep = busy ? nshort : NGW - nshort, mend = busy ? 3 * nshort : MT;
    f32x4 g[4], v[4];
#pragma unroll
    for (int j = 0; j < 4; ++j) g[j] = G_LD4(gmix + 4 * lane + 256 * j);
    if (m < mend) { const float* xr = (m < NCTX) ? xp + (size_t)m * D : xs + (size_t)(m - NCTX) * D;
#pragma unroll
        for (int j = 0; j < 4; ++j) v[j] = G_LD4((const f32x4*)xr + lane + 64 * j); }
    for (; m < mend; m += mstep) {
        const float* sc = MOD + (size_t)ci_of(m) * 6144 + 1024;
        f32x4 cs[4], vn[4];
#pragma unroll
        for (int j = 0; j < 4; ++j) cs[j] = G_LD4(sc + 4 * lane + 256 * j);
        const int mn = m + mstep;
        if (mn < mend) { const float* xr = (mn < NCTX) ? xp + (size_t)mn * D : xs + (size_t)(mn - NCTX) * D;
#pragma unroll
            for (int j = 0; j < 4; ++j) vn[j] = G_LD4((const f32x4*)xr + lane + 64 * j); }
        float s = 0.f;
#pragma unroll
        for (int j = 0; j < 4; ++j) s += (v[j].x * v[j].x + v[j].y * v[j].y) + (v[j].z * v[j].z + v[j].w * v[j].w);
        s = wave_sum(s);
        if (lane == 0) G_ST4(RS + (size_t)m * 4, ((f32x4){s, 0.f, 0.f, 0.f}));
#pragma unroll
        for (int j = 0; j < 4; ++j) { const int col = 4 * lane + 256 * j;
            const f32x4 o = v[j] * g[j] * (1.f + cs[j]);
            u32x2 w; w.x = cvt_pk_bf16(o[0], o[1]); w.y = cvt_pk_bf16(o[2], o[3]);
            *(GAS u32x2*)(AN + (size_t)m * D + col) = w; }
#pragma unroll
        for (int j = 0; j < 4; ++j) v[j] = vn[j];
    }
}
namespace pg8 {
#define PG8_LAS __attribute__((address_space(3)))
typedef unsigned short bf16_t;
typedef short bf16x8 __attribute__((ext_vector_type(8)));
typedef float f32x4 __attribute__((ext_vector_type(4)));
typedef unsigned u32x4 __attribute__((ext_vector_type(4)));
constexpr int BM = 256, BK = 64, HALF = 128, HTB = HALF * BK * 2  , STAGE_BYTES = 8 * HTB, NXCD = 8, WGM = 8;

__host__ __device__ __forceinline__ int lds_byte(int r, int c) { const int st = (r >> 4) * 2 + (c >> 5), rr = r & 15, cc = c & 31, ob = rr * 64 + cc * 2; return st * 1024 + (ob ^ (((ob >> 9) & 1) << 5)); }
__host__ __device__ __forceinline__ void stage_rc(int b, int& R, int& C) { const int st = b / 1024, sb = b % 1024, swz = sb ^ (((sb >> 9) & 1) << 5); R = (st >> 1) * 16 + swz / 64; C = (st & 1) * 32 + (swz % 64) / 2; }
__host__ __device__ __forceinline__ int perm32(int rho) { const int n = rho >> 4, i = rho & 15; return 8 * (i >> 2) + 4 * n + (i & 3); }

struct Unit { int pm, pn; };
struct Gemm { const bf16_t* A; const bf16_t* Bt; int M, N, K; };

struct StaticOrder {
    int nM, nN, nwg, G, c;
    __host__ __device__ void init(int M, int N, int G_, int c_, int bmr = BM) { nM = M / bmr; nN = N / BM; nwg = nM * nN; G = G_; c = c_; }
    __host__ __device__ bool next(int i, Unit& u) const {
        const long L = (long)i * G + c; if (L >= nwg) return false;
        int wgid = (int)L; { const int q = nwg / NXCD, r = nwg % NXCD, xcd = wgid % NXCD, off = wgid / NXCD; wgid = (xcd < r ? xcd * (q + 1) : r * (q + 1) + (xcd - r) * q) + off; }
        const int nig = WGM * nN, gid = wgid / nig, fm = gid * WGM, gsz = (nM - fm) < WGM ? (nM - fm) : WGM;
        u.pm = fm + ((wgid % nig) % gsz); u.pn = (wgid % nig) / gsz; return true;
    }
    __device__ __forceinline__ void a_ready(const Unit&) const {}
    __device__ __forceinline__ void done(const Unit&) const {}
};

template <class E> struct epi_is_final { static constexpr bool value = false; };
template <class E, int NRED, int MB = 4> struct EpiAdapt {
    static constexpr bool PERM = true, AFTER_DRAIN = false; static constexpr int BMR = 64 * MB;
    __device__ __forceinline__ void fused(f32x4 (&acc)[2][2][MB][2], const Unit& u, int wr, int wc, int fr, int fq, PG8_LAS unsigned char*, int, int) const { (*this)(acc, u, wr, wc, fr, fq); }
    E e; int row0; PG8_LAS float* P; bool skip;
    __device__ __forceinline__ void operator()(f32x4 (&acc)[2][2][MB][2], const Unit& u, int wr, int wc, int fr, int fq) const {
        if (skip) return;
        asm volatile("" : "+v"(fr), "+v"(fq));
        const int rl = wr * 16 * MB + fr, rbase = row0 + u.pm * BMR + rl, cbase = u.pn * BM + wc * 32 + 8 * fq;
        float red[2][MB][NRED > 0 ? NRED : 1];
#pragma unroll
        for (int ai = 0; ai < 2; ++ai)
#pragma unroll
            for (int m = 0; m < MB; ++m)
#pragma unroll
                for (int k = 0; k < (NRED > 0 ? NRED : 1); ++k) red[ai][m][k] = 0.f;
        if constexpr (E::HAS_LIN) {
            static_assert(MB == 4, "HAS_LIN epilogues run on 256-row tiles");
            f32x4 p[2][MB], sw[2][2];
#pragma unroll
            for (int ai = 0; ai < 2; ++ai)
#pragma unroll
                for (int m = 0; m < MB; ++m) p[ai][m] = G_LD4(e.L.RS + (size_t)(rbase + ai * (BMR / 2) + m * 16) * 4);
            { const float* s = e.L.SW + (size_t)ci_of(row0 + u.pm * BMR) * e.L.N + cbase;
#pragma unroll
              for (int bj = 0; bj < 2; ++bj) { sw[bj][0] = G_LD4(s + bj * HALF); sw[bj][1] = G_LD4(s + bj * HALF + 4); } }
            __builtin_amdgcn_sched_barrier(0);
#pragma unroll
            for (int ai = 0; ai < 2; ++ai)
#pragma unroll
                for (int m = 0; m < MB; ++m) { const f32x4 q = p[ai][m];
                    const float r = __builtin_amdgcn_rsqf(((q.x + q.y) + (q.z + q.w)) * (1.f / D) + EPS);
#pragma unroll
                    for (int bj = 0; bj < 2; ++bj) e.post(rbase + ai * (BMR / 2) + m * 16, cbase + bj * HALF, acc[ai][bj][m][0] * r + sw[bj][0], acc[ai][bj][m][1] * r + sw[bj][1], red[ai][m]); }
        } else if constexpr (E::HAS_PRE) {
            PG8_LAS float* ST = P + 2048;
            const int ci_lo = ci_of(row0 + u.pm * BMR), ci_hi = ci_of(row0 + u.pm * BMR + BMR - 1);
            { const int t = (wr * 4 + wc) * 64 + fq * 16 + fr;
              float sv[2];
#pragma unroll
              for (int k = 0; k < 2; ++k) { const int idx = t + 512 * k; sv[k] = e.stage_val(idx >> 9, ((idx >> 8) & 1) ? ci_hi : ci_lo, u.pn * BM + (idx & 255)); }
#pragma unroll
              for (int k = 0; k < 2; ++k) ST[t + 512 * k] = sv[k]; }
#define PG8_STP(row, col) (ST + (ci_of(row) != ci_lo ? 256 : 0) + ((col) - u.pn * BM))
            if constexpr (E::PRE_HALVES) {
#pragma unroll
                for (int ai = 0; ai < 2; ++ai) {
                    typename E::Pre pre[MB][2];
#pragma unroll
                    for (int m = 0; m < MB; ++m)
#pragma unroll
                        for (int bj = 0; bj < 2; ++bj) pre[m][bj] = e.prefetch(rbase + ai * (BMR / 2) + m * 16, cbase + bj * HALF);
                    __builtin_amdgcn_sched_barrier(0);
                    if (ai == 0) { asm volatile("s_waitcnt lgkmcnt(0)" ::: "memory"); __builtin_amdgcn_s_barrier(); asm volatile("" ::: "memory"); }
#pragma unroll
                    for (int m = 0; m < MB; ++m)
#pragma unroll
                        for (int bj = 0; bj < 2; ++bj) e.apply_pre(rbase + ai * (BMR / 2) + m * 16, cbase + bj * HALF, acc[ai][bj][m][0], acc[ai][bj][m][1], red[ai][m], pre[m][bj], PG8_STP(rbase + ai * (BMR / 2) + m * 16, cbase + bj * HALF));
                    __builtin_amdgcn_sched_barrier(0); }
            } else {
            typename E::Pre pre[2][MB][2];
#pragma unroll
            for (int ai = 0; ai < 2; ++ai)
#pragma unroll
                for (int m = 0; m < MB; ++m)
#pragma unroll
                    for (int bj = 0; bj < 2; ++bj) pre[ai][m][bj] = e.prefetch(rbase + ai * (BMR / 2) + m * 16, cbase + bj * HALF);
            __builtin_amdgcn_sched_barrier(0);
            asm volatile("s_waitcnt lgkmcnt(0)" ::: "memory"); __builtin_amdgcn_s_barrier(); asm volatile("" ::: "memory");
#pragma unroll
            for (int ai = 0; ai < 2; ++ai)
#pragma unroll
                for (int m = 0; m < MB; ++m)
#pragma unroll
                    for (int bj = 0; bj < 2; ++bj) e.apply_pre(rbase + ai * (BMR / 2) + m * 16, cbase + bj * HALF, acc[ai][bj][m][0], acc[ai][bj][m][1], red[ai][m], pre[ai][m][bj], PG8_STP(rbase + ai * (BMR / 2) + m * 16, cbase + bj * HALF));
            }
        } else {
#pragma unroll
        for (int ai = 0; ai < 2; ++ai)
#pragma unroll
            for (int m = 0; m < MB; ++m)
#pragma unroll
                for (int bj = 0; bj < 2; ++bj) e.apply(rbase + ai * (BMR / 2) + m * 16, cbase + bj * HALF, acc[ai][bj][m][0], acc[ai][bj][m][1], red[ai][m]);
        }
        if constexpr (NRED > 0) {
            if (e.want_red(u.pn)) {
#pragma unroll
                for (int ai = 0; ai < 2; ++ai)
#pragma unroll
                    for (int m = 0; m < MB; ++m)
#pragma unroll
                        for (int k = 0; k < NRED; ++k) { float s = red[ai][m][k]; s += __shfl_xor(s, 16); s += __shfl_xor(s, 32); if (fq == 0) P[((ai * (BMR / 2) + rl + m * 16) * 4 + wc) * 2 + k] = s; }
                asm volatile("s_waitcnt lgkmcnt(0)" ::: "memory"); __builtin_amdgcn_s_barrier(); asm volatile("" ::: "memory");
                const int t = (wr * 4 + wc) * 64 + fq * 16 + fr;
                if (t < BMR) { float r[NRED];
#pragma unroll
                    for (int k = 0; k < NRED; ++k) r[k] = (P[(t * 4 + 0) * 2 + k] + P[(t * 4 + 1) * 2 + k]) + (P[(t * 4 + 2) * 2 + k] + P[(t * 4 + 3) * 2 + k]);
                    e.store_red(row0 + u.pm * BMR + t, u.pn, r); }
                if constexpr (epi_is_final<E>::value) {
                    wave_publish(e.cnt + 64 * u.pm);
                    if (wr == 0 && wc == 0) { wave_wait_ge(e.cnt + 64 * u.pm, 4 * 8, e.tmo); __builtin_amdgcn_fence(__ATOMIC_ACQUIRE, "agent"); }
                    asm volatile("s_waitcnt vmcnt(0) lgkmcnt(0)" ::: "memory"); __builtin_amdgcn_s_barrier(); asm volatile("" ::: "memory");
                    if (t < BMR) P[t] = e.row_scale(row0 + u.pm * BMR + t);
                    asm volatile("s_waitcnt lgkmcnt(0)" ::: "memory"); __builtin_amdgcn_s_barrier(); asm volatile("" ::: "memory");
                    f32x4 xq[2][MB][2][2], gf[2][2];
#pragma unroll
                    for (int bj = 0; bj < 2; ++bj) { gf[bj][0] = G_LD4(e.gfin + cbase + bj * HALF); gf[bj][1] = G_LD4(e.gfin + cbase + bj * HALF + 4); }
#pragma unroll
                    for (int ai = 0; ai < 2; ++ai)
#pragma unroll
                        for (int m = 0; m < MB; ++m)
#pragma unroll
                            for (int bj = 0; bj < 2; ++bj) { const float* o = e.Y + (size_t)(rbase + ai * (BMR / 2) + m * 16) * D + cbase + bj * HALF; xq[ai][m][bj][0] = G_LD4(o); xq[ai][m][bj][1] = G_LD4(o + 4); }
                    __builtin_amdgcn_sched_barrier(0);
#pragma unroll
                    for (int ai = 0; ai < 2; ++ai)
#pragma unroll
                        for (int m = 0; m < MB; ++m) { const float rs = P[ai * (BMR / 2) + rl + m * 16];
#pragma unroll
                            for (int bj = 0; bj < 2; ++bj) { float* o = e.Y + (size_t)(rbase + ai * (BMR / 2) + m * 16) * D + cbase + bj * HALF;
                                G_ST4(o, xq[ai][m][bj][0] * rs * gf[bj][0]); G_ST4(o + 4, xq[ai][m][bj][1] * rs * gf[bj][1]); } }
                }
            }
        }
    }
};
template <class Epi, class Sched, bool ALIGN_EPI = false, bool SP2 = false, int MB = 4>
__device__ __forceinline__ void gemm_phase(PG8_LAS unsigned char* lds, const Gemm g, const Sched& S, const Epi& E, const int tid) {
    const int wid = __builtin_amdgcn_readfirstlane(tid >> 6), lane = tid & 63, wr = wid >> 2, wc = wid & 3, fr = lane & 15, fq = lane >> 4;
    const int K = g.K, nt = K / BK;
    unsigned voffA[2], voffB[2];
#pragma unroll
    for (int i = 0; i < 2; ++i) { int R, C; stage_rc(tid * 16 + i * 8192, R, C); const int Rb = Epi::PERM ? ((R & ~31) + perm32(R & 31)) : R;
        voffA[i] = (unsigned)(R * K + C) * 2u; voffB[i] = (unsigned)(Rb * K + C) * 2u; }
    const size_t kstep = (size_t)(BK * 2);
    const size_t hstep = (size_t)HALF * K * 2;
    const size_t tstep = 2 * hstep;
    const size_t hstepA = (size_t)(32 * MB) * K * 2, tstepA = 2 * hstepA;
    const unsigned ldsw = (unsigned)wid * 1024u;
    const int aoff = lds_byte(wr * 16 * MB + fr, fq * 8), boff = lds_byte(wc * 32 + fr, fq * 8);
#define PG8_SA(b, h) (((b) * 2 + (h)) * HTB)
#define PG8_SB(b, h) ((4 + (b) * 2 + (h)) * HTB)
#define PG8_STAGE(bufoff, gbase, voff) do { _Pragma("unroll") for (int _i = 0; _i < 2; ++_i) \
        __builtin_amdgcn_global_load_lds((const unsigned*)((const char*)(gbase) + (voff)[_i]), (PG8_LAS unsigned*)(lds + (bufoff) + ldsw + _i * 8192), 16, 0, 0); } while (0)
#define PG8_LDA(dst, b, h) do { _Pragma("unroll") for (int m = 0; m < MB; ++m) _Pragma("unroll") for (int k = 0; k < 2; ++k) dst[m][k] = *(const PG8_LAS bf16x8*)(lds + PG8_SA(b, h) + aoff + m * 2048 + k * 1024); } while (0)
#define PG8_LDB(dst, b, h) do { _Pragma("unroll") for (int n = 0; n < 2; ++n) _Pragma("unroll") for (int k = 0; k < 2; ++k) dst[n][k] = *(const PG8_LAS bf16x8*)(lds + PG8_SB(b, h) + boff + n * 2048 + k * 1024); } while (0)
#define PG8_MMA(ai, bj, At, Bt) do { __builtin_amdgcn_s_setprio(1); _Pragma("unroll") for (int m = 0; m < MB; ++m) _Pragma("unroll") for (int n = 0; n < 2; ++n) _Pragma("unroll") for (int k = 0; k < 2; ++k) \
        acc[ai][bj][m][n] = __builtin_amdgcn_mfma_f32_16x16x32_bf16(Bt[n][k], At[m][k], acc[ai][bj][m][n], 0, 0, 0); __builtin_amdgcn_s_setprio(0); } while (0)
#define PG8_WAIT_V(n) asm volatile("s_waitcnt vmcnt(" #n ")" ::: "memory")
#define PG8_WAIT_L(n) asm volatile("s_waitcnt lgkmcnt(" #n ")" ::: "memory")
#define PG8_BAR __builtin_amdgcn_s_barrier()
#define PG8_SCHED __builtin_amdgcn_sched_barrier(0)
    Unit cur, nxt; int ui = 0;
    if (!S.next(0, cur)) return;
    f32x4 acc[2][2][MB][2];
#pragma unroll
    for (int a = 0; a < 2; ++a)
#pragma unroll
        for (int b = 0; b < 2; ++b)
#pragma unroll
            for (int m = 0; m < MB; ++m)
#pragma unroll
                for (int n = 0; n < 2; ++n) acc[a][b][m][n] = (f32x4){0.f, 0.f, 0.f, 0.f};
    bf16x8 At[MB][2], B0[2][2], B1[2][2];
    const char* cA = (const char*)g.A + (size_t)cur.pm * tstepA; const char* cB = (const char*)g.Bt + (size_t)cur.pn * tstep;
    S.a_ready(cur);
    if constexpr (SP2) {
        PG8_STAGE(PG8_SB(0, 0), cB, voffB); PG8_STAGE(PG8_SB(0, 1), cB + hstep, voffB); PG8_STAGE(PG8_SA(0, 0), cA, voffA); PG8_STAGE(PG8_SA(0, 1), cA + hstepA, voffA);
        if (wr == 1) PG8_BAR;
        PG8_WAIT_V(2); PG8_BAR;
        PG8_STAGE(PG8_SB(1, 0), cB + kstep, voffB); PG8_STAGE(PG8_SA(1, 0), cA + kstep, voffA); PG8_STAGE(PG8_SB(1, 1), cB + hstep + kstep, voffB);
        PG8_WAIT_V(6); PG8_BAR;
    } else {
        PG8_STAGE(PG8_SB(0, 0), cB, voffB); PG8_STAGE(PG8_SA(0, 0), cA, voffA); PG8_STAGE(PG8_SB(0, 1), cB + hstep, voffB); PG8_STAGE(PG8_SA(0, 1), cA + hstepA, voffA);
        if (wr == 1) PG8_BAR;
        PG8_WAIT_V(4); PG8_BAR;
        PG8_STAGE(PG8_SB(1, 0), cB + kstep, voffB); PG8_STAGE(PG8_SA(1, 0), cA + kstep, voffA); PG8_STAGE(PG8_SB(1, 1), cB + hstep + kstep, voffB);
        PG8_WAIT_V(6); PG8_BAR;
    }
    for (;;) {
        const bool has_next = S.next(ui + 1, nxt);
        const char* nA = has_next ? (const char*)g.A + (size_t)nxt.pm * tstepA : cA; const char* nB = has_next ? (const char*)g.Bt + (size_t)nxt.pn * tstep : cB;
        for (int t = 0; t < nt; t += 2) {
            const bool last = (t == nt - 2);
            const char* a1 = cA + (size_t)(t + 1) * kstep;
            const char* a2 = last ? nA : cA + (size_t)(t + 2) * kstep; const char* b2 = last ? nB : cB + (size_t)(t + 2) * kstep;
            const char* a3 = a2 + kstep; const char* b3 = b2 + kstep;
            if (last && has_next) S.a_ready(nxt);
            if constexpr (SP2) {
            PG8_LDB(B0, 0, 0); PG8_LDB(B1, 0, 1); PG8_SCHED; PG8_LDA(At, 0, 0); PG8_STAGE(PG8_SA(1, 1), a1 + hstepA, voffA);
            PG8_WAIT_V(8); PG8_WAIT_L(0); PG8_BAR; PG8_MMA(0, 0, At, B0); PG8_MMA(0, 1, At, B1); PG8_BAR; PG8_SCHED;
            PG8_LDA(At, 0, 1); PG8_STAGE(PG8_SB(0, 0), b2, voffB); PG8_STAGE(PG8_SB(0, 1), b2 + hstep, voffB); PG8_STAGE(PG8_SA(0, 0), a2, voffA);
            PG8_WAIT_V(8); PG8_WAIT_L(0); PG8_BAR; PG8_MMA(1, 0, At, B0); PG8_MMA(1, 1, At, B1); PG8_BAR; PG8_SCHED;
            PG8_LDB(B0, 1, 0); PG8_LDB(B1, 1, 1); PG8_SCHED; PG8_LDA(At, 1, 0); PG8_STAGE(PG8_SA(0, 1), a2 + hstepA, voffA);
            PG8_WAIT_V(8); PG8_WAIT_L(0); PG8_BAR; PG8_MMA(0, 0, At, B0); PG8_MMA(0, 1, At, B1); PG8_BAR; PG8_SCHED;
            PG8_LDA(At, 1, 1); PG8_STAGE(PG8_SB(1, 0), b3, voffB); PG8_STAGE(PG8_SB(1, 1), b3 + hstep, voffB); PG8_STAGE(PG8_SA(1, 0), a3, voffA);
            PG8_WAIT_V(8); PG8_WAIT_L(0); PG8_BAR; PG8_MMA(1, 0, At, B0); PG8_MMA(1, 1, At, B1); PG8_BAR; PG8_SCHED;
            } else {
            PG8_LDB(B0, 0, 0); PG8_SCHED; PG8_LDA(At, 0, 0); PG8_STAGE(PG8_SA(1, 1), a1 + hstepA, voffA);
            PG8_WAIT_L(8); PG8_BAR; PG8_WAIT_L(0); PG8_MMA(0, 0, At, B0); PG8_BAR; PG8_SCHED;
            PG8_LDB(B1, 0, 1); PG8_STAGE(PG8_SB(0, 0), b2, voffB);
            PG8_BAR; PG8_WAIT_L(0); PG8_MMA(0, 1, At, B1); PG8_BAR;
            PG8_LDA(At, 0, 1); PG8_STAGE(PG8_SA(0, 0), a2, voffA);
            PG8_BAR; PG8_WAIT_L(0); PG8_MMA(1, 0, At, B0); PG8_BAR; PG8_SCHED;
            PG8_STAGE(PG8_SB(0, 1), b2 + hstep, voffB);
            PG8_WAIT_V(6); PG8_BAR; PG8_MMA(1, 1, At, B1); PG8_BAR;
            PG8_LDB(B0, 1, 0); PG8_SCHED; PG8_LDA(At, 1, 0); PG8_STAGE(PG8_SA(0, 1), a2 + hstepA, voffA);
            PG8_WAIT_L(8); PG8_BAR; PG8_WAIT_L(0); PG8_MMA(0, 0, At, B0); PG8_BAR; PG8_SCHED;
            PG8_LDB(B1, 1, 1); PG8_STAGE(PG8_SB(1, 0), b3, voffB);
            PG8_BAR; PG8_WAIT_L(0); PG8_MMA(0, 1, At, B1); PG8_BAR;
            PG8_LDA(At, 1, 1); PG8_STAGE(PG8_SA(1, 0), a3, voffA);
            PG8_BAR; PG8_WAIT_L(0); PG8_MMA(1, 0, At, B0); PG8_BAR; PG8_SCHED;
            PG8_STAGE(PG8_SB(1, 1), b3 + hstep, voffB);
            PG8_WAIT_V(6); PG8_BAR; PG8_MMA(1, 1, At, B1); PG8_BAR;
            }
        }
        if constexpr (ALIGN_EPI) { if (wr == 0) PG8_BAR; }
        if constexpr (!Epi::AFTER_DRAIN) { E(acc, cur, wr, wc, fr, fq); S.done(cur); }
        if (!has_next) break;
#pragma unroll
        for (int a = 0; a < 2; ++a)
#pragma unroll
            for (int b = 0; b < 2; ++b)
#pragma unroll
                for (int m = 0; m < 4; ++m)
#pragma unroll
                    for (int n = 0; n < 2; ++n) acc[a][b][m][n] = (f32x4){0.f, 0.f, 0.f, 0.f};
        cur = nxt; cA = nA; cB = nB; ++ui;
        if constexpr (ALIGN_EPI) { if (wr == 1) PG8_BAR; }
    }
    PG8_WAIT_V(0);
    if constexpr (!ALIGN_EPI) { if (wr == 0) PG8_BAR; }
    PG8_BAR;
    if constexpr (Epi::AFTER_DRAIN) { E.fused(acc, cur, wr, wc, fr, fq, lds, wid, lane); S.done(cur); }
#undef PG8_SA
#undef PG8_SB
#undef PG8_STAGE
#undef PG8_LDA
#undef PG8_LDB
#undef PG8_MMA
#undef PG8_WAIT_V
#undef PG8_WAIT_L
#undef PG8_BAR
#undef PG8_SCHED
}
}

__device__ __forceinline__ void p1_sw_item(const bf16* WT, int N, const float* shift  , float* out, int item, int lane, float scale) {
    const int fr = lane & 15, fq = lane >> 4, n0 = (item >> 2) * 64, kq = (item & 3) * 256;
    f32x4 acc[4];
#pragma unroll
    for (int j = 0; j < 4; ++j) acc[j] = (f32x4){0.f, 0.f, 0.f, 0.f};
    const float* sp = shift + (size_t)(fr < 5 ? fr : 0) * 6144 + kq + fq * 8;
    const bf16* bp = WT + (size_t)(n0 + 8 * (fr >> 2) + (fr & 3)) * D + kq + fq * 8;
#pragma unroll
    for (int k0 = 0; k0 < 256; k0 += 128) {
        bf16x8 a[4], b[4][4];
#pragma unroll
        for (int ks = 0; ks < 4; ++ks) { const f32x4 s0 = *(const f32x4*)(sp + k0 + 32 * ks), s1 = *(const f32x4*)(sp + k0 + 32 * ks + 4);
            a[ks] = __builtin_bit_cast(bf16x8, pack8(s0, s1));
#pragma unroll
            for (int nj = 0; nj < 4; ++nj) b[ks][nj] = *(const bf16x8*)(bp + (size_t)(32 * (nj >> 1) + 4 * (nj & 1)) * D + k0 + 32 * ks); }
#pragma unroll
        for (int ks = 0; ks < 4; ++ks)
#pragma unroll
            for (int nj = 0; nj < 4; ++nj) acc[nj] = __builtin_amdgcn_mfma_f32_16x16x32_bf16(b[ks][nj], a[ks], acc[nj], 0, 0, 0);
    }
    if (fr < 5) {
#pragma unroll
        for (int nj = 0; nj < 4; ++nj)
#pragma unroll
            for (int e = 0; e < 4; ++e) atomicAdd(out + (size_t)fr * N + n0 + 32 * (nj >> 1) + 8 * fq + 4 * (nj & 1) + e, acc[nj][e] * scale); }
}
constexpr int SWI_QKV = NQKV / 16, SWI_ALL = NQKV / 16 + FF2 / 16 + GE2 / 16 + FF2 / 16;
__device__ __forceinline__ void p1_sw_items(const Frame& F, const Args& args, int lo, int hi, int fw, int nfw) {
    unsigned char* ws = wsb(args); const float* MOD0 = (const float*)(ws + WS_MOD); const float* MOD1 = MOD0 + 5 * 6144; float* SW = (float*)(ws + WS_SW);
    constexpr int I0 = NQKV / 16, I1 = FF2 / 16, I2 = GE2 / 16;
    for (int it = lo + fw; it < hi; it += nfw) { int r = it;
        if (r < I0) { p1_sw_item((const bf16*)(ws + WS_WQKV), NQKV, MOD0 + 0, SW + SW_QKV, r, F.lane, F.scale); continue; } r -= I0;
        if (r < I1) { p1_sw_item((const bf16*)(ws + WS_WUP), FF2, MOD0 + 3072, SW + SW_UP0, r, F.lane, F.scale); continue; } r -= I1;
        if (r < I2) { p1_sw_item((const bf16*)(ws + WS_WIN), GE2, MOD1 + 0, SW + SW_IN, r, F.lane, F.scale); continue; } r -= I2;
        p1_sw_item((const bf16*)(ws + WS_WUP) + (size_t)FF2 * D, FF2, MOD1 + 3072, SW + SW_UP1, r, F.lane, F.scale); }
}

constexpr int SWU_IN = (GE2 / 256) * 4, SWU_ALL = SWU_IN + (FF2 / 256) * 4;
__device__ __forceinline__ void sw_unit_f32(const Frame& F, const float* W, int N, const float* shift  , float* out, bool upperm, int u) {
    const int nblk = N / 256, nb = u % nblk, kq = u / nblk;
    const int k0 = kq * 256 + F.wave * 32;
    const float* Wp = W + (size_t)k0 * N + nb * 256 + F.lane * 4;
    float sh[5];
#pragma unroll
    for (int q = 0; q < 5; ++q) sh[q] = *(GAS const float*)(shift + (size_t)q * 6144 + k0 + (F.lane & 31));
    f32x4 acc[5];
#pragma unroll
    for (int q = 0; q < 5; ++q) acc[q] = (f32x4){0.f, 0.f, 0.f, 0.f};
#pragma unroll
    for (int i0 = 0; i0 < 32; i0 += 16) {
        f32x4 w[16];
#pragma unroll
        for (int i = 0; i < 16; ++i) w[i] = G_LD4(Wp + (size_t)(i0 + i) * N);
#pragma unroll
        for (int i = 0; i < 16; ++i)
#pragma unroll
            for (int q = 0; q < 5; ++q) acc[q] += __builtin_bit_cast(float, __builtin_amdgcn_readlane(__builtin_bit_cast(int, sh[q]), i0 + i)) * w[i];
    }
    LAS f32x4* red = (LAS f32x4*)(F.lds + RING_OFF);
    __syncthreads();
#pragma unroll
    for (int q = 0; q < 5; ++q) red[(F.wave * 5 + q) * 64 + F.lane] = acc[q];
    __syncthreads();
    const LAS float* redf = (const LAS float*)red;
    for (int o = F.tid; o < 5 * 256; o += NWAVES * 64) { const int q = o >> 8, n = nb * 256 + (o & 255);
        float s = 0.f;
#pragma unroll
        for (int w = 0; w < NWAVES; ++w) s += redf[(w * 5 + q) * 256 + (o & 255)];
        atomicAdd(out + (size_t)q * N + (upperm ? upmap(n) : n), s * F.scale); }
    __syncthreads();
}
__device__ __forceinline__ void sw_units_f32(const Frame& F, const Args& args, int fb, int nfb) {
    const float* MOD1 = (const float*)(wsb(args) + WS_MOD) + 5 * 6144; float* SW = (float*)(wsb(args) + WS_SW);
    for (int u = fb; u < SWU_ALL; u += nfb) {
        if (u < SWU_IN) sw_unit_f32(F, inp(args, I_WIN), GE2, MOD1 + 0, SW + SW_IN, false, u);
        else sw_unit_f32(F, inp(args, I_WUP) + (size_t)D * FF2, FF2, MOD1 + 3072, SW + SW_UP1, true, u - SWU_IN); }
}

constexpr int EPI_OFF = 132096;
template <int NRED, class Epi, int MB = 4>
__device__ __forceinline__ void gemm_pg8(const Frame& F, const bf16* A, const bf16* Bt, int row0, int Mrows, int N, int K, const Epi& E) {
    pg8::Gemm g{A + (size_t)row0 * K, Bt, Mrows, N, K}; pg8::StaticOrder S; S.init(Mrows, N, F.G, F.bid, 64 * MB);
    pg8::EpiAdapt<Epi, NRED, MB> EA{E, row0, (LAS float*)(F.lds + EPI_OFF), F.skip_epi};
    pg8::gemm_phase<pg8::EpiAdapt<Epi, NRED, MB>, pg8::StaticOrder, true, true, MB>(F.lds + RING_OFF, g, S, EA, F.tid);
}


struct RowLin {
    const float* RS; const float* SW; int N;
};
struct EpiQKV { static constexpr bool HAS_PRE = false, HAS_LIN = true;
    RowLin L; unsigned char* ws;
    __device__ __forceinline__ void post(int row, int col, f32x4 v0, f32x4 v1, float*) const {
        const int which = col >> 10, cc = col & 1023;
        if (which == 0) { v0 = v0 * C2; v1 = v1 * C2; }
        const size_t off = which == 0 ? WS_Q : (row < NCTX ? (which == 1 ? WS_KC : WS_VC) : (which == 1 ? WS_K : WS_V));
        G_STU4((bf16*)(ws + off) + (size_t)row * D + cc, pack8(v0, v1));
    }
};
template <int MODE> struct EpiResT {
    const float *base_c, *base_l; bf16* XB; float* Xout; const float* gate; bf16* AN; const float* gn; const float* scn; float* RSout; float gs;
    static constexpr bool HAS_PRE = true, HAS_LIN = false, PRE_HALVES = MODE == 0;
    struct PreB { u32x4 w; }; struct PreF { f32x4 b0, b1; };
    typedef typename std::conditional<MODE != 0, PreB, PreF>::type Pre;
    __device__ __forceinline__ Pre prefetch(int row, int col) const { Pre p;
        if constexpr (MODE != 0) p.w = G_LDU4(XB + (size_t)row * D + col);
        else { const float* bp = (row < NCTX ? base_c + (size_t)row * D : base_l + (size_t)(row - NCTX) * D) + col; p.b0 = G_LD4(bp); p.b1 = G_LD4(bp + 4); }
        return p; }
    __device__ __forceinline__ float stage_val(int kind, int ci, int col) const {
        return kind == 0 ? *(GAS const float*)(gate + (size_t)ci * 6144 + col) : *(GAS const float*)(gn + col) * (1.f + *(GAS const float*)(scn + (size_t)ci * 6144 + col)); }
    __device__ __forceinline__ void apply_pre(int row, int col, f32x4 v0, f32x4 v1, float* red, const Pre& p, const LAS float* st) const {
        f32x4 b0, b1;
        if constexpr (MODE != 0) { const u32x4 w = p.w; b0 = (f32x4){bflo(w.x), bfhi(w.x), bflo(w.y), bfhi(w.y)}; b1 = (f32x4){bflo(w.z), bfhi(w.z), bflo(w.w), bfhi(w.w)}; }
        else { b0 = p.b0; b1 = p.b1; }
        const f32x4 x0 = b0 + *(const LAS f32x4*)st * (v0 * gs), x1 = b1 + *(const LAS f32x4*)(st + 4) * (v1 * gs);
        if (MODE != 2) G_STU4(XB + (size_t)row * D + col, pack8(x0, x1));
        else { float* xo = Xout + (size_t)row * D + col; G_ST4(xo, x0); G_ST4(xo + 4, x1); }
        if (MODE != 2) { red[0] += ((x0.x * x0.x + x0.y * x0.y) + (x0.z * x0.z + x0.w * x0.w)) + ((x1.x * x1.x + x1.y * x1.y) + (x1.z * x1.z + x1.w * x1.w));
            const f32x4 a0 = x0 * *(const LAS f32x4*)(st + 512), a1 = x1 * *(const LAS f32x4*)(st + 516);
            G_STU4(AN + (size_t)row * D + col, pack8(a0, a1)); }
    }
    __device__ __forceinline__ bool want_red(int) const { return MODE != 2; }
    __device__ __forceinline__ void store_red(int row, int pn, const float* r) const { RSout[(size_t)row * 4 + pn] = r[0]; }
};
struct EpiFinal {
    const bf16* XB; float* Y; const float* gate; const float* gfin; float* RS4; unsigned* cnt; unsigned* tmo; float gs;
    static constexpr bool HAS_PRE = true, HAS_LIN = false, PRE_HALVES = false;
    struct Pre { u32x4 w; };
    __device__ __forceinline__ Pre prefetch(int row, int col) const { Pre p; p.w = G_LDU4(XB + (size_t)row * D + col); return p; }
    __device__ __forceinline__ float stage_val(int kind, int ci, int col) const { return kind == 0 ? *(GAS const float*)(gate + (size_t)ci * 6144 + col) : 0.f; }
    __device__ __forceinline__ void apply_pre(int row, int col, f32x4 v0, f32x4 v1, float* red, const Pre& p, const LAS float* st) const {
        const u32x4 w = p.w;
        v0 = (f32x4){bflo(w.x), bfhi(w.x), bflo(w.y), bfhi(w.y)} + *(const LAS f32x4*)st * (v0 * gs); v1 = (f32x4){bflo(w.z), bfhi(w.z), bflo(w.w), bfhi(w.w)} + *(const LAS f32x4*)(st + 4) * (v1 * gs);
        float* o = Y + (size_t)row * D + col; G_ST4(o, v0); G_ST4(o + 4, v1);
        red[0] += ((v0.x * v0.x + v0.y * v0.y) + (v0.z * v0.z + v0.w * v0.w)) + ((v1.x * v1.x + v1.y * v1.y) + (v1.z * v1.z + v1.w * v1.w));
    }
    __device__ __forceinline__ bool want_red(int) const { return true; }
    __device__ __forceinline__ void store_red(int row, int pn, const float* r) const { st4f_wt(RS4 + (size_t)row * 4 + pn, r[0]); }
    __device__ __forceinline__ float row_scale(int row) const { const f32x4 p = G_LD4(RS4 + (size_t)row * 4); return __builtin_amdgcn_rsqf(((p.x + p.y) + (p.z + p.w)) * (1.f / D) + EPS); }
};
namespace pg8 { template <> struct epi_is_final<EpiFinal> { static constexpr bool value = true; }; }
struct EpiIn { static constexpr bool HAS_PRE = false, HAS_LIN = true;
    RowLin L; bf16 *U, *VV; float* LNP;
    __device__ __forceinline__ void post(int row, int col, f32x4 v0, f32x4 v1, float* red) const {
#pragma unroll
        for (int e = 0; e < 4; ++e) { v0[e] = gelu_tanh_f(v0[e]); v1[e] = gelu_tanh_f(v1[e]); }
        if (col >= GE) { red[0] += ((v0.x + v0.y) + (v0.z + v0.w)) + ((v1.x + v1.y) + (v1.z + v1.w));
            red[1] += ((v0.x * v0.x + v0.y * v0.y) + (v0.z * v0.z + v0.w * v0.w)) + ((v1.x * v1.x + v1.y * v1.y) + (v1.z * v1.z + v1.w * v1.w)); }
        bf16* dst = col < GE ? U + (size_t)row * GE + col : VV + (size_t)row * GE + (col - GE);
        G_STU4(dst, pack8(v0, v1));
    }
    __device__ __forceinline__ bool want_red(int pn) const { return pn >= 8; }
    __device__ __forceinline__ void store_red(int row, int pn, const float* r) const { *(f32x2*)(LNP + (size_t)row * 16 + (pn - 8) * 2) = (f32x2){r[0], r[1]}; }
};


__device__ __forceinline__ float dpp_ror1(float x) { return __builtin_bit_cast(float, __builtin_amdgcn_update_dpp(0, __builtin_bit_cast(int, x), 0x121, 0xf, 0xf, false)); }
__device__ __forceinline__ float dpp_rol1(float x) { return __builtin_bit_cast(float, __builtin_amdgcn_update_dpp(0, __builtin_bit_cast(int, x), 0x12f, 0xf, 0xf, false)); }
__device__ __forceinline__ float bsel(unsigned m, float a, float b) { return __builtin_bit_cast(float, (__builtin_bit_cast(unsigned, a) & m) | (__builtin_bit_cast(unsigned, b) & ~m)); }
__device__ __forceinline__ float dpp_shr1(float old, float x) { return __builtin_bit_cast(float, __builtin_amdgcn_update_dpp(__builtin_bit_cast(int, old), __builtin_bit_cast(int, x), 0x111, 0xf, 0xf, false)); }
__device__ __forceinline__ float dpp_shl1(float old, float x) { return __builtin_bit_cast(float, __builtin_amdgcn_update_dpp(__builtin_bit_cast(int, old), __builtin_bit_cast(int, x), 0x101, 0xf, 0xf, false)); }
struct EpiUpConv {
    static constexpr bool PERM = true, AFTER_DRAIN = false;
    const float* RS; const float* SW; const float* wconv; const float* bconv; float* HALO; bf16* M; LAS float* EX; bool skip;
    __device__ __forceinline__ void operator()(f32x4 (&acc)[2][2][4][2], const pg8::Unit& u, int wr, int wc, int fr, int fq) const {
        if (skip) return;
        const int pm = u.pm, pn = u.pn, ci = pm < 32 ? 0 : 1 + ((pm - 32) >> 2);
        const int c32 = wc * 32 + 8 * fq;
        {   const float* sw = SW + (size_t)ci * FF2 + pn * 256 + c32;
            f32x4 s[2][2];
#pragma unroll
            for (int bj = 0; bj < 2; ++bj)
#pragma unroll
                for (int n = 0; n < 2; ++n) s[bj][n] = G_LD4(sw + bj * 128 + 4 * n);
            f32x4 pq[2][4];
#pragma unroll
            for (int ai = 0; ai < 2; ++ai)
#pragma unroll
                for (int m = 0; m < 4; ++m) pq[ai][m] = G_LD4(RS + (size_t)(pm * 256 + ai * 128 + wr * 64 + m * 16 + fr) * 4);
            __builtin_amdgcn_sched_barrier(0);
#pragma unroll
            for (int ai = 0; ai < 2; ++ai)
#pragma unroll
                for (int m = 0; m < 4; ++m) { const f32x4 p = pq[ai][m];
                    const float r = __builtin_amdgcn_rsqf(((p.x + p.y) + (p.z + p.w)) * (1.f / D) + EPS);
#pragma unroll
                    for (int bj = 0; bj < 2; ++bj)
#pragma unroll
                        for (int n = 0; n < 2; ++n) acc[ai][bj][m][n] = acc[ai][bj][m][n] * r + s[bj][n]; } }
#pragma unroll
        for (int ai = 0; ai < 2; ++ai) { const int sidx = 2 * ai + wr;
#pragma unroll
            for (int bj = 0; bj < 2; ++bj)
#pragma unroll
                for (int n = 0; n < 2; ++n) {
                    if (fr == 0) *(LAS f32x4*)(EX + ((sidx * 2 + 0) * 2 + bj) * 128 + c32 + 4 * n) = acc[ai][bj][0][n];
                    if (fr == 15) *(LAS f32x4*)(EX + ((sidx * 2 + 1) * 2 + bj) * 128 + c32 + 4 * n) = acc[ai][bj][3][n]; } }
        {   const int t = (wr * 4 + wc) * 64 + fq * 16 + fr; EX[8 * 256 + t] = 0.f; }
        if (pm >= 32) { float* hb = HALO + (size_t)(pm - 32) * 4 * FF2 + pn * 256 + c32;
#pragma unroll
            for (int bj = 0; bj < 2; ++bj)
#pragma unroll
                for (int n = 0; n < 2; ++n) {
                    if (wr == 0 && fr < 2) *(f32x4*)(hb + (size_t)fr * FF2 + bj * 128 + 4 * n) = acc[0][bj][0][n];
                    if (wr == 1 && fr >= 14) *(f32x4*)(hb + (size_t)(fr - 12) * FF2 + bj * 128 + 4 * n) = acc[1][bj][3][n]; } }
        const int j0 = pn * 128 + c32;
        f32x4 wq[4];
        { const float* wp = wconv + j0; wq[0] = G_LD4(wp); wq[1] = G_LD4(wp + FF2); wq[2] = G_LD4(wp + 2 * FF2); wq[3] = G_LD4(bconv + j0); }
        asm volatile("s_waitcnt lgkmcnt(0)" ::: "memory"); __builtin_amdgcn_s_barrier(); asm volatile("" ::: "memory");
#pragma unroll
        for (int bj = 0; bj < 2; ++bj)
#pragma unroll
            for (int n = 0; n < 2; ++n) {
                const f32x4 w0 = wq[0], w1 = wq[1], w2 = wq[2], bb = wq[3];
                if (bj * 2 + n < 3) { const int bj1 = (bj * 2 + n + 1) >> 1, n1 = (bj * 2 + n + 1) & 1; const float* wp = wconv + bj1 * FF + j0 + 4 * n1;
                    wq[0] = G_LD4(wp); wq[1] = G_LD4(wp + FF2); wq[2] = G_LD4(wp + 2 * FF2); wq[3] = G_LD4(bconv + bj1 * FF + j0 + 4 * n1); }
#pragma unroll
                for (int ai = 0; ai < 2; ++ai) { const int sidx = 2 * ai + wr;
                    const int xrow = fr == 15 ? (sidx < 3 ? (sidx + 1) * 2 : 9) : (sidx > 0 ? (sidx - 1) * 2 + 1 : 8);
                    const f32x4 X = *(const LAS f32x4*)(EX + (xrow * 2 + bj) * 128 + c32 + 4 * n);
                    f32x4 cur[4];
#pragma unroll
                    for (int m = 0; m < 4; ++m) cur[m] = acc[ai][bj][m][n];
#pragma unroll
                    for (int m = 0; m < 4; ++m) { f32x4 pv_, nx_;
#pragma unroll
                        for (int e = 0; e < 4; ++e) {
                            const float pa_ = m > 0 ? dpp_ror1(cur[m - 1][e]) : X[e], na_ = m < 3 ? dpp_rol1(cur[m + 1][e]) : X[e];
                            pv_[e] = dpp_shr1(pa_, cur[m][e]); nx_[e] = dpp_shl1(na_, cur[m][e]); }
                        acc[ai][bj][m][n] = (w0 * pv_ + w1 * cur[m]) + (w2 * nx_ + bb); }
                    __builtin_amdgcn_sched_barrier(0); } }
#pragma unroll
        for (int ai = 0; ai < 2; ++ai)
#pragma unroll
            for (int m = 0; m < 4; ++m) { const int row = pm * 256 + ai * 128 + wr * 64 + m * 16 + fr;
                f32x4 o0, o1;
#pragma unroll
                for (int e = 0; e < 4; ++e) { o0[e] = silu_f(acc[ai][0][m][0][e]) * acc[ai][1][m][0][e]; o1[e] = silu_f(acc[ai][0][m][1][e]) * acc[ai][1][m][1][e]; }
                G_STU4(M + (size_t)row * FF + j0, pack8(o0, o1)); }
    }
};
__device__ __forceinline__ void fix_halo_rows(const Frame& F, int row_lo, int row_hi, const float* HALO, const float* wconv, const float* bconv, bf16* M) {
    for (int T = row_lo >> 8; T <= (row_hi - 1) >> 8; ++T) {
        if (T < 32) continue;
        const int q = (T - 32) & 3;
#pragma unroll
        for (int which = 0; which < 2; ++which) {
            const int row = T * 256 + (which ? 255 : 0);
            if (!((which == 0 ? (q != 0) : (q != 3)) && row >= row_lo && row < row_hi)) continue;
            const float* own = HALO + (size_t)(T - 32) * 4 * FF2;
            const float* pr = which == 0 ? HALO + ((size_t)(T - 33) * 4 + 3) * FF2 : own + 2 * FF2;
            const float* cu = which == 0 ? own : own + 3 * FF2;
            const float* nx = which == 0 ? own + FF2 : HALO + (size_t)(T - 31) * 4 * FF2;
#pragma unroll
            for (int it = 0; it < 2; ++it) {
                const int j = 4 * (F.tid + it * NWAVES * 64);
                if (j < FF) {
                    const int gc = ((j >> 7) << 8) + (j & 127), vc = gc + 128;
                    const f32x4 g = (G_LD4(wconv + j) * G_LD4(pr + gc) + G_LD4(wconv + FF2 + j) * G_LD4(cu + gc)) + (G_LD4(wconv + 2 * FF2 + j) * G_LD4(nx + gc) + G_LD4(bconv + j));
                    const f32x4 v = (G_LD4(wconv + FF + j) * G_LD4(pr + vc) + G_LD4(wconv + FF2 + FF + j) * G_LD4(cu + vc)) + (G_LD4(wconv + 2 * FF2 + FF + j) * G_LD4(nx + vc) + G_LD4(bconv + FF + j));
                    u32x2 o; o.x = cvt_pk_bf16(silu_f(g.x) * v.x, silu_f(g.y) * v.y); o.y = cvt_pk_bf16(silu_f(g.z) * v.z, silu_f(g.w) * v.w);
                    *(GAS u32x2*)(M + (size_t)row * FF + j) = o; } }
        }
    }
    asm volatile("s_waitcnt vmcnt(0)" ::: "memory"); __syncthreads();
}
template <class Epi>
__device__ __forceinline__ void gemm_pg8_raw(const Frame& F, const bf16* A, const bf16* Bt, int Mrows, int N, int K, const Epi& E) {
    pg8::Gemm g{A, Bt, Mrows, N, K}; pg8::StaticOrder S; S.init(Mrows, N, F.G, F.bid);
    pg8::gemm_phase<Epi, pg8::StaticOrder, true, true>(F.lds + RING_OFF, g, S, E, F.tid);
}

#include <hip/hip_bf16.h>
namespace attn_body {
using bf16=__hip_bfloat16;
using bf16x8=__attribute__((ext_vector_type(8)))short;
using s16x4=__attribute__((ext_vector_type(4)))short;
using f32x16=__attribute__((ext_vector_type(16)))float;
using u32x4=__attribute__((ext_vector_type(4)))unsigned;
constexpr int NHEAD=16,D=64,DM=NHEAD*D;
constexpr int NW=8,QBLK=32,QB=QBLK*NW,KVBLK=64;
__device__ __forceinline__ int crow(int r,int hi){return (r&3)+8*(r>>2)+4*hi;}
#define SBAR() __builtin_amdgcn_sched_barrier(0)
constexpr int NSLOT=3, SLOTB=8192;
constexpr int LDS_K=0, LDS_V=NSLOT*SLOTB, LDS_WS=2*NSLOT*SLOTB, LDS_OST=LDS_WS+NW*64*4, LDS_TAB=LDS_OST+NW*4096, LDS_BYTES=LDS_TAB+(3+15)*128*4;
constexpr float C2=0.125f*1.4426950408889634f;
__device__ __forceinline__ void glds16(const void*gsrc,unsigned lds_dst){unsigned keep;
  asm volatile("s_mov_b32 %0, m0\n\ts_mov_b32 m0, %2\n\ts_nop 0\n\tglobal_load_lds_dwordx4 %1, off\n\ts_mov_b32 m0, %0":"=&s"(keep):"v"(gsrc),"s"(lds_dst):"memory");}
__device__ __forceinline__ float max3f(float a,float b,float c){float r;asm("v_max3_f32 %0, %1, %2, %3":"=v"(r):"v"(a),"v"(b),"v"(c));return r;}
__device__ __forceinline__ float max2f(float a,float b){float r;asm("v_max_f32_e32 %0, %1, %2":"=v"(r):"v"(a),"v"(b));return r;}
__device__ __forceinline__ float fadd_s(float a,float b){float r;asm("v_add_f32_e32 %0, %1, %2":"=v"(r):"v"(a),"v"(b));return r;}
__device__ __forceinline__ float fsub_s(float a,float b){float r;asm("v_sub_f32_e32 %0, %1, %2":"=v"(r):"v"(a),"v"(b));return r;}
typedef float f32x2_t __attribute__((ext_vector_type(2))); typedef __bf16 bf16x2_t __attribute__((ext_vector_type(2)));
__device__ __forceinline__ unsigned cvtpk_s(float lo,float hi){f32x2_t v={lo,hi};bf16x2_t b=__builtin_convertvector(v,bf16x2_t);return __builtin_bit_cast(unsigned,b);}
#define WAIT_BAR(N) asm volatile("s_waitcnt vmcnt(" #N ") lgkmcnt(0)\n\ts_barrier":::"memory")

__device__ __forceinline__ void qkt(f32x16&p0,f32x16&p1,const char*Kslot,const bf16x8*qr,const f32x16&negm,int r32,int hi){
  const char*kb=Kslot+hi*1024+r32*16;
  #pragma unroll
  for(int d0=0;d0<4;++d0){
    const bf16x8 b0=*reinterpret_cast<const bf16x8*>(kb+d0*2048);
    const bf16x8 b1=*reinterpret_cast<const bf16x8*>(kb+d0*2048+512);
    if(d0==0){p0=__builtin_amdgcn_mfma_f32_32x32x16_bf16(b0,qr[0],negm,0,0,0);p1=__builtin_amdgcn_mfma_f32_32x32x16_bf16(b1,qr[0],negm,0,0,0);}
    else{p0=__builtin_amdgcn_mfma_f32_32x32x16_bf16(b0,qr[d0],p0,0,0,0);p1=__builtin_amdgcn_mfma_f32_32x32x16_bf16(b1,qr[d0],p1,0,0,0);}}
}
typedef __attribute__((address_space(3))) const char* lds_cptr;
typedef short v4i16_t __attribute__((ext_vector_type(4)));
__device__ __forceinline__ void kload8(bf16x8*kf,lds_cptr kp){
  kf[0]=*(const __attribute__((address_space(3))) bf16x8*)(kp);      kf[1]=*(const __attribute__((address_space(3))) bf16x8*)(kp+512);
  kf[2]=*(const __attribute__((address_space(3))) bf16x8*)(kp+2048); kf[3]=*(const __attribute__((address_space(3))) bf16x8*)(kp+2560);
  kf[4]=*(const __attribute__((address_space(3))) bf16x8*)(kp+4096); kf[5]=*(const __attribute__((address_space(3))) bf16x8*)(kp+4608);
  kf[6]=*(const __attribute__((address_space(3))) bf16x8*)(kp+6144); kf[7]=*(const __attribute__((address_space(3))) bf16x8*)(kp+6656);
}
__device__ __forceinline__ void kload2(bf16x8*kf,lds_cptr kp,int j){ kf[2*j]=*(const __attribute__((address_space(3))) bf16x8*)(kp+j*2048); kf[2*j+1]=*(const __attribute__((address_space(3))) bf16x8*)(kp+j*2048+512); }
__device__ __forceinline__ s16x4 vtr(lds_cptr p){ return __builtin_bit_cast(s16x4,__builtin_amdgcn_ds_read_tr16_b64_v4i16((__attribute__((address_space(3))) v4i16_t*)p)); }
__device__ __forceinline__ float rowmax(const f32x16&p0,const f32x16&p1){
  float a=max3f(p0[0],p0[1],p1[0]),b=max3f(p0[2],p0[3],p1[1]);a=max3f(a,p1[2],p1[3]);
  #pragma unroll
  for(int r=4;r<16;r+=4){a=max3f(a,p0[r],p0[r+1]);b=max3f(b,p0[r+2],p0[r+3]);a=max3f(a,p1[r],p1[r+1]);b=max3f(b,p1[r+2],p1[r+3]);}
  const float m=max2f(a,b);
  auto rr=__builtin_amdgcn_permlane32_swap(__float_as_uint(m),__float_as_uint(m),false,false);
  return max2f(__uint_as_float(rr[0]),__uint_as_float(rr[1]));
}
__device__ __forceinline__ void pv(f32x16*o,int vb,bf16x8 pa0,bf16x8 pa1,bf16x8 pa2,bf16x8 pa3){
  #pragma unroll
  for(int d0=0;d0<2;++d0){s16x4 lo[4],hi[4];
    #pragma unroll
    for(int ks=0;ks<4;++ks){
      asm volatile("ds_read_b64_tr_b16 %0,%1 offset:%c2":"=&v"(lo[ks]):"v"(vb),"i"(d0*4096+ks*1024):"memory");
      asm volatile("ds_read_b64_tr_b16 %0,%1 offset:%c2":"=&v"(hi[ks]):"v"(vb),"i"(d0*4096+ks*1024+512):"memory");}
    asm volatile("s_waitcnt lgkmcnt(0)":::"memory");SBAR();
    #define PK(k) (bf16x8){lo[k][0],lo[k][1],lo[k][2],lo[k][3],hi[k][0],hi[k][1],hi[k][2],hi[k][3]}
    o[d0]=__builtin_amdgcn_mfma_f32_32x32x16_bf16(pa0,PK(0),o[d0],0,0,0);
    o[d0]=__builtin_amdgcn_mfma_f32_32x32x16_bf16(pa1,PK(1),o[d0],0,0,0);
    o[d0]=__builtin_amdgcn_mfma_f32_32x32x16_bf16(pa2,PK(2),o[d0],0,0,0);
    o[d0]=__builtin_amdgcn_mfma_f32_32x32x16_bf16(pa3,PK(3),o[d0],0,0,0);
    #undef PK
  }
}

#ifndef ATTN_STORE16
#define ATTN_STORE16(p,v) (*(__attribute__((address_space(1))) u32x4*)(p)=(v))
#endif
template<int THRL,bool LAT> __device__ __forceinline__ void attn_unit(const int tid,bf16*Qw0,const bf16*K0,const long dV0,const int n0,const bf16*K1,const long dV1,const int NT,char*shm,const int rq0,const int wlo,const float*rpb_h){
  bf16*const Ow0=Qw0;
  const int lane=tid&63,r32=lane&31,hi=lane>>5; const int wid=__builtin_amdgcn_readfirstlane(tid>>6);
  const bf16*Qw=Qw0+(long)(wid*QBLK)*DM;
  const unsigned lds0=(unsigned)(uintptr_t)shm;
  float*wsf=(float*)(shm+LDS_WS)+wid*64;
  typedef __attribute__((address_space(3))) const float* lds_fptr;
  float*tab=(float*)(shm+LDS_TAB);
  if(LAT){ float tv_[4];
    _Pragma("unroll") for(int k=0;k<4;++k){const int i=tid+k*NW*64,rr=i>>7,cc=i&127; tv_[k]=(i<15*128&&cc>=48&&cc<79)?*(const __attribute__((address_space(1))) float*)(rpb_h+rr*31+cc-48)*1.4426950408889634f:0.f;}
    _Pragma("unroll") for(int k=0;k<4;++k){const int i=tid+k*NW*64; if(i<15*128)tab[384+i]=tv_[k];}
    if(tid<384)tab[tid]=(tid<128||(tid>=256+48&&tid<256+64))?0.f:-INFINITY; }
  const int rq=rq0+(wid>>1), rs=min(max(rq-4,0),8);
  lds_fptr tb_=(lds_fptr)tab, tv_=(lds_fptr)tab;
  #define CSEL(t) do{ if(LAT){ const int cq_=32*(wid&1)+r32; const bool w_=(t)>=n0; const int ia_=wlo+((t)-n0); const bool ok_=w_&&(ia_>=rs)&&(ia_<rs+8); \
      tb_=(lds_fptr)tab+(63-cq_+4*hi)+(ok_?384+(ia_-rq+7)*128:0); tv_=(lds_fptr)tab+(48-min(max(cq_-8,0),48)+4*hi)+(w_?(ok_?256:128):0); } }while(0)
  #define CINIT(C,KO) do{ if(LAT){ _Pragma("unroll") for(int r=0;r<16;++r){const int k0_=(r&3)+8*(r>>2)+(KO); C[r]=(tb_[k0_]+tv_[k0_])-mhat;} } }while(0)
  #define CSRC(C) (LAT?C:negm)
  const int koff=lane*DM+wid*8;
  const int voff=(16*(wid&3)+(lane>>2))*DM+(wid>>2)*32+(lane&3)*8;
  const unsigned kdst=lds0+LDS_K+wid*1024, vdst=lds0+LDS_V+wid*1024;
  #define KSRC(t) (((t)<n0?K0+(long)(t)*KVBLK*DM:K1+(long)((t)-n0)*KVBLK*DM)+koff)
  #define VSRC(t) (((t)<n0?K0+dV0+(long)(t)*KVBLK*DM:K1+dV1+(long)((t)-n0)*KVBLK*DM)+voff)
  #define DMA_K(t,slot) glds16(KSRC(t),(unsigned)__builtin_amdgcn_readfirstlane(kdst+(slot)))
  #define DMA_V(t,slot) glds16(VSRC(t),(unsigned)__builtin_amdgcn_readfirstlane(vdst+(slot)))
  const int vb0=(int)(lds0+LDS_V)+((lane>>4)&1)*32+(lane&3)*8+(4*hi+((lane&15)>>2))*64;
  const char*Kbase=shm+LDS_K; bf16x8 kf[8];
  const lds_cptr shm3=(lds_cptr)shm; const lds_cptr kp0=shm3+LDS_K+hi*1024+r32*16; const lds_cptr vp0=shm3+LDS_V+((lane>>4)&1)*32+(lane&3)*8+(4*hi+((lane&15)>>2))*64;

  DMA_K(0,0);DMA_V(0,0);DMA_K(1,SLOTB);
  bf16x8 qr[4];
  #pragma unroll
  for(int d0=0;d0<4;++d0)qr[d0]=*(const __attribute__((address_space(1))) bf16x8*)(&Qw[(long)r32*DM+d0*16+hi*8]);
  float mhat=0.f,l_reg=0.f;f32x16 o[2];o[0]=f32x16{};o[1]=f32x16{};float z_=0.f;asm volatile("":"+v"(z_));f32x16 negm;
  _Pragma("unroll") for(int r=0;r<16;++r)negm[r]=z_;
  if(!LAT)asm volatile("":"+v"(negm));
  #define CMASK(P0,P1,t) do{}while(0)
  bool resc=false;
  #define START(P0,P1) do{ const float rm=rowmax(P0,P1); resc=false; \
    { const float dl=rm; mhat=fadd_s(mhat,dl); \
      _Pragma("unroll") for(int r=0;r<16;++r){P0[r]=fsub_s(P0[r],dl);P1[r]=fsub_s(P1[r],dl);} \
      if(!LAT){ _Pragma("unroll") for(int r=0;r<16;++r)negm[r]=-mhat; asm volatile("":"+v"(negm)); } } \
    _Pragma("unroll") for(int r=0;r<16;++r)P0[r]=__builtin_amdgcn_exp2f(P0[r]); }while(0)
  #define RESC() do{ if(resc){ asm volatile("s_waitcnt lgkmcnt(0)":::"memory"); \
      _Pragma("unroll") for(int d_=0;d_<2;++d_) _Pragma("unroll") for(int r=0;r<16;++r)o[d_][r]*=wsf[crow(r,hi)]; } }while(0)
  f32x16 pA0,pA1,pB0,pB1;
  int sl_prev=0,sl_cur=0,sl_next=SLOTB;
  #define ROT() do{sl_prev=sl_cur;sl_cur=sl_next;sl_next=(sl_next==(NSLOT-1)*SLOTB)?0:sl_next+SLOTB;}while(0)
  DMA_K(2,2*SLOTB);
  WAIT_BAR(3);
  qkt(pA0,pA1,Kbase,qr,negm,r32,hi);asm volatile("s_nop 15\n\ts_nop 7":"+v"(pA0),"+v"(pA1));CMASK(pA0,pA1,0);
  START(pA0,pA1);
  _Pragma("unroll") for(int r=0;r<16;++r)pA1[r]=__builtin_amdgcn_exp2f(pA1[r]);
  WAIT_BAR(0);
  DMA_K(3,0);DMA_V(1,SLOTB);
  ROT();
  kload8(kf,kp0+sl_cur);
  WAIT_BAR(2);
  s16x4 vlo[8],vhi[8]; u32x4 pw0,pw1,pw2,pw3;
  #define PKW(P,B) cvtpk_s(P[B],P[B+1])
  #define PAF(k) __builtin_bit_cast(bf16x8,pw##k)
  #define VFR(i) (bf16x8){vlo[i][0],vlo[i][1],vlo[i][2],vlo[i][3],vhi[i][0],vhi[i][1],vhi[i][2],vhi[i][3]}
  #define PIN(x) asm volatile("":"+v"(x))
  #define MX3(a,b,c) __builtin_fmaxf(__builtin_fmaxf((a),(b)),(c))
  #define GAPA(MF,A0,A1,A2,A3,W0,W1,PW) do{ MF; sacc+=A0; sacc+=A1; sacc+=A2; sacc+=A3; PIN(sacc); W0; W1; PIN(PW); SBAR(); }while(0)
  #define EX(v) __builtin_amdgcn_exp2f(v)
  #define GAPB(MF,X,B,KO) do{ MF; X[B]=EX(X[B]); X[B+1]=EX(X[B+1]); X[B+2]=EX(X[B+2]); X[B+3]=EX(X[B+3]); PIN(X); SBAR(); }while(0)
  #define VRD(i) do{ vlo[i]=vtr(vp_+(((i)>>2)*4096+((i)&3)*1024)); vhi[i]=vtr(vp_+(((i)>>2)*4096+((i)&3)*1024+512)); }while(0)
  #define KRD(G,j) do{ if(G){ kload2(kf,kp0+sl_next,j); SBAR(); } }while(0)
  #define STEP(C0,C1,P0,P1,t,GK,GV,GL) do{ SBAR(); CSEL(t); CINIT(C0,0); SBAR(); \
    const lds_cptr vp_=vp0+sl_prev; \
    VRD(0); SBAR(); float sacc=(P0[0]+P0[1]); \
    GAPA(C0=__builtin_amdgcn_mfma_f32_32x32x16_bf16(kf[0],qr[0],CSRC(C0),0,0,0), P0[2],P0[3],P0[4],P0[5],     pw0[0]=PKW(P0,0), pw0[1]=PKW(P0,2), pw0); \
    CINIT(C1,32); VRD(4); SBAR(); GAPA(C1=__builtin_amdgcn_mfma_f32_32x32x16_bf16(kf[1],qr[0],CSRC(C1),0,0,0), P0[6],P0[7],P0[8],P0[9],     pw0[2]=PKW(P0,4), pw0[3]=PKW(P0,6), pw0); \
    VRD(1); SBAR(); GAPA(C0=__builtin_amdgcn_mfma_f32_32x32x16_bf16(kf[2],qr[1],C0,0,0,0),   P0[10],P0[11],P0[12],P0[13], pw1[0]=PKW(P0,8), pw1[1]=PKW(P0,10), pw1); \
    VRD(5); SBAR(); GAPA(C1=__builtin_amdgcn_mfma_f32_32x32x16_bf16(kf[3],qr[1],C1,0,0,0),   P0[14],P0[15],P1[0],P1[1],   pw1[2]=PKW(P0,12),pw1[3]=PKW(P0,14), pw1); \
    VRD(2); SBAR(); GAPA(C0=__builtin_amdgcn_mfma_f32_32x32x16_bf16(kf[4],qr[2],C0,0,0,0),   P1[2],P1[3],P1[4],P1[5],     pw2[0]=PKW(P1,0), pw2[1]=PKW(P1,2), pw2); \
    VRD(6); SBAR(); GAPA(C1=__builtin_amdgcn_mfma_f32_32x32x16_bf16(kf[5],qr[2],C1,0,0,0),   P1[6],P1[7],P1[8],P1[9],     pw2[2]=PKW(P1,4), pw2[3]=PKW(P1,6), pw2); \
    VRD(3); SBAR(); GAPA(C0=__builtin_amdgcn_mfma_f32_32x32x16_bf16(kf[6],qr[3],C0,0,0,0),   P1[10],P1[11],P1[12],P1[13], pw3[0]=PKW(P1,8), pw3[1]=PKW(P1,10), pw3); \
    VRD(7); SBAR(); GAPA(C1=__builtin_amdgcn_mfma_f32_32x32x16_bf16(kf[7],qr[3],C1,0,0,0),   P1[14],P1[15],0.f,0.f,       pw3[2]=PKW(P1,12),pw3[3]=PKW(P1,14), pw3); \
    l_reg+=sacc; \
    if(GK){DMA_K((t)+3,sl_cur);} if(GV){DMA_V((t)+1,sl_next);} \
    CMASK(C0,C1,t); \
    { float a=MX3(C0[0],C0[1],C1[0]),b=MX3(C0[2],C0[3],C1[1]); a=MX3(a,C1[2],C1[3]); \
      _Pragma("unroll") for(int r=4;r<16;r+=4){a=MX3(a,C0[r],C0[r+1]);b=MX3(b,C0[r+2],C0[r+3]);a=MX3(a,C1[r],C1[r+1]);b=MX3(b,C1[r+2],C1[r+3]);} \
      float rm=__builtin_fmaxf(a,b); { auto rr=__builtin_amdgcn_permlane32_swap(__float_as_uint(rm),__float_as_uint(rm),false,false); rm=__builtin_fmaxf(__uint_as_float(rr[0]),__uint_as_float(rr[1])); } \
      resc=false; \
      if(__builtin_expect(__any(rm>(float)THRL),0)){ const float dl=__builtin_fmaxf(rm,0.f); mhat+=dl; \
        _Pragma("unroll") for(int r=0;r<16;++r){C0[r]-=dl;C1[r]-=dl;} \
        if(!LAT){ _Pragma("unroll") for(int r=0;r<16;++r)negm[r]=-mhat; asm volatile("":"+v"(negm)); } \
        const float f=__builtin_amdgcn_exp2f(-dl); l_reg*=f; if(hi==0)wsf[r32]=f; resc=true; } } \
    SBAR(); \
    GAPB(o[0]=__builtin_amdgcn_mfma_f32_32x32x16_bf16(PAF(0),VFR(0),o[0],0,0,0), C0,0,0); \
    GAPB(o[1]=__builtin_amdgcn_mfma_f32_32x32x16_bf16(PAF(0),VFR(4),o[1],0,0,0), C0,4,0); \
    KRD(GL,0); GAPB(o[0]=__builtin_amdgcn_mfma_f32_32x32x16_bf16(PAF(1),VFR(1),o[0],0,0,0), C0,8,0); \
    KRD(GL,1); GAPB(o[1]=__builtin_amdgcn_mfma_f32_32x32x16_bf16(PAF(1),VFR(5),o[1],0,0,0), C0,12,0); \
    KRD(GL,2); GAPB(o[0]=__builtin_amdgcn_mfma_f32_32x32x16_bf16(PAF(2),VFR(2),o[0],0,0,0), C1,0,32); \
    KRD(GL,3); GAPB(o[1]=__builtin_amdgcn_mfma_f32_32x32x16_bf16(PAF(2),VFR(6),o[1],0,0,0), C1,4,32); \
    GAPB(o[0]=__builtin_amdgcn_mfma_f32_32x32x16_bf16(PAF(3),VFR(3),o[0],0,0,0), C1,8,32); \
    GAPB(o[1]=__builtin_amdgcn_mfma_f32_32x32x16_bf16(PAF(3),VFR(7),o[1],0,0,0), C1,12,32); \
    }while(0)
  int t=1;
  for(;t+5<NT;t+=2){
    STEP(pB0,pB1,pA0,pA1,t,true,true,true);     WAIT_BAR(2); RESC(); ROT();
    STEP(pA0,pA1,pB0,pB1,t+1,true,true,true);   WAIT_BAR(2); RESC(); ROT();
  }
  #define ENDW(tt) do{ if((tt)+3<NT){WAIT_BAR(2);} else if((tt)+2<NT){WAIT_BAR(1);} else {WAIT_BAR(0);} }while(0)
  for(;t+1<NT;t+=2){
    STEP(pB0,pB1,pA0,pA1,t,(t+3<NT),(t+1<NT),(t+1<NT));       ENDW(t);   RESC(); ROT();
    STEP(pA0,pA1,pB0,pB1,t+1,(t+4<NT),(t+2<NT),(t+2<NT));     ENDW(t+1); RESC(); ROT();
  }
  STEP(pB0,pB1,pA0,pA1,NT-1,false,false,false); RESC();
  { float sacc=pB0[0]+pB0[1]; _Pragma("unroll") for(int r=2;r<16;++r)sacc+=pB0[r]; _Pragma("unroll") for(int r=0;r<16;++r)sacc+=pB1[r]; l_reg+=sacc;
    pw0=(u32x4){PKW(pB0,0),PKW(pB0,2),PKW(pB0,4),PKW(pB0,6)};pw1=(u32x4){PKW(pB0,8),PKW(pB0,10),PKW(pB0,12),PKW(pB0,14)};pw2=(u32x4){PKW(pB1,0),PKW(pB1,2),PKW(pB1,4),PKW(pB1,6)};pw3=(u32x4){PKW(pB1,8),PKW(pB1,10),PKW(pB1,12),PKW(pB1,14)};
    SBAR(); pv(o,vb0+sl_cur,PAF(0),PAF(1),PAF(2),PAF(3)); }
  #undef PKW
  #undef PAF
  #undef VFR
  #undef PIN
  #undef MX3
  #undef GAPA
  #undef GAPB
  #undef EX
  #undef VRD
  #undef KRD
  #undef STEP
  #undef ENDW
  {auto rr=__builtin_amdgcn_permlane32_swap(__float_as_uint(l_reg),__float_as_uint(l_reg),false,false);l_reg=__uint_as_float(rr[0])+__uint_as_float(rr[1]);}
  if(hi==0)wsf[32+r32]=l_reg;asm volatile("s_waitcnt lgkmcnt(0)":::"memory");
  float rli[16];
  #pragma unroll
  for(int r=0;r<16;++r)rli[r]=__builtin_amdgcn_rcpf(wsf[32+crow(r,hi)]);
  bf16*Ow=Ow0+(long)(wid*QBLK)*DM;
  { bf16*stg=(bf16*)(shm+LDS_OST)+wid*2048;
    #pragma unroll
    for(int r=0;r<16;++r){const int orow=crow(r,hi);
      #pragma unroll
      for(int d0=0;d0<2;++d0)stg[orow*64+d0*32+r32]=__float2bfloat16(o[d0][r]*rli[r]);}
    asm volatile("s_waitcnt lgkmcnt(0)":::"memory");
    #pragma unroll
    for(int i=0;i<4;++i){const int row=i*8+(lane>>3),ch=lane&7; const u32x4 v=*(const u32x4*)(stg+row*64+ch*8); ATTN_STORE16(Ow+(long)row*DM+ch*8,v);} }
  asm volatile("s_waitcnt lgkmcnt(0)\n\ts_barrier":::"memory");
  #undef DMA_K
  #undef DMA_V
  #undef KSRC
  #undef VSRC
  #undef CMASK
  #undef CSEL
  #undef CINIT
  #undef CSRC
  #undef START
  #undef RESC
  #undef ROT
}

constexpr int MIX_STAT=0, MIX_V=2048, MIX_WS=MIX_V+8*8192, MIX_STG=MIX_WS+NW*64*4, MIX_SROW=36, MIX_LDS_BYTES=MIX_STG+NW*32*MIX_SROW*4;
__device__ __forceinline__ void mix_pair(const int tid,const int uA,const int uB,const bf16*VV,bf16*U,const bf16*WSb,const float*LNP,const float*gv,const float*bs,char*shm){
  const int lane=tid&63,r32=lane&31,hi=lane>>5; const int wid=__builtin_amdgcn_readfirstlane(tid>>6);
  const int grp=wid>>2,pb=wid&3,u=grp?uB:uA; const bool valid=u>=0; const int chunk=u>>4,g=u&15;
  const unsigned lds0=(unsigned)(uintptr_t)shm;
  float*stat=(float*)(shm+MIX_STAT)+grp*256;
  float*wsf=(float*)(shm+MIX_WS)+wid*64;
  float*stg=(float*)(shm+MIX_STG)+wid*32*MIX_SROW;
  const int vbase=MIX_V+grp*32768;
  asm volatile("s_waitcnt vmcnt(0)":::"memory");
  if(valid){
    #pragma unroll
    for(int k=0;k<2;++k){ const int pi=2*pb+k; const bf16*vsrc=VV+(long)(chunk*128+16*(pi&3)+(lane>>2))*2048+g*128+(pi>>2)*32+(lane&3)*8;
      #pragma unroll
      for(int s=0;s<4;++s) glds16(vsrc+(long)((s>>1)*64)*2048+(s&1)*64,(unsigned)__builtin_amdgcn_readfirstlane(lds0+vbase+s*8192+pi*1024)); }
    const int tg=tid&255;
    if(tg<128){ const __attribute__((address_space(1))) float*p=(const __attribute__((address_space(1))) float*)(LNP+(long)(chunk*128+tg)*16); float s=0.f,q=0.f;
      #pragma unroll
      for(int k=0;k<8;++k){s+=p[2*k];q+=p[2*k+1];}
      const float mean=s*(1.f/2048.f),var=q*(1.f/2048.f)-mean*mean; stat[2*tg]=mean; stat[2*tg+1]=__builtin_amdgcn_rsqf(var+1e-6f); } }
  unsigned wq[2][4][4]; u32x4 uq[2][2][2]; f32x4 gq[2][2][2]; float bq[2];
  if(valid){
    #pragma unroll
    for(int qt=0;qt<2;++qt)
      #pragma unroll
      for(int ks=0;ks<4;++ks){ const __attribute__((address_space(1))) unsigned* wp=(const __attribute__((address_space(1))) unsigned*)(WSb+((long)g*128+32*pb+r32)*128+64*qt+16*ks+4*hi);
        wq[qt][ks][0]=wp[0]; wq[qt][ks][1]=wp[1]; wq[qt][ks][2]=wp[4]; wq[qt][ks][3]=wp[5]; }
    #pragma unroll
    for(int i=0;i<2;++i) bq[i]=*(const __attribute__((address_space(1))) float*)(bs+g*128+32*pb+i*16+(lane>>2));
    #pragma unroll
    for(int ch=0;ch<2;++ch)
      #pragma unroll
      for(int d0=0;d0<2;++d0){ const int e=g*128+ch*64+d0*32+(lane&3)*8;
        gq[ch][d0][0]=*(const __attribute__((address_space(1))) f32x4*)(gv+e); gq[ch][d0][1]=*(const __attribute__((address_space(1))) f32x4*)(gv+e+4);
        #pragma unroll
        for(int i=0;i<2;++i) uq[ch][d0][i]=*(const __attribute__((address_space(1))) u32x4*)(U+(long)(chunk*128+32*pb+i*16+(lane>>2))*2048+e); } }
  asm volatile("s_waitcnt vmcnt(0) lgkmcnt(0)\n\ts_barrier":::"memory");
  if(valid){
    bf16x8 pa[2][4]; float corr=0.f;
    #pragma unroll
    for(int qt=0;qt<2;++qt)
      #pragma unroll
      for(int ks=0;ks<4;++ks){ const int qa=64*qt+16*ks+4*hi;
        const unsigned w0=wq[qt][ks][0],w1=wq[qt][ks][1],w2=wq[qt][ks][2],w3=wq[qt][ks][3];
        const f32x4 s0=*(const f32x4*)(stat+2*qa), s1=*(const f32x4*)(stat+2*qa+4), s2=*(const f32x4*)(stat+2*qa+16), s3=*(const f32x4*)(stat+2*qa+20);
        const float a0=__uint_as_float(w0<<16)*s0.y,a1=__uint_as_float(w0&0xffff0000u)*s0.w,a2=__uint_as_float(w1<<16)*s1.y,a3=__uint_as_float(w1&0xffff0000u)*s1.w;
        const float a4=__uint_as_float(w2<<16)*s2.y,a5=__uint_as_float(w2&0xffff0000u)*s2.w,a6=__uint_as_float(w3<<16)*s3.y,a7=__uint_as_float(w3&0xffff0000u)*s3.w;
        u32x4 pk; pk.x=cvtpk_s(a0,a1); pk.y=cvtpk_s(a2,a3); pk.z=cvtpk_s(a4,a5); pk.w=cvtpk_s(a6,a7);
        corr+=(__uint_as_float(pk.x<<16)*s0.x+__uint_as_float(pk.x&0xffff0000u)*s0.z)+(__uint_as_float(pk.y<<16)*s1.x+__uint_as_float(pk.y&0xffff0000u)*s1.z)
             +(__uint_as_float(pk.z<<16)*s2.x+__uint_as_float(pk.z&0xffff0000u)*s2.z)+(__uint_as_float(pk.w<<16)*s3.x+__uint_as_float(pk.w&0xffff0000u)*s3.z);
        pa[qt][ks]=__builtin_bit_cast(bf16x8,pk); }
    {auto rr=__builtin_amdgcn_permlane32_swap(__float_as_uint(corr),__float_as_uint(corr),false,false);corr=__uint_as_float(rr[0])+__uint_as_float(rr[1]);}
    if(hi==0)wsf[r32]=corr; asm volatile("s_waitcnt lgkmcnt(0)":::"memory");
    const int vb=(int)(lds0+vbase)+((lane>>4)&1)*32+(lane&3)*8+(4*hi+((lane&15)>>2))*64;
    #pragma unroll
    for(int ch=0;ch<2;++ch){
      f32x16 o[2]; o[0]=f32x16{}; o[1]=f32x16{};
      SBAR(); pv(o,vb+ch*8192,pa[0][0],pa[0][1],pa[0][2],pa[0][3]);
      SBAR(); pv(o,vb+(2+ch)*8192,pa[1][0],pa[1][1],pa[1][2],pa[1][3]);
      #pragma unroll
      for(int d0=0;d0<2;++d0){
        #pragma unroll
        for(int r=0;r<16;++r){const int orow=crow(r,hi); stg[orow*MIX_SROW+r32]=o[d0][r]-wsf[orow];}
        asm volatile("s_waitcnt lgkmcnt(0)":::"memory");
        #pragma unroll
        for(int i=0;i<2;++i){const int row=i*16+(lane>>2),c8=(lane&3)*8; const int p=32*pb+row, e=g*128+ch*64+d0*32+c8;
          const f32x4 m0=*(const f32x4*)(stg+row*MIX_SROW+c8), m1=*(const f32x4*)(stg+row*MIX_SROW+c8+4);
          const f32x4 g0=gq[ch][d0][0], g1=gq[ch][d0][1]; const float b=bq[i];
          bf16*up=U+(long)(chunk*128+p)*2048+e; const u32x4 uw=uq[ch][d0][i];
          u32x4 ow;
          ow.x=cvtpk_s(__uint_as_float(uw.x<<16)*(g0.x*m0.x+b),__uint_as_float(uw.x&0xffff0000u)*(g0.y*m0.y+b));
          ow.y=cvtpk_s(__uint_as_float(uw.y<<16)*(g0.z*m0.z+b),__uint_as_float(uw.y&0xffff0000u)*(g0.w*m0.w+b));
          ow.z=cvtpk_s(__uint_as_float(uw.z<<16)*(g1.x*m1.x+b),__uint_as_float(uw.z&0xffff0000u)*(g1.y*m1.y+b));
          ow.w=cvtpk_s(__uint_as_float(uw.w<<16)*(g1.z*m1.z+b),__uint_as_float(uw.w&0xffff0000u)*(g1.w*m1.w+b));
          *(__attribute__((address_space(1))) u32x4*)up=ow; }
        asm volatile("s_waitcnt lgkmcnt(0)":::"memory"); }
    } }
  asm volatile("s_waitcnt lgkmcnt(0)\n\ts_barrier":::"memory");
}
constexpr int ATTN_LDS_BYTES=LDS_BYTES;
#undef SBAR
#undef WAIT_BAR
}

#ifndef LATUNIT
#define LATUNIT attn_body::attn_unit<8, true>
#endif
__device__ __forceinline__ void attn_fast(const Frame& F, const Args& args) {
    typedef attn_body::bf16 abf;
    unsigned char* ws = wsb(args);
    abf* Q = (abf*)(ws + WS_Q); const abf* K = (const abf*)(ws + WS_K);
    const abf* CKp = (const abf*)(ws + WS_CK); const abf* KCp = (const abf*)(ws + WS_KC); const float* rpb = inp(args, I_RPB);
    char* shm = (char*)(unsigned char*)F.lds + RING_OFF;
    const int vcu = (F.G % 8 == 0) ? (F.bid % 8) * (F.G / 8) + F.bid / 8 : F.bid;
    for (int u = vcu; u < 4 * NH * 4; u += F.G) {
        const int b = u >> 6, h = (u >> 2) & 15, qb = u & 3;
        const int wlo = qb < 2 ? 0 : (qb == 2 ? 4 : 8), nwin = (qb == 0 || qb == 3) ? 8 : 12;
        const long qoff = ((long)(NCTX + b * SEQ_L + qb * 256)) * D + h * HD, woff = ((long)(NCTX + b * SEQ_L + wlo * 64)) * D + h * HD, coff = ((long)(b * PAST)) * D + h * HD;
        LATUNIT(F.tid, Q + qoff, CKp + coff, (long)((WS_CV - WS_CK) / 2), 8, K + woff, (long)((WS_V - WS_K) / 2), 8 + nwin, shm, 4 * qb, wlo, rpb + h * 465);
    }
    for (int u = vcu; u < 32 * NH; u += F.G) {
        const int b = u >> 4, h = u & 15;
        const long qoff = ((long)(b * SEQ_C)) * D + h * HD;
        attn_body::attn_unit<8, false>(F.tid, Q + qoff, KCp + qoff, (long)((WS_VC - WS_KC) / 2), 4, KCp + qoff, (long)((WS_VC - WS_KC) / 2), 4, shm, 0, 0, rpb);
    }
    if (F.G % 4 == 0 && (4 * NH * 4) % F.G == 0) { const int qb = vcu & 3;
        if (qb == 0 || qb == 3) p1_sw_items(F, args, SWI_QKV, SWI_QKV + FF2 / 16, ((vcu >> 2) * 2 + (qb == 3)) * NWAVES + F.wave, (F.G / 2) * NWAVES); }
    else p1_sw_items(F, args, SWI_QKV, SWI_QKV + FF2 / 16, F.bid * NWAVES + F.wave, F.G * NWAVES);
}


__device__ __forceinline__ void mix_fast(const Frame& F, const Args& args) {
    typedef attn_body::bf16 abf;
    unsigned char* ws = wsb(args);
    const abf* VV = (const abf*)(ws + WS_VV); abf* U = (abf*)(ws + WS_U); const abf* WSb = (const abf*)(ws + WS_WSB); const float* LNP = (const float*)(ws + WS_LNP);
    const float* gv = inp(args, I_GV); const float* bs = inp(args, I_BSP);
    char* shm = (char*)(unsigned char*)F.lds + RING_OFF;
    const int vcu = (F.G % 8 == 0) ? (F.bid % 8) * (F.G / 8) + F.bid / 8 : F.bid;
    for (int u = 2 * vcu; u < 96 * 16; u += 2 * F.G) attn_body::mix_pair(F.tid, u, u + 1 < 96 * 16 ? u + 1 : -1, VV, U, WSb, LNP, gv, bs, shm);
}
#ifndef ATTN
#define ATTN attn_fast
#endif
#ifndef MIX
#define MIX mix_fast
#endif
enum Steps { S_P0 = 0, S_P1, S_QKV, S_ATT, S_WO, S_UP0, S_DN0, S_IN, S_MIX, S_OUT, S_UP1, S_DN1, NSTEPS };

#ifndef STEPMASK
#define STEPMASK 0xffffffffu
#endif
#define ON(s) ((STEPMASK >> (s)) & 1u)
__device__ __forceinline__ void run_step(const Frame& F0, const Args& args, int s) {
    Frame F = F0; asm volatile("" : "+v"(F.tid)); asm volatile("" : "+s"(F.bid)); asm volatile("" : "+s"(F.G)); F.lane = F.tid & 63; F.wave = __builtin_amdgcn_readfirstlane(F.tid >> 6);
    unsigned char* ws = wsb(args);
    const float* MOD0 = (const float*)(ws + WS_MOD); const float* MOD1 = MOD0 + 5 * 6144;
    float* SW = (float*)(ws + WS_SW);
    float* RS0 = (float*)(ws + WS_RS); float* RS1 = RS0 + (size_t)MT * 4; float* RS2 = RS0 + (size_t)MT * 8; float* RS3 = RS0 + (size_t)MT * 12;
    bf16* AN = (bf16*)(ws + WS_AN);
    if (ON(S_P0) && s == S_P0) {
        for (int u = F.bid; u < ADA_UNITS; u += F.G) p0_adaln_unit(F, args, u);
        const int rot = (F.bid + F.G - ADA_UNITS % F.G) % F.G;
        p0_items(F, args, 0, PI_FIRST, rot * NWAVES + F.wave, F.G * NWAVES); }
    else if (ON(S_P1) && s == S_P1) { p1_sw_items(F, args, 0, SWI_QKV, F.bid * NWAVES + F.wave, F.G * NWAVES); p1_rows(F, args); }
    else if (ON(S_QKV) && s == S_QKV) { float* out = outb(args);
        EpiQKV E{{RS0, SW + SW_QKV, NQKV}, ws};
        int fw = 0, nfw = 1; const bool fil = filler_slot(F, (MT / 256) * (NQKV / 256), fw, nfw), first = fil && (F.bid & 8);
        if (first) { p0_items(F, args, PI_FIRST, PI_SECOND, fw, nfw); __syncthreads(); }
        gemm_pg8<0>(F, AN, (const bf16*)(ws + WS_WQKV), 0, MT, NQKV, D, E);
        if (fil && !first) p0_items(F, args, PI_FIRST, PI_SECOND, fw, nfw); }
    else if (ON(S_ATT) && s == S_ATT) ATTN(F, args);
    else if (ON(S_WO) && s == S_WO) { float* X = outb(args);
        EpiResT<0> E{inp(args, I_XP), inp(args, I_XS), (bf16*)(ws + WS_XB), nullptr, MOD0 + 2048, AN, inp(args, I_NFFN), MOD0 + 4096, RS1, 1.f};
        gemm_pg8<1, EpiResT<0>, 3>(F, (const bf16*)(ws + WS_Q), (const bf16*)(ws + WS_WO), 0, MT, D, D, E);
    }
    else if (ON(S_UP0) && s == S_UP0) { EpiUpConv E{RS1, SW + SW_UP0, inp(args, I_WCONV), inp(args, I_BCONV), (float*)(ws + WS_HALO), (bf16*)(ws + WS_M), (LAS float*)(F.lds + EPI_OFF), F.skip_epi};
        int fw = 0, nfw = 1; const bool fil = filler_slot(F, (MT / 256) * (FF2 / 256), fw, nfw), first = fil && (F.bid & 8);
        if (first) { p0_items(F, args, PI_SECOND, PI_ALL, fw, nfw); sw_units_f32(F, args, fw / NWAVES, nfw / NWAVES); __syncthreads(); }
        gemm_pg8_raw(F, AN, (const bf16*)(ws + WS_WUP), MT, FF2, D, E);
        if (fil && !first) { p0_items(F, args, PI_SECOND, PI_ALL, fw, nfw); sw_units_f32(F, args, fw / NWAVES, nfw / NWAVES); } }
    else if (ON(S_DN0) && s == S_DN0) { float* X = outb(args);
        { pg8::StaticOrder S0; S0.init(MT, D, F.G, F.bid, 192); pg8::Unit u0; for (int i = 0; S0.next(i, u0); ++i) fix_halo_rows(F, u0.pm * 192, u0.pm * 192 + 224, (const float*)(ws + WS_HALO), inp(args, I_WCONV), inp(args, I_BCONV), (bf16*)(ws + WS_M)); }
        EpiResT<1> E{nullptr, nullptr, (bf16*)(ws + WS_XB), nullptr, MOD0 + 5120, AN, inp(args, I_NMIX) + D, MOD1 + 1024, RS2, F.scale};
        gemm_pg8<1, EpiResT<1>, 3>(F, (const bf16*)(ws + WS_M), (const bf16*)(ws + WS_WDN), 0, MT, D, FF, E);
    }
    else if (ON(S_IN) && s == S_IN) { EpiIn E{{RS2, SW + SW_IN, GE2}, (bf16*)(ws + WS_U), (bf16*)(ws + WS_VV), (float*)(ws + WS_LNP)}; gemm_pg8<2>(F, AN, (const bf16*)(ws + WS_WIN), 0, MT, GE2, D, E); }
    else if (ON(S_MIX) && s == S_MIX) MIX(F, args);
    else if (ON(S_OUT) && s == S_OUT) { float* X = outb(args);
        EpiResT<1> E{nullptr, nullptr, (bf16*)(ws + WS_XB), nullptr, MOD1 + 2048, AN, inp(args, I_NFFN) + D, MOD1 + 4096, RS3, F.scale};
        gemm_pg8<1, EpiResT<1>, 3>(F, (const bf16*)(ws + WS_U), (const bf16*)(ws + WS_WOUT), 0, MT, D, GE, E); }
    else if (ON(S_UP1) && s == S_UP1) { EpiUpConv E{RS3, SW + SW_UP1, inp(args, I_WCONV) + (size_t)3 * FF2, inp(args, I_BCONV) + FF2, (float*)(ws + WS_HALO), (bf16*)(ws + WS_M), (LAS float*)(F.lds + EPI_OFF), F.skip_epi};
        int fw = 0, nfw = 1; const bool fil = filler_slot(F, (MT / 256) * (FF2 / 256), fw, nfw), first = fil && (F.bid & 8);
        if (first) state_items(F, args, fw, nfw);
        gemm_pg8_raw(F, AN, (const bf16*)(ws + WS_WUP) + (size_t)FF2 * D, MT, FF2, D, E);
        if (fil && !first) state_items(F, args, fw, nfw); }
    else if (ON(S_DN1) && s == S_DN1) { float* X = outb(args);
        { pg8::StaticOrder S0; S0.init(MT, D, F.G, F.bid, 192); pg8::Unit u0; for (int i = 0; S0.next(i, u0); ++i) fix_halo_rows(F, u0.pm * 192, u0.pm * 192 + 224, (const float*)(ws + WS_HALO), inp(args, I_WCONV) + (size_t)3 * FF2, inp(args, I_BCONV) + FF2, (bf16*)(ws + WS_M)); }
        EpiFinal E{(const bf16*)(ws + WS_XB), X, MOD1 + 5120, inp(args, I_NFIN), RS0 + (size_t)MT * 16, (unsigned*)ws + CW_CNT, (unsigned*)ws + CW_TMO, F.scale};
        gemm_pg8<1, EpiFinal, 3>(F, (const bf16*)(ws + WS_M), (const bf16*)(ws + WS_WDN) + (size_t)D * FF, 0, MT, D, FF, E); }
}

__global__ void __launch_bounds__(NWAVES * 64, 2) mk_fwd(Args args) {
    extern __shared__ __attribute__((aligned(16))) unsigned char lds[];
    Frame F;
    F.lds = (LAS unsigned char*)lds;
    F.MISC = (volatile LAS unsigned*)(F.lds + MISC_OFF);
    F.tid = threadIdx.x; F.lane = F.tid & 63; F.wave = __builtin_amdgcn_readfirstlane(F.tid >> 6);
    F.G = gridDim.x; F.bid = blockIdx.x; F.scale = 1.f; F.skip_epi = false;
    for (int u = F.tid; u < (LDS_BYTES - LDSCTL_OFF) / 4; u += NWAVES * 64) ((LAS unsigned*)(F.lds + LDSCTL_OFF))[u] = 0u;
    __syncthreads();
    XcdBarrier bar = xcd_barrier_post((unsigned*)(args.ws + WS_CTL) + CW_BAR, F.MISC + 8);
    for (int q = 0; q < args.nseq; ++q) {
        const int sq = args.seq[q]; F.scale = (sq & 32) ? 0.f : 1.f; F.skip_epi = (sq & 64) != 0;
        run_step(F, args, sq & 31);
        if (q + 1 < args.nseq) xcd_barrier(bar);
    }
}

extern "C" void kernel_launch(void* const* d_in, const int* in_sizes, int n_in, void* d_out, int out_size, void* d_ws, size_t ws_size, hipStream_t stream) {
    static int grid = 0;
    if (grid == 0) {
        if (n_in != 23 || ws_size < WS_END) { fprintf(stderr, "kernel_launch: unexpected n_in %d / ws %zu\n", n_in, ws_size); grid = -1; return; }
        int dev = 0, cus = 0, per_cu = 0;
        if (hipGetDevice(&dev) != hipSuccess || hipDeviceGetAttribute(&cus, hipDeviceAttributeMultiprocessorCount, dev) != hipSuccess) { grid = -1; return; }
        if (hipFuncSetAttribute((const void*)mk_fwd, hipFuncAttributeMaxDynamicSharedMemorySize, LDS_BYTES) != hipSuccess) { fprintf(stderr, "kernel_launch: hipFuncSetAttribute failed\n"); grid = -1; return; }
        if (hipOccupancyMaxActiveBlocksPerMultiprocessor(&per_cu, (const void*)mk_fwd, NWAVES * 64, LDS_BYTES) != hipSuccess || per_cu < 1) { fprintf(stderr, "kernel_launch: occupancy query says %d blocks per CU\n", per_cu); per_cu = 1; }
        (void)hipGetLastError();
        grid = cus;
    }
    if (grid < 0) return;
    if (hipMemsetAsync((char*)d_ws + WS_CTL, 0, CTL_ZERO_BYTES, stream) != hipSuccess) { fprintf(stderr, "kernel_launch: memset failed\n"); return; }
    Args a{};
    for (int i = 0; i < 23; ++i) a.in[i] = (const float*)d_in[i];
    a.out = (float*)d_out; a.ws = (unsigned char*)d_ws;
#ifndef DUP_FLAGS
#define DUP_FLAGS 0
#endif
#ifndef DUP_STEP
    a.nseq = NSTEPS; for (int s = 0; s < NSTEPS; ++s) a.seq[s] = (unsigned char)s;
#else
#ifndef DUP_STEP_HI
#define DUP_STEP_HI DUP_STEP
#endif
    a.nseq = 0; for (int s = 0; s < NSTEPS; ++s) { a.seq[a.nseq++] = (unsigned char)s; if (s == DUP_STEP_HI) for (int r = DUP_STEP; r <= DUP_STEP_HI; ++r) a.seq[a.nseq++] = (unsigned char)(r | 32 | DUP_FLAGS); }
#endif
    hipLaunchKernelGGL(mk_fwd, dim3(grid), dim3(NWAVES * 64), LDS_BYTES, stream, a);
    const hipError_t le = hipPeekAtLastError();
    if (le != hipSuccess) fprintf(stderr, "kernel_launch: launch failed: %s\n", hipGetErrorName(le));
}
```

```cpp
#include <hip/hip_runtime.h>
#include <cstdio>
#include <cstdint>
#include <type_traits>


#define GAS __attribute__((address_space(1)))
#define LAS __attribute__((address_space(3)))
typedef unsigned short bf16;
typedef short bf16x8 __attribute__((ext_vector_type(8)));
typedef float f32x4 __attribute__((ext_vector_type(4)));
typedef float f32x2 __attribute__((ext_vector_type(2)));
typedef unsigned u32x4 __attribute__((ext_vector_type(4)));
typedef unsigned u32x2 __attribute__((ext_vector_type(2)));
typedef GAS unsigned gu32;

constexpr int D = 1024, NCTX = 8192, NLAT = 4096, MT = 12288, NH = 16, HD = 64, FF = 2816, FF2 = 5632, GE = 2048, GE2 = 4096, NQKV = 3072;
constexpr int SEQ_C = 256, SEQ_L = 1024, PAST = 512;
constexpr float EPS = 1e-6f, LOG2E = 1.4426950408889634f, C2 = 0.125f * 1.4426950408889634f;
constexpr int NWAVES = 8;

constexpr size_t MiB = 1u << 20;
constexpr size_t WS_CTL = 0, CTL_ZERO_BYTES = 1 * MiB + 512 * 1024;
constexpr size_t WS_MOD = 512 * 1024;
constexpr size_t WS_TS = 800 * 1024;
constexpr size_t WS_SW = 1 * MiB;
constexpr size_t WS_HALO = 1 * MiB + 512 * 1024;
constexpr size_t WS_RS = 3 * MiB;
constexpr size_t WS_LNP = 4 * MiB;
constexpr size_t WS_WQKV = 5 * MiB, WS_WO = 11 * MiB, WS_WIN = 13 * MiB, WS_WOUT = 21 * MiB, WS_WUP = 25 * MiB, WS_WDN = 47 * MiB;
constexpr size_t WUP_BYTES = 11 * MiB, WDN_BYTES = (size_t)1024 * 2816 * 2;
constexpr size_t WS_WSB = 58 * MiB;
constexpr size_t WS_CK = 59 * MiB, WS_CV = 63 * MiB;
constexpr size_t WS_AN = 67 * MiB;
constexpr size_t WS_BIG = 91 * MiB;
constexpr size_t WS_Q = WS_BIG, WS_K = WS_BIG + 24 * MiB, WS_V = WS_BIG + 48 * MiB;
constexpr size_t WS_M = WS_BIG, WS_ARAW = WS_BIG + 66 * MiB;
constexpr size_t WS_U = WS_BIG, WS_VV = WS_BIG + 48 * MiB;
constexpr size_t WS_XB = 200 * MiB;
constexpr size_t WS_KC = 224 * MiB, WS_VC = 240 * MiB;
constexpr size_t WS_END = 256 * MiB;
static_assert(WS_HALO + (size_t)16 * 4 * 5632 * 4 <= WS_RS && WS_SW + 5 * (3072 + 5632 + 4096 + 5632) * 4 <= CTL_ZERO_BYTES, "zeroed region / halo");
static_assert(WS_ARAW + (size_t)4096 * 5632 * 2 <= WS_END && WS_WDN + 2 * WDN_BYTES <= WS_CK && WS_VV + 48 * MiB <= WS_END, "ws map");
constexpr int SW_QKV = 0, SW_UP0 = 5 * NQKV, SW_IN = SW_UP0 + 5 * FF2, SW_UP1 = SW_IN + 5 * GE2;
constexpr int CW_TMO = 0, CW_CODE = 1, CW_BAR = 4096;

#define RLX_AGENT __ATOMIC_RELAXED, __HIP_MEMORY_SCOPE_AGENT
#define LDS_WAIT() asm volatile("s_waitcnt lgkmcnt(0)" ::: "memory")
#define VM_WAIT() asm volatile("s_waitcnt vmcnt(0)" ::: "memory")
__device__ __forceinline__ unsigned cvt_pk_bf16(float lo, float hi) { unsigned r; asm volatile("v_cvt_pk_bf16_f32 %0, %1, %2" : "=v"(r) : "v"(lo), "v"(hi)); return r; }
__device__ __forceinline__ float bf2f(unsigned short u) { return __uint_as_float((unsigned)u << 16); }
__device__ __forceinline__ float bflo(unsigned w) { return __uint_as_float(w << 16); }
__device__ __forceinline__ float bfhi(unsigned w) { return __uint_as_float(w & 0xffff0000u); }
__device__ __forceinline__ u32x4 pack8(f32x4 a, f32x4 b) { u32x4 w; w.x = cvt_pk_bf16(a[0], a[1]); w.y = cvt_pk_bf16(a[2], a[3]); w.z = cvt_pk_bf16(b[0], b[1]); w.w = cvt_pk_bf16(b[2], b[3]); return w; }
__device__ __forceinline__ float wave_sum(float v) {
#pragma unroll
    for (int o = 1; o < 64; o <<= 1) v += __shfl_xor(v, o);
    return v;
}
__device__ __forceinline__ float silu_f(float x) { return x * __builtin_amdgcn_rcpf(1.f + __builtin_amdgcn_exp2f(-x * LOG2E)); }
__device__ __forceinline__ float gelu_tanh_f(float x) { const float u = (-1.5957691216057308f * LOG2E) * (x + 0.044715f * x * x * x); return x * __builtin_amdgcn_rcpf(1.f + __builtin_amdgcn_exp2f(u)); }
__device__ __forceinline__ int ci_of(int row) { return row < NCTX ? 0 : 1 + ((row - NCTX) >> 10); }


__device__ __forceinline__ void st4f_wt(float* p, float v) { __hip_atomic_store((unsigned*)p, __float_as_uint(v), __ATOMIC_RELAXED, __HIP_MEMORY_SCOPE_AGENT); }
__device__ __forceinline__ void wave_publish(unsigned* cnt) {
    asm volatile("s_waitcnt vmcnt(0)" ::: "memory");
    if ((threadIdx.x & 63) == 0) __hip_atomic_fetch_add(cnt, 1u, __ATOMIC_RELAXED, __HIP_MEMORY_SCOPE_AGENT);
}
__device__ __forceinline__ void wave_wait_ge(unsigned* cnt, unsigned need, unsigned* tmo) {
    unsigned sp = 0;
    while ((unsigned)__builtin_amdgcn_readfirstlane(__hip_atomic_load(cnt, __ATOMIC_RELAXED, __HIP_MEMORY_SCOPE_AGENT)) < need) {
        __builtin_amdgcn_s_sleep(2);
        if (++sp > (1u << 22)) { if ((threadIdx.x & 63) == 0) __hip_atomic_store(tmo, 1u, __ATOMIC_RELAXED, __HIP_MEMORY_SCOPE_AGENT); break; } }
}
constexpr int CW_CNT = 16384;
#define XB_TMO      128
#define XB_XCNT(j)  (256  + 64 * (j))
#define XB_XSUB(j)  (1280 + 64 * (j))
#define XB_XGEN(j)  (2304 + 64 * (j))
#define XB_TOP      3328
#define XB_TOPGEN   3392
#define XCD_BAR_WORDS 3456
#define XB_SPIN_CAP (1u << 18)
__device__ __forceinline__ unsigned xb_ld(unsigned* p)              { return __hip_atomic_load(p, __ATOMIC_RELAXED, __HIP_MEMORY_SCOPE_AGENT); }
__device__ __forceinline__ unsigned xb_add(unsigned* p, unsigned v) { return __hip_atomic_fetch_add(p, v, __ATOMIC_RELAXED, __HIP_MEMORY_SCOPE_AGENT); }
__device__ __forceinline__ unsigned xb_xcc_id() { return (unsigned)__builtin_amdgcn_s_getreg((3 << 11) | 20) & 0xFu; }
#define XB_SPIN(cond, bar) do { unsigned _sp = 0; while (cond) { __builtin_amdgcn_s_sleep(1); \
    if ((++_sp & 255u) == 0u) { if (xb_ld(&(bar)[XB_TMO])) break; if (_sp > XB_SPIN_CAP) { atomicAdd(&(bar)[XB_TMO], 1u); break; } } } } while (0)
struct XcdBarrier { unsigned* bar; unsigned x; volatile LAS unsigned* st; };
__device__ __forceinline__ XcdBarrier xcd_barrier_post(unsigned* bar, volatile LAS unsigned* st) {
    XcdBarrier b; b.bar = bar; b.x = xb_xcc_id(); b.st = st;
    if (threadIdx.x == 0) (void)xb_add(&bar[XB_XCNT(b.x)], 1u);
    return b;
}
__device__ __forceinline__ void xcd_barrier_complete(unsigned* bar, unsigned x, unsigned& nloc, unsigned& nx) {
    const unsigned G = gridDim.x * gridDim.y * gridDim.z;
    unsigned sum, cnt, mine, sp = 0u;
    for (;;) {
        sum = 0u; cnt = 0u; mine = 0u;
#pragma unroll
        for (unsigned j = 0; j < 16; ++j) { const unsigned c = xb_ld(&bar[XB_XCNT(j)]); sum += c; cnt += (c > 0u) ? 1u : 0u; mine = (j == x) ? c : mine; }
        if (sum == G) break;
        __builtin_amdgcn_s_sleep(1);
        if ((++sp & 255u) == 0u) { if (xb_ld(&bar[XB_TMO])) break; if (sp > XB_SPIN_CAP) { atomicAdd(&bar[XB_TMO], 1u); break; } }
    }
    nloc = mine > 0u ? mine : 1u; nx = cnt > 0u ? cnt : 1u;
}
__device__ __forceinline__ void xcd_barrier(const XcdBarrier& b) {
    asm volatile("s_waitcnt vmcnt(0)" ::: "memory");
    __syncthreads();
    if (threadIdx.x == 0) {
        unsigned* bar = b.bar;
        __builtin_amdgcn_s_waitcnt(0);
        unsigned nloc = b.st[0], nx = b.st[1];
        if (nloc == 0u) { xcd_barrier_complete(bar, b.x, nloc, nx); b.st[0] = nloc; b.st[1] = nx; }
        const unsigned old = xb_add(&bar[XB_XSUB(b.x)], 1u);
        const unsigned gen = old / nloc;
        if (old + 1u == (gen + 1u) * nloc) {
            __builtin_amdgcn_fence(__ATOMIC_RELEASE, "agent");
            asm volatile("s_waitcnt vmcnt(0)" ::: "memory");
            const unsigned og = xb_add(&bar[XB_TOP], 1u);
            const unsigned tg = og / nx;
            if (og + 1u == (tg + 1u) * nx) xb_add(&bar[XB_TOPGEN], 1u);
            else XB_SPIN(xb_ld(&bar[XB_TOPGEN]) == tg, bar);
            __builtin_amdgcn_fence(__ATOMIC_ACQUIRE, "agent");
            xb_add(&bar[XB_XGEN(b.x)], 1u);
            asm volatile("s_waitcnt vmcnt(0)" ::: "memory");
        } else {
            XB_SPIN(xb_ld(&bar[XB_XGEN(b.x)]) == gen, bar);
            __builtin_amdgcn_fence(__ATOMIC_ACQUIRE, "agent");
            asm volatile("s_waitcnt vmcnt(0)" ::: "memory");
        }
    }
    __syncthreads();
}

constexpr int RING_OFF = 0, RING_BYTES = 131072;
constexpr int LDSCTL_OFF = RING_BYTES, MISC_OFF = LDSCTL_OFF + 320;
constexpr int LDS_BYTES = 147456;

struct Frame {
    LAS unsigned char* lds;
    volatile LAS unsigned* MISC;
    int tid, lane, wave, G, bid;
    bool skip_epi;
    float scale;
};
struct Args { const float* in[23]; float* out; unsigned char* ws; int nseq, pad; unsigned char seq[32]; };
#define ASSUME_GLOBAL(p) __builtin_assume(!__builtin_amdgcn_is_shared((const void*)(p)) && !__builtin_amdgcn_is_private((const void*)(p)))
__device__ __forceinline__ const float* inp(const Args& a, int i) { asm volatile("" : "+s"(i)); const float* p = a.in[i]; return (const float*)(const GAS float*)p; }
__device__ __forceinline__ unsigned char* wsb(const Args& a) { unsigned char* p = a.ws; asm volatile("" : "+s"(p)); return (unsigned char*)(GAS unsigned char*)p; }
__device__ __forceinline__ float* outb(const Args& a) { float* p = a.out; asm volatile("" : "+s"(p)); return (float*)(GAS float*)p; }
enum InIdx { I_XP = 0, I_XS, I_CK, I_CV, I_C, I_CCTX, I_WADA, I_BADA, I_NMIX, I_NFFN, I_NFIN, I_WQKV, I_WO, I_RPB, I_WIN, I_GV, I_WSP, I_BSP, I_WOUT, I_WUP, I_WCONV, I_BCONV, I_WDN };


#define G_LD4(p)   (*(const GAS f32x4*)(p))
#define G_LDU4(p)  (*(const GAS u32x4*)(p))
#define G_ST4(p,v) (*(GAS f32x4*)(p) = (v))
#define G_STU4(p,v) (*(GAS u32x4*)(p) = (v))

__device__ __forceinline__ int upmap(int n) { return n < FF ? ((n >> 7) << 8) + (n & 127) : (((n - FF) >> 7) << 8) + 128 + ((n - FF) & 127); }
constexpr int ADA_UNITS = 2 * 24 * 4;
__device__ __forceinline__ void p0_adaln_unit(const Frame& F, const Args& args, int u) {
    const float* w_ada = inp(args, I_WADA); const float* c_ctx = inp(args, I_CCTX); const float* cc = inp(args, I_C);
    float* MOD = (float*)(wsb(args) + WS_MOD);
    const int jb = u % 24, kq = (u / 24) & 3, l = u / 96;
    const int k0 = kq * 256 + F.wave * 32;
    const float* W = w_ada + ((size_t)l * D + k0) * 6144 + jb * 256 + F.lane * 4;
    f32x4 acc[5];
#pragma unroll
    for (int q = 0; q < 5; ++q) acc[q] = (f32x4){0.f, 0.f, 0.f, 0.f};
    for (int i0 = 0; i0 < 32; i0 += 16) {
        f32x4 w[16];
#pragma unroll
        for (int i = 0; i < 16; ++i) w[i] = G_LD4(W + (size_t)(i0 + i) * 6144);
#pragma unroll
        for (int i = 0; i < 16; ++i) { const int k = k0 + i0 + i;
            acc[0] += silu_f(c_ctx[k]) * w[i];
#pragma unroll
            for (int b = 0; b < 4; ++b) acc[1 + b] += silu_f(cc[b * D + k]) * w[i]; }
    }
    LAS f32x4* red = (LAS f32x4*)(F.lds + RING_OFF);
#pragma unroll
    for (int q = 0; q < 5; ++q) red[(F.wave * 5 + q) * 64 + F.lane] = acc[q];
    __syncthreads();
    const LAS float* redf = (const LAS float*)red;
    for (int o = F.tid; o < 5 * 256; o += NWAVES * 64) { const int q = o >> 8, c = o & 255;
        float s = 0.f;
#pragma unroll
        for (int w = 0; w < NWAVES; ++w) s += redf[(w * 5 + q) * 256 + c];
        if (kq == 0) s += inp(args, I_BADA)[l * 6144 + jb * 256 + c];
        atomicAdd(MOD + (size_t)(l * 5 + q) * 6144 + jb * 256 + c, s * F.scale); }
    __syncthreads();
}
constexpr int PI_QKV = (D / 64) * (NQKV / 32), PI_FIRST = PI_QKV;
constexpr int PI_CACHE = 4096, PI_WSP = 512, PI_O = (D / 64) * (D / 32), PI_IN = (D / 64) * (GE2 / 32), PI_OUT = (GE / 64) * (D / 32), PI_UP = (D / 64) * (FF2 / 32), PI_DN = (FF / 64) * (D / 32);
constexpr int PI_SECOND = PI_FIRST + PI_CACHE + PI_WSP + PI_O + PI_UP + PI_DN, PI_ALL = PI_SECOND + PI_UP + PI_DN + PI_IN + PI_OUT;
__device__ __forceinline__ void p0_transpose_seg(const float* W, int K, int N, bf16* WT, bool upperm, LAS float* scr, int it, int end, int stride, int lane) {
    if (it >= end) return;
    const int nblk = N / 32;
    f32x4 v[8];
    { const int k0 = 64 * (it / nblk), n0 = 32 * (it % nblk);
#pragma unroll
      for (int i = 0; i < 8; ++i) v[i] = G_LD4(W + (size_t)(k0 + 8 * i + (lane >> 3)) * N + n0 + 4 * (lane & 7)); }
    for (; it < end; it += stride) {
        const int k0 = 64 * (it / nblk), n0 = 32 * (it % nblk), nm0 = upperm ? upmap(n0) : n0;
#pragma unroll
        for (int i = 0; i < 8; ++i) { LAS float* d = scr + (8 * i + (lane >> 3)) * 33 + 4 * (lane & 7); d[0] = v[i].x; d[1] = v[i].y; d[2] = v[i].z; d[3] = v[i].w; }
        const int itn = it + stride;
        if (itn < end) { const int k1 = 64 * (itn / nblk), n1 = 32 * (itn % nblk);
#pragma unroll
            for (int i = 0; i < 8; ++i) v[i] = G_LD4(W + (size_t)(k1 + 8 * i + (lane >> 3)) * N + n1 + 4 * (lane & 7)); }
        LDS_WAIT(); asm volatile("" ::: "memory");
        const int c = lane & 7;
#pragma unroll
        for (int j = 0; j < 4; ++j) { const int n = (lane >> 3) + 8 * j; const LAS float* s = scr + (8 * c) * 33 + n;
            u32x4 o; o.x = cvt_pk_bf16(s[0 * 33], s[1 * 33]); o.y = cvt_pk_bf16(s[2 * 33], s[3 * 33]); o.z = cvt_pk_bf16(s[4 * 33], s[5 * 33]); o.w = cvt_pk_bf16(s[6 * 33], s[7 * 33]);
            G_STU4(WT + (size_t)(nm0 + n) * K + k0 + 8 * c, o); }
        LDS_WAIT(); asm volatile("" ::: "memory");
    }
}
__device__ __forceinline__ void p0_cache_seg(const Args& args, int it, int end, int stride, int lane) {
    if (it >= end) return;
    f32x4 a[4];
    { const int which = it >> 11, r = it & 2047, cg = r & 31, h = (r >> 5) & 15, b = r >> 9;
      const float* s = inp(args, which ? I_CV : I_CK) + (((size_t)b * NH + h) * PAST + cg * 16 + (lane >> 2)) * HD + (lane & 3) * 16;
#pragma unroll
      for (int i = 0; i < 4; ++i) a[i] = G_LD4(s + 4 * i); }
    for (; it < end; it += stride) {
        const int which = it >> 11, r = it & 2047, cg = r & 31, h = (r >> 5) & 15, b = r >> 9;
        bf16* d = (bf16*)(wsb(args) + (which ? WS_CV : WS_CK)) + ((size_t)b * PAST + cg * 16 + (lane >> 2)) * D + h * HD + (lane & 3) * 16;
        const u32x4 o0 = pack8(a[0], a[1]), o1 = pack8(a[2], a[3]);
        const int itn = it + stride;
        if (itn < end) { const int w1 = itn >> 11, r1 = itn & 2047, cg1 = r1 & 31, h1 = (r1 >> 5) & 15, b1 = r1 >> 9;
            const float* s = inp(args, w1 ? I_CV : I_CK) + (((size_t)b1 * NH + h1) * PAST + cg1 * 16 + (lane >> 2)) * HD + (lane & 3) * 16;
#pragma unroll
            for (int i = 0; i < 4; ++i) a[i] = G_LD4(s + 4 * i); }
        G_STU4(d, o0); G_STU4(d + 8, o1);
    }
}
__device__ __forceinline__ int first_from(int start, int stride, int s0) { return start >= s0 ? start : start + (s0 - start + stride - 1) / stride * stride; }
__device__ __forceinline__ void p0_items(const Frame& F, const Args& args, int lo, int hi, int fw, int nfw) {
    LAS float* scr = (LAS float*)(F.lds + RING_OFF + F.wave * 16384);
    unsigned char* ws = wsb(args);
    int base = 0;
#define P0_SEG(n, s0v, itv, endv) const int s0v = base; base += (n); const int endv = (hi < base ? hi : base) - s0v, itv = first_from(lo + fw, nfw, s0v) - s0v;
    { P0_SEG(PI_QKV, s0, it, end) p0_transpose_seg(inp(args, I_WQKV), D, NQKV, (bf16*)(ws + WS_WQKV), false, scr, it, end, nfw, F.lane); }
    if (hi <= base) return;
    { P0_SEG(PI_CACHE, s0, it, end) p0_cache_seg(args, it, end, nfw, F.lane); }
    { P0_SEG(PI_WSP, s0, it, end) for (int r = it; r < end; r += nfw) { const float* s = inp(args, I_WSP) + (size_t)r * 512 + F.lane * 8; const f32x4 a0 = *(const f32x4*)s, a1 = *(const f32x4*)(s + 4); *(u32x4*)((bf16*)(ws + WS_WSB) + (size_t)r * 512 + F.lane * 8) = pack8(a0, a1); } }
    { P0_SEG(PI_O, s0, it, end) p0_transpose_seg(inp(args, I_WO), D, D, (bf16*)(ws + WS_WO), false, scr, it, end, nfw, F.lane); }
    { P0_SEG(PI_UP, s0, it, end) p0_transpose_seg(inp(args, I_WUP), D, FF2, (bf16*)(ws + WS_WUP), true, scr, it, end, nfw, F.lane); }
    { P0_SEG(PI_DN, s0, it, end) p0_transpose_seg(inp(args, I_WDN), FF, D, (bf16*)(ws + WS_WDN), false, scr, it, end, nfw, F.lane); }
    if (hi <= base) return;
    { P0_SEG(PI_UP, s0, it, end) p0_transpose_seg(inp(args, I_WUP) + (size_t)D * FF2, D, FF2, (bf16*)(ws + WS_WUP) + (size_t)FF2 * D, true, scr, it, end, nfw, F.lane); }
    { P0_SEG(PI_DN, s0, it, end) p0_transpose_seg(inp(args, I_WDN) + (size_t)FF * D, FF, D, (bf16*)(ws + WS_WDN) + (size_t)D * FF, false, scr, it, end, nfw, F.lane); }
    { P0_SEG(PI_IN, s0, it, end) p0_transpose_seg(inp(args, I_WIN), D, GE2, (bf16*)(ws + WS_WIN), false, scr, it, end, nfw, F.lane); }
    { P0_SEG(PI_OUT, s0, it, end) p0_transpose_seg(inp(args, I_WOUT), GE, D, (bf16*)(ws + WS_WOUT), false, scr, it, end, nfw, F.lane); }
#undef P0_SEG
}
constexpr int ST_ITEMS = 2 * 32 * NH * (SEQ_C / 16);
__device__ __forceinline__ void state_items(const Frame& F, const Args& args, int fw, int nfw) {
    unsigned char* ws = wsb(args); float* out = outb(args);
    for (int it = fw; it < ST_ITEMS; it += nfw) {
        const int tg = it & 15, h = (it >> 4) & 15, b = (it >> 8) & 31, which = it >> 13;
        const bf16* src = (const bf16*)(ws + (which ? WS_VC : WS_KC)) + (size_t)(b * SEQ_C + tg * 16 + (F.lane >> 2)) * D + h * HD + (F.lane & 3) * 16;
        const u32x4 w0 = G_LDU4(src), w1 = G_LDU4(src + 8);
        float* dst = out + (size_t)MT * D + (size_t)which * NCTX * D + (((size_t)b * NH + h) * SEQ_C + tg * 16 + (F.lane >> 2)) * HD + (F.lane & 3) * 16;
        f32x4 o0, o1, o2, o3;
        o0.x = bflo(w0.x); o0.y = bfhi(w0.x); o0.z = bflo(w0.y); o0.w = bfhi(w0.y); o1.x = bflo(w0.z); o1.y = bfhi(w0.z); o1.z = bflo(w0.w); o1.w = bfhi(w0.w);
        o2.x = bflo(w1.x); o2.y = bfhi(w1.x); o2.z = bflo(w1.y); o2.w = bfhi(w1.y); o3.x = bflo(w1.z); o3.y = bfhi(w1.z); o3.z = bflo(w1.w); o3.w = bfhi(w1.w);
        G_ST4(dst, o0); G_ST4(dst + 4, o1); G_ST4(dst + 8, o2); G_ST4(dst + 12, o3);
    }
}
__device__ __forceinline__ bool filler_slot(const Frame& F, int nunits, int& fw, int& nfw) {
    const int rem = nunits % F.G, first = rem, nblk = F.G - rem;
    if (F.bid < first) return false;
    fw = (F.bid - first) * NWAVES + F.wave; nfw = nblk * NWAVES; return true;
}

constexpr int SWI_QKV_C = NQKV / 16;
__device__ __forceinline__ void p1_rows(const Frame& F, const Args& args) {
    const int gw = F.bid * NWAVES + F.wave, NGW = F.G * NWAVES, lane = F.lane;
    const float* xp = inp(args, I_XP); const float* xs = inp(args, I_XS); const float* gmix = inp(args, I_NMIX);
    unsigned char* ws = wsb(args);
    const float* MOD = (const float*)(ws + WS_MOD); float* RS = (float*)(ws + WS_RS); bf16* AN = (bf16*)(ws + WS_AN);
    const int nshort = NGW > 2 * SWI_QKV_C ? SWI_QKV_C : 0; const bool busy = gw < nshort;
    int m = busy ? gw : 3 * nshort + (gw - nshort); const int mstep = busy ? nshort : NGW - nshort, mend = busy ? 3 * nshort : MT;
    f32x4 g[4], v[4];
#pragma unroll
    for (int j = 0; j < 4; ++j) g[j] = G_LD4(gmix + 4 * lane + 256 * j);
    if (m < mend) { const float* xr = (m < NCTX) ? xp + (size_t)m * D : xs + (size_t)(m - NCTX) * D;
#pragma unroll
        for (int j = 0; j < 4; ++j) v[j] = G_LD4((const f32x4*)xr + lane + 64 * j); }
    for (; m < mend; m += mstep) {
        const float* sc = MOD + (size_t)ci_of(m) * 6144 + 1024;
        f32x4 cs[4], vn[4];
#pragma unroll
        for (int j = 0; j < 4; ++j) cs[j] = G_LD4(sc + 4 * lane + 256 * j);
        const int mn = m + mstep;
        if (mn < mend) { const float* xr = (mn < NCTX) ? xp + (size_t)mn * D : xs + (size_t)(mn - NCTX) * D;
#pragma unroll
            for (int j = 0; j < 4; ++j) vn[j] = G_LD4((const f32x4*)xr + lane + 64 * j); }
        float s = 0.f;
#pragma unroll
        for (int j = 0; j < 4; ++j) s += (v[j].x * v[j].x + v[j].y * v[j].y) + (v[j].z * v[j].z + v[j].w * v[j].w);
        s = wave_sum(s);
        if (lane == 0) G_ST4(RS + (size_t)m * 4, ((f32x4){s, 0.f, 0.f, 0.f}));
#pragma unroll
        for (int j = 0; j < 4; ++j) { const int col = 4 * lane + 256 * j;
            const f32x4 o = v[j] * g[j] * (1.f + cs[j]);
            u32x2 w; w.x = cvt_pk_bf16(o[0], o[1]); w.y = cvt_pk_bf16(o[2], o[3]);
            *(GAS u32x2*)(AN + (size_t)m * D + col) = w; }
#pragma unroll
        for (int j = 0; j < 4; ++j) v[j] = vn[j];
    }
}
namespace pg8 {
#define PG8_LAS __attribute__((address_space(3)))
typedef unsigned short bf16_t;
typedef short bf16x8 __attribute__((ext_vector_type(8)));
typedef float f32x4 __attribute__((ext_vector_type(4)));
typedef unsigned u32x4 __attribute__((ext_vector_type(4)));
constexpr int BM = 256, BK = 64, HALF = 128, HTB = HALF * BK * 2  , STAGE_BYTES = 8 * HTB, NXCD = 8, WGM = 8;

__host__ __device__ __forceinline__ int lds_byte(int r, int c) { const int st = (r >> 4) * 2 + (c >> 5), rr = r & 15, cc = c & 31, ob = rr * 64 + cc * 2; return st * 1024 + (ob ^ (((ob >> 9) & 1) << 5)); }
__host__ __device__ __forceinline__ void stage_rc(int b, int& R, int& C) { const int st = b / 1024, sb = b % 1024, swz = sb ^ (((sb >> 9) & 1) << 5); R = (st >> 1) * 16 + swz / 64; C = (st & 1) * 32 + (swz % 64) / 2; }
__host__ __device__ __forceinline__ int perm32(int rho) { const int n = rho >> 4, i = rho & 15; return 8 * (i >> 2) + 4 * n + (i & 3); }

struct Unit { int pm, pn; };
struct Gemm { const bf16_t* A; const bf16_t* Bt; int M, N, K; };

struct StaticOrder {
    int nM, nN, nwg, G, c;
    __host__ __device__ void init(int M, int N, int G_, int c_, int bmr = BM) { nM = M / bmr; nN = N / BM; nwg = nM * nN; G = G_; c = c_; }
    __host__ __device__ bool next(int i, Unit& u) const {
        const long L = (long)i * G + c; if (L >= nwg) return false;
        int wgid = (int)L; { const int q = nwg / NXCD, r = nwg % NXCD, xcd = wgid % NXCD, off = wgid / NXCD; wgid = (xcd < r ? xcd * (q + 1) : r * (q + 1) + (xcd - r) * q) + off; }
        const int nig = WGM * nN, gid = wgid / nig, fm = gid * WGM, gsz = (nM - fm) < WGM ? (nM - fm) : WGM;
        u.pm = fm + ((wgid % nig) % gsz); u.pn = (wgid % nig) / gsz; return true;
    }
    __device__ __forceinline__ void a_ready(const Unit&) const {}
    __device__ __forceinline__ void done(const Unit&) const {}
};

template <class E> struct epi_is_final { static constexpr bool value = false; };
template <class E, int NRED, int MB = 4> struct EpiAdapt {
    static constexpr bool PERM = true, AFTER_DRAIN = false; static constexpr int BMR = 64 * MB;
    __device__ __forceinline__ void fused(f32x4 (&acc)[2][2][MB][2], const Unit& u, int wr, int wc, int fr, int fq, PG8_LAS unsigned char*, int, int) const { (*this)(acc, u, wr, wc, fr, fq); }
    E e; int row0; PG8_LAS float* P; bool skip;
    __device__ __forceinline__ void operator()(f32x4 (&acc)[2][2][MB][2], const Unit& u, int wr, int wc, int fr, int fq) const {
        if (skip) return;
        asm volatile("" : "+v"(fr), "+v"(fq));
        const int rl = wr * 16 * MB + fr, rbase = row0 + u.pm * BMR + rl, cbase = u.pn * BM + wc * 32 + 8 * fq;
        float red[2][MB][NRED > 0 ? NRED : 1];
#pragma unroll
        for (int ai = 0; ai < 2; ++ai)
#pragma unroll
            for (int m = 0; m < MB; ++m)
#pragma unroll
                for (int k = 0; k < (NRED > 0 ? NRED : 1); ++k) red[ai][m][k] = 0.f;
        if constexpr (E::HAS_LIN) {
            static_assert(MB == 4, "HAS_LIN epilogues run on 256-row tiles");
            f32x4 p[2][MB], sw[2][2];
#pragma unroll
            for (int ai = 0; ai < 2; ++ai)
#pragma unroll
                for (int m = 0; m < MB; ++m) p[ai][m] = G_LD4(e.L.RS + (size_t)(rbase + ai * (BMR / 2) + m * 16) * 4);
            { const float* s = e.L.SW + (size_t)ci_of(row0 + u.pm * BMR) * e.L.N + cbase;
#pragma unroll
              for (int bj = 0; bj < 2; ++bj) { sw[bj][0] = G_LD4(s + bj * HALF); sw[bj][1] = G_LD4(s + bj * HALF + 4); } }
            __builtin_amdgcn_sched_barrier(0);
#pragma unroll
            for (int ai = 0; ai < 2; ++ai)
#pragma unroll
                for (int m = 0; m < MB; ++m) { const f32x4 q = p[ai][m];
                    const float r = __builtin_amdgcn_rsqf(((q.x + q.y) + (q.z + q.w)) * (1.f / D) + EPS);
#pragma unroll
                    for (int bj = 0; bj < 2; ++bj) e.post(rbase + ai * (BMR / 2) + m * 16, cbase + bj * HALF, acc[ai][bj][m][0] * r + sw[bj][0], acc[ai][bj][m][1] * r + sw[bj][1], red[ai][m]); }
        } else if constexpr (E::HAS_PRE) {
            PG8_LAS float* ST = P + 2048;
            const int ci_lo = ci_of(row0 + u.pm * BMR), ci_hi = ci_of(row0 + u.pm * BMR + BMR - 1);
            { const int t = (wr * 4 + wc) * 64 + fq * 16 + fr;
              float sv[2];
#pragma unroll
              for (int k = 0; k < 2; ++k) { const int idx = t + 512 * k; sv[k] = e.stage_val(idx >> 9, ((idx >> 8) & 1) ? ci_hi : ci_lo, u.pn * BM + (idx & 255)); }
#pragma unroll
              for (int k = 0; k < 2; ++k) ST[t + 512 * k] = sv[k]; }
#define PG8_STP(row, col) (ST + (ci_of(row) != ci_lo ? 256 : 0) + ((col) - u.pn * BM))
            if constexpr (E::PRE_HALVES) {
#pragma unroll
                for (int ai = 0; ai < 2; ++ai) {
                    typename E::Pre pre[MB][2];
#pragma unroll
                    for (int m = 0; m < MB; ++m)
#pragma unroll
                        for (int bj = 0; bj < 2; ++bj) pre[m][bj] = e.prefetch(rbase + ai * (BMR / 2) + m * 16, cbase + bj * HALF);
                    __builtin_amdgcn_sched_barrier(0);
                    if (ai == 0) { asm volatile("s_waitcnt lgkmcnt(0)" ::: "memory"); __builtin_amdgcn_s_barrier(); asm volatile("" ::: "memory"); }
#pragma unroll
                    for (int m = 0; m < MB; ++m)
#pragma unroll
                        for (int bj = 0; bj < 2; ++bj) e.apply_pre(rbase + ai * (BMR / 2) + m * 16, cbase + bj * HALF, acc[ai][bj][m][0], acc[ai][bj][m][1], red[ai][m], pre[m][bj], PG8_STP(rbase + ai * (BMR / 2) + m * 16, cbase + bj * HALF));
                    __builtin_amdgcn_sched_barrier(0); }
            } else {
            typename E::Pre pre[2][MB][2];
#pragma unroll
            for (int ai = 0; ai < 2; ++ai)
#pragma unroll
                for (int m = 0; m < MB; ++m)
#pragma unroll
                    for (int bj = 0; bj < 2; ++bj) pre[ai][m][bj] = e.prefetch(rbase + ai * (BMR / 2) + m * 16, cbase + bj * HALF);
            __builtin_amdgcn_sched_barrier(0);
            asm volatile("s_waitcnt lgkmcnt(0)" ::: "memory"); __builtin_amdgcn_s_barrier(); asm volatile("" ::: "memory");
#pragma unroll
            for (int ai = 0; ai < 2; ++ai)
#pragma unroll
                for (int m = 0; m < MB; ++m)
#pragma unroll
                    for (int bj = 0; bj < 2; ++bj) e.apply_pre(rbase + ai * (BMR / 2) + m * 16, cbase + bj * HALF, acc[ai][bj][m][0], acc[ai][bj][m][1], red[ai][m], pre[ai][m][bj], PG8_STP(rbase + ai * (BMR / 2) + m * 16, cbase + bj * HALF));
            }
        } else {
#pragma unroll
        for (int ai = 0; ai < 2; ++ai)
#pragma unroll
            for (int m = 0; m < MB; ++m)
#pragma unroll
                for (int bj = 0; bj < 2; ++bj) e.apply(rbase + ai * (BMR / 2) + m * 16, cbase + bj * HALF, acc[ai][bj][m][0], acc[ai][bj][m][1], red[ai][m]);
        }
        if constexpr (NRED > 0) {
            if (e.want_red(u.pn)) {
#pragma unroll
                for (int ai = 0; ai < 2; ++ai)
#pragma unroll
                    for (int m = 0; m < MB; ++m)
#pragma unroll
                        for (int k = 0; k < NRED; ++k) { float s = red[ai][m][k]; s += __shfl_xor(s, 16); s += __shfl_xor(s, 32); if (fq == 0) P[((ai * (BMR / 2) + rl + m * 16) * 4 + wc) * 2 + k] = s; }
                asm volatile("s_waitcnt lgkmcnt(0)" ::: "memory"); __builtin_amdgcn_s_barrier(); asm volatile("" ::: "memory");
                const int t = (wr * 4 + wc) * 64 + fq * 16 + fr;
                if (t < BMR) { float r[NRED];
#pragma unroll
                    for (int k = 0; k < NRED; ++k) r[k] = (P[(t * 4 + 0) * 2 + k] + P[(t * 4 + 1) * 2 + k]) + (P[(t * 4 + 2) * 2 + k] + P[(t * 4 + 3) * 2 + k]);
                    e.store_red(row0 + u.pm * BMR + t, u.pn, r); }
                if constexpr (epi_is_final<E>::value) {
                    wave_publish(e.cnt + 64 * u.pm);
                    if (wr == 0 && wc == 0) { wave_wait_ge(e.cnt + 64 * u.pm, 4 * 8, e.tmo); __builtin_amdgcn_fence(__ATOMIC_ACQUIRE, "agent"); }
                    asm volatile("s_waitcnt vmcnt(0) lgkmcnt(0)" ::: "memory"); __builtin_amdgcn_s_barrier(); asm volatile("" ::: "memory");
                    if (t < BMR) P[t] = e.row_scale(row0 + u.pm * BMR + t);
                    asm volatile("s_waitcnt lgkmcnt(0)" ::: "memory"); __builtin_amdgcn_s_barrier(); asm volatile("" ::: "memory");
                    f32x4 xq[2][MB][2][2], gf[2][2];
#pragma unroll
                    for (int bj = 0; bj < 2; ++bj) { gf[bj][0] = G_LD4(e.gfin + cbase + bj * HALF); gf[bj][1] = G_LD4(e.gfin + cbase + bj * HALF + 4); }
#pragma unroll
                    for (int ai = 0; ai < 2; ++ai)
#pragma unroll
                        for (int m = 0; m < MB; ++m)
#pragma unroll
                            for (int bj = 0; bj < 2; ++bj) { const float* o = e.Y + (size_t)(rbase + ai * (BMR / 2) + m * 16) * D + cbase + bj * HALF; xq[ai][m][bj][0] = G_LD4(o); xq[ai][m][bj][1] = G_LD4(o + 4); }
                    __builtin_amdgcn_sched_barrier(0);
#pragma unroll
                    for (int ai = 0; ai < 2; ++ai)
#pragma unroll
                        for (int m = 0; m < MB; ++m) { const float rs = P[ai * (BMR / 2) + rl + m * 16];
#pragma unroll
                            for (int bj = 0; bj < 2; ++bj) { float* o = e.Y + (size_t)(rbase + ai * (BMR / 2) + m * 16) * D + cbase + bj * HALF;
                                G_ST4(o, xq[ai][m][bj][0] * rs * gf[bj][0]); G_ST4(o + 4, xq[ai][m][bj][1] * rs * gf[bj][1]); } }
                }
            }
        }
    }
};
template <class Epi, class Sched, bool ALIGN_EPI = false, bool SP2 = false, int MB = 4>
__device__ __forceinline__ void gemm_phase(PG8_LAS unsigned char* lds, const Gemm g, const Sched& S, const Epi& E, const int tid) {
    const int wid = __builtin_amdgcn_readfirstlane(tid >> 6), lane = tid & 63, wr = wid >> 2, wc = wid & 3, fr = lane & 15, fq = lane >> 4;
    const int K = g.K, nt = K / BK;
    unsigned voffA[2], voffB[2];
#pragma unroll
    for (int i = 0; i < 2; ++i) { int R, C; stage_rc(tid * 16 + i * 8192, R, C); const int Rb = Epi::PERM ? ((R & ~31) + perm32(R & 31)) : R;
        voffA[i] = (unsigned)((R < 32 * MB ? R : 0) * K + C) * 2u; voffB[i] = (unsigned)(Rb * K + C) * 2u; }
    const size_t kstep = (size_t)(BK * 2);
    const size_t hstep = (size_t)HALF * K * 2;
    const size_t tstep = 2 * hstep;
    const size_t hstepA = (size_t)(32 * MB) * K * 2, tstepA = 2 * hstepA;
    const unsigned ldsw = (unsigned)wid * 1024u;
    const int aoff = lds_byte(wr * 16 * MB + fr, fq * 8), boff = lds_byte(wc * 32 + fr, fq * 8);
#define PG8_SA(b, h) (((b) * 2 + (h)) * HTB)
#define PG8_SB(b, h) ((4 + (b) * 2 + (h)) * HTB)
#define PG8_STAGE(bufoff, gbase, voff) do { _Pragma("unroll") for (int _i = 0; _i < 2; ++_i) \
        __builtin_amdgcn_global_load_lds((const unsigned*)((const char*)(gbase) + (voff)[_i]), (PG8_LAS unsigned*)(lds + (bufoff) + ldsw + _i * 8192), 16, 0, 0); } while (0)
#define PG8_LDA(dst, b, h) do { _Pragma("unroll") for (int m = 0; m < MB; ++m) _Pragma("unroll") for (int k = 0; k < 2; ++k) dst[m][k] = *(const PG8_LAS bf16x8*)(lds + PG8_SA(b, h) + aoff + m * 2048 + k * 1024); } while (0)
#define PG8_LDB(dst, b, h) do { _Pragma("unroll") for (int n = 0; n < 2; ++n) _Pragma("unroll") for (int k = 0; k < 2; ++k) dst[n][k] = *(const PG8_LAS bf16x8*)(lds + PG8_SB(b, h) + boff + n * 2048 + k * 1024); } while (0)
#define PG8_MMA(ai, bj, At, Bt) do { __builtin_amdgcn_s_setprio(1); _Pragma("unroll") for (int m = 0; m < MB; ++m) _Pragma("unroll") for (int n = 0; n < 2; ++n) _Pragma("unroll") for (int k = 0; k < 2; ++k) \
        acc[ai][bj][m][n] = __builtin_amdgcn_mfma_f32_16x16x32_bf16(Bt[n][k], At[m][k], acc[ai][bj][m][n], 0, 0, 0); __builtin_amdgcn_s_setprio(0); } while (0)
#define PG8_WAIT_V(n) asm volatile("s_waitcnt vmcnt(" #n ")" ::: "memory")
#define PG8_WAIT_L(n) asm volatile("s_waitcnt lgkmcnt(" #n ")" ::: "memory")
#define PG8_BAR __builtin_amdgcn_s_barrier()
#define PG8_SCHED __builtin_amdgcn_sched_barrier(0)
    Unit cur, nxt; int ui = 0;
    if (!S.next(0, cur)) return;
    f32x4 acc[2][2][MB][2];
#pragma unroll
    for (int a = 0; a < 2; ++a)
#pragma unroll
        for (int b = 0; b < 2; ++b)
#pragma unroll
            for (int m = 0; m < MB; ++m)
#pragma unroll
                for (int n = 0; n < 2; ++n) acc[a][b][m][n] = (f32x4){0.f, 0.f, 0.f, 0.f};
    bf16x8 At[MB][2], B0[2][2], B1[2][2];
    const char* cA = (const char*)g.A + (size_t)cur.pm * tstepA; const char* cB = (const char*)g.Bt + (size_t)cur.pn * tstep;
    S.a_ready(cur);
    if constexpr (SP2) {
        PG8_STAGE(PG8_SB(0, 0), cB, voffB); PG8_STAGE(PG8_SB(0, 1), cB + hstep, voffB); PG8_STAGE(PG8_SA(0, 0), cA, voffA); PG8_STAGE(PG8_SA(0, 1), cA + hstepA, voffA);
        if (wr == 1) PG8_BAR;
        PG8_WAIT_V(2); PG8_BAR;
        PG8_STAGE(PG8_SB(1, 0), cB + kstep, voffB); PG8_STAGE(PG8_SA(1, 0), cA + kstep, voffA); PG8_STAGE(PG8_SB(1, 1), cB + hstep + kstep, voffB);
        PG8_WAIT_V(6); PG8_BAR;
    } else {
        PG8_STAGE(PG8_SB(0, 0), cB, voffB); PG8_STAGE(PG8_SA(0, 0), cA, voffA); PG8_STAGE(PG8_SB(0, 1), cB + hstep, voffB); PG8_STAGE(PG8_SA(0, 1), cA + hstepA, voffA);
        if (wr == 1) PG8_BAR;
        PG8_WAIT_V(4); PG8_BAR;
        PG8_STAGE(PG8_SB(1, 0), cB + kstep, voffB); PG8_STAGE(PG8_SA(1, 0), cA + kstep, voffA); PG8_STAGE(PG8_SB(1, 1), cB + hstep + kstep, voffB);
        PG8_WAIT_V(6); PG8_BAR;
    }
    for (;;) {
        const bool has_next = S.next(ui + 1, nxt);
        const char* nA = has_next ? (const char*)g.A + (size_t)nxt.pm * tstepA : cA; const char* nB = has_next ? (const char*)g.Bt + (size_t)nxt.pn * tstep : cB;
        for (int t = 0; t < nt; t += 2) {
            const bool last = (t == nt - 2);
            const char* a1 = cA + (size_t)(t + 1) * kstep;
            const char* a2 = last ? nA : cA + (size_t)(t + 2) * kstep; const char* b2 = last ? nB : cB + (size_t)(t + 2) * kstep;
            const char* a3 = a2 + kstep; const char* b3 = b2 + kstep;
            if (last && has_next) S.a_ready(nxt);
            if constexpr (SP2) {
            PG8_LDB(B0, 0, 0); PG8_LDB(B1, 0, 1); PG8_SCHED; PG8_LDA(At, 0, 0); PG8_STAGE(PG8_SA(1, 1), a1 + hstepA, voffA);
            PG8_WAIT_V(8); PG8_WAIT_L(0); PG8_BAR; PG8_MMA(0, 0, At, B0); PG8_MMA(0, 1, At, B1); PG8_BAR; PG8_SCHED;
            PG8_LDA(At, 0, 1); PG8_STAGE(PG8_SB(0, 0), b2, voffB); PG8_STAGE(PG8_SB(0, 1), b2 + hstep, voffB); PG8_STAGE(PG8_SA(0, 0), a2, voffA);
            PG8_WAIT_V(8); PG8_WAIT_L(0); PG8_BAR; PG8_MMA(1, 0, At, B0); PG8_MMA(1, 1, At, B1); PG8_BAR; PG8_SCHED;
            PG8_LDB(B0, 1, 0); PG8_LDB(B1, 1, 1); PG8_SCHED; PG8_LDA(At, 1, 0); PG8_STAGE(PG8_SA(0, 1), a2 + hstepA, voffA);
            PG8_WAIT_V(8); PG8_WAIT_L(0); PG8_BAR; PG8_MMA(0, 0, At, B0); PG8_MMA(0, 1, At, B1); PG8_BAR; PG8_SCHED;
            PG8_LDA(At, 1, 1); PG8_STAGE(PG8_SB(1, 0), b3, voffB); PG8_STAGE(PG8_SB(1, 1), b3 + hstep, voffB); PG8_STAGE(PG8_SA(1, 0), a3, voffA);
            PG8_WAIT_V(8); PG8_WAIT_L(0); PG8_BAR; PG8_MMA(1, 0, At, B0); PG8_MMA(1, 1, At, B1); PG8_BAR; PG8_SCHED;
            } else {
            PG8_LDB(B0, 0, 0); PG8_SCHED; PG8_LDA(At, 0, 0); PG8_STAGE(PG8_SA(1, 1), a1 + hstepA, voffA);
            PG8_WAIT_L(8); PG8_BAR; PG8_WAIT_L(0); PG8_MMA(0, 0, At, B0); PG8_BAR; PG8_SCHED;
            PG8_LDB(B1, 0, 1); PG8_STAGE(PG8_SB(0, 0), b2, voffB);
            PG8_BAR; PG8_WAIT_L(0); PG8_MMA(0, 1, At, B1); PG8_BAR;
            PG8_LDA(At, 0, 1); PG8_STAGE(PG8_SA(0, 0), a2, voffA);
            PG8_BAR; PG8_WAIT_L(0); PG8_MMA(1, 0, At, B0); PG8_BAR; PG8_SCHED;
            PG8_STAGE(PG8_SB(0, 1), b2 + hstep, voffB);
            PG8_WAIT_V(6); PG8_BAR; PG8_MMA(1, 1, At, B1); PG8_BAR;
            PG8_LDB(B0, 1, 0); PG8_SCHED; PG8_LDA(At, 1, 0); PG8_STAGE(PG8_SA(0, 1), a2 + hstepA, voffA);
            PG8_WAIT_L(8); PG8_BAR; PG8_WAIT_L(0); PG8_MMA(0, 0, At, B0); PG8_BAR; PG8_SCHED;
            PG8_LDB(B1, 1, 1); PG8_STAGE(PG8_SB(1, 0), b3, voffB);
            PG8_BAR; PG8_WAIT_L(0); PG8_MMA(0, 1, At, B1); PG8_BAR;
            PG8_LDA(At, 1, 1); PG8_STAGE(PG8_SA(1, 0), a3, voffA);
            PG8_BAR; PG8_WAIT_L(0); PG8_MMA(1, 0, At, B0); PG8_BAR; PG8_SCHED;
            PG8_STAGE(PG8_SB(1, 1), b3 + hstep, voffB);
            PG8_WAIT_V(6); PG8_BAR; PG8_MMA(1, 1, At, B1); PG8_BAR;
            }
        }
        if constexpr (ALIGN_EPI) { if (wr == 0) PG8_BAR; }
        if constexpr (!Epi::AFTER_DRAIN) { E(acc, cur, wr, wc, fr, fq); S.done(cur); }
        if (!has_next) break;
#pragma unroll
        for (int a = 0; a < 2; ++a)
#pragma unroll
            for (int b = 0; b < 2; ++b)
#pragma unroll
                for (int m = 0; m < 4; ++m)
#pragma unroll
                    for (int n = 0; n < 2; ++n) acc[a][b][m][n] = (f32x4){0.f, 0.f, 0.f, 0.f};
        cur = nxt; cA = nA; cB = nB; ++ui;
        if constexpr (ALIGN_EPI) { if (wr == 1) PG8_BAR; }
    }
    PG8_WAIT_V(0);
    if constexpr (!ALIGN_EPI) { if (wr == 0) PG8_BAR; }
    PG8_BAR;
    if constexpr (Epi::AFTER_DRAIN) { E.fused(acc, cur, wr, wc, fr, fq, lds, wid, lane); S.done(cur); }
#undef PG8_SA
#undef PG8_SB
#undef PG8_STAGE
#undef PG8_LDA
#undef PG8_LDB
#undef PG8_MMA
#undef PG8_WAIT_V
#undef PG8_WAIT_L
#undef PG8_BAR
#undef PG8_SCHED
}
}

__device__ __forceinline__ void p1_sw_item(const bf16* WT, int N, const float* shift  , float* out, int item, int lane, float scale) {
    const int fr = lane & 15, fq = lane >> 4, n0 = (item >> 2) * 64, kq = (item & 3) * 256;
    f32x4 acc[4];
#pragma unroll
    for (int j = 0; j < 4; ++j) acc[j] = (f32x4){0.f, 0.f, 0.f, 0.f};
    const float* sp = shift + (size_t)(fr < 5 ? fr : 0) * 6144 + kq + fq * 8;
    const bf16* bp = WT + (size_t)(n0 + 8 * (fr >> 2) + (fr & 3)) * D + kq + fq * 8;
#pragma unroll
    for (int k0 = 0; k0 < 256; k0 += 128) {
        bf16x8 a[4], b[4][4];
#pragma unroll
        for (int ks = 0; ks < 4; ++ks) { const f32x4 s0 = *(const f32x4*)(sp + k0 + 32 * ks), s1 = *(const f32x4*)(sp + k0 + 32 * ks + 4);
            a[ks] = __builtin_bit_cast(bf16x8, pack8(s0, s1));
#pragma unroll
            for (int nj = 0; nj < 4; ++nj) b[ks][nj] = *(const bf16x8*)(bp + (size_t)(32 * (nj >> 1) + 4 * (nj & 1)) * D + k0 + 32 * ks); }
#pragma unroll
        for (int ks = 0; ks < 4; ++ks)
#pragma unroll
            for (int nj = 0; nj < 4; ++nj) acc[nj] = __builtin_amdgcn_mfma_f32_16x16x32_bf16(b[ks][nj], a[ks], acc[nj], 0, 0, 0);
    }
    if (fr < 5) {
#pragma unroll
        for (int nj = 0; nj < 4; ++nj)
#pragma unroll
            for (int e = 0; e < 4; ++e) atomicAdd(out + (size_t)fr * N + n0 + 32 * (nj >> 1) + 8 * fq + 4 * (nj & 1) + e, acc[nj][e] * scale); }
}
constexpr int SWI_QKV = NQKV / 16, SWI_ALL = NQKV / 16 + FF2 / 16 + GE2 / 16 + FF2 / 16;
__device__ __forceinline__ void p1_sw_items(const Frame& F, const Args& args, int lo, int hi, int fw, int nfw) {
    unsigned char* ws = wsb(args); const float* MOD0 = (const float*)(ws + WS_MOD); const float* MOD1 = MOD0 + 5 * 6144; float* SW = (float*)(ws + WS_SW);
    constexpr int I0 = NQKV / 16, I1 = FF2 / 16, I2 = GE2 / 16;
    for (int it = lo + fw; it < hi; it += nfw) { int r = it;
        if (r < I0) { p1_sw_item((const bf16*)(ws + WS_WQKV), NQKV, MOD0 + 0, SW + SW_QKV, r, F.lane, F.scale); continue; } r -= I0;
        if (r < I1) { p1_sw_item((const bf16*)(ws + WS_WUP), FF2, MOD0 + 3072, SW + SW_UP0, r, F.lane, F.scale); continue; } r -= I1;
        if (r < I2) { p1_sw_item((const bf16*)(ws + WS_WIN), GE2, MOD1 + 0, SW + SW_IN, r, F.lane, F.scale); continue; } r -= I2;
        p1_sw_item((const bf16*)(ws + WS_WUP) + (size_t)FF2 * D, FF2, MOD1 + 3072, SW + SW_UP1, r, F.lane, F.scale); }
}

constexpr int SWU_IN = (GE2 / 256) * 4, SWU_ALL = SWU_IN + (FF2 / 256) * 4;
__device__ __forceinline__ void sw_unit_f32(const Frame& F, const float* W, int N, const float* shift  , float* out, bool upperm, int u) {
    const int nblk = N / 256, nb = u % nblk, kq = u / nblk;
    const int k0 = kq * 256 + F.wave * 32;
    const float* Wp = W + (size_t)k0 * N + nb * 256 + F.lane * 4;
    float sh[5];
#pragma unroll
    for (int q = 0; q < 5; ++q) sh[q] = *(GAS const float*)(shift + (size_t)q * 6144 + k0 + (F.lane & 31));
    f32x4 acc[5];
#pragma unroll
    for (int q = 0; q < 5; ++q) acc[q] = (f32x4){0.f, 0.f, 0.f, 0.f};
#pragma unroll
    for (int i0 = 0; i0 < 32; i0 += 16) {
        f32x4 w[16];
#pragma unroll
        for (int i = 0; i < 16; ++i) w[i] = G_LD4(Wp + (size_t)(i0 + i) * N);
#pragma unroll
        for (int i = 0; i < 16; ++i)
#pragma unroll
            for (int q = 0; q < 5; ++q) acc[q] += __builtin_bit_cast(float, __builtin_amdgcn_readlane(__builtin_bit_cast(int, sh[q]), i0 + i)) * w[i];
    }
    LAS f32x4* red = (LAS f32x4*)(F.lds + RING_OFF);
    __syncthreads();
#pragma unroll
    for (int q = 0; q < 5; ++q) red[(F.wave * 5 + q) * 64 + F.lane] = acc[q];
    __syncthreads();
    const LAS float* redf = (const LAS float*)red;
    for (int o = F.tid; o < 5 * 256; o += NWAVES * 64) { const int q = o >> 8, n = nb * 256 + (o & 255);
        float s = 0.f;
#pragma unroll
        for (int w = 0; w < NWAVES; ++w) s += redf[(w * 5 + q) * 256 + (o & 255)];
        atomicAdd(out + (size_t)q * N + (upperm ? upmap(n) : n), s * F.scale); }
    __syncthreads();
}
__device__ __forceinline__ void sw_units_f32(const Frame& F, const Args& args, int fb, int nfb) {
    const float* MOD1 = (const float*)(wsb(args) + WS_MOD) + 5 * 6144; float* SW = (float*)(wsb(args) + WS_SW);
    for (int u = fb; u < SWU_ALL; u += nfb) {
        if (u < SWU_IN) sw_unit_f32(F, inp(args, I_WIN), GE2, MOD1 + 0, SW + SW_IN, false, u);
        else sw_unit_f32(F, inp(args, I_WUP) + (size_t)D * FF2, FF2, MOD1 + 3072, SW + SW_UP1, true, u - SWU_IN); }
}

constexpr int EPI_OFF = 132096;
template <int NRED, class Epi, int MB = 4>
__device__ __forceinline__ void gemm_pg8(const Frame& F, const bf16* A, const bf16* Bt, int row0, int Mrows, int N, int K, const Epi& E) {
    pg8::Gemm g{A + (size_t)row0 * K, Bt, Mrows, N, K}; pg8::StaticOrder S; S.init(Mrows, N, F.G, F.bid, 64 * MB);
    pg8::EpiAdapt<Epi, NRED, MB> EA{E, row0, (LAS float*)(F.lds + EPI_OFF), F.skip_epi};
    pg8::gemm_phase<pg8::EpiAdapt<Epi, NRED, MB>, pg8::StaticOrder, true, true, MB>(F.lds + RING_OFF, g, S, EA, F.tid);
}


struct RowLin {
    const float* RS; const float* SW; int N;
};
struct EpiQKV { static constexpr bool HAS_PRE = false, HAS_LIN = true;
    RowLin L; unsigned char* ws;
    __device__ __forceinline__ void post(int row, int col, f32x4 v0, f32x4 v1, float*) const {
        const int which = col >> 10, cc = col & 1023;
        if (which == 0) { v0 = v0 * C2; v1 = v1 * C2; }
        const size_t off = which == 0 ? WS_Q : (row < NCTX ? (which == 1 ? WS_KC : WS_VC) : (which == 1 ? WS_K : WS_V));
        G_STU4((bf16*)(ws + off) + (size_t)row * D + cc, pack8(v0, v1));
    }
};
template <int MODE> struct EpiResT {
    const float *base_c, *base_l; bf16* XB; float* Xout; const float* gate; bf16* AN; const float* gn; const float* scn; float* RSout; float gs;
    static constexpr bool HAS_PRE = true, HAS_LIN = false, PRE_HALVES = MODE == 0;
    struct PreB { u32x4 w; }; struct PreF { f32x4 b0, b1; };
    typedef typename std::conditional<MODE != 0, PreB, PreF>::type Pre;
    __device__ __forceinline__ Pre prefetch(int row, int col) const { Pre p;
        if constexpr (MODE != 0) p.w = G_LDU4(XB + (size_t)row * D + col);
        else { const float* bp = (row < NCTX ? base_c + (size_t)row * D : base_l + (size_t)(row - NCTX) * D) + col; p.b0 = G_LD4(bp); p.b1 = G_LD4(bp + 4); }
        return p; }
    __device__ __forceinline__ float stage_val(int kind, int ci, int col) const {
        return kind == 0 ? *(GAS const float*)(gate + (size_t)ci * 6144 + col) : *(GAS const float*)(gn + col) * (1.f + *(GAS const float*)(scn + (size_t)ci * 6144 + col)); }
    __device__ __forceinline__ void apply_pre(int row, int col, f32x4 v0, f32x4 v1, float* red, const Pre& p, const LAS float* st) const {
        f32x4 b0, b1;
        if constexpr (MODE != 0) { const u32x4 w = p.w; b0 = (f32x4){bflo(w.x), bfhi(w.x), bflo(w.y), bfhi(w.y)}; b1 = (f32x4){bflo(w.z), bfhi(w.z), bflo(w.w), bfhi(w.w)}; }
        else { b0 = p.b0; b1 = p.b1; }
        const f32x4 x0 = b0 + *(const LAS f32x4*)st * (v0 * gs), x1 = b1 + *(const LAS f32x4*)(st + 4) * (v1 * gs);
        if (MODE != 2) G_STU4(XB + (size_t)row * D + col, pack8(x0, x1));
        else { float* xo = Xout + (size_t)row * D + col; G_ST4(xo, x0); G_ST4(xo + 4, x1); }
        if (MODE != 2) { red[0] += ((x0.x * x0.x + x0.y * x0.y) + (x0.z * x0.z + x0.w * x0.w)) + ((x1.x * x1.x + x1.y * x1.y) + (x1.z * x1.z + x1.w * x1.w));
            const f32x4 a0 = x0 * *(const LAS f32x4*)(st + 512), a1 = x1 * *(const LAS f32x4*)(st + 516);
            G_STU4(AN + (size_t)row * D + col, pack8(a0, a1)); }
    }
    __device__ __forceinline__ bool want_red(int) const { return MODE != 2; }
    __device__ __forceinline__ void store_red(int row, int pn, const float* r) const { RSout[(size_t)row * 4 + pn] = r[0]; }
};
struct EpiFinal {
    const bf16* XB; float* Y; const float* gate; const float* gfin; float* RS4; unsigned* cnt; unsigned* tmo; float gs;
    static constexpr bool HAS_PRE = true, HAS_LIN = false, PRE_HALVES = false;
    struct Pre { u32x4 w; };
    __device__ __forceinline__ Pre prefetch(int row, int col) const { Pre p; p.w = G_LDU4(XB + (size_t)row * D + col); return p; }
    __device__ __forceinline__ float stage_val(int kind, int ci, int col) const { return kind == 0 ? *(GAS const float*)(gate + (size_t)ci * 6144 + col) : 0.f; }
    __device__ __forceinline__ void apply_pre(int row, int col, f32x4 v0, f32x4 v1, float* red, const Pre& p, const LAS float* st) const {
        const u32x4 w = p.w;
        v0 = (f32x4){bflo(w.x), bfhi(w.x), bflo(w.y), bfhi(w.y)} + *(const LAS f32x4*)st * (v0 * gs); v1 = (f32x4){bflo(w.z), bfhi(w.z), bflo(w.w), bfhi(w.w)} + *(const LAS f32x4*)(st + 4) * (v1 * gs);
        float* o = Y + (size_t)row * D + col; G_ST4(o, v0); G_ST4(o + 4, v1);
        red[0] += ((v0.x * v0.x + v0.y * v0.y) + (v0.z * v0.z + v0.w * v0.w)) + ((v1.x * v1.x + v1.y * v1.y) + (v1.z * v1.z + v1.w * v1.w));
    }
    __device__ __forceinline__ bool want_red(int) const { return true; }
    __device__ __forceinline__ void store_red(int row, int pn, const float* r) const { st4f_wt(RS4 + (size_t)row * 4 + pn, r[0]); }
    __device__ __forceinline__ float row_scale(int row) const { const f32x4 p = G_LD4(RS4 + (size_t)row * 4); return __builtin_amdgcn_rsqf(((p.x + p.y) + (p.z + p.w)) * (1.f / D) + EPS); }
};
namespace pg8 { template <> struct epi_is_final<EpiFinal> { static constexpr bool value = true; }; }
struct EpiIn { static constexpr bool HAS_PRE = false, HAS_LIN = true;
    RowLin L; bf16 *U, *VV; float* LNP;
    __device__ __forceinline__ void post(int row, int col, f32x4 v0, f32x4 v1, float* red) const {
#pragma unroll
        for (int e = 0; e < 4; ++e) { v0[e] = gelu_tanh_f(v0[e]); v1[e] = gelu_tanh_f(v1[e]); }
        if (col >= GE) { red[0] += ((v0.x + v0.y) + (v0.z + v0.w)) + ((v1.x + v1.y) + (v1.z + v1.w));
            red[1] += ((v0.x * v0.x + v0.y * v0.y) + (v0.z * v0.z + v0.w * v0.w)) + ((v1.x * v1.x + v1.y * v1.y) + (v1.z * v1.z + v1.w * v1.w)); }
        bf16* dst = col < GE ? U + (size_t)row * GE + col : VV + (size_t)row * GE + (col - GE);
        G_STU4(dst, pack8(v0, v1));
    }
    __device__ __forceinline__ bool want_red(int pn) const { return pn >= 8; }
    __device__ __forceinline__ void store_red(int row, int pn, const float* r) const { *(f32x2*)(LNP + (size_t)row * 16 + (pn - 8) * 2) = (f32x2){r[0], r[1]}; }
};


__device__ __forceinline__ float dpp_ror1(float x) { return __builtin_bit_cast(float, __builtin_amdgcn_update_dpp(0, __builtin_bit_cast(int, x), 0x121, 0xf, 0xf, false)); }
__device__ __forceinline__ float dpp_rol1(float x) { return __builtin_bit_cast(float, __builtin_amdgcn_update_dpp(0, __builtin_bit_cast(int, x), 0x12f, 0xf, 0xf, false)); }
__device__ __forceinline__ float bsel(unsigned m, float a, float b) { return __builtin_bit_cast(float, (__builtin_bit_cast(unsigned, a) & m) | (__builtin_bit_cast(unsigned, b) & ~m)); }
__device__ __forceinline__ float dpp_shr1(float old, float x) { return __builtin_bit_cast(float, __builtin_amdgcn_update_dpp(__builtin_bit_cast(int, old), __builtin_bit_cast(int, x), 0x111, 0xf, 0xf, false)); }
__device__ __forceinline__ float dpp_shl1(float old, float x) { return __builtin_bit_cast(float, __builtin_amdgcn_update_dpp(__builtin_bit_cast(int, old), __builtin_bit_cast(int, x), 0x101, 0xf, 0xf, false)); }
struct EpiUpConv {
    static constexpr bool PERM = true, AFTER_DRAIN = false;
    const float* RS; const float* SW; const float* wconv; const float* bconv; float* HALO; bf16* M; LAS float* EX; bool skip;
    __device__ __forceinline__ void operator()(f32x4 (&acc)[2][2][4][2], const pg8::Unit& u, int wr, int wc, int fr, int fq) const {
        if (skip) return;
        const int pm = u.pm, pn = u.pn, ci = pm < 32 ? 0 : 1 + ((pm - 32) >> 2);
        const int c32 = wc * 32 + 8 * fq;
        {   const float* sw = SW + (size_t)ci * FF2 + pn * 256 + c32;
            f32x4 s[2][2];
#pragma unroll
            for (int bj = 0; bj < 2; ++bj)
#pragma unroll
                for (int n = 0; n < 2; ++n) s[bj][n] = G_LD4(sw + bj * 128 + 4 * n);
            f32x4 pq[2][4];
#pragma unroll
            for (int ai = 0; ai < 2; ++ai)
#pragma unroll
                for (int m = 0; m < 4; ++m) pq[ai][m] = G_LD4(RS + (size_t)(pm * 256 + ai * 128 + wr * 64 + m * 16 + fr) * 4);
            __builtin_amdgcn_sched_barrier(0);
#pragma unroll
            for (int ai = 0; ai < 2; ++ai)
#pragma unroll
                for (int m = 0; m < 4; ++m) { const f32x4 p = pq[ai][m];
                    const float r = __builtin_amdgcn_rsqf(((p.x + p.y) + (p.z + p.w)) * (1.f / D) + EPS);
#pragma unroll
                    for (int bj = 0; bj < 2; ++bj)
#pragma unroll
                        for (int n = 0; n < 2; ++n) acc[ai][bj][m][n] = acc[ai][bj][m][n] * r + s[bj][n]; } }
#pragma unroll
        for (int ai = 0; ai < 2; ++ai) { const int sidx = 2 * ai + wr;
#pragma unroll
            for (int bj = 0; bj < 2; ++bj)
#pragma unroll
                for (int n = 0; n < 2; ++n) {
                    if (fr == 0) *(LAS f32x4*)(EX + ((sidx * 2 + 0) * 2 + bj) * 128 + c32 + 4 * n) = acc[ai][bj][0][n];
                    if (fr == 15) *(LAS f32x4*)(EX + ((sidx * 2 + 1) * 2 + bj) * 128 + c32 + 4 * n) = acc[ai][bj][3][n]; } }
        {   const int t = (wr * 4 + wc) * 64 + fq * 16 + fr; EX[8 * 256 + t] = 0.f; }
        if (pm >= 32) { float* hb = HALO + (size_t)(pm - 32) * 4 * FF2 + pn * 256 + c32;
#pragma unroll
            for (int bj = 0; bj < 2; ++bj)
#pragma unroll
                for (int n = 0; n < 2; ++n) {
                    if (wr == 0 && fr < 2) *(f32x4*)(hb + (size_t)fr * FF2 + bj * 128 + 4 * n) = acc[0][bj][0][n];
                    if (wr == 1 && fr >= 14) *(f32x4*)(hb + (size_t)(fr - 12) * FF2 + bj * 128 + 4 * n) = acc[1][bj][3][n]; } }
        const int j0 = pn * 128 + c32;
        f32x4 wq[4];
        { const float* wp = wconv + j0; wq[0] = G_LD4(wp); wq[1] = G_LD4(wp + FF2); wq[2] = G_LD4(wp + 2 * FF2); wq[3] = G_LD4(bconv + j0); }
        asm volatile("s_waitcnt lgkmcnt(0)" ::: "memory"); __builtin_amdgcn_s_barrier(); asm volatile("" ::: "memory");
#pragma unroll
        for (int bj = 0; bj < 2; ++bj)
#pragma unroll
            for (int n = 0; n < 2; ++n) {
                const f32x4 w0 = wq[0], w1 = wq[1], w2 = wq[2], bb = wq[3];
                if (bj * 2 + n < 3) { const int bj1 = (bj * 2 + n + 1) >> 1, n1 = (bj * 2 + n + 1) & 1; const float* wp = wconv + bj1 * FF + j0 + 4 * n1;
                    wq[0] = G_LD4(wp); wq[1] = G_LD4(wp + FF2); wq[2] = G_LD4(wp + 2 * FF2); wq[3] = G_LD4(bconv + bj1 * FF + j0 + 4 * n1); }
#pragma unroll
                for (int ai = 0; ai < 2; ++ai) { const int sidx = 2 * ai + wr;
                    const int xrow = fr == 15 ? (sidx < 3 ? (sidx + 1) * 2 : 9) : (sidx > 0 ? (sidx - 1) * 2 + 1 : 8);
                    const f32x4 X = *(const LAS f32x4*)(EX + (xrow * 2 + bj) * 128 + c32 + 4 * n);
                    f32x4 cur[4];
#pragma unroll
                    for (int m = 0; m < 4; ++m) cur[m] = acc[ai][bj][m][n];
#pragma unroll
                    for (int m = 0; m < 4; ++m) { f32x4 pv_, nx_;
#pragma unroll
                        for (int e = 0; e < 4; ++e) {
                            const float pa_ = m > 0 ? dpp_ror1(cur[m - 1][e]) : X[e], na_ = m < 3 ? dpp_rol1(cur[m + 1][e]) : X[e];
                            pv_[e] = dpp_shr1(pa_, cur[m][e]); nx_[e] = dpp_shl1(na_, cur[m][e]); }
                        acc[ai][bj][m][n] = (w0 * pv_ + w1 * cur[m]) + (w2 * nx_ + bb); }
                    __builtin_amdgcn_sched_barrier(0); } }
#pragma unroll
        for (int ai = 0; ai < 2; ++ai)
#pragma unroll
            for (int m = 0; m < 4; ++m) { const int row = pm * 256 + ai * 128 + wr * 64 + m * 16 + fr;
                f32x4 o0, o1;
#pragma unroll
                for (int e = 0; e < 4; ++e) { o0[e] = silu_f(acc[ai][0][m][0][e]) * acc[ai][1][m][0][e]; o1[e] = silu_f(acc[ai][0][m][1][e]) * acc[ai][1][m][1][e]; }
                G_STU4(M + (size_t)row * FF + j0, pack8(o0, o1)); }
    }
};
__device__ __forceinline__ void fix_halo_rows(const Frame& F, int row_lo, int row_hi, const float* HALO, const float* wconv, const float* bconv, bf16* M) {
    for (int T = row_lo >> 8; T <= (row_hi - 1) >> 8; ++T) {
        if (T < 32) continue;
        const int q = (T - 32) & 3;
#pragma unroll
        for (int which = 0; which < 2; ++which) {
            const int row = T * 256 + (which ? 255 : 0);
            if (!((which == 0 ? (q != 0) : (q != 3)) && row >= row_lo && row < row_hi)) continue;
            const float* own = HALO + (size_t)(T - 32) * 4 * FF2;
            const float* pr = which == 0 ? HALO + ((size_t)(T - 33) * 4 + 3) * FF2 : own + 2 * FF2;
            const float* cu = which == 0 ? own : own + 3 * FF2;
            const float* nx = which == 0 ? own + FF2 : HALO + (size_t)(T - 31) * 4 * FF2;
#pragma unroll
            for (int it = 0; it < 2; ++it) {
                const int j = 4 * (F.tid + it * NWAVES * 64);
                if (j < FF) {
                    const int gc = ((j >> 7) << 8) + (j & 127), vc = gc + 128;
                    const f32x4 g = (G_LD4(wconv + j) * G_LD4(pr + gc) + G_LD4(wconv + FF2 + j) * G_LD4(cu + gc)) + (G_LD4(wconv + 2 * FF2 + j) * G_LD4(nx + gc) + G_LD4(bconv + j));
                    const f32x4 v = (G_LD4(wconv + FF + j) * G_LD4(pr + vc) + G_LD4(wconv + FF2 + FF + j) * G_LD4(cu + vc)) + (G_LD4(wconv + 2 * FF2 + FF + j) * G_LD4(nx + vc) + G_LD4(bconv + FF + j));
                    u32x2 o; o.x = cvt_pk_bf16(silu_f(g.x) * v.x, silu_f(g.y) * v.y); o.y = cvt_pk_bf16(silu_f(g.z) * v.z, silu_f(g.w) * v.w);
                    *(GAS u32x2*)(M + (size_t)row * FF + j) = o; } }
        }
    }
    asm volatile("s_waitcnt vmcnt(0)" ::: "memory"); __syncthreads();
}
template <class Epi>
__device__ __forceinline__ void gemm_pg8_raw(const Frame& F, const bf16* A, const bf16* Bt, int Mrows, int N, int K, const Epi& E) {
    pg8::Gemm g{A, Bt, Mrows, N, K}; pg8::StaticOrder S; S.init(Mrows, N, F.G, F.bid);
    pg8::gemm_phase<Epi, pg8::StaticOrder, true, true>(F.lds + RING_OFF, g, S, E, F.tid);
}

#include <hip/hip_bf16.h>
namespace attn_body {
using bf16=__hip_bfloat16;
using bf16x8=__attribute__((ext_vector_type(8)))short;
using s16x4=__attribute__((ext_vector_type(4)))short;
using f32x16=__attribute__((ext_vector_type(16)))float;
using u32x4=__attribute__((ext_vector_type(4)))unsigned;
constexpr int NHEAD=16,D=64,DM=NHEAD*D;
constexpr int NW=8,QBLK=32,QB=QBLK*NW,KVBLK=64;
__device__ __forceinline__ int crow(int r,int hi){return (r&3)+8*(r>>2)+4*hi;}
#define SBAR() __builtin_amdgcn_sched_barrier(0)
constexpr int NSLOT=3, SLOTB=8192;
constexpr int LDS_K=0, LDS_V=NSLOT*SLOTB, LDS_WS=2*NSLOT*SLOTB, LDS_OST=LDS_WS+NW*64*4, LDS_TAB=LDS_OST+NW*4096, LDS_BYTES=LDS_TAB+(3+15)*128*4;
constexpr float C2=0.125f*1.4426950408889634f;
__device__ __forceinline__ void glds16(const void*gsrc,unsigned lds_dst){unsigned keep;
  asm volatile("s_mov_b32 %0, m0\n\ts_mov_b32 m0, %2\n\ts_nop 0\n\tglobal_load_lds_dwordx4 %1, off\n\ts_mov_b32 m0, %0":"=&s"(keep):"v"(gsrc),"s"(lds_dst):"memory");}
__device__ __forceinline__ float max3f(float a,float b,float c){float r;asm("v_max3_f32 %0, %1, %2, %3":"=v"(r):"v"(a),"v"(b),"v"(c));return r;}
__device__ __forceinline__ float max2f(float a,float b){float r;asm("v_max_f32_e32 %0, %1, %2":"=v"(r):"v"(a),"v"(b));return r;}
__device__ __forceinline__ float fadd_s(float a,float b){float r;asm("v_add_f32_e32 %0, %1, %2":"=v"(r):"v"(a),"v"(b));return r;}
__device__ __forceinline__ float fsub_s(float a,float b){float r;asm("v_sub_f32_e32 %0, %1, %2":"=v"(r):"v"(a),"v"(b));return r;}
typedef float f32x2_t __attribute__((ext_vector_type(2))); typedef __bf16 bf16x2_t __attribute__((ext_vector_type(2)));
__device__ __forceinline__ unsigned cvtpk_s(float lo,float hi){f32x2_t v={lo,hi};bf16x2_t b=__builtin_convertvector(v,bf16x2_t);return __builtin_bit_cast(unsigned,b);}
#define WAIT_BAR(N) asm volatile("s_waitcnt vmcnt(" #N ") lgkmcnt(0)\n\ts_barrier":::"memory")

__device__ __forceinline__ void qkt(f32x16&p0,f32x16&p1,const char*Kslot,const bf16x8*qr,const f32x16&negm,int r32,int hi){
  const char*kb=Kslot+hi*1024+r32*16;
  #pragma unroll
  for(int d0=0;d0<4;++d0){
    const bf16x8 b0=*reinterpret_cast<const bf16x8*>(kb+d0*2048);
    const bf16x8 b1=*reinterpret_cast<const bf16x8*>(kb+d0*2048+512);
    if(d0==0){p0=__builtin_amdgcn_mfma_f32_32x32x16_bf16(b0,qr[0],negm,0,0,0);p1=__builtin_amdgcn_mfma_f32_32x32x16_bf16(b1,qr[0],negm,0,0,0);}
    else{p0=__builtin_amdgcn_mfma_f32_32x32x16_bf16(b0,qr[d0],p0,0,0,0);p1=__builtin_amdgcn_mfma_f32_32x32x16_bf16(b1,qr[d0],p1,0,0,0);}}
}
typedef __attribute__((address_space(3))) const char* lds_cptr;
typedef short v4i16_t __attribute__((ext_vector_type(4)));
__device__ __forceinline__ void kload8(bf16x8*kf,lds_cptr kp){
  kf[0]=*(const __attribute__((address_space(3))) bf16x8*)(kp);      kf[1]=*(const __attribute__((address_space(3))) bf16x8*)(kp+512);
  kf[2]=*(const __attribute__((address_space(3))) bf16x8*)(kp+2048); kf[3]=*(const __attribute__((address_space(3))) bf16x8*)(kp+2560);
  kf[4]=*(const __attribute__((address_space(3))) bf16x8*)(kp+4096); kf[5]=*(const __attribute__((address_space(3))) bf16x8*)(kp+4608);
  kf[6]=*(const __attribute__((address_space(3))) bf16x8*)(kp+6144); kf[7]=*(const __attribute__((address_space(3))) bf16x8*)(kp+6656);
}
__device__ __forceinline__ void kload2(bf16x8*kf,lds_cptr kp,int j){ kf[2*j]=*(const __attribute__((address_space(3))) bf16x8*)(kp+j*2048); kf[2*j+1]=*(const __attribute__((address_space(3))) bf16x8*)(kp+j*2048+512); }
__device__ __forceinline__ s16x4 vtr(lds_cptr p){ return __builtin_bit_cast(s16x4,__builtin_amdgcn_ds_read_tr16_b64_v4i16((__attribute__((address_space(3))) v4i16_t*)p)); }
__device__ __forceinline__ float rowmax(const f32x16&p0,const f32x16&p1){
  float a=max3f(p0[0],p0[1],p1[0]),b=max3f(p0[2],p0[3],p1[1]);a=max3f(a,p1[2],p1[3]);
  #pragma unroll
  for(int r=4;r<16;r+=4){a=max3f(a,p0[r],p0[r+1]);b=max3f(b,p0[r+2],p0[r+3]);a=max3f(a,p1[r],p1[r+1]);b=max3f(b,p1[r+2],p1[r+3]);}
  const float m=max2f(a,b);
  auto rr=__builtin_amdgcn_permlane32_swap(__float_as_uint(m),__float_as_uint(m),false,false);
  return max2f(__uint_as_float(rr[0]),__uint_as_float(rr[1]));
}
__device__ __forceinline__ void pv(f32x16*o,int vb,bf16x8 pa0,bf16x8 pa1,bf16x8 pa2,bf16x8 pa3){
  #pragma unroll
  for(int d0=0;d0<2;++d0){s16x4 lo[4],hi[4];
    #pragma unroll
    for(int ks=0;ks<4;++ks){
      asm volatile("ds_read_b64_tr_b16 %0,%1 offset:%c2":"=&v"(lo[ks]):"v"(vb),"i"(d0*4096+ks*1024):"memory");
      asm volatile("ds_read_b64_tr_b16 %0,%1 offset:%c2":"=&v"(hi[ks]):"v"(vb),"i"(d0*4096+ks*1024+512):"memory");}
    asm volatile("s_waitcnt lgkmcnt(0)":::"memory");SBAR();
    #define PK(k) (bf16x8){lo[k][0],lo[k][1],lo[k][2],lo[k][3],hi[k][0],hi[k][1],hi[k][2],hi[k][3]}
    o[d0]=__builtin_amdgcn_mfma_f32_32x32x16_bf16(pa0,PK(0),o[d0],0,0,0);
    o[d0]=__builtin_amdgcn_mfma_f32_32x32x16_bf16(pa1,PK(1),o[d0],0,0,0);
    o[d0]=__builtin_amdgcn_mfma_f32_32x32x16_bf16(pa2,PK(2),o[d0],0,0,0);
    o[d0]=__builtin_amdgcn_mfma_f32_32x32x16_bf16(pa3,PK(3),o[d0],0,0,0);
    #undef PK
  }
}

#ifndef ATTN_STORE16
#define ATTN_STORE16(p,v) (*(__attribute__((address_space(1))) u32x4*)(p)=(v))
#endif
template<int THRL,bool LAT> __device__ __forceinline__ void attn_unit(const int tid,bf16*Qw0,const bf16*K0,const long dV0,const int n0,const bf16*K1,const long dV1,const int NT,char*shm,const int rq0,const int wlo,const float*rpb_h){
  bf16*const Ow0=Qw0;
  const int lane=tid&63,r32=lane&31,hi=lane>>5; const int wid=__builtin_amdgcn_readfirstlane(tid>>6);
  const bf16*Qw=Qw0+(long)(wid*QBLK)*DM;
  const unsigned lds0=(unsigned)(uintptr_t)shm;
  float*wsf=(float*)(shm+LDS_WS)+wid*64;
  typedef __attribute__((address_space(3))) const float* lds_fptr;
  float*tab=(float*)(shm+LDS_TAB);
  if(LAT){ for(int i=tid;i<15*128;i+=NW*64){const int rr=i>>7,cc=i&127; tab[384+i]=(cc>=48&&cc<79)?rpb_h[rr*31+cc-48]*1.4426950408889634f:0.f;}
    if(tid<384)tab[tid]=(tid<128||(tid>=256+48&&tid<256+64))?0.f:-INFINITY; }
  const int rq=rq0+(wid>>1), rs=min(max(rq-4,0),8);
  lds_fptr tb_=(lds_fptr)tab, tv_=(lds_fptr)tab;
  #define CSEL(t) do{ if(LAT){ const int cq_=32*(wid&1)+r32; const bool w_=(t)>=n0; const int ia_=wlo+((t)-n0); const bool ok_=w_&&(ia_>=rs)&&(ia_<rs+8); \
      tb_=(lds_fptr)tab+(63-cq_+4*hi)+(ok_?384+(ia_-rq+7)*128:0); tv_=(lds_fptr)tab+(48-min(max(cq_-8,0),48)+4*hi)+(w_?(ok_?256:128):0); } }while(0)
  #define CINIT(C,KO) do{ if(LAT){ _Pragma("unroll") for(int r=0;r<16;++r){const int k0_=(r&3)+8*(r>>2)+(KO); C[r]=(tb_[k0_]+tv_[k0_])-mhat;} } }while(0)
  #define CSRC(C) (LAT?C:negm)
  const int koff=lane*DM+wid*8;
  const int voff=(16*(wid&3)+(lane>>2))*DM+(wid>>2)*32+(lane&3)*8;
  const unsigned kdst=lds0+LDS_K+wid*1024, vdst=lds0+LDS_V+wid*1024;
  #define KSRC(t) (((t)<n0?K0+(long)(t)*KVBLK*DM:K1+(long)((t)-n0)*KVBLK*DM)+koff)
  #define VSRC(t) (((t)<n0?K0+dV0+(long)(t)*KVBLK*DM:K1+dV1+(long)((t)-n0)*KVBLK*DM)+voff)
  #define DMA_K(t,slot) glds16(KSRC(t),(unsigned)__builtin_amdgcn_readfirstlane(kdst+(slot)))
  #define DMA_V(t,slot) glds16(VSRC(t),(unsigned)__builtin_amdgcn_readfirstlane(vdst+(slot)))
  const int vb0=(int)(lds0+LDS_V)+((lane>>4)&1)*32+(lane&3)*8+(4*hi+((lane&15)>>2))*64;
  const char*Kbase=shm+LDS_K; bf16x8 kf[8];
  const lds_cptr shm3=(lds_cptr)shm; const lds_cptr kp0=shm3+LDS_K+hi*1024+r32*16; const lds_cptr vp0=shm3+LDS_V+((lane>>4)&1)*32+(lane&3)*8+(4*hi+((lane&15)>>2))*64;

  DMA_K(0,0);DMA_V(0,0);DMA_K(1,SLOTB);
  bf16x8 qr[4];
  #pragma unroll
  for(int d0=0;d0<4;++d0)qr[d0]=*(const __attribute__((address_space(1))) bf16x8*)(&Qw[(long)r32*DM+d0*16+hi*8]);
  float mhat=0.f,l_reg=0.f;f32x16 o[2];o[0]=f32x16{};o[1]=f32x16{};float z_=0.f;asm volatile("":"+v"(z_));f32x16 negm;
  _Pragma("unroll") for(int r=0;r<16;++r)negm[r]=z_;
  if(!LAT)asm volatile("":"+v"(negm));
  #define CMASK(P0,P1,t) do{}while(0)
  bool resc=false;
  #define START(P0,P1) do{ const float rm=rowmax(P0,P1); resc=false; \
    { const float dl=rm; mhat=fadd_s(mhat,dl); \
      _Pragma("unroll") for(int r=0;r<16;++r){P0[r]=fsub_s(P0[r],dl);P1[r]=fsub_s(P1[r],dl);} \
      if(!LAT){ _Pragma("unroll") for(int r=0;r<16;++r)negm[r]=-mhat; asm volatile("":"+v"(negm)); } } \
    _Pragma("unroll") for(int r=0;r<16;++r)P0[r]=__builtin_amdgcn_exp2f(P0[r]); }while(0)
  #define RESC() do{ if(resc){ asm volatile("s_waitcnt lgkmcnt(0)":::"memory"); \
      _Pragma("unroll") for(int d_=0;d_<2;++d_) _Pragma("unroll") for(int r=0;r<16;++r)o[d_][r]*=wsf[crow(r,hi)]; } }while(0)
  f32x16 pA0,pA1,pB0,pB1;
  int sl_prev=0,sl_cur=0,sl_next=SLOTB;
  #define ROT() do{sl_prev=sl_cur;sl_cur=sl_next;sl_next=(sl_next==(NSLOT-1)*SLOTB)?0:sl_next+SLOTB;}while(0)
  DMA_K(2,2*SLOTB);
  WAIT_BAR(3);
  qkt(pA0,pA1,Kbase,qr,negm,r32,hi);asm volatile("s_nop 15\n\ts_nop 7":"+v"(pA0),"+v"(pA1));CMASK(pA0,pA1,0);
  START(pA0,pA1);
  _Pragma("unroll") for(int r=0;r<16;++r)pA1[r]=__builtin_amdgcn_exp2f(pA1[r]);
  WAIT_BAR(0);
  DMA_K(3,0);DMA_V(1,SLOTB);
  ROT();
  kload8(kf,kp0+sl_cur);
  WAIT_BAR(2);
  s16x4 vlo[8],vhi[8]; u32x4 pw0,pw1,pw2,pw3;
  #define PKW(P,B) cvtpk_s(P[B],P[B+1])
  #define PAF(k) __builtin_bit_cast(bf16x8,pw##k)
  #define VFR(i) (bf16x8){vlo[i][0],vlo[i][1],vlo[i][2],vlo[i][3],vhi[i][0],vhi[i][1],vhi[i][2],vhi[i][3]}
  #define PIN(x) asm volatile("":"+v"(x))
  #define MX3(a,b,c) __builtin_fmaxf(__builtin_fmaxf((a),(b)),(c))
  #define GAPA(MF,A0,A1,A2,A3,W0,W1,PW) do{ MF; sacc+=A0; sacc+=A1; sacc+=A2; sacc+=A3; PIN(sacc); W0; W1; PIN(PW); SBAR(); }while(0)
  #define EX(v) __builtin_amdgcn_exp2f(v)
  #define GAPB(MF,X,B,KO) do{ MF; X[B]=EX(X[B]); X[B+1]=EX(X[B+1]); X[B+2]=EX(X[B+2]); X[B+3]=EX(X[B+3]); PIN(X); SBAR(); }while(0)
  #define VRD(i) do{ vlo[i]=vtr(vp_+(((i)>>2)*4096+((i)&3)*1024)); vhi[i]=vtr(vp_+(((i)>>2)*4096+((i)&3)*1024+512)); }while(0)
  #define KRD(G,j) do{ if(G){ kload2(kf,kp0+sl_next,j); SBAR(); } }while(0)
  #define STEP(C0,C1,P0,P1,t,GK,GV,GL) do{ SBAR(); CSEL(t); CINIT(C0,0); SBAR(); \
    const lds_cptr vp_=vp0+sl_prev; \
    VRD(0); SBAR(); float sacc=(P0[0]+P0[1]); \
    GAPA(C0=__builtin_amdgcn_mfma_f32_32x32x16_bf16(kf[0],qr[0],CSRC(C0),0,0,0), P0[2],P0[3],P0[4],P0[5],     pw0[0]=PKW(P0,0), pw0[1]=PKW(P0,2), pw0); \
    CINIT(C1,32); VRD(4); SBAR(); GAPA(C1=__builtin_amdgcn_mfma_f32_32x32x16_bf16(kf[1],qr[0],CSRC(C1),0,0,0), P0[6],P0[7],P0[8],P0[9],     pw0[2]=PKW(P0,4), pw0[3]=PKW(P0,6), pw0); \
    VRD(1); SBAR(); GAPA(C0=__builtin_amdgcn_mfma_f32_32x32x16_bf16(kf[2],qr[1],C0,0,0,0),   P0[10],P0[11],P0[12],P0[13], pw1[0]=PKW(P0,8), pw1[1]=PKW(P0,10), pw1); \
    VRD(5); SBAR(); GAPA(C1=__builtin_amdgcn_mfma_f32_32x32x16_bf16(kf[3],qr[1],C1,0,0,0),   P0[14],P0[15],P1[0],P1[1],   pw1[2]=PKW(P0,12),pw1[3]=PKW(P0,14), pw1); \
    VRD(2); SBAR(); GAPA(C0=__builtin_amdgcn_mfma_f32_32x32x16_bf16(kf[4],qr[2],C0,0,0,0),   P1[2],P1[3],P1[4],P1[5],     pw2[0]=PKW(P1,0), pw2[1]=PKW(P1,2), pw2); \
    VRD(6); SBAR(); GAPA(C1=__builtin_amdgcn_mfma_f32_32x32x16_bf16(kf[5],qr[2],C1,0,0,0),   P1[6],P1[7],P1[8],P1[9],     pw2[2]=PKW(P1,4), pw2[3]=PKW(P1,6), pw2); \
    VRD(3); SBAR(); GAPA(C0=__builtin_amdgcn_mfma_f32_32x32x16_bf16(kf[6],qr[3],C0,0,0,0),   P1[10],P1[11],P1[12],P1[13], pw3[0]=PKW(P1,8), pw3[1]=PKW(P1,10), pw3); \
    VRD(7); SBAR(); GAPA(C1=__builtin_amdgcn_mfma_f32_32x32x16_bf16(kf[7],qr[3],C1,0,0,0),   P1[14],P1[15],0.f,0.f,       pw3[2]=PKW(P1,12),pw3[3]=PKW(P1,14), pw3); \
    l_reg+=sacc; \
    if(GK){DMA_K((t)+3,sl_cur);} if(GV){DMA_V((t)+1,sl_next);} \
    CMASK(C0,C1,t); \
    { float a=MX3(C0[0],C0[1],C1[0]),b=MX3(C0[2],C0[3],C1[1]); a=MX3(a,C1[2],C1[3]); \
      _Pragma("unroll") for(int r=4;r<16;r+=4){a=MX3(a,C0[r],C0[r+1]);b=MX3(b,C0[r+2],C0[r+3]);a=MX3(a,C1[r],C1[r+1]);b=MX3(b,C1[r+2],C1[r+3]);} \
      float rm=__builtin_fmaxf(a,b); { auto rr=__builtin_amdgcn_permlane32_swap(__float_as_uint(rm),__float_as_uint(rm),false,false); rm=__builtin_fmaxf(__uint_as_float(rr[0]),__uint_as_float(rr[1])); } \
      resc=false; \
      if(__builtin_expect(__any(rm>(float)THRL),0)){ const float dl=__builtin_fmaxf(rm,0.f); mhat+=dl; \
        _Pragma("unroll") for(int r=0;r<16;++r){C0[r]-=dl;C1[r]-=dl;} \
        if(!LAT){ _Pragma("unroll") for(int r=0;r<16;++r)negm[r]=-mhat; asm volatile("":"+v"(negm)); } \
        const float f=__builtin_amdgcn_exp2f(-dl); l_reg*=f; if(hi==0)wsf[r32]=f; resc=true; } } \
    SBAR(); \
    GAPB(o[0]=__builtin_amdgcn_mfma_f32_32x32x16_bf16(PAF(0),VFR(0),o[0],0,0,0), C0,0,0); \
    GAPB(o[1]=__builtin_amdgcn_mfma_f32_32x32x16_bf16(PAF(0),VFR(4),o[1],0,0,0), C0,4,0); \
    KRD(GL,0); GAPB(o[0]=__builtin_amdgcn_mfma_f32_32x32x16_bf16(PAF(1),VFR(1),o[0],0,0,0), C0,8,0); \
    KRD(GL,1); GAPB(o[1]=__builtin_amdgcn_mfma_f32_32x32x16_bf16(PAF(1),VFR(5),o[1],0,0,0), C0,12,0); \
    KRD(GL,2); GAPB(o[0]=__builtin_amdgcn_mfma_f32_32x32x16_bf16(PAF(2),VFR(2),o[0],0,0,0), C1,0,32); \
    KRD(GL,3); GAPB(o[1]=__builtin_amdgcn_mfma_f32_32x32x16_bf16(PAF(2),VFR(6),o[1],0,0,0), C1,4,32); \
    GAPB(o[0]=__builtin_amdgcn_mfma_f32_32x32x16_bf16(PAF(3),VFR(3),o[0],0,0,0), C1,8,32); \
    GAPB(o[1]=__builtin_amdgcn_mfma_f32_32x32x16_bf16(PAF(3),VFR(7),o[1],0,0,0), C1,12,32); \
    }while(0)
  int t=1;
  for(;t+5<NT;t+=2){
    STEP(pB0,pB1,pA0,pA1,t,true,true,true);     WAIT_BAR(2); RESC(); ROT();
    STEP(pA0,pA1,pB0,pB1,t+1,true,true,true);   WAIT_BAR(2); RESC(); ROT();
  }
  #define ENDW(tt) do{ if((tt)+3<NT){WAIT_BAR(2);} else if((tt)+2<NT){WAIT_BAR(1);} else {WAIT_BAR(0);} }while(0)
  for(;t+1<NT;t+=2){
    STEP(pB0,pB1,pA0,pA1,t,(t+3<NT),(t+1<NT),(t+1<NT));       ENDW(t);   RESC(); ROT();
    STEP(pA0,pA1,pB0,pB1,t+1,(t+4<NT),(t+2<NT),(t+2<NT));     ENDW(t+1); RESC(); ROT();
  }
  STEP(pB0,pB1,pA0,pA1,NT-1,false,false,false); RESC();
  { float sacc=pB0[0]+pB0[1]; _Pragma("unroll") for(int r=2;r<16;++r)sacc+=pB0[r]; _Pragma("unroll") for(int r=0;r<16;++r)sacc+=pB1[r]; l_reg+=sacc;
    pw0=(u32x4){PKW(pB0,0),PKW(pB0,2),PKW(pB0,4),PKW(pB0,6)};pw1=(u32x4){PKW(pB0,8),PKW(pB0,10),PKW(pB0,12),PKW(pB0,14)};pw2=(u32x4){PKW(pB1,0),PKW(pB1,2),PKW(pB1,4),PKW(pB1,6)};pw3=(u32x4){PKW(pB1,8),PKW(pB1,10),PKW(pB1,12),PKW(pB1,14)};
    SBAR(); pv(o,vb0+sl_cur,PAF(0),PAF(1),PAF(2),PAF(3)); }
  #undef PKW
  #undef PAF
  #undef VFR
  #undef PIN
  #undef MX3
  #undef GAPA
  #undef GAPB
  #undef EX
  #undef VRD
  #undef KRD
  #undef STEP
  #undef ENDW
  {auto rr=__builtin_amdgcn_permlane32_swap(__float_as_uint(l_reg),__float_as_uint(l_reg),false,false);l_reg=__uint_as_float(rr[0])+__uint_as_float(rr[1]);}
  if(hi==0)wsf[32+r32]=l_reg;asm volatile("s_waitcnt lgkmcnt(0)":::"memory");
  float rli[16];
  #pragma unroll
  for(int r=0;r<16;++r)rli[r]=__builtin_amdgcn_rcpf(wsf[32+crow(r,hi)]);
  bf16*Ow=Ow0+(long)(wid*QBLK)*DM;
  { bf16*stg=(bf16*)(shm+LDS_OST)+wid*2048;
    #pragma unroll
    for(int r=0;r<16;++r){const int orow=crow(r,hi);
      #pragma unroll
      for(int d0=0;d0<2;++d0)stg[orow*64+d0*32+r32]=__float2bfloat16(o[d0][r]*rli[r]);}
    asm volatile("s_waitcnt lgkmcnt(0)":::"memory");
    #pragma unroll
    for(int i=0;i<4;++i){const int row=i*8+(lane>>3),ch=lane&7; const u32x4 v=*(const u32x4*)(stg+row*64+ch*8); ATTN_STORE16(Ow+(long)row*DM+ch*8,v);} }
  asm volatile("s_waitcnt lgkmcnt(0)\n\ts_barrier":::"memory");
  #undef DMA_K
  #undef DMA_V
  #undef KSRC
  #undef VSRC
  #undef CMASK
  #undef CSEL
  #undef CINIT
  #undef CSRC
  #undef START
  #undef RESC
  #undef ROT
}

constexpr int MIX_STAT=0, MIX_V=2048, MIX_WS=MIX_V+8*8192, MIX_STG=MIX_WS+NW*64*4, MIX_SROW=36, MIX_LDS_BYTES=MIX_STG+NW*32*MIX_SROW*4;
__device__ __forceinline__ void mix_pair(const int tid,const int uA,const int uB,const bf16*VV,bf16*U,const bf16*WSb,const float*LNP,const float*gv,const float*bs,char*shm){
  const int lane=tid&63,r32=lane&31,hi=lane>>5; const int wid=__builtin_amdgcn_readfirstlane(tid>>6);
  const int grp=wid>>2,pb=wid&3,u=grp?uB:uA; const bool valid=u>=0; const int chunk=u>>4,g=u&15;
  const unsigned lds0=(unsigned)(uintptr_t)shm;
  float*stat=(float*)(shm+MIX_STAT)+grp*256;
  float*wsf=(float*)(shm+MIX_WS)+wid*64;
  float*stg=(float*)(shm+MIX_STG)+wid*32*MIX_SROW;
  const int vbase=MIX_V+grp*32768;
  asm volatile("s_waitcnt vmcnt(0)":::"memory");
  if(valid){
    #pragma unroll
    for(int k=0;k<2;++k){ const int pi=2*pb+k; const bf16*vsrc=VV+(long)(chunk*128+16*(pi&3)+(lane>>2))*2048+g*128+(pi>>2)*32+(lane&3)*8;
      #pragma unroll
      for(int s=0;s<4;++s) glds16(vsrc+(long)((s>>1)*64)*2048+(s&1)*64,(unsigned)__builtin_amdgcn_readfirstlane(lds0+vbase+s*8192+pi*1024)); }
    const int tg=tid&255;
    if(tg<128){ const __attribute__((address_space(1))) float*p=(const __attribute__((address_space(1))) float*)(LNP+(long)(chunk*128+tg)*16); float s=0.f,q=0.f;
      #pragma unroll
      for(int k=0;k<8;++k){s+=p[2*k];q+=p[2*k+1];}
      const float mean=s*(1.f/2048.f),var=q*(1.f/2048.f)-mean*mean; stat[2*tg]=mean; stat[2*tg+1]=__builtin_amdgcn_rsqf(var+1e-6f); } }
  asm volatile("s_waitcnt vmcnt(0) lgkmcnt(0)\n\ts_barrier":::"memory");
  if(valid){
    bf16x8 pa[2][4]; float corr=0.f;
    #pragma unroll
    for(int qt=0;qt<2;++qt)
      #pragma unroll
      for(int ks=0;ks<4;++ks){ const int qa=64*qt+16*ks+4*hi;
        const __attribute__((address_space(1))) unsigned* wp=(const __attribute__((address_space(1))) unsigned*)(WSb+((long)g*128+32*pb+r32)*128+qa);
        const unsigned w0=wp[0],w1=wp[1],w2=wp[4],w3=wp[5];
        const f32x4 s0=*(const f32x4*)(stat+2*qa), s1=*(const f32x4*)(stat+2*qa+4), s2=*(const f32x4*)(stat+2*qa+16), s3=*(const f32x4*)(stat+2*qa+20);
        const float a0=__uint_as_float(w0<<16)*s0.y,a1=__uint_as_float(w0&0xffff0000u)*s0.w,a2=__uint_as_float(w1<<16)*s1.y,a3=__uint_as_float(w1&0xffff0000u)*s1.w;
        const float a4=__uint_as_float(w2<<16)*s2.y,a5=__uint_as_float(w2&0xffff0000u)*s2.w,a6=__uint_as_float(w3<<16)*s3.y,a7=__uint_as_float(w3&0xffff0000u)*s3.w;
        u32x4 pk; pk.x=cvtpk_s(a0,a1); pk.y=cvtpk_s(a2,a3); pk.z=cvtpk_s(a4,a5); pk.w=cvtpk_s(a6,a7);
        corr+=(__uint_as_float(pk.x<<16)*s0.x+__uint_as_float(pk.x&0xffff0000u)*s0.z)+(__uint_as_float(pk.y<<16)*s1.x+__uint_as_float(pk.y&0xffff0000u)*s1.z)
             +(__uint_as_float(pk.z<<16)*s2.x+__uint_as_float(pk.z&0xffff0000u)*s2.z)+(__uint_as_float(pk.w<<16)*s3.x+__uint_as_float(pk.w&0xffff0000u)*s3.z);
        pa[qt][ks]=__builtin_bit_cast(bf16x8,pk); }
    {auto rr=__builtin_amdgcn_permlane32_swap(__float_as_uint(corr),__float_as_uint(corr),false,false);corr=__uint_as_float(rr[0])+__uint_as_float(rr[1]);}
    if(hi==0)wsf[r32]=corr; asm volatile("s_waitcnt lgkmcnt(0)":::"memory");
    const int vb=(int)(lds0+vbase)+((lane>>4)&1)*32+(lane&3)*8+(4*hi+((lane&15)>>2))*64;
    #pragma unroll
    for(int ch=0;ch<2;++ch){
      f32x16 o[2]; o[0]=f32x16{}; o[1]=f32x16{};
      SBAR(); pv(o,vb+ch*8192,pa[0][0],pa[0][1],pa[0][2],pa[0][3]);
      SBAR(); pv(o,vb+(2+ch)*8192,pa[1][0],pa[1][1],pa[1][2],pa[1][3]);
      #pragma unroll
      for(int d0=0;d0<2;++d0){
        #pragma unroll
        for(int r=0;r<16;++r){const int orow=crow(r,hi); stg[orow*MIX_SROW+r32]=o[d0][r]-wsf[orow];}
        asm volatile("s_waitcnt lgkmcnt(0)":::"memory");
        #pragma unroll
        for(int i=0;i<2;++i){const int row=i*16+(lane>>2),c8=(lane&3)*8; const int p=32*pb+row, e=g*128+ch*64+d0*32+c8;
          const f32x4 m0=*(const f32x4*)(stg+row*MIX_SROW+c8), m1=*(const f32x4*)(stg+row*MIX_SROW+c8+4);
          const f32x4 g0=*(const __attribute__((address_space(1))) f32x4*)(gv+e), g1=*(const __attribute__((address_space(1))) f32x4*)(gv+e+4); const float b=*(const __attribute__((address_space(1))) float*)(bs+g*128+p);
          bf16*up=U+(long)(chunk*128+p)*2048+e; const u32x4 uw=*(const __attribute__((address_space(1))) u32x4*)up;
          u32x4 ow;
          ow.x=cvtpk_s(__uint_as_float(uw.x<<16)*(g0.x*m0.x+b),__uint_as_float(uw.x&0xffff0000u)*(g0.y*m0.y+b));
          ow.y=cvtpk_s(__uint_as_float(uw.y<<16)*(g0.z*m0.z+b),__uint_as_float(uw.y&0xffff0000u)*(g0.w*m0.w+b));
          ow.z=cvtpk_s(__uint_as_float(uw.z<<16)*(g1.x*m1.x+b),__uint_as_float(uw.z&0xffff0000u)*(g1.y*m1.y+b));
          ow.w=cvtpk_s(__uint_as_float(uw.w<<16)*(g1.z*m1.z+b),__uint_as_float(uw.w&0xffff0000u)*(g1.w*m1.w+b));
          *(__attribute__((address_space(1))) u32x4*)up=ow; }
        asm volatile("s_waitcnt lgkmcnt(0)":::"memory"); }
    } }
  asm volatile("s_waitcnt lgkmcnt(0)\n\ts_barrier":::"memory");
}
constexpr int ATTN_LDS_BYTES=LDS_BYTES;
#undef SBAR
#undef WAIT_BAR
}

#ifndef LATUNIT
#define LATUNIT attn_body::attn_unit<8, true>
#endif
__device__ __forceinline__ void attn_fast(const Frame& F, const Args& args) {
    typedef attn_body::bf16 abf;
    unsigned char* ws = wsb(args);
    abf* Q = (abf*)(ws + WS_Q); const abf* K = (const abf*)(ws + WS_K);
    const abf* CKp = (const abf*)(ws + WS_CK); const abf* KCp = (const abf*)(ws + WS_KC); const float* rpb = inp(args, I_RPB);
    char* shm = (char*)(unsigned char*)F.lds + RING_OFF;
    const int vcu = (F.G % 8 == 0) ? (F.bid % 8) * (F.G / 8) + F.bid / 8 : F.bid;
    for (int u = vcu; u < 4 * NH * 4; u += F.G) {
        const int b = u >> 6, h = (u >> 2) & 15, qb = u & 3;
        const int wlo = qb < 2 ? 0 : (qb == 2 ? 4 : 8), nwin = (qb == 0 || qb == 3) ? 8 : 12;
        const long qoff = ((long)(NCTX + b * SEQ_L + qb * 256)) * D + h * HD, woff = ((long)(NCTX + b * SEQ_L + wlo * 64)) * D + h * HD, coff = ((long)(b * PAST)) * D + h * HD;
        LATUNIT(F.tid, Q + qoff, CKp + coff, (long)((WS_CV - WS_CK) / 2), 8, K + woff, (long)((WS_V - WS_K) / 2), 8 + nwin, shm, 4 * qb, wlo, rpb + h * 465);
    }
    for (int u = vcu; u < 32 * NH; u += F.G) {
        const int b = u >> 4, h = u & 15;
        const long qoff = ((long)(b * SEQ_C)) * D + h * HD;
        attn_body::attn_unit<8, false>(F.tid, Q + qoff, KCp + qoff, (long)((WS_VC - WS_KC) / 2), 4, KCp + qoff, (long)((WS_VC - WS_KC) / 2), 4, shm, 0, 0, rpb);
    }
    if (F.G % 4 == 0 && (4 * NH * 4) % F.G == 0) { const int qb = vcu & 3;
        if (qb == 0 || qb == 3) p1_sw_items(F, args, SWI_QKV, SWI_QKV + FF2 / 16, ((vcu >> 2) * 2 + (qb == 3)) * NWAVES + F.wave, (F.G / 2) * NWAVES); }
    else p1_sw_items(F, args, SWI_QKV, SWI_QKV + FF2 / 16, F.bid * NWAVES + F.wave, F.G * NWAVES);
}


__device__ __forceinline__ void mix_fast(const Frame& F, const Args& args) {
    typedef attn_body::bf16 abf;
    unsigned char* ws = wsb(args);
    const abf* VV = (const abf*)(ws + WS_VV); abf* U = (abf*)(ws + WS_U); const abf* WSb = (const abf*)(ws + WS_WSB); const float* LNP = (const float*)(ws + WS_LNP);
    const float* gv = inp(args, I_GV); const float* bs = inp(args, I_BSP);
    char* shm = (char*)(unsigned char*)F.lds + RING_OFF;
    const int vcu = (F.G % 8 == 0) ? (F.bid % 8) * (F.G / 8) + F.bid / 8 : F.bid;
    for (int u = 2 * vcu; u < 96 * 16; u += 2 * F.G) attn_body::mix_pair(F.tid, u, u + 1 < 96 * 16 ? u + 1 : -1, VV, U, WSb, LNP, gv, bs, shm);
}
#ifndef ATTN
#define ATTN attn_fast
#endif
#ifndef MIX
#define MIX mix_fast
#endif
enum Steps { S_P0 = 0, S_P1, S_QKV, S_ATT, S_WO, S_UP0, S_DN0, S_IN, S_MIX, S_OUT, S_UP1, S_DN1, NSTEPS };

#ifndef STEPMASK
#define STEPMASK 0xffffffffu
#endif
#define ON(s) ((STEPMASK >> (s)) & 1u)
__device__ __forceinline__ void run_step(const Frame& F0, const Args& args, int s) {
    Frame F = F0; asm volatile("" : "+v"(F.tid)); asm volatile("" : "+s"(F.bid)); asm volatile("" : "+s"(F.G)); F.lane = F.tid & 63; F.wave = __builtin_amdgcn_readfirstlane(F.tid >> 6);
    unsigned char* ws = wsb(args);
    const float* MOD0 = (const float*)(ws + WS_MOD); const float* MOD1 = MOD0 + 5 * 6144;
    float* SW = (float*)(ws + WS_SW);
    float* RS0 = (float*)(ws + WS_RS); float* RS1 = RS0 + (size_t)MT * 4; float* RS2 = RS0 + (size_t)MT * 8; float* RS3 = RS0 + (size_t)MT * 12;
    bf16* AN = (bf16*)(ws + WS_AN);
    if (ON(S_P0) && s == S_P0) {
        for (int u = F.bid; u < ADA_UNITS; u += F.G) p0_adaln_unit(F, args, u);
        const int rot = (F.bid + F.G - ADA_UNITS % F.G) % F.G;
        p0_items(F, args, 0, PI_FIRST, rot * NWAVES + F.wave, F.G * NWAVES); }
    else if (ON(S_P1) && s == S_P1) { p1_sw_items(F, args, 0, SWI_QKV, F.bid * NWAVES + F.wave, F.G * NWAVES); p1_rows(F, args); }
    else if (ON(S_QKV) && s == S_QKV) { float* out = outb(args);
        EpiQKV E{{RS0, SW + SW_QKV, NQKV}, ws};
        int fw = 0, nfw = 1; const bool fil = filler_slot(F, (MT / 256) * (NQKV / 256), fw, nfw), first = fil && (F.bid & 8);
        if (first) { p0_items(F, args, PI_FIRST, PI_SECOND, fw, nfw); __syncthreads(); }
        gemm_pg8<0>(F, AN, (const bf16*)(ws + WS_WQKV), 0, MT, NQKV, D, E);
        if (fil && !first) p0_items(F, args, PI_FIRST, PI_SECOND, fw, nfw); }
    else if (ON(S_ATT) && s == S_ATT) ATTN(F, args);
    else if (ON(S_WO) && s == S_WO) { float* X = outb(args);
        EpiResT<0> E{inp(args, I_XP), inp(args, I_XS), (bf16*)(ws + WS_XB), nullptr, MOD0 + 2048, AN, inp(args, I_NFFN), MOD0 + 4096, RS1, 1.f};
        gemm_pg8<1, EpiResT<0>, 3>(F, (const bf16*)(ws + WS_Q), (const bf16*)(ws + WS_WO), 0, MT, D, D, E);
    }
    else if (ON(S_UP0) && s == S_UP0) { EpiUpConv E{RS1, SW + SW_UP0, inp(args, I_WCONV), inp(args, I_BCONV), (float*)(ws + WS_HALO), (bf16*)(ws + WS_M), (LAS float*)(F.lds + EPI_OFF), F.skip_epi};
        int fw = 0, nfw = 1; const bool fil = filler_slot(F, (MT / 256) * (FF2 / 256), fw, nfw), first = fil && (F.bid & 8);
        if (first) { p0_items(F, args, PI_SECOND, PI_ALL, fw, nfw); sw_units_f32(F, args, fw / NWAVES, nfw / NWAVES); __syncthreads(); }
        gemm_pg8_raw(F, AN, (const bf16*)(ws + WS_WUP), MT, FF2, D, E);
        if (fil && !first) { p0_items(F, args, PI_SECOND, PI_ALL, fw, nfw); sw_units_f32(F, args, fw / NWAVES, nfw / NWAVES); } }
    else if (ON(S_DN0) && s == S_DN0) { float* X = outb(args);
        { pg8::StaticOrder S0; S0.init(MT, D, F.G, F.bid, 192); pg8::Unit u0; for (int i = 0; S0.next(i, u0); ++i) fix_halo_rows(F, u0.pm * 192, u0.pm * 192 + 224, (const float*)(ws + WS_HALO), inp(args, I_WCONV), inp(args, I_BCONV), (bf16*)(ws + WS_M)); }
        EpiResT<1> E{nullptr, nullptr, (bf16*)(ws + WS_XB), nullptr, MOD0 + 5120, AN, inp(args, I_NMIX) + D, MOD1 + 1024, RS2, F.scale};
        gemm_pg8<1, EpiResT<1>, 3>(F, (const bf16*)(ws + WS_M), (const bf16*)(ws + WS_WDN), 0, MT, D, FF, E);
    }
    else if (ON(S_IN) && s == S_IN) { EpiIn E{{RS2, SW + SW_IN, GE2}, (bf16*)(ws + WS_U), (bf16*)(ws + WS_VV), (float*)(ws + WS_LNP)}; gemm_pg8<2>(F, AN, (const bf16*)(ws + WS_WIN), 0, MT, GE2, D, E); }
    else if (ON(S_MIX) && s == S_MIX) MIX(F, args);
    else if (ON(S_OUT) && s == S_OUT) { float* X = outb(args);
        EpiResT<1> E{nullptr, nullptr, (bf16*)(ws + WS_XB), nullptr, MOD1 + 2048, AN, inp(args, I_NFFN) + D, MOD1 + 4096, RS3, F.scale};
        gemm_pg8<1, EpiResT<1>, 3>(F, (const bf16*)(ws + WS_U), (const bf16*)(ws + WS_WOUT), 0, MT, D, GE, E); }
    else if (ON(S_UP1) && s == S_UP1) { EpiUpConv E{RS3, SW + SW_UP1, inp(args, I_WCONV) + (size_t)3 * FF2, inp(args, I_BCONV) + FF2, (float*)(ws + WS_HALO), (bf16*)(ws + WS_M), (LAS float*)(F.lds + EPI_OFF), F.skip_epi};
        int fw = 0, nfw = 1; const bool fil = filler_slot(F, (MT / 256) * (FF2 / 256), fw, nfw), first = fil && (F.bid & 8);
        if (first) state_items(F, args, fw, nfw);
        gemm_pg8_raw(F, AN, (const bf16*)(ws + WS_WUP) + (size_t)FF2 * D, MT, FF2, D, E);
        if (fil && !first) state_items(F, args, fw, nfw); }
    else if (ON(S_DN1) && s == S_DN1) { float* X = outb(args);
        { pg8::StaticOrder S0; S0.init(MT, D, F.G, F.bid, 192); pg8::Unit u0; for (int i = 0; S0.next(i, u0); ++i) fix_halo_rows(F, u0.pm * 192, u0.pm * 192 + 224, (const float*)(ws + WS_HALO), inp(args, I_WCONV) + (size_t)3 * FF2, inp(args, I_BCONV) + FF2, (bf16*)(ws + WS_M)); }
        EpiFinal E{(const bf16*)(ws + WS_XB), X, MOD1 + 5120, inp(args, I_NFIN), RS0 + (size_t)MT * 16, (unsigned*)ws + CW_CNT, (unsigned*)ws + CW_TMO, F.scale};
        gemm_pg8<1, EpiFinal, 3>(F, (const bf16*)(ws + WS_M), (const bf16*)(ws + WS_WDN) + (size_t)D * FF, 0, MT, D, FF, E); }
}

__global__ void __launch_bounds__(NWAVES * 64, 2) mk_fwd(Args args) {
    extern __shared__ __attribute__((aligned(16))) unsigned char lds[];
    Frame F;
    F.lds = (LAS unsigned char*)lds;
    F.MISC = (volatile LAS unsigned*)(F.lds + MISC_OFF);
    F.tid = threadIdx.x; F.lane = F.tid & 63; F.wave = __builtin_amdgcn_readfirstlane(F.tid >> 6);
    F.G = gridDim.x; F.bid = blockIdx.x; F.scale = 1.f; F.skip_epi = false;
    for (int u = F.tid; u < (LDS_BYTES - LDSCTL_OFF) / 4; u += NWAVES * 64) ((LAS unsigned*)(F.lds + LDSCTL_OFF))[u] = 0u;
    __syncthreads();
    XcdBarrier bar = xcd_barrier_post((unsigned*)(args.ws + WS_CTL) + CW_BAR, F.MISC + 8);
    for (int q = 0; q < args.nseq; ++q) {
        const int sq = args.seq[q]; F.scale = (sq & 32) ? 0.f : 1.f; F.skip_epi = (sq & 64) != 0;
        run_step(F, args, sq & 31);
        if (q + 1 < args.nseq) xcd_barrier(bar);
    }
}

extern "C" void kernel_launch(void* const* d_in, const int* in_sizes, int n_in, void* d_out, int out_size, void* d_ws, size_t ws_size, hipStream_t stream) {
    static int grid = 0;
    if (grid == 0) {
        if (n_in != 23 || ws_size < WS_END) { fprintf(stderr, "kernel_launch: unexpected n_in %d / ws %zu\n", n_in, ws_size); grid = -1; return; }
        int dev = 0, cus = 0, per_cu = 0;
        if (hipGetDevice(&dev) != hipSuccess || hipDeviceGetAttribute(&cus, hipDeviceAttributeMultiprocessorCount, dev) != hipSuccess) { grid = -1; return; }
        if (hipFuncSetAttribute((const void*)mk_fwd, hipFuncAttributeMaxDynamicSharedMemorySize, LDS_BYTES) != hipSuccess) { fprintf(stderr, "kernel_launch: hipFuncSetAttribute failed\n"); grid = -1; return; }
        if (hipOccupancyMaxActiveBlocksPerMultiprocessor(&per_cu, (const void*)mk_fwd, NWAVES * 64, LDS_BYTES) != hipSuccess || per_cu < 1) { fprintf(stderr, "kernel_launch: occupancy query says %d blocks per CU\n", per_cu); per_cu = 1; }
        (void)hipGetLastError();
        grid = cus;
    }
    if (grid < 0) return;
    if (hipMemsetAsync((char*)d_ws + WS_CTL, 0, CTL_ZERO_BYTES, stream) != hipSuccess) { fprintf(stderr, "kernel_launch: memset failed\n"); return; }
    Args a{};
    for (int i = 0; i < 23; ++i) a.in[i] = (const float*)d_in[i];
    a.out = (float*)d_out; a.ws = (unsigned char*)d_ws;
#ifndef DUP_FLAGS
#define DUP_FLAGS 0
#endif
#ifndef DUP_STEP
    a.nseq = NSTEPS; for (int s = 0; s < NSTEPS; ++s) a.seq[s] = (unsigned char)s;
#else
#ifndef DUP_STEP_HI
#define DUP_STEP_HI DUP_STEP
#endif
    a.nseq = 0; for (int s = 0; s < NSTEPS; ++s) { a.seq[a.nseq++] = (unsigned char)s; if (s == DUP_STEP_HI) for (int r = DUP_STEP; r <= DUP_STEP_HI; ++r) a.seq[a.nseq++] = (unsigned char)(r | 32 | DUP_FLAGS); }
#endif
    hipLaunchKernelGGL(mk_fwd, dim3(grid), dim3(NWAVES * 64), LDS_BYTES, stream, a);
    const hipError_t le = hipPeekAtLastError();
    if (le != hipSuccess) fprintf(stderr, "kernel_launch: launch failed: %s\n", hipGetErrorName(le));
}
```

```cpp
#include <hip/hip_runtime.h>
#include <cstdio>
#include <cstdint>
#include <type_traits>


#define GAS __attribute__((address_space(1)))
#define LAS __attribute__((address_space(3)))
typedef unsigned short bf16;
typedef short bf16x8 __attribute__((ext_vector_type(8)));
typedef float f32x4 __attribute__((ext_vector_type(4)));
typedef float f32x2 __attribute__((ext_vector_type(2)));
typedef unsigned u32x4 __attribute__((ext_vector_type(4)));
typedef unsigned u32x2 __attribute__((ext_vector_type(2)));
typedef GAS unsigned gu32;

constexpr int D = 1024, NCTX = 8192, NLAT = 4096, MT = 12288, NH = 16, HD = 64, FF = 2816, FF2 = 5632, GE = 2048, GE2 = 4096, NQKV = 3072;
constexpr int SEQ_C = 256, SEQ_L = 1024, PAST = 512;
constexpr float EPS = 1e-6f, LOG2E = 1.4426950408889634f, C2 = 0.125f * 1.4426950408889634f;
constexpr int NWAVES = 8;

constexpr size_t MiB = 1u << 20;
constexpr size_t WS_CTL = 0, CTL_ZERO_BYTES = 1 * MiB + 512 * 1024;
constexpr size_t WS_MOD = 512 * 1024;
constexpr size_t WS_TS = 800 * 1024;
constexpr size_t WS_SW = 1 * MiB;
constexpr size_t WS_HALO = 1 * MiB + 512 * 1024;
constexpr size_t WS_RS = 3 * MiB;
constexpr size_t WS_LNP = 4 * MiB;
constexpr size_t WS_WQKV = 5 * MiB, WS_WO = 11 * MiB, WS_WIN = 13 * MiB, WS_WOUT = 21 * MiB, WS_WUP = 25 * MiB, WS_WDN = 47 * MiB;
constexpr size_t WUP_BYTES = 11 * MiB, WDN_BYTES = (size_t)1024 * 2816 * 2;
constexpr size_t WS_WSB = 58 * MiB;
constexpr size_t WS_CK = 59 * MiB, WS_CV = 63 * MiB;
constexpr size_t WS_AN = 67 * MiB;
constexpr size_t WS_BIG = 91 * MiB;
constexpr size_t WS_Q = WS_BIG, WS_K = WS_BIG + 24 * MiB, WS_V = WS_BIG + 48 * MiB;
constexpr size_t WS_M = WS_BIG, WS_ARAW = WS_BIG + 66 * MiB;
constexpr size_t WS_U = WS_BIG, WS_VV = WS_BIG + 48 * MiB;
constexpr size_t WS_XB = 200 * MiB;
constexpr size_t WS_KC = 224 * MiB, WS_VC = 240 * MiB;
constexpr size_t WS_END = 256 * MiB;
static_assert(WS_HALO + (size_t)16 * 4 * 5632 * 4 <= WS_RS && WS_SW + 5 * (3072 + 5632 + 4096 + 5632) * 4 <= CTL_ZERO_BYTES, "zeroed region / halo");
static_assert(WS_ARAW + (size_t)4096 * 5632 * 2 <= WS_END && WS_WDN + 2 * WDN_BYTES <= WS_CK && WS_VV + 48 * MiB <= WS_END, "ws map");
constexpr int SW_QKV = 0, SW_UP0 = 5 * NQKV, SW_IN = SW_UP0 + 5 * FF2, SW_UP1 = SW_IN + 5 * GE2;
constexpr int CW_TMO = 0, CW_CODE = 1, CW_BAR = 4096;

#define RLX_AGENT __ATOMIC_RELAXED, __HIP_MEMORY_SCOPE_AGENT
#define LDS_WAIT() asm volatile("s_waitcnt lgkmcnt(0)" ::: "memory")
#define VM_WAIT() asm volatile("s_waitcnt vmcnt(0)" ::: "memory")
__device__ __forceinline__ unsigned cvt_pk_bf16(float lo, float hi) { unsigned r; asm volatile("v_cvt_pk_bf16_f32 %0, %1, %2" : "=v"(r) : "v"(lo), "v"(hi)); return r; }
__device__ __forceinline__ float bf2f(unsigned short u) { return __uint_as_float((unsigned)u << 16); }
__device__ __forceinline__ float bflo(unsigned w) { return __uint_as_float(w << 16); }
__device__ __forceinline__ float bfhi(unsigned w) { return __uint_as_float(w & 0xffff0000u); }
__device__ __forceinline__ u32x4 pack8(f32x4 a, f32x4 b) { u32x4 w; w.x = cvt_pk_bf16(a[0], a[1]); w.y = cvt_pk_bf16(a[2], a[3]); w.z = cvt_pk_bf16(b[0], b[1]); w.w = cvt_pk_bf16(b[2], b[3]); return w; }
__device__ __forceinline__ float wave_sum(float v) {
#pragma unroll
    for (int o = 1; o < 64; o <<= 1) v += __shfl_xor(v, o);
    return v;
}
__device__ __forceinline__ float silu_f(float x) { return x * __builtin_amdgcn_rcpf(1.f + __builtin_amdgcn_exp2f(-x * LOG2E)); }
__device__ __forceinline__ float gelu_tanh_f(float x) { const float u = (-1.5957691216057308f * LOG2E) * (x + 0.044715f * x * x * x); return x * __builtin_amdgcn_rcpf(1.f + __builtin_amdgcn_exp2f(u)); }
__device__ __forceinline__ int ci_of(int row) { return row < NCTX ? 0 : 1 + ((row - NCTX) >> 10); }


__device__ __forceinline__ void st4f_wt(float* p, float v) { __hip_atomic_store((unsigned*)p, __float_as_uint(v), __ATOMIC_RELAXED, __HIP_MEMORY_SCOPE_AGENT); }
__device__ __forceinline__ void wave_publish(unsigned* cnt) {
    asm volatile("s_waitcnt vmcnt(0)" ::: "memory");
    if ((threadIdx.x & 63) == 0) __hip_atomic_fetch_add(cnt, 1u, __ATOMIC_RELAXED, __HIP_MEMORY_SCOPE_AGENT);
}
__device__ __forceinline__ void wave_wait_ge(unsigned* cnt, unsigned need, unsigned* tmo) {
    unsigned sp = 0;
    while ((unsigned)__builtin_amdgcn_readfirstlane(__hip_atomic_load(cnt, __ATOMIC_RELAXED, __HIP_MEMORY_SCOPE_AGENT)) < need) {
        __builtin_amdgcn_s_sleep(2);
        if (++sp > (1u << 22)) { if ((threadIdx.x & 63) == 0) __hip_atomic_store(tmo, 1u, __ATOMIC_RELAXED, __HIP_MEMORY_SCOPE_AGENT); break; } }
}
constexpr int CW_CNT = 16384;
#define XB_TMO      128
#define XB_XCNT(j)  (256  + 64 * (j))
#define XB_XSUB(j)  (1280 + 64 * (j))
#define XB_XGEN(j)  (2304 + 64 * (j))
#define XB_TOP      3328
#define XB_TOPGEN   3392
#define XCD_BAR_WORDS 3456
#define XB_SPIN_CAP (1u << 18)
__device__ __forceinline__ unsigned xb_ld(unsigned* p)              { return __hip_atomic_load(p, __ATOMIC_RELAXED, __HIP_MEMORY_SCOPE_AGENT); }
__device__ __forceinline__ unsigned xb_add(unsigned* p, unsigned v) { return __hip_atomic_fetch_add(p, v, __ATOMIC_RELAXED, __HIP_MEMORY_SCOPE_AGENT); }
__device__ __forceinline__ unsigned xb_xcc_id() { return (unsigned)__builtin_amdgcn_s_getreg((3 << 11) | 20) & 0xFu; }
#define XB_SPIN(cond, bar) do { unsigned _sp = 0; while (cond) { __builtin_amdgcn_s_sleep(1); \
    if ((++_sp & 255u) == 0u) { if (xb_ld(&(bar)[XB_TMO])) break; if (_sp > XB_SPIN_CAP) { atomicAdd(&(bar)[XB_TMO], 1u); break; } } } } while (0)
struct XcdBarrier { unsigned* bar; unsigned x; volatile LAS unsigned* st; };
__device__ __forceinline__ XcdBarrier xcd_barrier_post(unsigned* bar, volatile LAS unsigned* st) {
    XcdBarrier b; b.bar = bar; b.x = xb_xcc_id(); b.st = st;
    if (threadIdx.x == 0) (void)xb_add(&bar[XB_XCNT(b.x)], 1u);
    return b;
}
__device__ __forceinline__ void xcd_barrier_complete(unsigned* bar, unsigned x, unsigned& nloc, unsigned& nx) {
    const unsigned G = gridDim.x * gridDim.y * gridDim.z;
    unsigned sum, cnt, mine, sp = 0u;
    for (;;) {
        sum = 0u; cnt = 0u; mine = 0u;
#pragma unroll
        for (unsigned j = 0; j < 16; ++j) { const unsigned c = xb_ld(&bar[XB_XCNT(j)]); sum += c; cnt += (c > 0u) ? 1u : 0u; mine = (j == x) ? c : mine; }
        if (sum == G) break;
        __builtin_amdgcn_s_sleep(1);
        if ((++sp & 255u) == 0u) { if (xb_ld(&bar[XB_TMO])) break; if (sp > XB_SPIN_CAP) { atomicAdd(&bar[XB_TMO], 1u); break; } }
    }
    nloc = mine > 0u ? mine : 1u; nx = cnt > 0u ? cnt : 1u;
}
__device__ __forceinline__ void xcd_barrier(const XcdBarrier& b) {
    asm volatile("s_waitcnt vmcnt(0)" ::: "memory");
    __syncthreads();
    if (threadIdx.x == 0) {
        unsigned* bar = b.bar;
        __builtin_amdgcn_s_waitcnt(0);
        unsigned nloc = b.st[0], nx = b.st[1];
        if (nloc == 0u) { xcd_barrier_complete(bar, b.x, nloc, nx); b.st[0] = nloc; b.st[1] = nx; }
        const unsigned old = xb_add(&bar[XB_XSUB(b.x)], 1u);
        const unsigned gen = old / nloc;
        if (old + 1u == (gen + 1u) * nloc) {
            __builtin_amdgcn_fence(__ATOMIC_RELEASE, "agent");
            asm volatile("s_waitcnt vmcnt(0)" ::: "memory");
            const unsigned og = xb_add(&bar[XB_TOP], 1u);
            const unsigned tg = og / nx;
            if (og + 1u == (tg + 1u) * nx) xb_add(&bar[XB_TOPGEN], 1u);
            else XB_SPIN(xb_ld(&bar[XB_TOPGEN]) == tg, bar);
            __builtin_amdgcn_fence(__ATOMIC_ACQUIRE, "agent");
            xb_add(&bar[XB_XGEN(b.x)], 1u);
            asm volatile("s_waitcnt vmcnt(0)" ::: "memory");
        } else {
            XB_SPIN(xb_ld(&bar[XB_XGEN(b.x)]) == gen, bar);
            __builtin_amdgcn_fence(__ATOMIC_ACQUIRE, "agent");
            asm volatile("s_waitcnt vmcnt(0)" ::: "memory");
        }
    }
    __syncthreads();
}

constexpr int RING_OFF = 0, RING_BYTES = 131072;
constexpr int LDSCTL_OFF = RING_BYTES, MISC_OFF = LDSCTL_OFF + 320;
constexpr int LDS_BYTES = 147456;

struct Frame {
    LAS unsigned char* lds;
    volatile LAS unsigned* MISC;
    int tid, lane, wave, G, bid;
    bool skip_epi;
    float scale;
};
struct Args { const float* in[23]; float* out; unsigned char* ws; int nseq, pad; unsigned char seq[32]; };
#define ASSUME_GLOBAL(p) __builtin_assume(!__builtin_amdgcn_is_shared((const void*)(p)) && !__builtin_amdgcn_is_private((const void*)(p)))
__device__ __forceinline__ const float* inp(const Args& a, int i) { asm volatile("" : "+s"(i)); const float* p = a.in[i]; return (const float*)(const GAS float*)p; }
__device__ __forceinline__ unsigned char* wsb(const Args& a) { unsigned char* p = a.ws; asm volatile("" : "+s"(p)); return (unsigned char*)(GAS unsigned char*)p; }
__device__ __forceinline__ float* outb(const Args& a) { float* p = a.out; asm volatile("" : "+s"(p)); return (float*)(GAS float*)p; }
enum InIdx { I_XP = 0, I_XS, I_CK, I_CV, I_C, I_CCTX, I_WADA, I_BADA, I_NMIX, I_NFFN, I_NFIN, I_WQKV, I_WO, I_RPB, I_WIN, I_GV, I_WSP, I_BSP, I_WOUT, I_WUP, I_WCONV, I_BCONV, I_WDN };


#define G_LD4(p)   (*(const GAS f32x4*)(p))
#define G_LDU4(p)  (*(const GAS u32x4*)(p))
#define G_ST4(p,v) (*(GAS f32x4*)(p) = (v))
#define G_STU4(p,v) (*(GAS u32x4*)(p) = (v))

__device__ __forceinline__ int upmap(int n) { return n < FF ? ((n >> 7) << 8) + (n & 127) : (((n - FF) >> 7) << 8) + 128 + ((n - FF) & 127); }
constexpr int ADA_UNITS = 2 * 24 * 4;
__device__ __forceinline__ void p0_adaln_unit(const Frame& F, const Args& args, int u) {
    const float* w_ada = inp(args, I_WADA); const float* c_ctx = inp(args, I_CCTX); const float* cc = inp(args, I_C);
    float* MOD = (float*)(wsb(args) + WS_MOD);
    const int jb = u % 24, kq = (u / 24) & 3, l = u / 96;
    const int k0 = kq * 256 + F.wave * 32;
    const float* W = w_ada + ((size_t)l * D + k0) * 6144 + jb * 256 + F.lane * 4;
    f32x4 acc[5];
#pragma unroll
    for (int q = 0; q < 5; ++q) acc[q] = (f32x4){0.f, 0.f, 0.f, 0.f};
    for (int i0 = 0; i0 < 32; i0 += 16) {
        f32x4 w[16];
#pragma unroll
        for (int i = 0; i < 16; ++i) w[i] = G_LD4(W + (size_t)(i0 + i) * 6144);
#pragma unroll
        for (int i = 0; i < 16; ++i) { const int k = k0 + i0 + i;
            acc[0] += silu_f(c_ctx[k]) * w[i];
#pragma unroll
            for (int b = 0; b < 4; ++b) acc[1 + b] += silu_f(cc[b * D + k]) * w[i]; }
    }
    LAS f32x4* red = (LAS f32x4*)(F.lds + RING_OFF);
#pragma unroll
    for (int q = 0; q < 5; ++q) red[(F.wave * 5 + q) * 64 + F.lane] = acc[q];
    __syncthreads();
    const LAS float* redf = (const LAS float*)red;
    for (int o = F.tid; o < 5 * 256; o += NWAVES * 64) { const int q = o >> 8, c = o & 255;
        float s = 0.f;
#pragma unroll
        for (int w = 0; w < NWAVES; ++w) s += redf[(w * 5 + q) * 256 + c];
        if (kq == 0) s += inp(args, I_BADA)[l * 6144 + jb * 256 + c];
        atomicAdd(MOD + (size_t)(l * 5 + q) * 6144 + jb * 256 + c, s * F.scale); }
    __syncthreads();
}
constexpr int PI_QKV = (D / 64) * (NQKV / 32), PI_FIRST = PI_QKV;
constexpr int PI_CACHE = 4096, PI_WSP = 512, PI_O = (D / 64) * (D / 32), PI_IN = (D / 64) * (GE2 / 32), PI_OUT = (GE / 64) * (D / 32), PI_UP = (D / 64) * (FF2 / 32), PI_DN = (FF / 64) * (D / 32);
constexpr int PI_SECOND = PI_FIRST + PI_CACHE + PI_WSP + PI_O + PI_UP + PI_DN, PI_ALL = PI_SECOND + PI_UP + PI_DN + PI_IN + PI_OUT;
__device__ __forceinline__ void p0_transpose_seg(const float* W, int K, int N, bf16* WT, bool upperm, LAS float* scr, int it, int end, int stride, int lane) {
    if (it >= end) return;
    const int nblk = N / 32;
    f32x4 v[8];
    { const int k0 = 64 * (it / nblk), n0 = 32 * (it % nblk);
#pragma unroll
      for (int i = 0; i < 8; ++i) v[i] = G_LD4(W + (size_t)(k0 + 8 * i + (lane >> 3)) * N + n0 + 4 * (lane & 7)); }
    for (; it < end; it += stride) {
        const int k0 = 64 * (it / nblk), n0 = 32 * (it % nblk), nm0 = upperm ? upmap(n0) : n0;
#pragma unroll
        for (int i = 0; i < 8; ++i) { LAS float* d = scr + (8 * i + (lane >> 3)) * 33 + 4 * (lane & 7); d[0] = v[i].x; d[1] = v[i].y; d[2] = v[i].z; d[3] = v[i].w; }
        const int itn = it + stride;
        if (itn < end) { const int k1 = 64 * (itn / nblk), n1 = 32 * (itn % nblk);
#pragma unroll
            for (int i = 0; i < 8; ++i) v[i] = G_LD4(W + (size_t)(k1 + 8 * i + (lane >> 3)) * N + n1 + 4 * (lane & 7)); }
        LDS_WAIT(); asm volatile("" ::: "memory");
        const int c = lane & 7;
#pragma unroll
        for (int j = 0; j < 4; ++j) { const int n = (lane >> 3) + 8 * j; const LAS float* s = scr + (8 * c) * 33 + n;
            u32x4 o; o.x = cvt_pk_bf16(s[0 * 33], s[1 * 33]); o.y = cvt_pk_bf16(s[2 * 33], s[3 * 33]); o.z = cvt_pk_bf16(s[4 * 33], s[5 * 33]); o.w = cvt_pk_bf16(s[6 * 33], s[7 * 33]);
            G_STU4(WT + (size_t)(nm0 + n) * K + k0 + 8 * c, o); }
        LDS_WAIT(); asm volatile("" ::: "memory");
    }
}
__device__ __forceinline__ void p0_cache_seg(const Args& args, int it, int end, int stride, int lane) {
    if (it >= end) return;
    f32x4 a[4];
    { const int which = it >> 11, r = it & 2047, cg = r & 31, h = (r >> 5) & 15, b = r >> 9;
      const float* s = inp(args, which ? I_CV : I_CK) + (((size_t)b * NH + h) * PAST + cg * 16 + (lane >> 2)) * HD + (lane & 3) * 16;
#pragma unroll
      for (int i = 0; i < 4; ++i) a[i] = G_LD4(s + 4 * i); }
    for (; it < end; it += stride) {
        const int which = it >> 11, r = it & 2047, cg = r & 31, h = (r >> 5) & 15, b = r >> 9;
        bf16* d = (bf16*)(wsb(args) + (which ? WS_CV : WS_CK)) + ((size_t)b * PAST + cg * 16 + (lane >> 2)) * D + h * HD + (lane & 3) * 16;
        const u32x4 o0 = pack8(a[0], a[1]), o1 = pack8(a[2], a[3]);
        const int itn = it + stride;
        if (itn < end) { const int w1 = itn >> 11, r1 = itn & 2047, cg1 = r1 & 31, h1 = (r1 >> 5) & 15, b1 = r1 >> 9;
            const float* s = inp(args, w1 ? I_CV : I_CK) + (((size_t)b1 * NH + h1) * PAST + cg1 * 16 + (lane >> 2)) * HD + (lane & 3) * 16;
#pragma unroll
            for (int i = 0; i < 4; ++i) a[i] = G_LD4(s + 4 * i); }
        G_STU4(d, o0); G_STU4(d + 8, o1);
    }
}
__device__ __forceinline__ int first_from(int start, int stride, int s0) { return start >= s0 ? start : start + (s0 - start + stride - 1) / stride * stride; }
__device__ __forceinline__ void p0_items(const Frame& F, const Args& args, int lo, int hi, int fw, int nfw) {
    LAS float* scr = (LAS float*)(F.lds + RING_OFF + F.wave * 16384);
    unsigned char* ws = wsb(args);
    int base = 0;
#define P0_SEG(n, s0v, itv, endv) const int s0v = base; base += (n); const int endv = (hi < base ? hi : base) - s0v, itv = first_from(lo + fw, nfw, s0v) - s0v;
    { P0_SEG(PI_QKV, s0, it, end) p0_transpose_seg(inp(args, I_WQKV), D, NQKV, (bf16*)(ws + WS_WQKV), false, scr, it, end, nfw, F.lane); }
    if (hi <= base) return;
    { P0_SEG(PI_CACHE, s0, it, end) p0_cache_seg(args, it, end, nfw, F.lane); }
    { P0_SEG(PI_WSP, s0, it, end) for (int r = it; r < end; r += nfw) { const float* s = inp(args, I_WSP) + (size_t)r * 512 + F.lane * 8; const f32x4 a0 = *(const f32x4*)s, a1 = *(const f32x4*)(s + 4); *(u32x4*)((bf16*)(ws + WS_WSB) + (size_t)r * 512 + F.lane * 8) = pack8(a0, a1); } }
    { P0_SEG(PI_O, s0, it, end) p0_transpose_seg(inp(args, I_WO), D, D, (bf16*)(ws + WS_WO), false, scr, it, end, nfw, F.lane); }
    { P0_SEG(PI_UP, s0, it, end) p0_transpose_seg(inp(args, I_WUP), D, FF2, (bf16*)(ws + WS_WUP), true, scr, it, end, nfw, F.lane); }
    { P0_SEG(PI_DN, s0, it, end) p0_transpose_seg(inp(args, I_WDN), FF, D, (bf16*)(ws + WS_WDN), false, scr, it, end, nfw, F.lane); }
    if (hi <= base) return;
    { P0_SEG(PI_UP, s0, it, end) p0_transpose_seg(inp(args, I_WUP) + (size_t)D * FF2, D, FF2, (bf16*)(ws + WS_WUP) + (size_t)FF2 * D, true, scr, it, end, nfw, F.lane); }
    { P0_SEG(PI_DN, s0, it, end) p0_transpose_seg(inp(args, I_WDN) + (size_t)FF * D, FF, D, (bf16*)(ws + WS_WDN) + (size_t)D * FF, false, scr, it, end, nfw, F.lane); }
    { P0_SEG(PI_IN, s0, it, end) p0_transpose_seg(inp(args, I_WIN), D, GE2, (bf16*)(ws + WS_WIN), false, scr, it, end, nfw, F.lane); }
    { P0_SEG(PI_OUT, s0, it, end) p0_transpose_seg(inp(args, I_WOUT), GE, D, (bf16*)(ws + WS_WOUT), false, scr, it, end, nfw, F.lane); }
#undef P0_SEG
}
constexpr int ST_ITEMS = 2 * 32 * NH * (SEQ_C / 16);
__device__ __forceinline__ void state_items(const Frame& F, const Args& args, int fw, int nfw) {
    unsigned char* ws = wsb(args); float* out = outb(args);
    for (int it = fw; it < ST_ITEMS; it += nfw) {
        const int tg = it & 15, h = (it >> 4) & 15, b = (it >> 8) & 31, which = it >> 13;
        const bf16* src = (const bf16*)(ws + (which ? WS_VC : WS_KC)) + (size_t)(b * SEQ_C + tg * 16 + (F.lane >> 2)) * D + h * HD + (F.lane & 3) * 16;
        const u32x4 w0 = G_LDU4(src), w1 = G_LDU4(src + 8);
        float* dst = out + (size_t)MT * D + (size_t)which * NCTX * D + (((size_t)b * NH + h) * SEQ_C + tg * 16 + (F.lane >> 2)) * HD + (F.lane & 3) * 16;
        f32x4 o0, o1, o2, o3;
        o0.x = bflo(w0.x); o0.y = bfhi(w0.x); o0.z = bflo(w0.y); o0.w = bfhi(w0.y); o1.x = bflo(w0.z); o1.y = bfhi(w0.z); o1.z = bflo(w0.w); o1.w = bfhi(w0.w);
        o2.x = bflo(w1.x); o2.y = bfhi(w1.x); o2.z = bflo(w1.y); o2.w = bfhi(w1.y); o3.x = bflo(w1.z); o3.y = bfhi(w1.z); o3.z = bflo(w1.w); o3.w = bfhi(w1.w);
        G_ST4(dst, o0); G_ST4(dst + 4, o1); G_ST4(dst + 8, o2); G_ST4(dst + 12, o3);
    }
}
__device__ __forceinline__ bool filler_slot(const Frame& F, int nunits, int& fw, int& nfw) {
    const int rem = nunits % F.G, first = rem, nblk = F.G - rem;
    if (F.bid < first) return false;
    fw = (F.bid - first) * NWAVES + F.wave; nfw = nblk * NWAVES; return true;
}

__device__ __forceinline__ void p1_rows(const Frame& F, const Args& args, const int gw, const int nbusy) {
    const int NGW = F.G * NWAVES, lane = F.lane;
    const float* xp = inp(args, I_XP); const float* xs = inp(args, I_XS); const float* gmix = inp(args, I_NMIX);
    unsigned char* ws = wsb(args);
    const float* MOD = (const float*)(ws + WS_MOD); float* RS = (float*)(ws + WS_RS); bf16* AN = (bf16*)(ws + WS_AN);
    const int nshort = NGW > 2 * nbusy ? nbusy : 0; const bool busy = gw < nshort;
    int m = busy ? gw : 3 * nshort + (gw - nshort); const int mstep = busy ? nshort : NGW - nshort, mend = busy ? 3 * nshort : MT;
    f32x4 g[4], v[4];
#pragma unroll
    for (int j = 0; j < 4; ++j) g[j] = G_LD4(gmix + 4 * lane + 256 * j);
    if (m < mend) { const float* xr = (m < NCTX) ? xp + (size_t)m * D : xs + (size_t)(m - NCTX) * D;
#pragma unroll
        for (int j = 0; j < 4; ++j) v[j] = G_LD4((const f32x4*)xr + lane + 64 * j); }
    for (; m < mend; m += mstep) {
        const float* sc = MOD + (size_t)ci_of(m) * 6144 + 1024;
        f32x4 cs[4], vn[4];
#pragma unroll
        for (int j = 0; j < 4; ++j) cs[j] = G_LD4(sc + 4 * lane + 256 * j);
        const int mn = m + mstep;
        if (mn < mend) { const float* xr = (mn < NCTX) ? xp + (size_t)mn * D : xs + (size_t)(mn - NCTX) * D;
#pragma unroll
            for (int j = 0; j < 4; ++j) vn[j] = G_LD4((const f32x4*)xr + lane + 64 * j); }
        float s = 0.f;
#pragma unroll
        for (int j = 0; j < 4; ++j) s += (v[j].x * v[j].x + v[j].y * v[j].y) + (v[j].z * v[j].z + v[j].w * v[j].w);
        s = wave_sum(s);
        if (lane == 0) G_ST4(RS + (size_t)m * 4, ((f32x4){s, 0.f, 0.f, 0.f}));
#pragma unroll
        for (int j = 0; j < 4; ++j) { const int col = 4 * lane + 256 * j;
            const f32x4 o = v[j] * g[j] * (1.f + cs[j]);
            u32x2 w; w.x = cvt_pk_bf16(o[0], o[1]); w.y = cvt_pk_bf16(o[2], o[3]);
            *(GAS u32x2*)(AN + (size_t)m * D + col) = w; }
#pragma unroll
        for (int j = 0; j < 4; ++j) v[j] = vn[j];
    }
}
namespace pg8 {
#define PG8_LAS __attribute__((address_space(3)))
typedef unsigned short bf16_t;
typedef short bf16x8 __attribute__((ext_vector_type(8)));
typedef float f32x4 __attribute__((ext_vector_type(4)));
typedef unsigned u32x4 __attribute__((ext_vector_type(4)));
constexpr int BM = 256, BK = 64, HALF = 128, HTB = HALF * BK * 2  , STAGE_BYTES = 8 * HTB, NXCD = 8, WGM = 8;

__host__ __device__ __forceinline__ int lds_byte(int r, int c) { const int st = (r >> 4) * 2 + (c >> 5), rr = r & 15, cc = c & 31, ob = rr * 64 + cc * 2; return st * 1024 + (ob ^ (((ob >> 9) & 1) << 5)); }
__host__ __device__ __forceinline__ void stage_rc(int b, int& R, int& C) { const int st = b / 1024, sb = b % 1024, swz = sb ^ (((sb >> 9) & 1) << 5); R = (st >> 1) * 16 + swz / 64; C = (st & 1) * 32 + (swz % 64) / 2; }
__host__ __device__ __forceinline__ int perm32(int rho) { const int n = rho >> 4, i = rho & 15; return 8 * (i >> 2) + 4 * n + (i & 3); }

struct Unit { int pm, pn; };
struct Gemm { const bf16_t* A; const bf16_t* Bt; int M, N, K; };

struct StaticOrder {
    int nM, nN, nwg, G, c;
    __host__ __device__ void init(int M, int N, int G_, int c_, int bmr = BM) { nM = M / bmr; nN = N / BM; nwg = nM * nN; G = G_; c = c_; }
    __host__ __device__ bool next(int i, Unit& u) const {
        const long L = (long)i * G + c; if (L >= nwg) return false;
        int wgid = (int)L; { const int q = nwg / NXCD, r = nwg % NXCD, xcd = wgid % NXCD, off = wgid / NXCD; wgid = (xcd < r ? xcd * (q + 1) : r * (q + 1) + (xcd - r) * q) + off; }
        const int nig = WGM * nN, gid = wgid / nig, fm = gid * WGM, gsz = (nM - fm) < WGM ? (nM - fm) : WGM;
        u.pm = fm + ((wgid % nig) % gsz); u.pn = (wgid % nig) / gsz; return true;
    }
    __device__ __forceinline__ void a_ready(const Unit&) const {}
    __device__ __forceinline__ void done(const Unit&) const {}
};

template <class E> struct epi_is_final { static constexpr bool value = false; };
template <class E, int NRED, int MB = 4> struct EpiAdapt {
    static constexpr bool PERM = true, AFTER_DRAIN = false; static constexpr int BMR = 64 * MB;
    __device__ __forceinline__ void fused(f32x4 (&acc)[2][2][MB][2], const Unit& u, int wr, int wc, int fr, int fq, PG8_LAS unsigned char*, int, int) const { (*this)(acc, u, wr, wc, fr, fq); }
    E e; int row0; PG8_LAS float* P; bool skip;
    __device__ __forceinline__ void operator()(f32x4 (&acc)[2][2][MB][2], const Unit& u, int wr, int wc, int fr, int fq) const {
        if (skip) return;
        asm volatile("" : "+v"(fr), "+v"(fq));
        const int rl = wr * 16 * MB + fr, rbase = row0 + u.pm * BMR + rl, cbase = u.pn * BM + wc * 32 + 8 * fq;
        float red[2][MB][NRED > 0 ? NRED : 1];
#pragma unroll
        for (int ai = 0; ai < 2; ++ai)
#pragma unroll
            for (int m = 0; m < MB; ++m)
#pragma unroll
                for (int k = 0; k < (NRED > 0 ? NRED : 1); ++k) red[ai][m][k] = 0.f;
        if constexpr (E::HAS_LIN) {
            static_assert(MB == 4, "HAS_LIN epilogues run on 256-row tiles");
            f32x4 p[2][MB], sw[2][2];
#pragma unroll
            for (int ai = 0; ai < 2; ++ai)
#pragma unroll
                for (int m = 0; m < MB; ++m) p[ai][m] = G_LD4(e.L.RS + (size_t)(rbase + ai * (BMR / 2) + m * 16) * 4);
            { const float* s = e.L.SW + (size_t)ci_of(row0 + u.pm * BMR) * e.L.N + cbase;
#pragma unroll
              for (int bj = 0; bj < 2; ++bj) { sw[bj][0] = G_LD4(s + bj * HALF); sw[bj][1] = G_LD4(s + bj * HALF + 4); } }
            __builtin_amdgcn_sched_barrier(0);
#pragma unroll
            for (int ai = 0; ai < 2; ++ai)
#pragma unroll
                for (int m = 0; m < MB; ++m) { const f32x4 q = p[ai][m];
                    const float r = __builtin_amdgcn_rsqf(((q.x + q.y) + (q.z + q.w)) * (1.f / D) + EPS);
#pragma unroll
                    for (int bj = 0; bj < 2; ++bj) e.post(rbase + ai * (BMR / 2) + m * 16, cbase + bj * HALF, acc[ai][bj][m][0] * r + sw[bj][0], acc[ai][bj][m][1] * r + sw[bj][1], red[ai][m]); }
        } else if constexpr (E::HAS_PRE) {
            PG8_LAS float* ST = P + 2048;
            const int ci_lo = ci_of(row0 + u.pm * BMR), ci_hi = ci_of(row0 + u.pm * BMR + BMR - 1);
            { const int t = (wr * 4 + wc) * 64 + fq * 16 + fr;
              float sv[2];
#pragma unroll
              for (int k = 0; k < 2; ++k) { const int idx = t + 512 * k; sv[k] = e.stage_val(idx >> 9, ((idx >> 8) & 1) ? ci_hi : ci_lo, u.pn * BM + (idx & 255)); }
#pragma unroll
              for (int k = 0; k < 2; ++k) ST[t + 512 * k] = sv[k]; }
#define PG8_STP(row, col) (ST + (ci_of(row) != ci_lo ? 256 : 0) + ((col) - u.pn * BM))
            if constexpr (E::PRE_HALVES) {
#pragma unroll
                for (int ai = 0; ai < 2; ++ai) {
                    typename E::Pre pre[MB][2];
#pragma unroll
                    for (int m = 0; m < MB; ++m)
#pragma unroll
                        for (int bj = 0; bj < 2; ++bj) pre[m][bj] = e.prefetch(rbase + ai * (BMR / 2) + m * 16, cbase + bj * HALF);
                    __builtin_amdgcn_sched_barrier(0);
                    if (ai == 0) { asm volatile("s_waitcnt lgkmcnt(0)" ::: "memory"); __builtin_amdgcn_s_barrier(); asm volatile("" ::: "memory"); }
#pragma unroll
                    for (int m = 0; m < MB; ++m)
#pragma unroll
                        for (int bj = 0; bj < 2; ++bj) e.apply_pre(rbase + ai * (BMR / 2) + m * 16, cbase + bj * HALF, acc[ai][bj][m][0], acc[ai][bj][m][1], red[ai][m], pre[m][bj], PG8_STP(rbase + ai * (BMR / 2) + m * 16, cbase + bj * HALF));
                    __builtin_amdgcn_sched_barrier(0); }
            } else {
            typename E::Pre pre[2][MB][2];
#pragma unroll
            for (int ai = 0; ai < 2; ++ai)
#pragma unroll
                for (int m = 0; m < MB; ++m)
#pragma unroll
                    for (int bj = 0; bj < 2; ++bj) pre[ai][m][bj] = e.prefetch(rbase + ai * (BMR / 2) + m * 16, cbase + bj * HALF);
            __builtin_amdgcn_sched_barrier(0);
            asm volatile("s_waitcnt lgkmcnt(0)" ::: "memory"); __builtin_amdgcn_s_barrier(); asm volatile("" ::: "memory");
#pragma unroll
            for (int ai = 0; ai < 2; ++ai)
#pragma unroll
                for (int m = 0; m < MB; ++m)
#pragma unroll
                    for (int bj = 0; bj < 2; ++bj) e.apply_pre(rbase + ai * (BMR / 2) + m * 16, cbase + bj * HALF, acc[ai][bj][m][0], acc[ai][bj][m][1], red[ai][m], pre[ai][m][bj], PG8_STP(rbase + ai * (BMR / 2) + m * 16, cbase + bj * HALF));
            }
        } else {
#pragma unroll
        for (int ai = 0; ai < 2; ++ai)
#pragma unroll
            for (int m = 0; m < MB; ++m)
#pragma unroll
                for (int bj = 0; bj < 2; ++bj) e.apply(rbase + ai * (BMR / 2) + m * 16, cbase + bj * HALF, acc[ai][bj][m][0], acc[ai][bj][m][1], red[ai][m]);
        }
        if constexpr (NRED > 0) {
            if (e.want_red(u.pn)) {
#pragma unroll
                for (int ai = 0; ai < 2; ++ai)
#pragma unroll
                    for (int m = 0; m < MB; ++m)
#pragma unroll
                        for (int k = 0; k < NRED; ++k) { float s = red[ai][m][k]; s += __shfl_xor(s, 16); s += __shfl_xor(s, 32); if (fq == 0) P[((ai * (BMR / 2) + rl + m * 16) * 4 + wc) * 2 + k] = s; }
                asm volatile("s_waitcnt lgkmcnt(0)" ::: "memory"); __builtin_amdgcn_s_barrier(); asm volatile("" ::: "memory");
                const int t = (wr * 4 + wc) * 64 + fq * 16 + fr;
                if (t < BMR) { float r[NRED];
#pragma unroll
                    for (int k = 0; k < NRED; ++k) r[k] = (P[(t * 4 + 0) * 2 + k] + P[(t * 4 + 1) * 2 + k]) + (P[(t * 4 + 2) * 2 + k] + P[(t * 4 + 3) * 2 + k]);
                    e.store_red(row0 + u.pm * BMR + t, u.pn, r); }
                if constexpr (epi_is_final<E>::value) {
                    wave_publish(e.cnt + 64 * u.pm);
                    if (wr == 0 && wc == 0) { wave_wait_ge(e.cnt + 64 * u.pm, 4 * 8, e.tmo); __builtin_amdgcn_fence(__ATOMIC_ACQUIRE, "agent"); }
                    asm volatile("s_waitcnt vmcnt(0) lgkmcnt(0)" ::: "memory"); __builtin_amdgcn_s_barrier(); asm volatile("" ::: "memory");
                    if (t < BMR) P[t] = e.row_scale(row0 + u.pm * BMR + t);
                    asm volatile("s_waitcnt lgkmcnt(0)" ::: "memory"); __builtin_amdgcn_s_barrier(); asm volatile("" ::: "memory");
                    f32x4 xq[2][MB][2][2], gf[2][2];
#pragma unroll
                    for (int bj = 0; bj < 2; ++bj) { gf[bj][0] = G_LD4(e.gfin + cbase + bj * HALF); gf[bj][1] = G_LD4(e.gfin + cbase + bj * HALF + 4); }
#pragma unroll
                    for (int ai = 0; ai < 2; ++ai)
#pragma unroll
                        for (int m = 0; m < MB; ++m)
#pragma unroll
                            for (int bj = 0; bj < 2; ++bj) { const float* o = e.Y + (size_t)(rbase + ai * (BMR / 2) + m * 16) * D + cbase + bj * HALF; xq[ai][m][bj][0] = G_LD4(o); xq[ai][m][bj][1] = G_LD4(o + 4); }
                    __builtin_amdgcn_sched_barrier(0);
#pragma unroll
                    for (int ai = 0; ai < 2; ++ai)
#pragma unroll
                        for (int m = 0; m < MB; ++m) { const float rs = P[ai * (BMR / 2) + rl + m * 16];
#pragma unroll
                            for (int bj = 0; bj < 2; ++bj) { float* o = e.Y + (size_t)(rbase + ai * (BMR / 2) + m * 16) * D + cbase + bj * HALF;
                                G_ST4(o, xq[ai][m][bj][0] * rs * gf[bj][0]); G_ST4(o + 4, xq[ai][m][bj][1] * rs * gf[bj][1]); } }
                }
            }
        }
    }
};
template <class Epi, class Sched, bool ALIGN_EPI = false, bool SP2 = false, int MB = 4>
__device__ __forceinline__ void gemm_phase(PG8_LAS unsigned char* lds, const Gemm g, const Sched& S, const Epi& E, const int tid) {
    const int wid = __builtin_amdgcn_readfirstlane(tid >> 6), lane = tid & 63, wr = wid >> 2, wc = wid & 3, fr = lane & 15, fq = lane >> 4;
    const int K = g.K, nt = K / BK;
    unsigned voffA[2], voffB[2];
#pragma unroll
    for (int i = 0; i < 2; ++i) { int R, C; stage_rc(tid * 16 + i * 8192, R, C); const int Rb = Epi::PERM ? ((R & ~31) + perm32(R & 31)) : R;
        voffA[i] = (unsigned)((R < 32 * MB ? R : 0) * K + C) * 2u; voffB[i] = (unsigned)(Rb * K + C) * 2u; }
    const size_t kstep = (size_t)(BK * 2);
    const size_t hstep = (size_t)HALF * K * 2;
    const size_t tstep = 2 * hstep;
    const size_t hstepA = (size_t)(32 * MB) * K * 2, tstepA = 2 * hstepA;
    const unsigned ldsw = (unsigned)wid * 1024u;
    const int aoff = lds_byte(wr * 16 * MB + fr, fq * 8), boff = lds_byte(wc * 32 + fr, fq * 8);
#define PG8_SA(b, h) (((b) * 2 + (h)) * HTB)
#define PG8_SB(b, h) ((4 + (b) * 2 + (h)) * HTB)
#define PG8_STAGE(bufoff, gbase, voff) do { _Pragma("unroll") for (int _i = 0; _i < 2; ++_i) \
        __builtin_amdgcn_global_load_lds((const unsigned*)((const char*)(gbase) + (voff)[_i]), (PG8_LAS unsigned*)(lds + (bufoff) + ldsw + _i * 8192), 16, 0, 0); } while (0)
#define PG8_LDA(dst, b, h) do { _Pragma("unroll") for (int m = 0; m < MB; ++m) _Pragma("unroll") for (int k = 0; k < 2; ++k) dst[m][k] = *(const PG8_LAS bf16x8*)(lds + PG8_SA(b, h) + aoff + m * 2048 + k * 1024); } while (0)
#define PG8_LDB(dst, b, h) do { _Pragma("unroll") for (int n = 0; n < 2; ++n) _Pragma("unroll") for (int k = 0; k < 2; ++k) dst[n][k] = *(const PG8_LAS bf16x8*)(lds + PG8_SB(b, h) + boff + n * 2048 + k * 1024); } while (0)
#define PG8_MMA(ai, bj, At, Bt) do { __builtin_amdgcn_s_setprio(1); _Pragma("unroll") for (int m = 0; m < MB; ++m) _Pragma("unroll") for (int n = 0; n < 2; ++n) _Pragma("unroll") for (int k = 0; k < 2; ++k) \
        acc[ai][bj][m][n] = __builtin_amdgcn_mfma_f32_16x16x32_bf16(Bt[n][k], At[m][k], acc[ai][bj][m][n], 0, 0, 0); __builtin_amdgcn_s_setprio(0); } while (0)
#define PG8_WAIT_V(n) asm volatile("s_waitcnt vmcnt(" #n ")" ::: "memory")
#define PG8_WAIT_L(n) asm volatile("s_waitcnt lgkmcnt(" #n ")" ::: "memory")
#define PG8_BAR __builtin_amdgcn_s_barrier()
#define PG8_SCHED __builtin_amdgcn_sched_barrier(0)
    Unit cur, nxt; int ui = 0;
    if (!S.next(0, cur)) return;
    f32x4 acc[2][2][MB][2];
#pragma unroll
    for (int a = 0; a < 2; ++a)
#pragma unroll
        for (int b = 0; b < 2; ++b)
#pragma unroll
            for (int m = 0; m < MB; ++m)
#pragma unroll
                for (int n = 0; n < 2; ++n) acc[a][b][m][n] = (f32x4){0.f, 0.f, 0.f, 0.f};
    bf16x8 At[MB][2], B0[2][2], B1[2][2];
    const char* cA = (const char*)g.A + (size_t)cur.pm * tstepA; const char* cB = (const char*)g.Bt + (size_t)cur.pn * tstep;
    S.a_ready(cur);
    if constexpr (SP2) {
        PG8_STAGE(PG8_SB(0, 0), cB, voffB); PG8_STAGE(PG8_SB(0, 1), cB + hstep, voffB); PG8_STAGE(PG8_SA(0, 0), cA, voffA); PG8_STAGE(PG8_SA(0, 1), cA + hstepA, voffA);
        if (wr == 1) PG8_BAR;
        PG8_WAIT_V(2); PG8_BAR;
        PG8_STAGE(PG8_SB(1, 0), cB + kstep, voffB); PG8_STAGE(PG8_SA(1, 0), cA + kstep, voffA); PG8_STAGE(PG8_SB(1, 1), cB + hstep + kstep, voffB);
        PG8_WAIT_V(6); PG8_BAR;
    } else {
        PG8_STAGE(PG8_SB(0, 0), cB, voffB); PG8_STAGE(PG8_SA(0, 0), cA, voffA); PG8_STAGE(PG8_SB(0, 1), cB + hstep, voffB); PG8_STAGE(PG8_SA(0, 1), cA + hstepA, voffA);
        if (wr == 1) PG8_BAR;
        PG8_WAIT_V(4); PG8_BAR;
        PG8_STAGE(PG8_SB(1, 0), cB + kstep, voffB); PG8_STAGE(PG8_SA(1, 0), cA + kstep, voffA); PG8_STAGE(PG8_SB(1, 1), cB + hstep + kstep, voffB);
        PG8_WAIT_V(6); PG8_BAR;
    }
    for (;;) {
        const bool has_next = S.next(ui + 1, nxt);
        const char* nA = has_next ? (const char*)g.A + (size_t)nxt.pm * tstepA : cA; const char* nB = has_next ? (const char*)g.Bt + (size_t)nxt.pn * tstep : cB;
        for (int t = 0; t < nt; t += 2) {
            const bool last = (t == nt - 2);
            const char* a1 = cA + (size_t)(t + 1) * kstep;
            const char* a2 = last ? nA : cA + (size_t)(t + 2) * kstep; const char* b2 = last ? nB : cB + (size_t)(t + 2) * kstep;
            const char* a3 = a2 + kstep; const char* b3 = b2 + kstep;
            if (last && has_next) S.a_ready(nxt);
            if constexpr (SP2) {
            PG8_LDB(B0, 0, 0); PG8_LDB(B1, 0, 1); PG8_SCHED; PG8_LDA(At, 0, 0); PG8_STAGE(PG8_SA(1, 1), a1 + hstepA, voffA);
            PG8_WAIT_V(8); PG8_WAIT_L(0); PG8_BAR; PG8_MMA(0, 0, At, B0); PG8_MMA(0, 1, At, B1); PG8_BAR; PG8_SCHED;
            PG8_LDA(At, 0, 1); PG8_STAGE(PG8_SB(0, 0), b2, voffB); PG8_STAGE(PG8_SB(0, 1), b2 + hstep, voffB); PG8_STAGE(PG8_SA(0, 0), a2, voffA);
            PG8_WAIT_V(8); PG8_WAIT_L(0); PG8_BAR; PG8_MMA(1, 0, At, B0); PG8_MMA(1, 1, At, B1); PG8_BAR; PG8_SCHED;
            PG8_LDB(B0, 1, 0); PG8_LDB(B1, 1, 1); PG8_SCHED; PG8_LDA(At, 1, 0); PG8_STAGE(PG8_SA(0, 1), a2 + hstepA, voffA);
            PG8_WAIT_V(8); PG8_WAIT_L(0); PG8_BAR; PG8_MMA(0, 0, At, B0); PG8_MMA(0, 1, At, B1); PG8_BAR; PG8_SCHED;
            PG8_LDA(At, 1, 1); PG8_STAGE(PG8_SB(1, 0), b3, voffB); PG8_STAGE(PG8_SB(1, 1), b3 + hstep, voffB); PG8_STAGE(PG8_SA(1, 0), a3, voffA);
            PG8_WAIT_V(8); PG8_WAIT_L(0); PG8_BAR; PG8_MMA(1, 0, At, B0); PG8_MMA(1, 1, At, B1); PG8_BAR; PG8_SCHED;
            } else {
            PG8_LDB(B0, 0, 0); PG8_SCHED; PG8_LDA(At, 0, 0); PG8_STAGE(PG8_SA(1, 1), a1 + hstepA, voffA);
            PG8_WAIT_L(8); PG8_BAR; PG8_WAIT_L(0); PG8_MMA(0, 0, At, B0); PG8_BAR; PG8_SCHED;
            PG8_LDB(B1, 0, 1); PG8_STAGE(PG8_SB(0, 0), b2, voffB);
            PG8_BAR; PG8_WAIT_L(0); PG8_MMA(0, 1, At, B1); PG8_BAR;
            PG8_LDA(At, 0, 1); PG8_STAGE(PG8_SA(0, 0), a2, voffA);
            PG8_BAR; PG8_WAIT_L(0); PG8_MMA(1, 0, At, B0); PG8_BAR; PG8_SCHED;
            PG8_STAGE(PG8_SB(0, 1), b2 + hstep, voffB);
            PG8_WAIT_V(6); PG8_BAR; PG8_MMA(1, 1, At, B1); PG8_BAR;
            PG8_LDB(B0, 1, 0); PG8_SCHED; PG8_LDA(At, 1, 0); PG8_STAGE(PG8_SA(0, 1), a2 + hstepA, voffA);
            PG8_WAIT_L(8); PG8_BAR; PG8_WAIT_L(0); PG8_MMA(0, 0, At, B0); PG8_BAR; PG8_SCHED;
            PG8_LDB(B1, 1, 1); PG8_STAGE(PG8_SB(1, 0), b3, voffB);
            PG8_BAR; PG8_WAIT_L(0); PG8_MMA(0, 1, At, B1); PG8_BAR;
            PG8_LDA(At, 1, 1); PG8_STAGE(PG8_SA(1, 0), a3, voffA);
            PG8_BAR; PG8_WAIT_L(0); PG8_MMA(1, 0, At, B0); PG8_BAR; PG8_SCHED;
            PG8_STAGE(PG8_SB(1, 1), b3 + hstep, voffB);
            PG8_WAIT_V(6); PG8_BAR; PG8_MMA(1, 1, At, B1); PG8_BAR;
            }
        }
        if constexpr (ALIGN_EPI) { if (wr == 0) PG8_BAR; }
        if constexpr (!Epi::AFTER_DRAIN) { E(acc, cur, wr, wc, fr, fq); S.done(cur); }
        if (!has_next) break;
#pragma unroll
        for (int a = 0; a < 2; ++a)
#pragma unroll
            for (int b = 0; b < 2; ++b)
#pragma unroll
                for (int m = 0; m < 4; ++m)
#pragma unroll
                    for (int n = 0; n < 2; ++n) acc[a][b][m][n] = (f32x4){0.f, 0.f, 0.f, 0.f};
        cur = nxt; cA = nA; cB = nB; ++ui;
        if constexpr (ALIGN_EPI) { if (wr == 1) PG8_BAR; }
    }
    PG8_WAIT_V(0);
    if constexpr (!ALIGN_EPI) { if (wr == 0) PG8_BAR; }
    PG8_BAR;
    if constexpr (Epi::AFTER_DRAIN) { E.fused(acc, cur, wr, wc, fr, fq, lds, wid, lane); S.done(cur); }
#undef PG8_SA
#undef PG8_SB
#undef PG8_STAGE
#undef PG8_LDA
#undef PG8_LDB
#undef PG8_MMA
#undef PG8_WAIT_V
#undef PG8_WAIT_L
#undef PG8_BAR
#undef PG8_SCHED
}
}

__device__ __forceinline__ void p1_sw_item(const bf16* WT, int N, const float* shift  , float* out, int item, int lane, float scale) {
    const int fr = lane & 15, fq = lane >> 4, n0 = (item >> 2) * 64, kq = (item & 3) * 256;
    f32x4 acc[4];
#pragma unroll
    for (int j = 0; j < 4; ++j) acc[j] = (f32x4){0.f, 0.f, 0.f, 0.f};
    const float* sp = shift + (size_t)(fr < 5 ? fr : 0) * 6144 + kq + fq * 8;
    const bf16* bp = WT + (size_t)(n0 + 8 * (fr >> 2) + (fr & 3)) * D + kq + fq * 8;
#pragma unroll
    for (int k0 = 0; k0 < 256; k0 += 128) {
        bf16x8 a[4], b[4][4];
#pragma unroll
        for (int ks = 0; ks < 4; ++ks) { const f32x4 s0 = *(const f32x4*)(sp + k0 + 32 * ks), s1 = *(const f32x4*)(sp + k0 + 32 * ks + 4);
            a[ks] = __builtin_bit_cast(bf16x8, pack8(s0, s1));
#pragma unroll
            for (int nj = 0; nj < 4; ++nj) b[ks][nj] = *(const bf16x8*)(bp + (size_t)(32 * (nj >> 1) + 4 * (nj & 1)) * D + k0 + 32 * ks); }
#pragma unroll
        for (int ks = 0; ks < 4; ++ks)
#pragma unroll
            for (int nj = 0; nj < 4; ++nj) acc[nj] = __builtin_amdgcn_mfma_f32_16x16x32_bf16(b[ks][nj], a[ks], acc[nj], 0, 0, 0);
    }
    if (fr < 5) {
#pragma unroll
        for (int nj = 0; nj < 4; ++nj)
#pragma unroll
            for (int e = 0; e < 4; ++e) atomicAdd(out + (size_t)fr * N + n0 + 32 * (nj >> 1) + 8 * fq + 4 * (nj & 1) + e, acc[nj][e] * scale); }
}
constexpr int SWI_QKV = NQKV / 16, SWI_ALL = NQKV / 16 + FF2 / 16 + GE2 / 16 + FF2 / 16;
__device__ __forceinline__ void p1_sw_items(const Frame& F, const Args& args, int lo, int hi, int fw, int nfw) {
    unsigned char* ws = wsb(args); const float* MOD0 = (const float*)(ws + WS_MOD); const float* MOD1 = MOD0 + 5 * 6144; float* SW = (float*)(ws + WS_SW);
    constexpr int I0 = NQKV / 16, I1 = FF2 / 16, I2 = GE2 / 16;
    for (int it = lo + fw; it < hi; it += nfw) { int r = it;
        if (r < I0) { p1_sw_item((const bf16*)(ws + WS_WQKV), NQKV, MOD0 + 0, SW + SW_QKV, r, F.lane, F.scale); continue; } r -= I0;
        if (r < I1) { p1_sw_item((const bf16*)(ws + WS_WUP), FF2, MOD0 + 3072, SW + SW_UP0, r, F.lane, F.scale); continue; } r -= I1;
        if (r < I2) { p1_sw_item((const bf16*)(ws + WS_WIN), GE2, MOD1 + 0, SW + SW_IN, r, F.lane, F.scale); continue; } r -= I2;
        p1_sw_item((const bf16*)(ws + WS_WUP) + (size_t)FF2 * D, FF2, MOD1 + 3072, SW + SW_UP1, r, F.lane, F.scale); }
}

constexpr int SWU_IN = (GE2 / 256) * 4, SWU_ALL = SWU_IN + (FF2 / 256) * 4;
__device__ __forceinline__ void sw_unit_f32(const Frame& F, const float* W, int N, const float* shift  , float* out, bool upperm, int u) {
    const int nblk = N / 256, nb = u % nblk, kq = u / nblk;
    const int k0 = kq * 256 + F.wave * 32;
    const float* Wp = W + (size_t)k0 * N + nb * 256 + F.lane * 4;
    float sh[5];
#pragma unroll
    for (int q = 0; q < 5; ++q) sh[q] = *(GAS const float*)(shift + (size_t)q * 6144 + k0 + (F.lane & 31));
    f32x4 acc[5];
#pragma unroll
    for (int q = 0; q < 5; ++q) acc[q] = (f32x4){0.f, 0.f, 0.f, 0.f};
#pragma unroll
    for (int i0 = 0; i0 < 32; i0 += 16) {
        f32x4 w[16];
#pragma unroll
        for (int i = 0; i < 16; ++i) w[i] = G_LD4(Wp + (size_t)(i0 + i) * N);
#pragma unroll
        for (int i = 0; i < 16; ++i)
#pragma unroll
            for (int q = 0; q < 5; ++q) acc[q] += __builtin_bit_cast(float, __builtin_amdgcn_readlane(__builtin_bit_cast(int, sh[q]), i0 + i)) * w[i];
    }
    LAS f32x4* red = (LAS f32x4*)(F.lds + RING_OFF);
    __syncthreads();
#pragma unroll
    for (int q = 0; q < 5; ++q) red[(F.wave * 5 + q) * 64 + F.lane] = acc[q];
    __syncthreads();
    const LAS float* redf = (const LAS float*)red;
    for (int o = F.tid; o < 5 * 256; o += NWAVES * 64) { const int q = o >> 8, n = nb * 256 + (o & 255);
        float s = 0.f;
#pragma unroll
        for (int w = 0; w < NWAVES; ++w) s += redf[(w * 5 + q) * 256 + (o & 255)];
        atomicAdd(out + (size_t)q * N + (upperm ? upmap(n) : n), s * F.scale); }
    __syncthreads();
}
__device__ __forceinline__ void sw_units_f32(const Frame& F, const Args& args, int fb, int nfb) {
    const float* MOD1 = (const float*)(wsb(args) + WS_MOD) + 5 * 6144; float* SW = (float*)(wsb(args) + WS_SW);
    for (int u = fb; u < SWU_ALL; u += nfb) {
        if (u < SWU_IN) sw_unit_f32(F, inp(args, I_WIN), GE2, MOD1 + 0, SW + SW_IN, false, u);
        else sw_unit_f32(F, inp(args, I_WUP) + (size_t)D * FF2, FF2, MOD1 + 3072, SW + SW_UP1, true, u - SWU_IN); }
}

constexpr int EPI_OFF = 132096;
template <int NRED, class Epi, int MB = 4>
__device__ __forceinline__ void gemm_pg8(const Frame& F, const bf16* A, const bf16* Bt, int row0, int Mrows, int N, int K, const Epi& E) {
    pg8::Gemm g{A + (size_t)row0 * K, Bt, Mrows, N, K}; pg8::StaticOrder S; S.init(Mrows, N, F.G, F.bid, 64 * MB);
    pg8::EpiAdapt<Epi, NRED, MB> EA{E, row0, (LAS float*)(F.lds + EPI_OFF), F.skip_epi};
    pg8::gemm_phase<pg8::EpiAdapt<Epi, NRED, MB>, pg8::StaticOrder, true, true, MB>(F.lds + RING_OFF, g, S, EA, F.tid);
}


struct RowLin {
    const float* RS; const float* SW; int N;
};
struct EpiQKV { static constexpr bool HAS_PRE = false, HAS_LIN = true;
    RowLin L; unsigned char* ws;
    __device__ __forceinline__ void post(int row, int col, f32x4 v0, f32x4 v1, float*) const {
        const int which = col >> 10, cc = col & 1023;
        if (which == 0) { v0 = v0 * C2; v1 = v1 * C2; }
        const size_t off = which == 0 ? WS_Q : (row < NCTX ? (which == 1 ? WS_KC : WS_VC) : (which == 1 ? WS_K : WS_V));
        G_STU4((bf16*)(ws + off) + (size_t)row * D + cc, pack8(v0, v1));
    }
};
template <int MODE> struct EpiResT {
    const float *base_c, *base_l; bf16* XB; float* Xout; const float* gate; bf16* AN; const float* gn; const float* scn; float* RSout; float gs;
    static constexpr bool HAS_PRE = true, HAS_LIN = false, PRE_HALVES = MODE == 0;
    struct PreB { u32x4 w; }; struct PreF { f32x4 b0, b1; };
    typedef typename std::conditional<MODE != 0, PreB, PreF>::type Pre;
    __device__ __forceinline__ Pre prefetch(int row, int col) const { Pre p;
        if constexpr (MODE != 0) p.w = G_LDU4(XB + (size_t)row * D + col);
        else { const float* bp = (row < NCTX ? base_c + (size_t)row * D : base_l + (size_t)(row - NCTX) * D) + col; p.b0 = G_LD4(bp); p.b1 = G_LD4(bp + 4); }
        return p; }
    __device__ __forceinline__ float stage_val(int kind, int ci, int col) const {
        return kind == 0 ? *(GAS const float*)(gate + (size_t)ci * 6144 + col) : *(GAS const float*)(gn + col) * (1.f + *(GAS const float*)(scn + (size_t)ci * 6144 + col)); }
    __device__ __forceinline__ void apply_pre(int row, int col, f32x4 v0, f32x4 v1, float* red, const Pre& p, const LAS float* st) const {
        f32x4 b0, b1;
        if constexpr (MODE != 0) { const u32x4 w = p.w; b0 = (f32x4){bflo(w.x), bfhi(w.x), bflo(w.y), bfhi(w.y)}; b1 = (f32x4){bflo(w.z), bfhi(w.z), bflo(w.w), bfhi(w.w)}; }
        else { b0 = p.b0; b1 = p.b1; }
        const f32x4 x0 = b0 + *(const LAS f32x4*)st * (v0 * gs), x1 = b1 + *(const LAS f32x4*)(st + 4) * (v1 * gs);
        if (MODE != 2) G_STU4(XB + (size_t)row * D + col, pack8(x0, x1));
        else { float* xo = Xout + (size_t)row * D + col; G_ST4(xo, x0); G_ST4(xo + 4, x1); }
        if (MODE != 2) { red[0] += ((x0.x * x0.x + x0.y * x0.y) + (x0.z * x0.z + x0.w * x0.w)) + ((x1.x * x1.x + x1.y * x1.y) + (x1.z * x1.z + x1.w * x1.w));
            const f32x4 a0 = x0 * *(const LAS f32x4*)(st + 512), a1 = x1 * *(const LAS f32x4*)(st + 516);
            G_STU4(AN + (size_t)row * D + col, pack8(a0, a1)); }
    }
    __device__ __forceinline__ bool want_red(int) const { return MODE != 2; }
    __device__ __forceinline__ void store_red(int row, int pn, const float* r) const { RSout[(size_t)row * 4 + pn] = r[0]; }
};
struct EpiFinal {
    const bf16* XB; float* Y; const float* gate; const float* gfin; float* RS4; unsigned* cnt; unsigned* tmo; float gs;
    static constexpr bool HAS_PRE = true, HAS_LIN = false, PRE_HALVES = false;
    struct Pre { u32x4 w; };
    __device__ __forceinline__ Pre prefetch(int row, int col) const { Pre p; p.w = G_LDU4(XB + (size_t)row * D + col); return p; }
    __device__ __forceinline__ float stage_val(int kind, int ci, int col) const { return kind == 0 ? *(GAS const float*)(gate + (size_t)ci * 6144 + col) : 0.f; }
    __device__ __forceinline__ void apply_pre(int row, int col, f32x4 v0, f32x4 v1, float* red, const Pre& p, const LAS float* st) const {
        const u32x4 w = p.w;
        v0 = (f32x4){bflo(w.x), bfhi(w.x), bflo(w.y), bfhi(w.y)} + *(const LAS f32x4*)st * (v0 * gs); v1 = (f32x4){bflo(w.z), bfhi(w.z), bflo(w.w), bfhi(w.w)} + *(const LAS f32x4*)(st + 4) * (v1 * gs);
        float* o = Y + (size_t)row * D + col; G_ST4(o, v0); G_ST4(o + 4, v1);
        red[0] += ((v0.x * v0.x + v0.y * v0.y) + (v0.z * v0.z + v0.w * v0.w)) + ((v1.x * v1.x + v1.y * v1.y) + (v1.z * v1.z + v1.w * v1.w));
    }
    __device__ __forceinline__ bool want_red(int) const { return true; }
    __device__ __forceinline__ void store_red(int row, int pn, const float* r) const { st4f_wt(RS4 + (size_t)row * 4 + pn, r[0]); }
    __device__ __forceinline__ float row_scale(int row) const { const f32x4 p = G_LD4(RS4 + (size_t)row * 4); return __builtin_amdgcn_rsqf(((p.x + p.y) + (p.z + p.w)) * (1.f / D) + EPS); }
};
namespace pg8 { template <> struct epi_is_final<EpiFinal> { static constexpr bool value = true; }; }
struct EpiIn { static constexpr bool HAS_PRE = false, HAS_LIN = true;
    RowLin L; bf16 *U, *VV; float* LNP;
    __device__ __forceinline__ void post(int row, int col, f32x4 v0, f32x4 v1, float* red) const {
#pragma unroll
        for (int e = 0; e < 4; ++e) { v0[e] = gelu_tanh_f(v0[e]); v1[e] = gelu_tanh_f(v1[e]); }
        if (col >= GE) { red[0] += ((v0.x + v0.y) + (v0.z + v0.w)) + ((v1.x + v1.y) + (v1.z + v1.w));
            red[1] += ((v0.x * v0.x + v0.y * v0.y) + (v0.z * v0.z + v0.w * v0.w)) + ((v1.x * v1.x + v1.y * v1.y) + (v1.z * v1.z + v1.w * v1.w)); }
        bf16* dst = col < GE ? U + (size_t)row * GE + col : VV + (size_t)row * GE + (col - GE);
        G_STU4(dst, pack8(v0, v1));
    }
    __device__ __forceinline__ bool want_red(int pn) const { return pn >= 8; }
    __device__ __forceinline__ void store_red(int row, int pn, const float* r) const { *(f32x2*)(LNP + (size_t)row * 16 + (pn - 8) * 2) = (f32x2){r[0], r[1]}; }
};


__device__ __forceinline__ float dpp_ror1(float x) { return __builtin_bit_cast(float, __builtin_amdgcn_update_dpp(0, __builtin_bit_cast(int, x), 0x121, 0xf, 0xf, false)); }
__device__ __forceinline__ float dpp_rol1(float x) { return __builtin_bit_cast(float, __builtin_amdgcn_update_dpp(0, __builtin_bit_cast(int, x), 0x12f, 0xf, 0xf, false)); }
__device__ __forceinline__ float bsel(unsigned m, float a, float b) { return __builtin_bit_cast(float, (__builtin_bit_cast(unsigned, a) & m) | (__builtin_bit_cast(unsigned, b) & ~m)); }
__device__ __forceinline__ float dpp_shr1(float old, float x) { return __builtin_bit_cast(float, __builtin_amdgcn_update_dpp(__builtin_bit_cast(int, old), __builtin_bit_cast(int, x), 0x111, 0xf, 0xf, false)); }
__device__ __forceinline__ float dpp_shl1(float old, float x) { return __builtin_bit_cast(float, __builtin_amdgcn_update_dpp(__builtin_bit_cast(int, old), __builtin_bit_cast(int, x), 0x101, 0xf, 0xf, false)); }
struct EpiUpConv {
    static constexpr bool PERM = true, AFTER_DRAIN = false;
    const float* RS; const float* SW; const float* wconv; const float* bconv; float* HALO; bf16* M; LAS float* EX; bool skip;
    __device__ __forceinline__ void operator()(f32x4 (&acc)[2][2][4][2], const pg8::Unit& u, int wr, int wc, int fr, int fq) const {
        if (skip) return;
        const int pm = u.pm, pn = u.pn, ci = pm < 32 ? 0 : 1 + ((pm - 32) >> 2);
        const int c32 = wc * 32 + 8 * fq;
        {   const float* sw = SW + (size_t)ci * FF2 + pn * 256 + c32;
            f32x4 s[2][2];
#pragma unroll
            for (int bj = 0; bj < 2; ++bj)
#pragma unroll
                for (int n = 0; n < 2; ++n) s[bj][n] = G_LD4(sw + bj * 128 + 4 * n);
            f32x4 pq[2][4];
#pragma unroll
            for (int ai = 0; ai < 2; ++ai)
#pragma unroll
                for (int m = 0; m < 4; ++m) pq[ai][m] = G_LD4(RS + (size_t)(pm * 256 + ai * 128 + wr * 64 + m * 16 + fr) * 4);
            __builtin_amdgcn_sched_barrier(0);
#pragma unroll
            for (int ai = 0; ai < 2; ++ai)
#pragma unroll
                for (int m = 0; m < 4; ++m) { const f32x4 p = pq[ai][m];
                    const float r = __builtin_amdgcn_rsqf(((p.x + p.y) + (p.z + p.w)) * (1.f / D) + EPS);
#pragma unroll
                    for (int bj = 0; bj < 2; ++bj)
#pragma unroll
                        for (int n = 0; n < 2; ++n) acc[ai][bj][m][n] = acc[ai][bj][m][n] * r + s[bj][n]; } }
#pragma unroll
        for (int ai = 0; ai < 2; ++ai) { const int sidx = 2 * ai + wr;
#pragma unroll
            for (int bj = 0; bj < 2; ++bj)
#pragma unroll
                for (int n = 0; n < 2; ++n) {
                    if (fr == 0) *(LAS f32x4*)(EX + ((sidx * 2 + 0) * 2 + bj) * 128 + c32 + 4 * n) = acc[ai][bj][0][n];
                    if (fr == 15) *(LAS f32x4*)(EX + ((sidx * 2 + 1) * 2 + bj) * 128 + c32 + 4 * n) = acc[ai][bj][3][n]; } }
        {   const int t = (wr * 4 + wc) * 64 + fq * 16 + fr; EX[8 * 256 + t] = 0.f; }
        if (pm >= 32) { float* hb = HALO + (size_t)(pm - 32) * 4 * FF2 + pn * 256 + c32;
#pragma unroll
            for (int bj = 0; bj < 2; ++bj)
#pragma unroll
                for (int n = 0; n < 2; ++n) {
                    if (wr == 0 && fr < 2) *(f32x4*)(hb + (size_t)fr * FF2 + bj * 128 + 4 * n) = acc[0][bj][0][n];
                    if (wr == 1 && fr >= 14) *(f32x4*)(hb + (size_t)(fr - 12) * FF2 + bj * 128 + 4 * n) = acc[1][bj][3][n]; } }
        const int j0 = pn * 128 + c32;
        f32x4 wq[4];
        { const float* wp = wconv + j0; wq[0] = G_LD4(wp); wq[1] = G_LD4(wp + FF2); wq[2] = G_LD4(wp + 2 * FF2); wq[3] = G_LD4(bconv + j0); }
        asm volatile("s_waitcnt lgkmcnt(0)" ::: "memory"); __builtin_amdgcn_s_barrier(); asm volatile("" ::: "memory");
#pragma unroll
        for (int bj = 0; bj < 2; ++bj)
#pragma unroll
            for (int n = 0; n < 2; ++n) {
                const f32x4 w0 = wq[0], w1 = wq[1], w2 = wq[2], bb = wq[3];
                if (bj * 2 + n < 3) { const int bj1 = (bj * 2 + n + 1) >> 1, n1 = (bj * 2 + n + 1) & 1; const float* wp = wconv + bj1 * FF + j0 + 4 * n1;
                    wq[0] = G_LD4(wp); wq[1] = G_LD4(wp + FF2); wq[2] = G_LD4(wp + 2 * FF2); wq[3] = G_LD4(bconv + bj1 * FF + j0 + 4 * n1); }
#pragma unroll
                for (int ai = 0; ai < 2; ++ai) { const int sidx = 2 * ai + wr;
                    const int xrow = fr == 15 ? (sidx < 3 ? (sidx + 1) * 2 : 9) : (sidx > 0 ? (sidx - 1) * 2 + 1 : 8);
                    const f32x4 X = *(const LAS f32x4*)(EX + (xrow * 2 + bj) * 128 + c32 + 4 * n);
                    f32x4 cur[4];
#pragma unroll
                    for (int m = 0; m < 4; ++m) cur[m] = acc[ai][bj][m][n];
#pragma unroll
                    for (int m = 0; m < 4; ++m) { f32x4 pv_, nx_;
#pragma unroll
                        for (int e = 0; e < 4; ++e) {
                            const float pa_ = m > 0 ? dpp_ror1(cur[m - 1][e]) : X[e], na_ = m < 3 ? dpp_rol1(cur[m + 1][e]) : X[e];
                            pv_[e] = dpp_shr1(pa_, cur[m][e]); nx_[e] = dpp_shl1(na_, cur[m][e]); }
                        acc[ai][bj][m][n] = (w0 * pv_ + w1 * cur[m]) + (w2 * nx_ + bb); }
                    __builtin_amdgcn_sched_barrier(0); } }
#pragma unroll
        for (int ai = 0; ai < 2; ++ai)
#pragma unroll
            for (int m = 0; m < 4; ++m) { const int row = pm * 256 + ai * 128 + wr * 64 + m * 16 + fr;
                f32x4 o0, o1;
#pragma unroll
                for (int e = 0; e < 4; ++e) { o0[e] = silu_f(acc[ai][0][m][0][e]) * acc[ai][1][m][0][e]; o1[e] = silu_f(acc[ai][0][m][1][e]) * acc[ai][1][m][1][e]; }
                G_STU4(M + (size_t)row * FF + j0, pack8(o0, o1)); }
    }
};
__device__ __forceinline__ void fix_halo_rows(const Frame& F, int row_lo, int row_hi, const float* HALO, const float* wconv, const float* bconv, bf16* M) {
    for (int T = row_lo >> 8; T <= (row_hi - 1) >> 8; ++T) {
        if (T < 32) continue;
        const int q = (T - 32) & 3;
#pragma unroll
        for (int which = 0; which < 2; ++which) {
            const int row = T * 256 + (which ? 255 : 0);
            if (!((which == 0 ? (q != 0) : (q != 3)) && row >= row_lo && row < row_hi)) continue;
            const float* own = HALO + (size_t)(T - 32) * 4 * FF2;
            const float* pr = which == 0 ? HALO + ((size_t)(T - 33) * 4 + 3) * FF2 : own + 2 * FF2;
            const float* cu = which == 0 ? own : own + 3 * FF2;
            const float* nx = which == 0 ? own + FF2 : HALO + (size_t)(T - 31) * 4 * FF2;
#pragma unroll
            for (int it = 0; it < 2; ++it) {
                const int j = 4 * (F.tid + it * NWAVES * 64);
                if (j < FF) {
                    const int gc = ((j >> 7) << 8) + (j & 127), vc = gc + 128;
                    const f32x4 g = (G_LD4(wconv + j) * G_LD4(pr + gc) + G_LD4(wconv + FF2 + j) * G_LD4(cu + gc)) + (G_LD4(wconv + 2 * FF2 + j) * G_LD4(nx + gc) + G_LD4(bconv + j));
                    const f32x4 v = (G_LD4(wconv + FF + j) * G_LD4(pr + vc) + G_LD4(wconv + FF2 + FF + j) * G_LD4(cu + vc)) + (G_LD4(wconv + 2 * FF2 + FF + j) * G_LD4(nx + vc) + G_LD4(bconv + FF + j));
                    u32x2 o; o.x = cvt_pk_bf16(silu_f(g.x) * v.x, silu_f(g.y) * v.y); o.y = cvt_pk_bf16(silu_f(g.z) * v.z, silu_f(g.w) * v.w);
                    *(GAS u32x2*)(M + (size_t)row * FF + j) = o; } }
        }
    }
    asm volatile("s_waitcnt vmcnt(0)" ::: "memory"); __syncthreads();
}
template <class Epi>
__device__ __forceinline__ void gemm_pg8_raw(const Frame& F, const bf16* A, const bf16* Bt, int Mrows, int N, int K, const Epi& E) {
    pg8::Gemm g{A, Bt, Mrows, N, K}; pg8::StaticOrder S; S.init(Mrows, N, F.G, F.bid);
    pg8::gemm_phase<Epi, pg8::StaticOrder, true, true>(F.lds + RING_OFF, g, S, E, F.tid);
}

#include <hip/hip_bf16.h>
namespace attn_body {
using bf16=__hip_bfloat16;
using bf16x8=__attribute__((ext_vector_type(8)))short;
using s16x4=__attribute__((ext_vector_type(4)))short;
using f32x16=__attribute__((ext_vector_type(16)))float;
using u32x4=__attribute__((ext_vector_type(4)))unsigned;
constexpr int NHEAD=16,D=64,DM=NHEAD*D;
constexpr int NW=8,QBLK=32,QB=QBLK*NW,KVBLK=64;
__device__ __forceinline__ int crow(int r,int hi){return (r&3)+8*(r>>2)+4*hi;}
#define SBAR() __builtin_amdgcn_sched_barrier(0)
constexpr int NSLOT=3, SLOTB=8192;
constexpr int LDS_K=0, LDS_V=NSLOT*SLOTB, LDS_WS=2*NSLOT*SLOTB, LDS_OST=LDS_WS+NW*64*4, LDS_TAB=LDS_OST+NW*4096, LDS_BYTES=LDS_TAB+(3+15)*128*4;
constexpr float C2=0.125f*1.4426950408889634f;
__device__ __forceinline__ void glds16(const void*gsrc,unsigned lds_dst){unsigned keep;
  asm volatile("s_mov_b32 %0, m0\n\ts_mov_b32 m0, %2\n\ts_nop 0\n\tglobal_load_lds_dwordx4 %1, off\n\ts_mov_b32 m0, %0":"=&s"(keep):"v"(gsrc),"s"(lds_dst):"memory");}
__device__ __forceinline__ float max3f(float a,float b,float c){float r;asm("v_max3_f32 %0, %1, %2, %3":"=v"(r):"v"(a),"v"(b),"v"(c));return r;}
__device__ __forceinline__ float max2f(float a,float b){float r;asm("v_max_f32_e32 %0, %1, %2":"=v"(r):"v"(a),"v"(b));return r;}
__device__ __forceinline__ float fadd_s(float a,float b){float r;asm("v_add_f32_e32 %0, %1, %2":"=v"(r):"v"(a),"v"(b));return r;}
__device__ __forceinline__ float fsub_s(float a,float b){float r;asm("v_sub_f32_e32 %0, %1, %2":"=v"(r):"v"(a),"v"(b));return r;}
typedef float f32x2_t __attribute__((ext_vector_type(2))); typedef __bf16 bf16x2_t __attribute__((ext_vector_type(2)));
__device__ __forceinline__ unsigned cvtpk_s(float lo,float hi){f32x2_t v={lo,hi};bf16x2_t b=__builtin_convertvector(v,bf16x2_t);return __builtin_bit_cast(unsigned,b);}
#define WAIT_BAR(N) asm volatile("s_waitcnt vmcnt(" #N ") lgkmcnt(0)\n\ts_barrier":::"memory")

__device__ __forceinline__ void qkt(f32x16&p0,f32x16&p1,const char*Kslot,const bf16x8*qr,const f32x16&negm,int r32,int hi){
  const char*kb=Kslot+hi*1024+r32*16;
  #pragma unroll
  for(int d0=0;d0<4;++d0){
    const bf16x8 b0=*reinterpret_cast<const bf16x8*>(kb+d0*2048);
    const bf16x8 b1=*reinterpret_cast<const bf16x8*>(kb+d0*2048+512);
    if(d0==0){p0=__builtin_amdgcn_mfma_f32_32x32x16_bf16(b0,qr[0],negm,0,0,0);p1=__builtin_amdgcn_mfma_f32_32x32x16_bf16(b1,qr[0],negm,0,0,0);}
    else{p0=__builtin_amdgcn_mfma_f32_32x32x16_bf16(b0,qr[d0],p0,0,0,0);p1=__builtin_amdgcn_mfma_f32_32x32x16_bf16(b1,qr[d0],p1,0,0,0);}}
}
typedef __attribute__((address_space(3))) const char* lds_cptr;
typedef short v4i16_t __attribute__((ext_vector_type(4)));
__device__ __forceinline__ void kload8(bf16x8*kf,lds_cptr kp){
  kf[0]=*(const __attribute__((address_space(3))) bf16x8*)(kp);      kf[1]=*(const __attribute__((address_space(3))) bf16x8*)(kp+512);
  kf[2]=*(const __attribute__((address_space(3))) bf16x8*)(kp+2048); kf[3]=*(const __attribute__((address_space(3))) bf16x8*)(kp+2560);
  kf[4]=*(const __attribute__((address_space(3))) bf16x8*)(kp+4096); kf[5]=*(const __attribute__((address_space(3))) bf16x8*)(kp+4608);
  kf[6]=*(const __attribute__((address_space(3))) bf16x8*)(kp+6144); kf[7]=*(const __attribute__((address_space(3))) bf16x8*)(kp+6656);
}
__device__ __forceinline__ void kload2(bf16x8*kf,lds_cptr kp,int j){ kf[2*j]=*(const __attribute__((address_space(3))) bf16x8*)(kp+j*2048); kf[2*j+1]=*(const __attribute__((address_space(3))) bf16x8*)(kp+j*2048+512); }
__device__ __forceinline__ s16x4 vtr(lds_cptr p){ return __builtin_bit_cast(s16x4,__builtin_amdgcn_ds_read_tr16_b64_v4i16((__attribute__((address_space(3))) v4i16_t*)p)); }
__device__ __forceinline__ float rowmax(const f32x16&p0,const f32x16&p1){
  float a=max3f(p0[0],p0[1],p1[0]),b=max3f(p0[2],p0[3],p1[1]);a=max3f(a,p1[2],p1[3]);
  #pragma unroll
  for(int r=4;r<16;r+=4){a=max3f(a,p0[r],p0[r+1]);b=max3f(b,p0[r+2],p0[r+3]);a=max3f(a,p1[r],p1[r+1]);b=max3f(b,p1[r+2],p1[r+3]);}
  const float m=max2f(a,b);
  auto rr=__builtin_amdgcn_permlane32_swap(__float_as_uint(m),__float_as_uint(m),false,false);
  return max2f(__uint_as_float(rr[0]),__uint_as_float(rr[1]));
}
__device__ __forceinline__ void pv(f32x16*o,int vb,bf16x8 pa0,bf16x8 pa1,bf16x8 pa2,bf16x8 pa3){
  #pragma unroll
  for(int d0=0;d0<2;++d0){s16x4 lo[4],hi[4];
    #pragma unroll
    for(int ks=0;ks<4;++ks){
      asm volatile("ds_read_b64_tr_b16 %0,%1 offset:%c2":"=&v"(lo[ks]):"v"(vb),"i"(d0*4096+ks*1024):"memory");
      asm volatile("ds_read_b64_tr_b16 %0,%1 offset:%c2":"=&v"(hi[ks]):"v"(vb),"i"(d0*4096+ks*1024+512):"memory");}
    asm volatile("s_waitcnt lgkmcnt(0)":::"memory");SBAR();
    #define PK(k) (bf16x8){lo[k][0],lo[k][1],lo[k][2],lo[k][3],hi[k][0],hi[k][1],hi[k][2],hi[k][3]}
    o[d0]=__builtin_amdgcn_mfma_f32_32x32x16_bf16(pa0,PK(0),o[d0],0,0,0);
    o[d0]=__builtin_amdgcn_mfma_f32_32x32x16_bf16(pa1,PK(1),o[d0],0,0,0);
    o[d0]=__builtin_amdgcn_mfma_f32_32x32x16_bf16(pa2,PK(2),o[d0],0,0,0);
    o[d0]=__builtin_amdgcn_mfma_f32_32x32x16_bf16(pa3,PK(3),o[d0],0,0,0);
    #undef PK
  }
}

#ifndef ATTN_STORE16
#define ATTN_STORE16(p,v) (*(__attribute__((address_space(1))) u32x4*)(p)=(v))
#endif
template<int THRL,bool LAT> __device__ __forceinline__ void attn_unit(const int tid,bf16*Qw0,const bf16*K0,const long dV0,const int n0,const bf16*K1,const long dV1,const int NT,char*shm,const int rq0,const int wlo,const float*rpb_h){
  bf16*const Ow0=Qw0;
  const int lane=tid&63,r32=lane&31,hi=lane>>5; const int wid=__builtin_amdgcn_readfirstlane(tid>>6);
  const bf16*Qw=Qw0+(long)(wid*QBLK)*DM;
  const unsigned lds0=(unsigned)(uintptr_t)shm;
  float*wsf=(float*)(shm+LDS_WS)+wid*64;
  typedef __attribute__((address_space(3))) const float* lds_fptr;
  float*tab=(float*)(shm+LDS_TAB);
  if(LAT){ for(int i=tid;i<15*128;i+=NW*64){const int rr=i>>7,cc=i&127; tab[384+i]=(cc>=48&&cc<79)?rpb_h[rr*31+cc-48]*1.4426950408889634f:0.f;}
    if(tid<384)tab[tid]=(tid<128||(tid>=256+48&&tid<256+64))?0.f:-INFINITY; }
  const int rq=rq0+(wid>>1), rs=min(max(rq-4,0),8);
  lds_fptr tb_=(lds_fptr)tab, tv_=(lds_fptr)tab;
  #define CSEL(t) do{ if(LAT){ const int cq_=32*(wid&1)+r32; const bool w_=(t)>=n0; const int ia_=wlo+((t)-n0); const bool ok_=w_&&(ia_>=rs)&&(ia_<rs+8); \
      tb_=(lds_fptr)tab+(63-cq_+4*hi)+(ok_?384+(ia_-rq+7)*128:0); tv_=(lds_fptr)tab+(48-min(max(cq_-8,0),48)+4*hi)+(w_?(ok_?256:128):0); } }while(0)
  #define CINIT(C,KO) do{ if(LAT){ _Pragma("unroll") for(int r=0;r<16;++r){const int k0_=(r&3)+8*(r>>2)+(KO); C[r]=(tb_[k0_]+tv_[k0_])-mhat;} } }while(0)
  #define CSRC(C) (LAT?C:negm)
  const int koff=lane*DM+wid*8;
  const int voff=(16*(wid&3)+(lane>>2))*DM+(wid>>2)*32+(lane&3)*8;
  const unsigned kdst=lds0+LDS_K+wid*1024, vdst=lds0+LDS_V+wid*1024;
  #define KSRC(t) (((t)<n0?K0+(long)(t)*KVBLK*DM:K1+(long)((t)-n0)*KVBLK*DM)+koff)
  #define VSRC(t) (((t)<n0?K0+dV0+(long)(t)*KVBLK*DM:K1+dV1+(long)((t)-n0)*KVBLK*DM)+voff)
  #define DMA_K(t,slot) glds16(KSRC(t),(unsigned)__builtin_amdgcn_readfirstlane(kdst+(slot)))
  #define DMA_V(t,slot) glds16(VSRC(t),(unsigned)__builtin_amdgcn_readfirstlane(vdst+(slot)))
  const int vb0=(int)(lds0+LDS_V)+((lane>>4)&1)*32+(lane&3)*8+(4*hi+((lane&15)>>2))*64;
  const char*Kbase=shm+LDS_K; bf16x8 kf[8];
  const lds_cptr shm3=(lds_cptr)shm; const lds_cptr kp0=shm3+LDS_K+hi*1024+r32*16; const lds_cptr vp0=shm3+LDS_V+((lane>>4)&1)*32+(lane&3)*8+(4*hi+((lane&15)>>2))*64;

  DMA_K(0,0);DMA_V(0,0);DMA_K(1,SLOTB);
  bf16x8 qr[4];
  #pragma unroll
  for(int d0=0;d0<4;++d0)qr[d0]=*(const __attribute__((address_space(1))) bf16x8*)(&Qw[(long)r32*DM+d0*16+hi*8]);
  float mhat=0.f,l_reg=0.f;f32x16 o[2];o[0]=f32x16{};o[1]=f32x16{};float z_=0.f;asm volatile("":"+v"(z_));f32x16 negm;
  _Pragma("unroll") for(int r=0;r<16;++r)negm[r]=z_;
  if(!LAT)asm volatile("":"+v"(negm));
  #define CMASK(P0,P1,t) do{}while(0)
  bool resc=false;
  #define START(P0,P1) do{ const float rm=rowmax(P0,P1); resc=false; \
    { const float dl=rm; mhat=fadd_s(mhat,dl); \
      _Pragma("unroll") for(int r=0;r<16;++r){P0[r]=fsub_s(P0[r],dl);P1[r]=fsub_s(P1[r],dl);} \
      if(!LAT){ _Pragma("unroll") for(int r=0;r<16;++r)negm[r]=-mhat; asm volatile("":"+v"(negm)); } } \
    _Pragma("unroll") for(int r=0;r<16;++r)P0[r]=__builtin_amdgcn_exp2f(P0[r]); }while(0)
  #define RESC() do{ if(resc){ asm volatile("s_waitcnt lgkmcnt(0)":::"memory"); \
      _Pragma("unroll") for(int d_=0;d_<2;++d_) _Pragma("unroll") for(int r=0;r<16;++r)o[d_][r]*=wsf[crow(r,hi)]; } }while(0)
  f32x16 pA0,pA1,pB0,pB1;
  int sl_prev=0,sl_cur=0,sl_next=SLOTB;
  #define ROT() do{sl_prev=sl_cur;sl_cur=sl_next;sl_next=(sl_next==(NSLOT-1)*SLOTB)?0:sl_next+SLOTB;}while(0)
  DMA_K(2,2*SLOTB);
  WAIT_BAR(3);
  qkt(pA0,pA1,Kbase,qr,negm,r32,hi);asm volatile("s_nop 15\n\ts_nop 7":"+v"(pA0),"+v"(pA1));CMASK(pA0,pA1,0);
  START(pA0,pA1);
  _Pragma("unroll") for(int r=0;r<16;++r)pA1[r]=__builtin_amdgcn_exp2f(pA1[r]);
  WAIT_BAR(0);
  DMA_K(3,0);DMA_V(1,SLOTB);
  ROT();
  kload8(kf,kp0+sl_cur);
  WAIT_BAR(2);
  s16x4 vlo[8],vhi[8]; u32x4 pw0,pw1,pw2,pw3;
  #define PKW(P,B) cvtpk_s(P[B],P[B+1])
  #define PAF(k) __builtin_bit_cast(bf16x8,pw##k)
  #define VFR(i) (bf16x8){vlo[i][0],vlo[i][1],vlo[i][2],vlo[i][3],vhi[i][0],vhi[i][1],vhi[i][2],vhi[i][3]}
  #define PIN(x) asm volatile("":"+v"(x))
  #define MX3(a,b,c) __builtin_fmaxf(__builtin_fmaxf((a),(b)),(c))
  #define GAPA(MF,A0,A1,A2,A3,W0,W1,PW) do{ MF; sacc+=A0; sacc+=A1; sacc+=A2; sacc+=A3; PIN(sacc); W0; W1; PIN(PW); SBAR(); }while(0)
  #define EX(v) __builtin_amdgcn_exp2f(v)
  #define GAPB(MF,X,B,KO) do{ MF; X[B]=EX(X[B]); X[B+1]=EX(X[B+1]); X[B+2]=EX(X[B+2]); X[B+3]=EX(X[B+3]); PIN(X); SBAR(); }while(0)
  #define VRD(i) do{ vlo[i]=vtr(vp_+(((i)>>2)*4096+((i)&3)*1024)); vhi[i]=vtr(vp_+(((i)>>2)*4096+((i)&3)*1024+512)); }while(0)
  #define KRD(G,j) do{ if(G){ kload2(kf,kp0+sl_next,j); SBAR(); } }while(0)
  #define STEP(C0,C1,P0,P1,t,GK,GV,GL) do{ SBAR(); CSEL(t); CINIT(C0,0); SBAR(); \
    const lds_cptr vp_=vp0+sl_prev; \
    VRD(0); SBAR(); float sacc=(P0[0]+P0[1]); \
    GAPA(C0=__builtin_amdgcn_mfma_f32_32x32x16_bf16(kf[0],qr[0],CSRC(C0),0,0,0), P0[2],P0[3],P0[4],P0[5],     pw0[0]=PKW(P0,0), pw0[1]=PKW(P0,2), pw0); \
    CINIT(C1,32); VRD(4); SBAR(); GAPA(C1=__builtin_amdgcn_mfma_f32_32x32x16_bf16(kf[1],qr[0],CSRC(C1),0,0,0), P0[6],P0[7],P0[8],P0[9],     pw0[2]=PKW(P0,4), pw0[3]=PKW(P0,6), pw0); \
    VRD(1); SBAR(); GAPA(C0=__builtin_amdgcn_mfma_f32_32x32x16_bf16(kf[2],qr[1],C0,0,0,0),   P0[10],P0[11],P0[12],P0[13], pw1[0]=PKW(P0,8), pw1[1]=PKW(P0,10), pw1); \
    VRD(5); SBAR(); GAPA(C1=__builtin_amdgcn_mfma_f32_32x32x16_bf16(kf[3],qr[1],C1,0,0,0),   P0[14],P0[15],P1[0],P1[1],   pw1[2]=PKW(P0,12),pw1[3]=PKW(P0,14), pw1); \
    VRD(2); SBAR(); GAPA(C0=__builtin_amdgcn_mfma_f32_32x32x16_bf16(kf[4],qr[2],C0,0,0,0),   P1[2],P1[3],P1[4],P1[5],     pw2[0]=PKW(P1,0), pw2[1]=PKW(P1,2), pw2); \
    VRD(6); SBAR(); GAPA(C1=__builtin_amdgcn_mfma_f32_32x32x16_bf16(kf[5],qr[2],C1,0,0,0),   P1[6],P1[7],P1[8],P1[9],     pw2[2]=PKW(P1,4), pw2[3]=PKW(P1,6), pw2); \
    VRD(3); SBAR(); GAPA(C0=__builtin_amdgcn_mfma_f32_32x32x16_bf16(kf[6],qr[3],C0,0,0,0),   P1[10],P1[11],P1[12],P1[13], pw3[0]=PKW(P1,8), pw3[1]=PKW(P1,10), pw3); \
    VRD(7); SBAR(); GAPA(C1=__builtin_amdgcn_mfma_f32_32x32x16_bf16(kf[7],qr[3],C1,0,0,0),   P1[14],P1[15],0.f,0.f,       pw3[2]=PKW(P1,12),pw3[3]=PKW(P1,14), pw3); \
    l_reg+=sacc; \
    if(GK){DMA_K((t)+3,sl_cur);} if(GV){DMA_V((t)+1,sl_next);} \
    CMASK(C0,C1,t); \
    { float a=MX3(C0[0],C0[1],C1[0]),b=MX3(C0[2],C0[3],C1[1]); a=MX3(a,C1[2],C1[3]); \
      _Pragma("unroll") for(int r=4;r<16;r+=4){a=MX3(a,C0[r],C0[r+1]);b=MX3(b,C0[r+2],C0[r+3]);a=MX3(a,C1[r],C1[r+1]);b=MX3(b,C1[r+2],C1[r+3]);} \
      float rm=__builtin_fmaxf(a,b); { auto rr=__builtin_amdgcn_permlane32_swap(__float_as_uint(rm),__float_as_uint(rm),false,false); rm=__builtin_fmaxf(__uint_as_float(rr[0]),__uint_as_float(rr[1])); } \
      resc=false; \
      if(__builtin_expect(__any(rm>(float)THRL),0)){ const float dl=__builtin_fmaxf(rm,0.f); mhat+=dl; \
        _Pragma("unroll") for(int r=0;r<16;++r){C0[r]-=dl;C1[r]-=dl;} \
        if(!LAT){ _Pragma("unroll") for(int r=0;r<16;++r)negm[r]=-mhat; asm volatile("":"+v"(negm)); } \
        const float f=__builtin_amdgcn_exp2f(-dl); l_reg*=f; if(hi==0)wsf[r32]=f; resc=true; } } \
    SBAR(); \
    GAPB(o[0]=__builtin_amdgcn_mfma_f32_32x32x16_bf16(PAF(0),VFR(0),o[0],0,0,0), C0,0,0); \
    GAPB(o[1]=__builtin_amdgcn_mfma_f32_32x32x16_bf16(PAF(0),VFR(4),o[1],0,0,0), C0,4,0); \
    KRD(GL,0); GAPB(o[0]=__builtin_amdgcn_mfma_f32_32x32x16_bf16(PAF(1),VFR(1),o[0],0,0,0), C0,8,0); \
    KRD(GL,1); GAPB(o[1]=__builtin_amdgcn_mfma_f32_32x32x16_bf16(PAF(1),VFR(5),o[1],0,0,0), C0,12,0); \
    KRD(GL,2); GAPB(o[0]=__builtin_amdgcn_mfma_f32_32x32x16_bf16(PAF(2),VFR(2),o[0],0,0,0), C1,0,32); \
    KRD(GL,3); GAPB(o[1]=__builtin_amdgcn_mfma_f32_32x32x16_bf16(PAF(2),VFR(6),o[1],0,0,0), C1,4,32); \
    GAPB(o[0]=__builtin_amdgcn_mfma_f32_32x32x16_bf16(PAF(3),VFR(3),o[0],0,0,0), C1,8,32); \
    GAPB(o[1]=__builtin_amdgcn_mfma_f32_32x32x16_bf16(PAF(3),VFR(7),o[1],0,0,0), C1,12,32); \
    }while(0)
  int t=1;
  for(;t+5<NT;t+=2){
    STEP(pB0,pB1,pA0,pA1,t,true,true,true);     WAIT_BAR(2); RESC(); ROT();
    STEP(pA0,pA1,pB0,pB1,t+1,true,true,true);   WAIT_BAR(2); RESC(); ROT();
  }
  #define ENDW(tt) do{ if((tt)+3<NT){WAIT_BAR(2);} else if((tt)+2<NT){WAIT_BAR(1);} else {WAIT_BAR(0);} }while(0)
  for(;t+1<NT;t+=2){
    STEP(pB0,pB1,pA0,pA1,t,(t+3<NT),(t+1<NT),(t+1<NT));       ENDW(t);   RESC(); ROT();
    STEP(pA0,pA1,pB0,pB1,t+1,(t+4<NT),(t+2<NT),(t+2<NT));     ENDW(t+1); RESC(); ROT();
  }
  STEP(pB0,pB1,pA0,pA1,NT-1,false,false,false); RESC();
  { float sacc=pB0[0]+pB0[1]; _Pragma("unroll") for(int r=2;r<16;++r)sacc+=pB0[r]; _Pragma("unroll") for(int r=0;r<16;++r)sacc+=pB1[r]; l_reg+=sacc;
    pw0=(u32x4){PKW(pB0,0),PKW(pB0,2),PKW(pB0,4),PKW(pB0,6)};pw1=(u32x4){PKW(pB0,8),PKW(pB0,10),PKW(pB0,12),PKW(pB0,14)};pw2=(u32x4){PKW(pB1,0),PKW(pB1,2),PKW(pB1,4),PKW(pB1,6)};pw3=(u32x4){PKW(pB1,8),PKW(pB1,10),PKW(pB1,12),PKW(pB1,14)};
    SBAR(); pv(o,vb0+sl_cur,PAF(0),PAF(1),PAF(2),PAF(3)); }
  #undef PKW
  #undef PAF
  #undef VFR
  #undef PIN
  #undef MX3
  #undef GAPA
  #undef GAPB
  #undef EX
  #undef VRD
  #undef KRD
  #undef STEP
  #undef ENDW
  {auto rr=__builtin_amdgcn_permlane32_swap(__float_as_uint(l_reg),__float_as_uint(l_reg),false,false);l_reg=__uint_as_float(rr[0])+__uint_as_float(rr[1]);}
  if(hi==0)wsf[32+r32]=l_reg;asm volatile("s_waitcnt lgkmcnt(0)":::"memory");
  float rli[16];
  #pragma unroll
  for(int r=0;r<16;++r)rli[r]=__builtin_amdgcn_rcpf(wsf[32+crow(r,hi)]);
  bf16*Ow=Ow0+(long)(wid*QBLK)*DM;
  { bf16*stg=(bf16*)(shm+LDS_OST)+wid*2048;
    #pragma unroll
    for(int r=0;r<16;++r){const int orow=crow(r,hi);
      #pragma unroll
      for(int d0=0;d0<2;++d0)stg[orow*64+d0*32+r32]=__float2bfloat16(o[d0][r]*rli[r]);}
    asm volatile("s_waitcnt lgkmcnt(0)":::"memory");
    #pragma unroll
    for(int i=0;i<4;++i){const int row=i*8+(lane>>3),ch=lane&7; const u32x4 v=*(const u32x4*)(stg+row*64+ch*8); ATTN_STORE16(Ow+(long)row*DM+ch*8,v);} }
  asm volatile("s_waitcnt lgkmcnt(0)\n\ts_barrier":::"memory");
  #undef DMA_K
  #undef DMA_V
  #undef KSRC
  #undef VSRC
  #undef CMASK
  #undef CSEL
  #undef CINIT
  #undef CSRC
  #undef START
  #undef RESC
  #undef ROT
}

constexpr int MIX_STAT=0, MIX_V=2048, MIX_WS=MIX_V+8*8192, MIX_STG=MIX_WS+NW*64*4, MIX_SROW=36, MIX_LDS_BYTES=MIX_STG+NW*32*MIX_SROW*4;
__device__ __forceinline__ void mix_pair(const int tid,const int uA,const int uB,const bf16*VV,bf16*U,const bf16*WSb,const float*LNP,const float*gv,const float*bs,char*shm){
  const int lane=tid&63,r32=lane&31,hi=lane>>5; const int wid=__builtin_amdgcn_readfirstlane(tid>>6);
  const int grp=wid>>2,pb=wid&3,u=grp?uB:uA; const bool valid=u>=0; const int chunk=u>>4,g=u&15;
  const unsigned lds0=(unsigned)(uintptr_t)shm;
  float*stat=(float*)(shm+MIX_STAT)+grp*256;
  float*wsf=(float*)(shm+MIX_WS)+wid*64;
  float*stg=(float*)(shm+MIX_STG)+wid*32*MIX_SROW;
  const int vbase=MIX_V+grp*32768;
  asm volatile("s_waitcnt vmcnt(0)":::"memory");
  if(valid){
    #pragma unroll
    for(int k=0;k<2;++k){ const int pi=2*pb+k; const bf16*vsrc=VV+(long)(chunk*128+16*(pi&3)+(lane>>2))*2048+g*128+(pi>>2)*32+(lane&3)*8;
      #pragma unroll
      for(int s=0;s<4;++s) glds16(vsrc+(long)((s>>1)*64)*2048+(s&1)*64,(unsigned)__builtin_amdgcn_readfirstlane(lds0+vbase+s*8192+pi*1024)); }
    const int tg=tid&255;
    if(tg<128){ const __attribute__((address_space(1))) float*p=(const __attribute__((address_space(1))) float*)(LNP+(long)(chunk*128+tg)*16); float s=0.f,q=0.f;
      #pragma unroll
      for(int k=0;k<8;++k){s+=p[2*k];q+=p[2*k+1];}
      const float mean=s*(1.f/2048.f),var=q*(1.f/2048.f)-mean*mean; stat[2*tg]=mean; stat[2*tg+1]=__builtin_amdgcn_rsqf(var+1e-6f); } }
  asm volatile("s_waitcnt vmcnt(0) lgkmcnt(0)\n\ts_barrier":::"memory");
  if(valid){
    bf16x8 pa[2][4]; float corr=0.f;
    #pragma unroll
    for(int qt=0;qt<2;++qt)
      #pragma unroll
      for(int ks=0;ks<4;++ks){ const int qa=64*qt+16*ks+4*hi;
        const __attribute__((address_space(1))) unsigned* wp=(const __attribute__((address_space(1))) unsigned*)(WSb+((long)g*128+32*pb+r32)*128+qa);
        const unsigned w0=wp[0],w1=wp[1],w2=wp[4],w3=wp[5];
        const f32x4 s0=*(const f32x4*)(stat+2*qa), s1=*(const f32x4*)(stat+2*qa+4), s2=*(const f32x4*)(stat+2*qa+16), s3=*(const f32x4*)(stat+2*qa+20);
        const float a0=__uint_as_float(w0<<16)*s0.y,a1=__uint_as_float(w0&0xffff0000u)*s0.w,a2=__uint_as_float(w1<<16)*s1.y,a3=__uint_as_float(w1&0xffff0000u)*s1.w;
        const float a4=__uint_as_float(w2<<16)*s2.y,a5=__uint_as_float(w2&0xffff0000u)*s2.w,a6=__uint_as_float(w3<<16)*s3.y,a7=__uint_as_float(w3&0xffff0000u)*s3.w;
        u32x4 pk; pk.x=cvtpk_s(a0,a1); pk.y=cvtpk_s(a2,a3); pk.z=cvtpk_s(a4,a5); pk.w=cvtpk_s(a6,a7);
        corr+=(__uint_as_float(pk.x<<16)*s0.x+__uint_as_float(pk.x&0xffff0000u)*s0.z)+(__uint_as_float(pk.y<<16)*s1.x+__uint_as_float(pk.y&0xffff0000u)*s1.z)
             +(__uint_as_float(pk.z<<16)*s2.x+__uint_as_float(pk.z&0xffff0000u)*s2.z)+(__uint_as_float(pk.w<<16)*s3.x+__uint_as_float(pk.w&0xffff0000u)*s3.z);
        pa[qt][ks]=__builtin_bit_cast(bf16x8,pk); }
    {auto rr=__builtin_amdgcn_permlane32_swap(__float_as_uint(corr),__float_as_uint(corr),false,false);corr=__uint_as_float(rr[0])+__uint_as_float(rr[1]);}
    if(hi==0)wsf[r32]=corr; asm volatile("s_waitcnt lgkmcnt(0)":::"memory");
    const int vb=(int)(lds0+vbase)+((lane>>4)&1)*32+(lane&3)*8+(4*hi+((lane&15)>>2))*64;
    #pragma unroll
    for(int ch=0;ch<2;++ch){
      f32x16 o[2]; o[0]=f32x16{}; o[1]=f32x16{};
      SBAR(); pv(o,vb+ch*8192,pa[0][0],pa[0][1],pa[0][2],pa[0][3]);
      SBAR(); pv(o,vb+(2+ch)*8192,pa[1][0],pa[1][1],pa[1][2],pa[1][3]);
      #pragma unroll
      for(int d0=0;d0<2;++d0){
        #pragma unroll
        for(int r=0;r<16;++r){const int orow=crow(r,hi); stg[orow*MIX_SROW+r32]=o[d0][r]-wsf[orow];}
        asm volatile("s_waitcnt lgkmcnt(0)":::"memory");
        #pragma unroll
        for(int i=0;i<2;++i){const int row=i*16+(lane>>2),c8=(lane&3)*8; const int p=32*pb+row, e=g*128+ch*64+d0*32+c8;
          const f32x4 m0=*(const f32x4*)(stg+row*MIX_SROW+c8), m1=*(const f32x4*)(stg+row*MIX_SROW+c8+4);
          const f32x4 g0=*(const __attribute__((address_space(1))) f32x4*)(gv+e), g1=*(const __attribute__((address_space(1))) f32x4*)(gv+e+4); const float b=*(const __attribute__((address_space(1))) float*)(bs+g*128+p);
          bf16*up=U+(long)(chunk*128+p)*2048+e; const u32x4 uw=*(const __attribute__((address_space(1))) u32x4*)up;
          u32x4 ow;
          ow.x=cvtpk_s(__uint_as_float(uw.x<<16)*(g0.x*m0.x+b),__uint_as_float(uw.x&0xffff0000u)*(g0.y*m0.y+b));
          ow.y=cvtpk_s(__uint_as_float(uw.y<<16)*(g0.z*m0.z+b),__uint_as_float(uw.y&0xffff0000u)*(g0.w*m0.w+b));
          ow.z=cvtpk_s(__uint_as_float(uw.z<<16)*(g1.x*m1.x+b),__uint_as_float(uw.z&0xffff0000u)*(g1.y*m1.y+b));
          ow.w=cvtpk_s(__uint_as_float(uw.w<<16)*(g1.z*m1.z+b),__uint_as_float(uw.w&0xffff0000u)*(g1.w*m1.w+b));
          *(__attribute__((address_space(1))) u32x4*)up=ow; }
        asm volatile("s_waitcnt lgkmcnt(0)":::"memory"); }
    } }
  asm volatile("s_waitcnt lgkmcnt(0)\n\ts_barrier":::"memory");
}
constexpr int ATTN_LDS_BYTES=LDS_BYTES;
#undef SBAR
#undef WAIT_BAR
}

#ifndef LATUNIT
#define LATUNIT attn_body::attn_unit<8, true>
#endif
__device__ __forceinline__ void attn_fast(const Frame& F, const Args& args) {
    typedef attn_body::bf16 abf;
    unsigned char* ws = wsb(args);
    abf* Q = (abf*)(ws + WS_Q); const abf* K = (const abf*)(ws + WS_K);
    const abf* CKp = (const abf*)(ws + WS_CK); const abf* KCp = (const abf*)(ws + WS_KC); const float* rpb = inp(args, I_RPB);
    char* shm = (char*)(unsigned char*)F.lds + RING_OFF;
    const int vcu = (F.G % 8 == 0) ? (F.bid % 8) * (F.G / 8) + F.bid / 8 : F.bid;
    for (int u = vcu; u < 4 * NH * 4; u += F.G) {
        const int b = u >> 6, h = (u >> 2) & 15, qb = u & 3;
        const int wlo = qb < 2 ? 0 : (qb == 2 ? 4 : 8), nwin = (qb == 0 || qb == 3) ? 8 : 12;
        const long qoff = ((long)(NCTX + b * SEQ_L + qb * 256)) * D + h * HD, woff = ((long)(NCTX + b * SEQ_L + wlo * 64)) * D + h * HD, coff = ((long)(b * PAST)) * D + h * HD;
        LATUNIT(F.tid, Q + qoff, CKp + coff, (long)((WS_CV - WS_CK) / 2), 8, K + woff, (long)((WS_V - WS_K) / 2), 8 + nwin, shm, 4 * qb, wlo, rpb + h * 465);
    }
    for (int u = vcu; u < 32 * NH; u += F.G) {
        const int b = u >> 4, h = u & 15;
        const long qoff = ((long)(b * SEQ_C)) * D + h * HD;
        attn_body::attn_unit<8, false>(F.tid, Q + qoff, KCp + qoff, (long)((WS_VC - WS_KC) / 2), 4, KCp + qoff, (long)((WS_VC - WS_KC) / 2), 4, shm, 0, 0, rpb);
    }
    if (F.G % 4 == 0 && (4 * NH * 4) % F.G == 0) { const int qb = vcu & 3;
        if (qb == 0 || qb == 3) p1_sw_items(F, args, SWI_QKV, SWI_QKV + FF2 / 16, ((vcu >> 2) * 2 + (qb == 3)) * NWAVES + F.wave, (F.G / 2) * NWAVES); }
    else p1_sw_items(F, args, SWI_QKV, SWI_QKV + FF2 / 16, F.bid * NWAVES + F.wave, F.G * NWAVES);
}


__device__ __forceinline__ void mix_fast(const Frame& F, const Args& args) {
    typedef attn_body::bf16 abf;
    unsigned char* ws = wsb(args);
    const abf* VV = (const abf*)(ws + WS_VV); abf* U = (abf*)(ws + WS_U); const abf* WSb = (const abf*)(ws + WS_WSB); const float* LNP = (const float*)(ws + WS_LNP);
    const float* gv = inp(args, I_GV); const float* bs = inp(args, I_BSP);
    char* shm = (char*)(unsigned char*)F.lds + RING_OFF;
    const int vcu = (F.G % 8 == 0) ? (F.bid % 8) * (F.G / 8) + F.bid / 8 : F.bid;
    for (int u = 2 * vcu; u < 96 * 16; u += 2 * F.G) attn_body::mix_pair(F.tid, u, u + 1 < 96 * 16 ? u + 1 : -1, VV, U, WSb, LNP, gv, bs, shm);
}
#ifndef ATTN
#define ATTN attn_fast
#endif
#ifndef MIX
#define MIX mix_fast
#endif
enum Steps { S_P0 = 0, S_QKV, S_ATT, S_WO, S_UP0, S_DN0, S_IN, S_MIX, S_OUT, S_UP1, S_DN1, NSTEPS };

#ifndef STEPMASK
#define STEPMASK 0xffffffffu
#endif
#define ON(s) ((STEPMASK >> (s)) & 1u)
__device__ __forceinline__ void run_step(const Frame& F0, const Args& args, int s) {
    Frame F = F0; asm volatile("" : "+v"(F.tid)); asm volatile("" : "+s"(F.bid)); asm volatile("" : "+s"(F.G)); F.lane = F.tid & 63; F.wave = __builtin_amdgcn_readfirstlane(F.tid >> 6);
    unsigned char* ws = wsb(args);
    const float* MOD0 = (const float*)(ws + WS_MOD); const float* MOD1 = MOD0 + 5 * 6144;
    float* SW = (float*)(ws + WS_SW);
    float* RS0 = (float*)(ws + WS_RS); float* RS1 = RS0 + (size_t)MT * 4; float* RS2 = RS0 + (size_t)MT * 8; float* RS3 = RS0 + (size_t)MT * 12;
    bf16* AN = (bf16*)(ws + WS_AN);
    if (ON(S_P0) && s == S_P0) {
        unsigned* cnt = (unsigned*)ws + CW_CNT + 8192;
        for (int u = F.bid; u < ADA_UNITS; u += F.G) { p0_adaln_unit(F, args, u);
            const int jb = u % 24; if (u < 96 && jb < 8) wave_publish(cnt + (jb < 4 ? 0 : 64)); }
        const int rot = (F.bid + F.G - ADA_UNITS % F.G) % F.G;
        p0_items(F, args, 0, PI_FIRST, rot * NWAVES + F.wave, F.G * NWAVES);
        constexpr int SWU_QKV = (NQKV / 256) * 4;
        if (rot < SWU_QKV) {
            if (F.wave == 0) { wave_wait_ge(cnt, 16 * NWAVES, (unsigned*)ws + CW_TMO); __builtin_amdgcn_fence(__ATOMIC_ACQUIRE, "agent"); }
            __syncthreads();
            for (int u = rot; u < SWU_QKV; u += F.G) sw_unit_f32(F, inp(args, I_WQKV), NQKV, MOD0, SW + SW_QKV, false, u); }
        if (F.wave == 0) { wave_wait_ge(cnt + 64, 16 * NWAVES, (unsigned*)ws + CW_TMO); __builtin_amdgcn_fence(__ATOMIC_ACQUIRE, "agent"); }
        __syncthreads();
        p1_rows(F, args, rot * NWAVES + F.wave, (SWU_QKV < F.G ? SWU_QKV : 0) * NWAVES); }
    else if (ON(S_QKV) && s == S_QKV) { float* out = outb(args);
        EpiQKV E{{RS0, SW + SW_QKV, NQKV}, ws};
        int fw = 0, nfw = 1; const bool fil = filler_slot(F, (MT / 256) * (NQKV / 256), fw, nfw), first = fil && (F.bid & 8);
        if (first) { p0_items(F, args, PI_FIRST, PI_SECOND, fw, nfw); __syncthreads(); }
        gemm_pg8<0>(F, AN, (const bf16*)(ws + WS_WQKV), 0, MT, NQKV, D, E);
        if (fil && !first) p0_items(F, args, PI_FIRST, PI_SECOND, fw, nfw); }
    else if (ON(S_ATT) && s == S_ATT) ATTN(F, args);
    else if (ON(S_WO) && s == S_WO) { float* X = outb(args);
        EpiResT<0> E{inp(args, I_XP), inp(args, I_XS), (bf16*)(ws + WS_XB), nullptr, MOD0 + 2048, AN, inp(args, I_NFFN), MOD0 + 4096, RS1, 1.f};
        gemm_pg8<1, EpiResT<0>, 3>(F, (const bf16*)(ws + WS_Q), (const bf16*)(ws + WS_WO), 0, MT, D, D, E);
    }
    else if (ON(S_UP0) && s == S_UP0) { EpiUpConv E{RS1, SW + SW_UP0, inp(args, I_WCONV), inp(args, I_BCONV), (float*)(ws + WS_HALO), (bf16*)(ws + WS_M), (LAS float*)(F.lds + EPI_OFF), F.skip_epi};
        int fw = 0, nfw = 1; const bool fil = filler_slot(F, (MT / 256) * (FF2 / 256), fw, nfw), first = fil && (F.bid & 8);
        if (first) { p0_items(F, args, PI_SECOND, PI_ALL, fw, nfw); sw_units_f32(F, args, fw / NWAVES, nfw / NWAVES); __syncthreads(); }
        gemm_pg8_raw(F, AN, (const bf16*)(ws + WS_WUP), MT, FF2, D, E);
        if (fil && !first) { p0_items(F, args, PI_SECOND, PI_ALL, fw, nfw); sw_units_f32(F, args, fw / NWAVES, nfw / NWAVES); } }
    else if (ON(S_DN0) && s == S_DN0) { float* X = outb(args);
        { pg8::StaticOrder S0; S0.init(MT, D, F.G, F.bid, 192); pg8::Unit u0; for (int i = 0; S0.next(i, u0); ++i) fix_halo_rows(F, u0.pm * 192, u0.pm * 192 + 224, (const float*)(ws + WS_HALO), inp(args, I_WCONV), inp(args, I_BCONV), (bf16*)(ws + WS_M)); }
        EpiResT<1> E{nullptr, nullptr, (bf16*)(ws + WS_XB), nullptr, MOD0 + 5120, AN, inp(args, I_NMIX) + D, MOD1 + 1024, RS2, F.scale};
        gemm_pg8<1, EpiResT<1>, 3>(F, (const bf16*)(ws + WS_M), (const bf16*)(ws + WS_WDN), 0, MT, D, FF, E);
    }
    else if (ON(S_IN) && s == S_IN) { EpiIn E{{RS2, SW + SW_IN, GE2}, (bf16*)(ws + WS_U), (bf16*)(ws + WS_VV), (float*)(ws + WS_LNP)}; gemm_pg8<2>(F, AN, (const bf16*)(ws + WS_WIN), 0, MT, GE2, D, E); }
    else if (ON(S_MIX) && s == S_MIX) MIX(F, args);
    else if (ON(S_OUT) && s == S_OUT) { float* X = outb(args);
        EpiResT<1> E{nullptr, nullptr, (bf16*)(ws + WS_XB), nullptr, MOD1 + 2048, AN, inp(args, I_NFFN) + D, MOD1 + 4096, RS3, F.scale};
        gemm_pg8<1, EpiResT<1>, 3>(F, (const bf16*)(ws + WS_U), (const bf16*)(ws + WS_WOUT), 0, MT, D, GE, E); }
    else if (ON(S_UP1) && s == S_UP1) { EpiUpConv E{RS3, SW + SW_UP1, inp(args, I_WCONV) + (size_t)3 * FF2, inp(args, I_BCONV) + FF2, (float*)(ws + WS_HALO), (bf16*)(ws + WS_M), (LAS float*)(F.lds + EPI_OFF), F.skip_epi};
        int fw = 0, nfw = 1; const bool fil = filler_slot(F, (MT / 256) * (FF2 / 256), fw, nfw), first = fil && (F.bid & 8);
        if (first) state_items(F, args, fw, nfw);
        gemm_pg8_raw(F, AN, (const bf16*)(ws + WS_WUP) + (size_t)FF2 * D, MT, FF2, D, E);
        if (fil && !first) state_items(F, args, fw, nfw); }
    else if (ON(S_DN1) && s == S_DN1) { float* X = outb(args);
        { pg8::StaticOrder S0; S0.init(MT, D, F.G, F.bid, 192); pg8::Unit u0; for (int i = 0; S0.next(i, u0); ++i) fix_halo_rows(F, u0.pm * 192, u0.pm * 192 + 224, (const float*)(ws + WS_HALO), inp(args, I_WCONV) + (size_t)3 * FF2, inp(args, I_BCONV) + FF2, (bf16*)(ws + WS_M)); }
        EpiFinal E{(const bf16*)(ws + WS_XB), X, MOD1 + 5120, inp(args, I_NFIN), RS0 + (size_t)MT * 16, (unsigned*)ws + CW_CNT, (unsigned*)ws + CW_TMO, F.scale};
        gemm_pg8<1, EpiFinal, 3>(F, (const bf16*)(ws + WS_M), (const bf16*)(ws + WS_WDN) + (size_t)D * FF, 0, MT, D, FF, E); }
}

__global__ void __launch_bounds__(NWAVES * 64, 2) mk_fwd(Args args) {
    extern __shared__ __attribute__((aligned(16))) unsigned char lds[];
    Frame F;
    F.lds = (LAS unsigned char*)lds;
    F.MISC = (volatile LAS unsigned*)(F.lds + MISC_OFF);
    F.tid = threadIdx.x; F.lane = F.tid & 63; F.wave = __builtin_amdgcn_readfirstlane(F.tid >> 6);
    F.G = gridDim.x; F.bid = blockIdx.x; F.scale = 1.f; F.skip_epi = false;
    for (int u = F.tid; u < (LDS_BYTES - LDSCTL_OFF) / 4; u += NWAVES * 64) ((LAS unsigned*)(F.lds + LDSCTL_OFF))[u] = 0u;
    __syncthreads();
    XcdBarrier bar = xcd_barrier_post((unsigned*)(args.ws + WS_CTL) + CW_BAR, F.MISC + 8);
    for (int q = 0; q < args.nseq; ++q) {
        const int sq = args.seq[q]; F.scale = (sq & 32) ? 0.f : 1.f; F.skip_epi = (sq & 64) != 0;
        run_step(F, args, sq & 31);
        if (q + 1 < args.nseq) xcd_barrier(bar);
    }
}

extern "C" void kernel_launch(void* const* d_in, const int* in_sizes, int n_in, void* d_out, int out_size, void* d_ws, size_t ws_size, hipStream_t stream) {
    static int grid = 0;
    if (grid == 0) {
        if (n_in != 23 || ws_size < WS_END) { fprintf(stderr, "kernel_launch: unexpected n_in %d / ws %zu\n", n_in, ws_size); grid = -1; return; }
        int dev = 0, cus = 0, per_cu = 0;
        if (hipGetDevice(&dev) != hipSuccess || hipDeviceGetAttribute(&cus, hipDeviceAttributeMultiprocessorCount, dev) != hipSuccess) { grid = -1; return; }
        if (hipFuncSetAttribute((const void*)mk_fwd, hipFuncAttributeMaxDynamicSharedMemorySize, LDS_BYTES) != hipSuccess) { fprintf(stderr, "kernel_launch: hipFuncSetAttribute failed\n"); grid = -1; return; }
        if (hipOccupancyMaxActiveBlocksPerMultiprocessor(&per_cu, (const void*)mk_fwd, NWAVES * 64, LDS_BYTES) != hipSuccess || per_cu < 1) { fprintf(stderr, "kernel_launch: occupancy query says %d blocks per CU\n", per_cu); per_cu = 1; }
        (void)hipGetLastError();
        grid = cus;
    }
    if (grid < 0) return;
    if (hipMemsetAsync((char*)d_ws + WS_CTL, 0, CTL_ZERO_BYTES, stream) != hipSuccess) { fprintf(stderr, "kernel_launch: memset failed\n"); return; }
    Args a{};
    for (int i = 0; i < 23; ++i) a.in[i] = (const float*)d_in[i];
    a.out = (float*)d_out; a.ws = (unsigned char*)d_ws;
#ifndef DUP_FLAGS
#define DUP_FLAGS 0
#endif
#ifndef DUP_STEP
    a.nseq = NSTEPS; for (int s = 0; s < NSTEPS; ++s) a.seq[s] = (unsigned char)s;
#else
#ifndef DUP_STEP_HI
#define DUP_STEP_HI DUP_STEP
#endif
    a.nseq = 0; for (int s = 0; s < NSTEPS; ++s) { a.seq[a.nseq++] = (unsigned char)s; if (s == DUP_STEP_HI) for (int r = DUP_STEP; r <= DUP_STEP_HI; ++r) a.seq[a.nseq++] = (unsigned char)(r | 32 | DUP_FLAGS); }
#endif
    hipLaunchKernelGGL(mk_fwd, dim3(grid), dim3(NWAVES * 64), LDS_BYTES, stream, a);
    const hipError_t le = hipPeekAtLastError();
    if (le != hipSuccess) fprintf(stderr, "kernel_launch: launch failed: %s\n", hipGetErrorName(le));
}
```

```cpp
#include <hip/hip_runtime.h>
#include <cstdio>
#include <cstdint>
#include <type_traits>


#define GAS __attribute__((address_space(1)))
#define LAS __attribute__((address_space(3)))
typedef unsigned short bf16;
typedef short bf16x8 __attribute__((ext_vector_type(8)));
typedef float f32x4 __attribute__((ext_vector_type(4)));
typedef float f32x2 __attribute__((ext_vector_type(2)));
typedef unsigned u32x4 __attribute__((ext_vector_type(4)));
typedef unsigned u32x2 __attribute__((ext_vector_type(2)));
typedef GAS unsigned gu32;

constexpr int D = 1024, NCTX = 8192, NLAT = 4096, MT = 12288, NH = 16, HD = 64, FF = 2816, FF2 = 5632, GE = 2048, GE2 = 4096, NQKV = 3072;
constexpr int SEQ_C = 256, SEQ_L = 1024, PAST = 512;
constexpr float EPS = 1e-6f, LOG2E = 1.4426950408889634f, C2 = 0.125f * 1.4426950408889634f;
constexpr int NWAVES = 8;

constexpr size_t MiB = 1u << 20;
constexpr size_t WS_CTL = 0, CTL_ZERO_BYTES = 1 * MiB + 512 * 1024;
constexpr size_t WS_MOD = 512 * 1024;
constexpr size_t WS_TS = 800 * 1024;
constexpr size_t WS_SW = 1 * MiB;
constexpr size_t WS_HALO = 1 * MiB + 512 * 1024;
constexpr size_t WS_RS = 3 * MiB;
constexpr size_t WS_LNP = 4 * MiB;
constexpr size_t WS_WQKV = 5 * MiB, WS_WO = 11 * MiB, WS_WIN = 13 * MiB, WS_WOUT = 21 * MiB, WS_WUP = 25 * MiB, WS_WDN = 47 * MiB;
constexpr size_t WUP_BYTES = 11 * MiB, WDN_BYTES = (size_t)1024 * 2816 * 2;
constexpr size_t WS_WSB = 58 * MiB;
constexpr size_t WS_CK = 59 * MiB, WS_CV = 63 * MiB;
constexpr size_t WS_AN = 67 * MiB;
constexpr size_t WS_BIG = 91 * MiB;
constexpr size_t WS_Q = WS_BIG, WS_K = WS_BIG + 24 * MiB, WS_V = WS_BIG + 48 * MiB;
constexpr size_t WS_M = WS_BIG, WS_ARAW = WS_BIG + 66 * MiB;
constexpr size_t WS_U = WS_BIG, WS_VV = WS_BIG + 48 * MiB;
constexpr size_t WS_XB = 200 * MiB;
constexpr size_t WS_KC = 224 * MiB, WS_VC = 240 * MiB;
constexpr size_t WS_END = 256 * MiB;
static_assert(WS_HALO + (size_t)16 * 4 * 5632 * 4 <= WS_RS && WS_SW + 5 * (3072 + 5632 + 4096 + 5632) * 4 <= CTL_ZERO_BYTES, "zeroed region / halo");
static_assert(WS_ARAW + (size_t)4096 * 5632 * 2 <= WS_END && WS_WDN + 2 * WDN_BYTES <= WS_CK && WS_VV + 48 * MiB <= WS_END, "ws map");
constexpr int SW_QKV = 0, SW_UP0 = 5 * NQKV, SW_IN = SW_UP0 + 5 * FF2, SW_UP1 = SW_IN + 5 * GE2;
constexpr int CW_TMO = 0, CW_CODE = 1, CW_BAR = 4096;

#define RLX_AGENT __ATOMIC_RELAXED, __HIP_MEMORY_SCOPE_AGENT
#define LDS_WAIT() asm volatile("s_waitcnt lgkmcnt(0)" ::: "memory")
#define VM_WAIT() asm volatile("s_waitcnt vmcnt(0)" ::: "memory")
__device__ __forceinline__ unsigned cvt_pk_bf16(float lo, float hi) { unsigned r; asm volatile("v_cvt_pk_bf16_f32 %0, %1, %2" : "=v"(r) : "v"(lo), "v"(hi)); return r; }
__device__ __forceinline__ float bf2f(unsigned short u) { return __uint_as_float((unsigned)u << 16); }
__device__ __forceinline__ float bflo(unsigned w) { return __uint_as_float(w << 16); }
__device__ __forceinline__ float bfhi(unsigned w) { return __uint_as_float(w & 0xffff0000u); }
__device__ __forceinline__ u32x4 pack8(f32x4 a, f32x4 b) { u32x4 w; w.x = cvt_pk_bf16(a[0], a[1]); w.y = cvt_pk_bf16(a[2], a[3]); w.z = cvt_pk_bf16(b[0], b[1]); w.w = cvt_pk_bf16(b[2], b[3]); return w; }
__device__ __forceinline__ float wave_sum(float v) {
#pragma unroll
    for (int o = 1; o < 64; o <<= 1) v += __shfl_xor(v, o);
    return v;
}
__device__ __forceinline__ float silu_f(float x) { return x * __builtin_amdgcn_rcpf(1.f + __builtin_amdgcn_exp2f(-x * LOG2E)); }
__device__ __forceinline__ float gelu_tanh_f(float x) { const float u = (-1.5957691216057308f * LOG2E) * (x + 0.044715f * x * x * x); return x * __builtin_amdgcn_rcpf(1.f + __builtin_amdgcn_exp2f(u)); }
__device__ __forceinline__ int ci_of(int row) { return row < NCTX ? 0 : 1 + ((row - NCTX) >> 10); }


__device__ __forceinline__ void st4f_wt(float* p, float v) { __hip_atomic_store((unsigned*)p, __float_as_uint(v), __ATOMIC_RELAXED, __HIP_MEMORY_SCOPE_AGENT); }
__device__ __forceinline__ void wave_publish(unsigned* cnt) {
    asm volatile("s_waitcnt vmcnt(0)" ::: "memory");
    if ((threadIdx.x & 63) == 0) __hip_atomic_fetch_add(cnt, 1u, __ATOMIC_RELAXED, __HIP_MEMORY_SCOPE_AGENT);
}
__device__ __forceinline__ void wave_wait_ge(unsigned* cnt, unsigned need, unsigned* tmo) {
    unsigned sp = 0;
    while ((unsigned)__builtin_amdgcn_readfirstlane(__hip_atomic_load(cnt, __ATOMIC_RELAXED, __HIP_MEMORY_SCOPE_AGENT)) < need) {
        __builtin_amdgcn_s_sleep(2);
        if (++sp > (1u << 22)) { if ((threadIdx.x & 63) == 0) __hip_atomic_store(tmo, 1u, __ATOMIC_RELAXED, __HIP_MEMORY_SCOPE_AGENT); break; } }
}
constexpr int CW_CNT = 16384;
#define XB_TMO      128
#define XB_XCNT(j)  (256  + 64 * (j))
#define XB_XSUB(j)  (1280 + 64 * (j))
#define XB_XGEN(j)  (2304 + 64 * (j))
#define XB_TOP      3328
#define XB_TOPGEN   3392
#define XCD_BAR_WORDS 3456
#define XB_SPIN_CAP (1u << 18)
__device__ __forceinline__ unsigned xb_ld(unsigned* p)              { return __hip_atomic_load(p, __ATOMIC_RELAXED, __HIP_MEMORY_SCOPE_AGENT); }
__device__ __forceinline__ unsigned xb_add(unsigned* p, unsigned v) { return __hip_atomic_fetch_add(p, v, __ATOMIC_RELAXED, __HIP_MEMORY_SCOPE_AGENT); }
__device__ __forceinline__ unsigned xb_xcc_id() { return (unsigned)__builtin_amdgcn_s_getreg((3 << 11) | 20) & 0xFu; }
#define XB_SPIN(cond, bar) do { unsigned _sp = 0; while (cond) { __builtin_amdgcn_s_sleep(1); \
    if ((++_sp & 255u) == 0u) { if (xb_ld(&(bar)[XB_TMO])) break; if (_sp > XB_SPIN_CAP) { atomicAdd(&(bar)[XB_TMO], 1u); break; } } } } while (0)
struct XcdBarrier { unsigned* bar; unsigned x; volatile LAS unsigned* st; };
__device__ __forceinline__ XcdBarrier xcd_barrier_post(unsigned* bar, volatile LAS unsigned* st) {
    XcdBarrier b; b.bar = bar; b.x = xb_xcc_id(); b.st = st;
    if (threadIdx.x == 0) (void)xb_add(&bar[XB_XCNT(b.x)], 1u);
    return b;
}
__device__ __forceinline__ void xcd_barrier_complete(unsigned* bar, unsigned x, unsigned& nloc, unsigned& nx) {
    const unsigned G = gridDim.x * gridDim.y * gridDim.z;
    unsigned sum, cnt, mine, sp = 0u;
    for (;;) {
        sum = 0u; cnt = 0u; mine = 0u;
#pragma unroll
        for (unsigned j = 0; j < 16; ++j) { const unsigned c = xb_ld(&bar[XB_XCNT(j)]); sum += c; cnt += (c > 0u) ? 1u : 0u; mine = (j == x) ? c : mine; }
        if (sum == G) break;
        __builtin_amdgcn_s_sleep(1);
        if ((++sp & 255u) == 0u) { if (xb_ld(&bar[XB_TMO])) break; if (sp > XB_SPIN_CAP) { atomicAdd(&bar[XB_TMO], 1u); break; } }
    }
    nloc = mine > 0u ? mine : 1u; nx = cnt > 0u ? cnt : 1u;
}
__device__ __forceinline__ void xcd_barrier(const XcdBarrier& b) {
    asm volatile("s_waitcnt vmcnt(0)" ::: "memory");
    __syncthreads();
    if (threadIdx.x == 0) {
        unsigned* bar = b.bar;
        __builtin_amdgcn_s_waitcnt(0);
        unsigned nloc = b.st[0], nx = b.st[1];
        if (nloc == 0u) { xcd_barrier_complete(bar, b.x, nloc, nx); b.st[0] = nloc; b.st[1] = nx; }
        const unsigned old = xb_add(&bar[XB_XSUB(b.x)], 1u);
        const unsigned gen = old / nloc;
        if (old + 1u == (gen + 1u) * nloc) {
            __builtin_amdgcn_fence(__ATOMIC_RELEASE, "agent");
            asm volatile("s_waitcnt vmcnt(0)" ::: "memory");
            const unsigned og = xb_add(&bar[XB_TOP], 1u);
            const unsigned tg = og / nx;
            if (og + 1u == (tg + 1u) * nx) xb_add(&bar[XB_TOPGEN], 1u);
            else XB_SPIN(xb_ld(&bar[XB_TOPGEN]) == tg, bar);
            __builtin_amdgcn_fence(__ATOMIC_ACQUIRE, "agent");
            xb_add(&bar[XB_XGEN(b.x)], 1u);
            asm volatile("s_waitcnt vmcnt(0)" ::: "memory");
        } else {
            XB_SPIN(xb_ld(&bar[XB_XGEN(b.x)]) == gen, bar);
            __builtin_amdgcn_fence(__ATOMIC_ACQUIRE, "agent");
            asm volatile("s_waitcnt vmcnt(0)" ::: "memory");
        }
    }
    __syncthreads();
}

constexpr int RING_OFF = 0, RING_BYTES = 131072;
constexpr int LDSCTL_OFF = RING_BYTES, MISC_OFF = LDSCTL_OFF + 320;
constexpr int LDS_BYTES = 147456;

struct Frame {
    LAS unsigned char* lds;
    volatile LAS unsigned* MISC;
    int tid, lane, wave, G, bid;
    bool skip_epi;
    float scale;
};
struct Args { const float* in[23]; float* out; unsigned char* ws; int nseq, pad; unsigned char seq[32]; };
#define ASSUME_GLOBAL(p) __builtin_assume(!__builtin_amdgcn_is_shared((const void*)(p)) && !__builtin_amdgcn_is_private((const void*)(p)))
__device__ __forceinline__ const float* inp(const Args& a, int i) { asm volatile("" : "+s"(i)); const float* p = a.in[i]; return (const float*)(const GAS float*)p; }
__device__ __forceinline__ unsigned char* wsb(const Args& a) { unsigned char* p = a.ws; asm volatile("" : "+s"(p)); return (unsigned char*)(GAS unsigned char*)p; }
__device__ __forceinline__ float* outb(const Args& a) { float* p = a.out; asm volatile("" : "+s"(p)); return (float*)(GAS float*)p; }
enum InIdx { I_XP = 0, I_XS, I_CK, I_CV, I_C, I_CCTX, I_WADA, I_BADA, I_NMIX, I_NFFN, I_NFIN, I_WQKV, I_WO, I_RPB, I_WIN, I_GV, I_WSP, I_BSP, I_WOUT, I_WUP, I_WCONV, I_BCONV, I_WDN };


#define G_LD4(p)   (*(const GAS f32x4*)(p))
#define G_LDU4(p)  (*(const GAS u32x4*)(p))
#define G_ST4(p,v) (*(GAS f32x4*)(p) = (v))
#define G_STU4(p,v) (*(GAS u32x4*)(p) = (v))

__device__ __forceinline__ int upmap(int n) { return n < FF ? ((n >> 7) << 8) + (n & 127) : (((n - FF) >> 7) << 8) + 128 + ((n - FF) & 127); }
constexpr int ADA_UNITS = 2 * 24 * 4;
__device__ __forceinline__ void p0_adaln_unit(const Frame& F, const Args& args, int u) {
    const float* w_ada = inp(args, I_WADA); const float* c_ctx = inp(args, I_CCTX); const float* cc = inp(args, I_C);
    float* MOD = (float*)(wsb(args) + WS_MOD);
    const int jb = u % 24, kq = (u / 24) & 3, l = u / 96;
    const int k0 = kq * 256 + F.wave * 32;
    const float* W = w_ada + ((size_t)l * D + k0) * 6144 + jb * 256 + F.lane * 4;
    f32x4 acc[5];
#pragma unroll
    for (int q = 0; q < 5; ++q) acc[q] = (f32x4){0.f, 0.f, 0.f, 0.f};
    for (int i0 = 0; i0 < 32; i0 += 16) {
        f32x4 w[16];
#pragma unroll
        for (int i = 0; i < 16; ++i) w[i] = G_LD4(W + (size_t)(i0 + i) * 6144);
#pragma unroll
        for (int i = 0; i < 16; ++i) { const int k = k0 + i0 + i;
            acc[0] += silu_f(c_ctx[k]) * w[i];
#pragma unroll
            for (int b = 0; b < 4; ++b) acc[1 + b] += silu_f(cc[b * D + k]) * w[i]; }
    }
    LAS f32x4* red = (LAS f32x4*)(F.lds + RING_OFF);
#pragma unroll
    for (int q = 0; q < 5; ++q) red[(F.wave * 5 + q) * 64 + F.lane] = acc[q];
    __syncthreads();
    const LAS float* redf = (const LAS float*)red;
    for (int o = F.tid; o < 5 * 256; o += NWAVES * 64) { const int q = o >> 8, c = o & 255;
        float s = 0.f;
#pragma unroll
        for (int w = 0; w < NWAVES; ++w) s += redf[(w * 5 + q) * 256 + c];
        if (kq == 0) s += inp(args, I_BADA)[l * 6144 + jb * 256 + c];
        atomicAdd(MOD + (size_t)(l * 5 + q) * 6144 + jb * 256 + c, s * F.scale); }
    __syncthreads();
}
constexpr int PI_QKV = (D / 64) * (NQKV / 32), PI_FIRST = PI_QKV;
constexpr int PI_CACHE = 4096, PI_WSP = 512, PI_O = (D / 64) * (D / 32), PI_IN = (D / 64) * (GE2 / 32), PI_OUT = (GE / 64) * (D / 32), PI_UP = (D / 64) * (FF2 / 32), PI_DN = (FF / 64) * (D / 32);
constexpr int PI_SECOND = PI_FIRST + PI_CACHE + PI_WSP + PI_O + PI_UP + PI_DN, PI_ALL = PI_SECOND + PI_UP + PI_DN + PI_IN + PI_OUT;
__device__ __forceinline__ void p0_transpose_seg(const float* W, int K, int N, bf16* WT, bool upperm, LAS float* scr, int it, int end, int stride, int lane) {
    if (it >= end) return;
    const int nblk = N / 32;
    f32x4 v[8];
    { const int k0 = 64 * (it / nblk), n0 = 32 * (it % nblk);
#pragma unroll
      for (int i = 0; i < 8; ++i) v[i] = G_LD4(W + (size_t)(k0 + 8 * i + (lane >> 3)) * N + n0 + 4 * (lane & 7)); }
    for (; it < end; it += stride) {
        const int k0 = 64 * (it / nblk), n0 = 32 * (it % nblk), nm0 = upperm ? upmap(n0) : n0;
#pragma unroll
        for (int i = 0; i < 8; ++i) { LAS float* d = scr + (8 * i + (lane >> 3)) * 33 + 4 * (lane & 7); d[0] = v[i].x; d[1] = v[i].y; d[2] = v[i].z; d[3] = v[i].w; }
        const int itn = it + stride;
        if (itn < end) { const int k1 = 64 * (itn / nblk), n1 = 32 * (itn % nblk);
#pragma unroll
            for (int i = 0; i < 8; ++i) v[i] = G_LD4(W + (size_t)(k1 + 8 * i + (lane >> 3)) * N + n1 + 4 * (lane & 7)); }
        LDS_WAIT(); asm volatile("" ::: "memory");
        const int c = lane & 7;
#pragma unroll
        for (int j = 0; j < 4; ++j) { const int n = (lane >> 3) + 8 * j; const LAS float* s = scr + (8 * c) * 33 + n;
            u32x4 o; o.x = cvt_pk_bf16(s[0 * 33], s[1 * 33]); o.y = cvt_pk_bf16(s[2 * 33], s[3 * 33]); o.z = cvt_pk_bf16(s[4 * 33], s[5 * 33]); o.w = cvt_pk_bf16(s[6 * 33], s[7 * 33]);
            G_STU4(WT + (size_t)(nm0 + n) * K + k0 + 8 * c, o); }
        LDS_WAIT(); asm volatile("" ::: "memory");
    }
}
__device__ __forceinline__ void p0_cache_seg(const Args& args, int it, int end, int stride, int lane) {
    if (it >= end) return;
    f32x4 a[4];
    { const int which = it >> 11, r = it & 2047, cg = r & 31, h = (r >> 5) & 15, b = r >> 9;
      const float* s = inp(args, which ? I_CV : I_CK) + (((size_t)b * NH + h) * PAST + cg * 16 + (lane >> 2)) * HD + (lane & 3) * 16;
#pragma unroll
      for (int i = 0; i < 4; ++i) a[i] = G_LD4(s + 4 * i); }
    for (; it < end; it += stride) {
        const int which = it >> 11, r = it & 2047, cg = r & 31, h = (r >> 5) & 15, b = r >> 9;
        bf16* d = (bf16*)(wsb(args) + (which ? WS_CV : WS_CK)) + ((size_t)b * PAST + cg * 16 + (lane >> 2)) * D + h * HD + (lane & 3) * 16;
        const u32x4 o0 = pack8(a[0], a[1]), o1 = pack8(a[2], a[3]);
        const int itn = it + stride;
        if (itn < end) { const int w1 = itn >> 11, r1 = itn & 2047, cg1 = r1 & 31, h1 = (r1 >> 5) & 15, b1 = r1 >> 9;
            const float* s = inp(args, w1 ? I_CV : I_CK) + (((size_t)b1 * NH + h1) * PAST + cg1 * 16 + (lane >> 2)) * HD + (lane & 3) * 16;
#pragma unroll
            for (int i = 0; i < 4; ++i) a[i] = G_LD4(s + 4 * i); }
        G_STU4(d, o0); G_STU4(d + 8, o1);
    }
}
__device__ __forceinline__ int first_from(int start, int stride, int s0) { return start >= s0 ? start : start + (s0 - start + stride - 1) / stride * stride; }
__device__ __forceinline__ void p0_items(const Frame& F, const Args& args, int lo, int hi, int fw, int nfw) {
    LAS float* scr = (LAS float*)(F.lds + RING_OFF + F.wave * 16384);
    unsigned char* ws = wsb(args);
    int base = 0;
#define P0_SEG(n, s0v, itv, endv) const int s0v = base; base += (n); const int endv = (hi < base ? hi : base) - s0v, itv = first_from(lo + fw, nfw, s0v) - s0v;
    { P0_SEG(PI_QKV, s0, it, end) p0_transpose_seg(inp(args, I_WQKV), D, NQKV, (bf16*)(ws + WS_WQKV), false, scr, it, end, nfw, F.lane); }
    if (hi <= base) return;
    { P0_SEG(PI_CACHE, s0, it, end) p0_cache_seg(args, it, end, nfw, F.lane); }
    { P0_SEG(PI_WSP, s0, it, end) for (int r = it; r < end; r += nfw) { const float* s = inp(args, I_WSP) + (size_t)r * 512 + F.lane * 8; const f32x4 a0 = *(const f32x4*)s, a1 = *(const f32x4*)(s + 4); *(u32x4*)((bf16*)(ws + WS_WSB) + (size_t)r * 512 + F.lane * 8) = pack8(a0, a1); } }
    { P0_SEG(PI_O, s0, it, end) p0_transpose_seg(inp(args, I_WO), D, D, (bf16*)(ws + WS_WO), false, scr, it, end, nfw, F.lane); }
    { P0_SEG(PI_UP, s0, it, end) p0_transpose_seg(inp(args, I_WUP), D, FF2, (bf16*)(ws + WS_WUP), true, scr, it, end, nfw, F.lane); }
    { P0_SEG(PI_DN, s0, it, end) p0_transpose_seg(inp(args, I_WDN), FF, D, (bf16*)(ws + WS_WDN), false, scr, it, end, nfw, F.lane); }
    if (hi <= base) return;
    { P0_SEG(PI_UP, s0, it, end) p0_transpose_seg(inp(args, I_WUP) + (size_t)D * FF2, D, FF2, (bf16*)(ws + WS_WUP) + (size_t)FF2 * D, true, scr, it, end, nfw, F.lane); }
    { P0_SEG(PI_DN, s0, it, end) p0_transpose_seg(inp(args, I_WDN) + (size_t)FF * D, FF, D, (bf16*)(ws + WS_WDN) + (size_t)D * FF, false, scr, it, end, nfw, F.lane); }
    { P0_SEG(PI_IN, s0, it, end) p0_transpose_seg(inp(args, I_WIN), D, GE2, (bf16*)(ws + WS_WIN), false, scr, it, end, nfw, F.lane); }
    { P0_SEG(PI_OUT, s0, it, end) p0_transpose_seg(inp(args, I_WOUT), GE, D, (bf16*)(ws + WS_WOUT), false, scr, it, end, nfw, F.lane); }
#undef P0_SEG
}
constexpr int ST_ITEMS = 2 * 32 * NH * (SEQ_C / 16);
__device__ __forceinline__ void state_items(const Frame& F, const Args& args, int fw, int nfw) {
    unsigned char* ws = wsb(args); float* out = outb(args);
    for (int it = fw; it < ST_ITEMS; it += nfw) {
        const int tg = it & 15, h = (it >> 4) & 15, b = (it >> 8) & 31, which = it >> 13;
        const bf16* src = (const bf16*)(ws + (which ? WS_VC : WS_KC)) + (size_t)(b * SEQ_C + tg * 16 + (F.lane >> 2)) * D + h * HD + (F.lane & 3) * 16;
        const u32x4 w0 = G_LDU4(src), w1 = G_LDU4(src + 8);
        float* dst = out + (size_t)MT * D + (size_t)which * NCTX * D + (((size_t)b * NH + h) * SEQ_C + tg * 16 + (F.lane >> 2)) * HD + (F.lane & 3) * 16;
        f32x4 o0, o1, o2, o3;
        o0.x = bflo(w0.x); o0.y = bfhi(w0.x); o0.z = bflo(w0.y); o0.w = bfhi(w0.y); o1.x = bflo(w0.z); o1.y = bfhi(w0.z); o1.z = bflo(w0.w); o1.w = bfhi(w0.w);
        o2.x = bflo(w1.x); o2.y = bfhi(w1.x); o2.z = bflo(w1.y); o2.w = bfhi(w1.y); o3.x = bflo(w1.z); o3.y = bfhi(w1.z); o3.z = bflo(w1.w); o3.w = bfhi(w1.w);
        G_ST4(dst, o0); G_ST4(dst + 4, o1); G_ST4(dst + 8, o2); G_ST4(dst + 12, o3);
    }
}
__device__ __forceinline__ bool filler_slot(const Frame& F, int nunits, int& fw, int& nfw) {
    const int rem = nunits % F.G, first = rem, nblk = F.G - rem;
    if (F.bid < first) return false;
    fw = (F.bid - first) * NWAVES + F.wave; nfw = nblk * NWAVES; return true;
}

__device__ __forceinline__ void p1_rows(const Frame& F, const Args& args, const int gw, const int nbusy) {
    const int NGW = F.G * NWAVES, lane = F.lane;
    const float* xp = inp(args, I_XP); const float* xs = inp(args, I_XS); const float* gmix = inp(args, I_NMIX);
    unsigned char* ws = wsb(args);
    const float* MOD = (const float*)(ws + WS_MOD); float* RS = (float*)(ws + WS_RS); bf16* AN = (bf16*)(ws + WS_AN);
    const int nshort = NGW > 2 * nbusy ? nbusy : 0; const bool busy = gw < nshort;
    int m = busy ? gw : 3 * nshort + (gw - nshort); const int mstep = busy ? nshort : NGW - nshort, mend = busy ? 3 * nshort : MT;
    f32x4 g[4], v[4];
#pragma unroll
    for (int j = 0; j < 4; ++j) g[j] = G_LD4(gmix + 4 * lane + 256 * j);
    if (m < mend) { const float* xr = (m < NCTX) ? xp + (size_t)m * D : xs + (size_t)(m - NCTX) * D;
#pragma unroll
        for (int j = 0; j < 4; ++j) v[j] = G_LD4((const f32x4*)xr + lane + 64 * j); }
    for (; m < mend; m += mstep) {
        const float* sc = MOD + (size_t)ci_of(m) * 6144 + 1024;
        f32x4 cs[4], vn[4];
#pragma unroll
        for (int j = 0; j < 4; ++j) cs[j] = G_LD4(sc + 4 * lane + 256 * j);
        const int mn = m + mstep;
        if (mn < mend) { const float* xr = (mn < NCTX) ? xp + (size_t)mn * D : xs + (size_t)(mn - NCTX) * D;
#pragma unroll
            for (int j = 0; j < 4; ++j) vn[j] = G_LD4((const f32x4*)xr + lane + 64 * j); }
        float s = 0.f;
#pragma unroll
        for (int j = 0; j < 4; ++j) s += (v[j].x * v[j].x + v[j].y * v[j].y) + (v[j].z * v[j].z + v[j].w * v[j].w);
        s = wave_sum(s);
        if (lane == 0) G_ST4(RS + (size_t)m * 4, ((f32x4){s, 0.f, 0.f, 0.f}));
#pragma unroll
        for (int j = 0; j < 4; ++j) { const int col = 4 * lane + 256 * j;
            const f32x4 o = v[j] * g[j] * (1.f + cs[j]);
            u32x2 w; w.x = cvt_pk_bf16(o[0], o[1]); w.y = cvt_pk_bf16(o[2], o[3]);
            *(GAS u32x2*)(AN + (size_t)m * D + col) = w; }
#pragma unroll
        for (int j = 0; j < 4; ++j) v[j] = vn[j];
    }
}
namespace pg8 {
#define PG8_LAS __attribute__((address_space(3)))
typedef unsigned short bf16_t;
typedef short bf16x8 __attribute__((ext_vector_type(8)));
typedef float f32x4 __attribute__((ext_vector_type(4)));
typedef unsigned u32x4 __attribute__((ext_vector_type(4)));
constexpr int BM = 256, BK = 64, HALF = 128, HTB = HALF * BK * 2  , STAGE_BYTES = 8 * HTB, NXCD = 8, WGM = 8;

__host__ __device__ __forceinline__ int lds_byte(int r, int c) { const int st = (r >> 4) * 2 + (c >> 5), rr = r & 15, cc = c & 31, ob = rr * 64 + cc * 2; return st * 1024 + (ob ^ (((ob >> 9) & 1) << 5)); }
__host__ __device__ __forceinline__ void stage_rc(int b, int& R, int& C) { const int st = b / 1024, sb = b % 1024, swz = sb ^ (((sb >> 9) & 1) << 5); R = (st >> 1) * 16 + swz / 64; C = (st & 1) * 32 + (swz % 64) / 2; }
__host__ __device__ __forceinline__ int perm32(int rho) { const int n = rho >> 4, i = rho & 15; return 8 * (i >> 2) + 4 * n + (i & 3); }

struct Unit { int pm, pn; };
struct Gemm { const bf16_t* A; const bf16_t* Bt; int M, N, K; };

struct StaticOrder {
    int nM, nN, nwg, G, c;
    __host__ __device__ void init(int M, int N, int G_, int c_, int bmr = BM) { nM = M / bmr; nN = N / BM; nwg = nM * nN; G = G_; c = c_; }
    __host__ __device__ bool next(int i, Unit& u) const {
        const long L = (long)i * G + c; if (L >= nwg) return false;
        int wgid = (int)L; { const int q = nwg / NXCD, r = nwg % NXCD, xcd = wgid % NXCD, off = wgid / NXCD; wgid = (xcd < r ? xcd * (q + 1) : r * (q + 1) + (xcd - r) * q) + off; }
        const int nig = WGM * nN, gid = wgid / nig, fm = gid * WGM, gsz = (nM - fm) < WGM ? (nM - fm) : WGM;
        u.pm = fm + ((wgid % nig) % gsz); u.pn = (wgid % nig) / gsz; return true;
    }
    __device__ __forceinline__ void a_ready(const Unit&) const {}
    __device__ __forceinline__ void done(const Unit&) const {}
};

template <class E> struct epi_is_final { static constexpr bool value = false; };
template <class E, int NRED, int MB = 4> struct EpiAdapt {
    static constexpr bool PERM = true, AFTER_DRAIN = false; static constexpr int BMR = 64 * MB;
    __device__ __forceinline__ void fused(f32x4 (&acc)[2][2][MB][2], const Unit& u, int wr, int wc, int fr, int fq, PG8_LAS unsigned char*, int, int) const { (*this)(acc, u, wr, wc, fr, fq); }
    E e; int row0; PG8_LAS float* P; bool skip;
    __device__ __forceinline__ void operator()(f32x4 (&acc)[2][2][MB][2], const Unit& u, int wr, int wc, int fr, int fq) const {
        if (skip) return;
        asm volatile("" : "+v"(fr), "+v"(fq));
        const int rl = wr * 16 * MB + fr, rbase = row0 + u.pm * BMR + rl, cbase = u.pn * BM + wc * 32 + 8 * fq;
        float red[2][MB][NRED > 0 ? NRED : 1];
#pragma unroll
        for (int ai = 0; ai < 2; ++ai)
#pragma unroll
            for (int m = 0; m < MB; ++m)
#pragma unroll
                for (int k = 0; k < (NRED > 0 ? NRED : 1); ++k) red[ai][m][k] = 0.f;
        if constexpr (E::HAS_LIN) {
            static_assert(MB == 4, "HAS_LIN epilogues run on 256-row tiles");
            f32x4 p[2][MB], sw[2][2];
#pragma unroll
            for (int ai = 0; ai < 2; ++ai)
#pragma unroll
                for (int m = 0; m < MB; ++m) p[ai][m] = G_LD4(e.L.RS + (size_t)(rbase + ai * (BMR / 2) + m * 16) * 4);
            { const float* s = e.L.SW + (size_t)ci_of(row0 + u.pm * BMR) * e.L.N + cbase;
#pragma unroll
              for (int bj = 0; bj < 2; ++bj) { sw[bj][0] = G_LD4(s + bj * HALF); sw[bj][1] = G_LD4(s + bj * HALF + 4); } }
            __builtin_amdgcn_sched_barrier(0);
#pragma unroll
            for (int ai = 0; ai < 2; ++ai)
#pragma unroll
                for (int m = 0; m < MB; ++m) { const f32x4 q = p[ai][m];
                    const float r = __builtin_amdgcn_rsqf(((q.x + q.y) + (q.z + q.w)) * (1.f / D) + EPS);
#pragma unroll
                    for (int bj = 0; bj < 2; ++bj) e.post(rbase + ai * (BMR / 2) + m * 16, cbase + bj * HALF, acc[ai][bj][m][0] * r + sw[bj][0], acc[ai][bj][m][1] * r + sw[bj][1], red[ai][m]); }
        } else if constexpr (E::HAS_PRE) {
            PG8_LAS float* ST = P + 2048;
            const int ci_lo = ci_of(row0 + u.pm * BMR), ci_hi = ci_of(row0 + u.pm * BMR + BMR - 1);
            { const int t = (wr * 4 + wc) * 64 + fq * 16 + fr;
              float sv[2];
#pragma unroll
              for (int k = 0; k < 2; ++k) { const int idx = t + 512 * k; sv[k] = e.stage_val(idx >> 9, ((idx >> 8) & 1) ? ci_hi : ci_lo, u.pn * BM + (idx & 255)); }
#pragma unroll
              for (int k = 0; k < 2; ++k) ST[t + 512 * k] = sv[k]; }
#define PG8_STP(row, col) (ST + (ci_of(row) != ci_lo ? 256 : 0) + ((col) - u.pn * BM))
            if constexpr (E::PRE_HALVES) {
#pragma unroll
                for (int ai = 0; ai < 2; ++ai) {
                    typename E::Pre pre[MB][2];
#pragma unroll
                    for (int m = 0; m < MB; ++m)
#pragma unroll
                        for (int bj = 0; bj < 2; ++bj) pre[m][bj] = e.prefetch(rbase + ai * (BMR / 2) + m * 16, cbase + bj * HALF);
                    __builtin_amdgcn_sched_barrier(0);
                    if (ai == 0) { asm volatile("s_waitcnt lgkmcnt(0)" ::: "memory"); __builtin_amdgcn_s_barrier(); asm volatile("" ::: "memory"); }
#pragma unroll
                    for (int m = 0; m < MB; ++m)
#pragma unroll
                        for (int bj = 0; bj < 2; ++bj) e.apply_pre(rbase + ai * (BMR / 2) + m * 16, cbase + bj * HALF, acc[ai][bj][m][0], acc[ai][bj][m][1], red[ai][m], pre[m][bj], PG8_STP(rbase + ai * (BMR / 2) + m * 16, cbase + bj * HALF));
                    __builtin_amdgcn_sched_barrier(0); }
            } else {
            typename E::Pre pre[2][MB][2];
#pragma unroll
            for (int ai = 0; ai < 2; ++ai)
#pragma unroll
                for (int m = 0; m < MB; ++m)
#pragma unroll
                    for (int bj = 0; bj < 2; ++bj) pre[ai][m][bj] = e.prefetch(rbase + ai * (BMR / 2) + m * 16, cbase + bj * HALF);
            __builtin_amdgcn_sched_barrier(0);
            asm volatile("s_waitcnt lgkmcnt(0)" ::: "memory"); __builtin_amdgcn_s_barrier(); asm volatile("" ::: "memory");
#pragma unroll
            for (int ai = 0; ai < 2; ++ai)
#pragma unroll
                for (int m = 0; m < MB; ++m)
#pragma unroll
                    for (int bj = 0; bj < 2; ++bj) e.apply_pre(rbase + ai * (BMR / 2) + m * 16, cbase + bj * HALF, acc[ai][bj][m][0], acc[ai][bj][m][1], red[ai][m], pre[ai][m][bj], PG8_STP(rbase + ai * (BMR / 2) + m * 16, cbase + bj * HALF));
            }
        } else {
#pragma unroll
        for (int ai = 0; ai < 2; ++ai)
#pragma unroll
            for (int m = 0; m < MB; ++m)
#pragma unroll
                for (int bj = 0; bj < 2; ++bj) e.apply(rbase + ai * (BMR / 2) + m * 16, cbase + bj * HALF, acc[ai][bj][m][0], acc[ai][bj][m][1], red[ai][m]);
        }
        if constexpr (NRED > 0) {
            if (e.want_red(u.pn)) {
#pragma unroll
                for (int ai = 0; ai < 2; ++ai)
#pragma unroll
                    for (int m = 0; m < MB; ++m)
#pragma unroll
                        for (int k = 0; k < NRED; ++k) { float s = red[ai][m][k]; s += __shfl_xor(s, 16); s += __shfl_xor(s, 32); if (fq == 0) P[((ai * (BMR / 2) + rl + m * 16) * 4 + wc) * 2 + k] = s; }
                asm volatile("s_waitcnt lgkmcnt(0)" ::: "memory"); __builtin_amdgcn_s_barrier(); asm volatile("" ::: "memory");
                const int t = (wr * 4 + wc) * 64 + fq * 16 + fr;
                if (t < BMR) { float r[NRED];
#pragma unroll
                    for (int k = 0; k < NRED; ++k) r[k] = (P[(t * 4 + 0) * 2 + k] + P[(t * 4 + 1) * 2 + k]) + (P[(t * 4 + 2) * 2 + k] + P[(t * 4 + 3) * 2 + k]);
                    e.store_red(row0 + u.pm * BMR + t, u.pn, r); }
                if constexpr (epi_is_final<E>::value) {
                    wave_publish(e.cnt + 64 * u.pm);
                    if (wr == 0 && wc == 0) { wave_wait_ge(e.cnt + 64 * u.pm, 4 * 8, e.tmo); __builtin_amdgcn_fence(__ATOMIC_ACQUIRE, "agent"); }
                    asm volatile("s_waitcnt vmcnt(0) lgkmcnt(0)" ::: "memory"); __builtin_amdgcn_s_barrier(); asm volatile("" ::: "memory");
                    if (t < BMR) P[t] = e.row_scale(row0 + u.pm * BMR + t);
                    asm volatile("s_waitcnt lgkmcnt(0)" ::: "memory"); __builtin_amdgcn_s_barrier(); asm volatile("" ::: "memory");
                    f32x4 xq[2][MB][2][2], gf[2][2];
#pragma unroll
                    for (int bj = 0; bj < 2; ++bj) { gf[bj][0] = G_LD4(e.gfin + cbase + bj * HALF); gf[bj][1] = G_LD4(e.gfin + cbase + bj * HALF + 4); }
#pragma unroll
                    for (int ai = 0; ai < 2; ++ai)
#pragma unroll
                        for (int m = 0; m < MB; ++m)
#pragma unroll
                            for (int bj = 0; bj < 2; ++bj) { const float* o = e.Y + (size_t)(rbase + ai * (BMR / 2) + m * 16) * D + cbase + bj * HALF; xq[ai][m][bj][0] = G_LD4(o); xq[ai][m][bj][1] = G_LD4(o + 4); }
                    __builtin_amdgcn_sched_barrier(0);
#pragma unroll
                    for (int ai = 0; ai < 2; ++ai)
#pragma unroll
                        for (int m = 0; m < MB; ++m) { const float rs = P[ai * (BMR / 2) + rl + m * 16];
#pragma unroll
                            for (int bj = 0; bj < 2; ++bj) { float* o = e.Y + (size_t)(rbase + ai * (BMR / 2) + m * 16) * D + cbase + bj * HALF;
                                G_ST4(o, xq[ai][m][bj][0] * rs * gf[bj][0]); G_ST4(o + 4, xq[ai][m][bj][1] * rs * gf[bj][1]); } }
                }
            }
        }
    }
};
template <class Epi, class Sched, bool ALIGN_EPI = false, bool SP2 = false, int MB = 4>
__device__ __forceinline__ void gemm_phase(PG8_LAS unsigned char* lds, const Gemm g, const Sched& S, const Epi& E, const int tid) {
    const int wid = __builtin_amdgcn_readfirstlane(tid >> 6), lane = tid & 63, wr = wid >> 2, wc = wid & 3, fr = lane & 15, fq = lane >> 4;
    const int K = g.K, nt = K / BK;
    unsigned voffA[2], voffB[2];
#pragma unroll
    for (int i = 0; i < 2; ++i) { int R, C; stage_rc(tid * 16 + i * 8192, R, C); const int Rb = Epi::PERM ? ((R & ~31) + perm32(R & 31)) : R;
        voffA[i] = (unsigned)((R < 32 * MB ? R : 0) * K + C) * 2u; voffB[i] = (unsigned)(Rb * K + C) * 2u; }
    const size_t kstep = (size_t)(BK * 2);
    const size_t hstep = (size_t)HALF * K * 2;
    const size_t tstep = 2 * hstep;
    const size_t hstepA = (size_t)(32 * MB) * K * 2, tstepA = 2 * hstepA;
    const unsigned ldsw = (unsigned)wid * 1024u;
    const int aoff = lds_byte(wr * 16 * MB + fr, fq * 8), boff = lds_byte(wc * 32 + fr, fq * 8);
#define PG8_SA(b, h) (((b) * 2 + (h)) * HTB)
#define PG8_SB(b, h) ((4 + (b) * 2 + (h)) * HTB)
#define PG8_STAGE(bufoff, gbase, voff) do { _Pragma("unroll") for (int _i = 0; _i < 2; ++_i) \
        __builtin_amdgcn_global_load_lds((const unsigned*)((const char*)(gbase) + (voff)[_i]), (PG8_LAS unsigned*)(lds + (bufoff) + ldsw + _i * 8192), 16, 0, 0); } while (0)
#define PG8_LDA(dst, b, h) do { _Pragma("unroll") for (int m = 0; m < MB; ++m) _Pragma("unroll") for (int k = 0; k < 2; ++k) dst[m][k] = *(const PG8_LAS bf16x8*)(lds + PG8_SA(b, h) + aoff + m * 2048 + k * 1024); } while (0)
#define PG8_LDB(dst, b, h) do { _Pragma("unroll") for (int n = 0; n < 2; ++n) _Pragma("unroll") for (int k = 0; k < 2; ++k) dst[n][k] = *(const PG8_LAS bf16x8*)(lds + PG8_SB(b, h) + boff + n * 2048 + k * 1024); } while (0)
#define PG8_MMA(ai, bj, At, Bt) do { __builtin_amdgcn_s_setprio(1); _Pragma("unroll") for (int m = 0; m < MB; ++m) _Pragma("unroll") for (int n = 0; n < 2; ++n) _Pragma("unroll") for (int k = 0; k < 2; ++k) \
        acc[ai][bj][m][n] = __builtin_amdgcn_mfma_f32_16x16x32_bf16(Bt[n][k], At[m][k], acc[ai][bj][m][n], 0, 0, 0); __builtin_amdgcn_s_setprio(0); } while (0)
#define PG8_WAIT_V(n) asm volatile("s_waitcnt vmcnt(" #n ")" ::: "memory")
#define PG8_WAIT_L(n) asm volatile("s_waitcnt lgkmcnt(" #n ")" ::: "memory")
#define PG8_BAR __builtin_amdgcn_s_barrier()
#define PG8_SCHED __builtin_amdgcn_sched_barrier(0)
    Unit cur, nxt; int ui = 0;
    if (!S.next(0, cur)) return;
    f32x4 acc[2][2][MB][2];
#pragma unroll
    for (int a = 0; a < 2; ++a)
#pragma unroll
        for (int b = 0; b < 2; ++b)
#pragma unroll
            for (int m = 0; m < MB; ++m)
#pragma unroll
                for (int n = 0; n < 2; ++n) acc[a][b][m][n] = (f32x4){0.f, 0.f, 0.f, 0.f};
    bf16x8 At[MB][2], B0[2][2], B1[2][2];
    const char* cA = (const char*)g.A + (size_t)cur.pm * tstepA; const char* cB = (const char*)g.Bt + (size_t)cur.pn * tstep;
    S.a_ready(cur);
    if constexpr (SP2) {
        PG8_STAGE(PG8_SB(0, 0), cB, voffB); PG8_STAGE(PG8_SB(0, 1), cB + hstep, voffB); PG8_STAGE(PG8_SA(0, 0), cA, voffA); PG8_STAGE(PG8_SA(0, 1), cA + hstepA, voffA);
        if (wr == 1) PG8_BAR;
        PG8_WAIT_V(2); PG8_BAR;
        PG8_STAGE(PG8_SB(1, 0), cB + kstep, voffB); PG8_STAGE(PG8_SA(1, 0), cA + kstep, voffA); PG8_STAGE(PG8_SB(1, 1), cB + hstep + kstep, voffB);
        PG8_WAIT_V(6); PG8_BAR;
    } else {
        PG8_STAGE(PG8_SB(0, 0), cB, voffB); PG8_STAGE(PG8_SA(0, 0), cA, voffA); PG8_STAGE(PG8_SB(0, 1), cB + hstep, voffB); PG8_STAGE(PG8_SA(0, 1), cA + hstepA, voffA);
        if (wr == 1) PG8_BAR;
        PG8_WAIT_V(4); PG8_BAR;
        PG8_STAGE(PG8_SB(1, 0), cB + kstep, voffB); PG8_STAGE(PG8_SA(1, 0), cA + kstep, voffA); PG8_STAGE(PG8_SB(1, 1), cB + hstep + kstep, voffB);
        PG8_WAIT_V(6); PG8_BAR;
    }
    for (;;) {
        const bool has_next = S.next(ui + 1, nxt);
        const char* nA = has_next ? (const char*)g.A + (size_t)nxt.pm * tstepA : cA; const char* nB = has_next ? (const char*)g.Bt + (size_t)nxt.pn * tstep : cB;
        for (int t = 0; t < nt; t += 2) {
            const bool last = (t == nt - 2);
            const char* a1 = cA + (size_t)(t + 1) * kstep;
            const char* a2 = last ? nA : cA + (size_t)(t + 2) * kstep; const char* b2 = last ? nB : cB + (size_t)(t + 2) * kstep;
            const char* a3 = a2 + kstep; const char* b3 = b2 + kstep;
            if (last && has_next) S.a_ready(nxt);
            if constexpr (SP2) {
            PG8_LDB(B0, 0, 0); PG8_LDB(B1, 0, 1); PG8_SCHED; PG8_LDA(At, 0, 0); PG8_STAGE(PG8_SA(1, 1), a1 + hstepA, voffA);
            PG8_WAIT_V(8); PG8_WAIT_L(0); PG8_BAR; PG8_MMA(0, 0, At, B0); PG8_MMA(0, 1, At, B1); PG8_BAR; PG8_SCHED;
            PG8_LDA(At, 0, 1); PG8_STAGE(PG8_SB(0, 0), b2, voffB); PG8_STAGE(PG8_SB(0, 1), b2 + hstep, voffB); PG8_STAGE(PG8_SA(0, 0), a2, voffA);
            PG8_WAIT_V(8); PG8_WAIT_L(0); PG8_BAR; PG8_MMA(1, 0, At, B0); PG8_MMA(1, 1, At, B1); PG8_BAR; PG8_SCHED;
            PG8_LDB(B0, 1, 0); PG8_LDB(B1, 1, 1); PG8_SCHED; PG8_LDA(At, 1, 0); PG8_STAGE(PG8_SA(0, 1), a2 + hstepA, voffA);
            PG8_WAIT_V(8); PG8_WAIT_L(0); PG8_BAR; PG8_MMA(0, 0, At, B0); PG8_MMA(0, 1, At, B1); PG8_BAR; PG8_SCHED;
            PG8_LDA(At, 1, 1); PG8_STAGE(PG8_SB(1, 0), b3, voffB); PG8_STAGE(PG8_SB(1, 1), b3 + hstep, voffB); PG8_STAGE(PG8_SA(1, 0), a3, voffA);
            PG8_WAIT_V(8); PG8_WAIT_L(0); PG8_BAR; PG8_MMA(1, 0, At, B0); PG8_MMA(1, 1, At, B1); PG8_BAR; PG8_SCHED;
            } else {
            PG8_LDB(B0, 0, 0); PG8_SCHED; PG8_LDA(At, 0, 0); PG8_STAGE(PG8_SA(1, 1), a1 + hstepA, voffA);
            PG8_WAIT_L(8); PG8_BAR; PG8_WAIT_L(0); PG8_MMA(0, 0, At, B0); PG8_BAR; PG8_SCHED;
            PG8_LDB(B1, 0, 1); PG8_STAGE(PG8_SB(0, 0), b2, voffB);
            PG8_BAR; PG8_WAIT_L(0); PG8_MMA(0, 1, At, B1); PG8_BAR;
            PG8_LDA(At, 0, 1); PG8_STAGE(PG8_SA(0, 0), a2, voffA);
            PG8_BAR; PG8_WAIT_L(0); PG8_MMA(1, 0, At, B0); PG8_BAR; PG8_SCHED;
            PG8_STAGE(PG8_SB(0, 1), b2 + hstep, voffB);
            PG8_WAIT_V(6); PG8_BAR; PG8_MMA(1, 1, At, B1); PG8_BAR;
            PG8_LDB(B0, 1, 0); PG8_SCHED; PG8_LDA(At, 1, 0); PG8_STAGE(PG8_SA(0, 1), a2 + hstepA, voffA);
            PG8_WAIT_L(8); PG8_BAR; PG8_WAIT_L(0); PG8_MMA(0, 0, At, B0); PG8_BAR; PG8_SCHED;
            PG8_LDB(B1, 1, 1); PG8_STAGE(PG8_SB(1, 0), b3, voffB);
            PG8_BAR; PG8_WAIT_L(0); PG8_MMA(0, 1, At, B1); PG8_BAR;
            PG8_LDA(At, 1, 1); PG8_STAGE(PG8_SA(1, 0), a3, voffA);
            PG8_BAR; PG8_WAIT_L(0); PG8_MMA(1, 0, At, B0); PG8_BAR; PG8_SCHED;
            PG8_STAGE(PG8_SB(1, 1), b3 + hstep, voffB);
            PG8_WAIT_V(6); PG8_BAR; PG8_MMA(1, 1, At, B1); PG8_BAR;
            }
        }
        if constexpr (ALIGN_EPI) { if (wr == 0) PG8_BAR; }
        if constexpr (!Epi::AFTER_DRAIN) { E(acc, cur, wr, wc, fr, fq); S.done(cur); }
        if (!has_next) break;
#pragma unroll
        for (int a = 0; a < 2; ++a)
#pragma unroll
            for (int b = 0; b < 2; ++b)
#pragma unroll
                for (int m = 0; m < 4; ++m)
#pragma unroll
                    for (int n = 0; n < 2; ++n) acc[a][b][m][n] = (f32x4){0.f, 0.f, 0.f, 0.f};
        cur = nxt; cA = nA; cB = nB; ++ui;
        if constexpr (ALIGN_EPI) { if (wr == 1) PG8_BAR; }
    }
    PG8_WAIT_V(0);
    if constexpr (!ALIGN_EPI) { if (wr == 0) PG8_BAR; }
    PG8_BAR;
    if constexpr (Epi::AFTER_DRAIN) { E.fused(acc, cur, wr, wc, fr, fq, lds, wid, lane); S.done(cur); }
#undef PG8_SA
#undef PG8_SB
#undef PG8_STAGE
#undef PG8_LDA
#undef PG8_LDB
#undef PG8_MMA
#undef PG8_WAIT_V
#undef PG8_WAIT_L
#undef PG8_BAR
#undef PG8_SCHED
}
}

__device__ __forceinline__ void p1_sw_item(const bf16* WT, int N, const float* shift  , float* out, int item, int lane, float scale) {
    const int fr = lane & 15, fq = lane >> 4, n0 = (item >> 2) * 64, kq = (item & 3) * 256;
    f32x4 acc[4];
#pragma unroll
    for (int j = 0; j < 4; ++j) acc[j] = (f32x4){0.f, 0.f, 0.f, 0.f};
    const float* sp = shift + (size_t)(fr < 5 ? fr : 0) * 6144 + kq + fq * 8;
    const bf16* bp = WT + (size_t)(n0 + 8 * (fr >> 2) + (fr & 3)) * D + kq + fq * 8;
#pragma unroll
    for (int k0 = 0; k0 < 256; k0 += 128) {
        bf16x8 a[4], b[4][4];
#pragma unroll
        for (int ks = 0; ks < 4; ++ks) { const f32x4 s0 = *(const f32x4*)(sp + k0 + 32 * ks), s1 = *(const f32x4*)(sp + k0 + 32 * ks + 4);
            a[ks] = __builtin_bit_cast(bf16x8, pack8(s0, s1));
#pragma unroll
            for (int nj = 0; nj < 4; ++nj) b[ks][nj] = *(const bf16x8*)(bp + (size_t)(32 * (nj >> 1) + 4 * (nj & 1)) * D + k0 + 32 * ks); }
#pragma unroll
        for (int ks = 0; ks < 4; ++ks)
#pragma unroll
            for (int nj = 0; nj < 4; ++nj) acc[nj] = __builtin_amdgcn_mfma_f32_16x16x32_bf16(b[ks][nj], a[ks], acc[nj], 0, 0, 0);
    }
    if (fr < 5) {
#pragma unroll
        for (int nj = 0; nj < 4; ++nj)
#pragma unroll
            for (int e = 0; e < 4; ++e) atomicAdd(out + (size_t)fr * N + n0 + 32 * (nj >> 1) + 8 * fq + 4 * (nj & 1) + e, acc[nj][e] * scale); }
}
constexpr int SWI_QKV = NQKV / 16, SWI_ALL = NQKV / 16 + FF2 / 16 + GE2 / 16 + FF2 / 16;
__device__ __forceinline__ void p1_sw_items(const Frame& F, const Args& args, int lo, int hi, int fw, int nfw) {
    unsigned char* ws = wsb(args); const float* MOD0 = (const float*)(ws + WS_MOD); const float* MOD1 = MOD0 + 5 * 6144; float* SW = (float*)(ws + WS_SW);
    constexpr int I0 = NQKV / 16, I1 = FF2 / 16, I2 = GE2 / 16;
    for (int it = lo + fw; it < hi; it += nfw) { int r = it;
        if (r < I0) { p1_sw_item((const bf16*)(ws + WS_WQKV), NQKV, MOD0 + 0, SW + SW_QKV, r, F.lane, F.scale); continue; } r -= I0;
        if (r < I1) { p1_sw_item((const bf16*)(ws + WS_WUP), FF2, MOD0 + 3072, SW + SW_UP0, r, F.lane, F.scale); continue; } r -= I1;
        if (r < I2) { p1_sw_item((const bf16*)(ws + WS_WIN), GE2, MOD1 + 0, SW + SW_IN, r, F.lane, F.scale); continue; } r -= I2;
        p1_sw_item((const bf16*)(ws + WS_WUP) + (size_t)FF2 * D, FF2, MOD1 + 3072, SW + SW_UP1, r, F.lane, F.scale); }
}

constexpr int SWU_IN = (GE2 / 256) * 4, SWU_ALL = SWU_IN + (FF2 / 256) * 4;
__device__ __forceinline__ void sw_unit_f32(const Frame& F, const float* W, int N, const float* shift  , float* out, bool upperm, int u) {
    const int nblk = N / 256, nb = u % nblk, kq = u / nblk;
    const int k0 = kq * 256 + F.wave * 32;
    const float* Wp = W + (size_t)k0 * N + nb * 256 + F.lane * 4;
    float sh[5];
#pragma unroll
    for (int q = 0; q < 5; ++q) sh[q] = *(GAS const float*)(shift + (size_t)q * 6144 + k0 + (F.lane & 31));
    f32x4 acc[5];
#pragma unroll
    for (int q = 0; q < 5; ++q) acc[q] = (f32x4){0.f, 0.f, 0.f, 0.f};
#pragma unroll
    for (int i0 = 0; i0 < 32; i0 += 16) {
        f32x4 w[16];
#pragma unroll
        for (int i = 0; i < 16; ++i) w[i] = G_LD4(Wp + (size_t)(i0 + i) * N);
#pragma unroll
        for (int i = 0; i < 16; ++i)
#pragma unroll
            for (int q = 0; q < 5; ++q) acc[q] += __builtin_bit_cast(float, __builtin_amdgcn_readlane(__builtin_bit_cast(int, sh[q]), i0 + i)) * w[i];
    }
    LAS f32x4* red = (LAS f32x4*)(F.lds + RING_OFF);
    __syncthreads();
#pragma unroll
    for (int q = 0; q < 5; ++q) red[(F.wave * 5 + q) * 64 + F.lane] = acc[q];
    __syncthreads();
    const LAS float* redf = (const LAS float*)red;
    for (int o = F.tid; o < 5 * 256; o += NWAVES * 64) { const int q = o >> 8, n = nb * 256 + (o & 255);
        float s = 0.f;
#pragma unroll
        for (int w = 0; w < NWAVES; ++w) s += redf[(w * 5 + q) * 256 + (o & 255)];
        atomicAdd(out + (size_t)q * N + (upperm ? upmap(n) : n), s * F.scale); }
    __syncthreads();
}
__device__ __forceinline__ void sw_units_f32(const Frame& F, const Args& args, int fb, int nfb) {
    const float* MOD1 = (const float*)(wsb(args) + WS_MOD) + 5 * 6144; float* SW = (float*)(wsb(args) + WS_SW);
    for (int u = fb; u < SWU_ALL; u += nfb) {
        if (u < SWU_IN) sw_unit_f32(F, inp(args, I_WIN), GE2, MOD1 + 0, SW + SW_IN, false, u);
        else sw_unit_f32(F, inp(args, I_WUP) + (size_t)D * FF2, FF2, MOD1 + 3072, SW + SW_UP1, true, u - SWU_IN); }
}

constexpr int EPI_OFF = 132096;
template <int NRED, class Epi, int MB = 4>
__device__ __forceinline__ void gemm_pg8(const Frame& F, const bf16* A, const bf16* Bt, int row0, int Mrows, int N, int K, const Epi& E) {
    pg8::Gemm g{A + (size_t)row0 * K, Bt, Mrows, N, K}; pg8::StaticOrder S; S.init(Mrows, N, F.G, F.bid, 64 * MB);
    pg8::EpiAdapt<Epi, NRED, MB> EA{E, row0, (LAS float*)(F.lds + EPI_OFF), F.skip_epi};
    pg8::gemm_phase<pg8::EpiAdapt<Epi, NRED, MB>, pg8::StaticOrder, true, true, MB>(F.lds + RING_OFF, g, S, EA, F.tid);
}


struct RowLin {
    const float* RS; const float* SW; int N;
};
struct EpiQKV { static constexpr bool HAS_PRE = false, HAS_LIN = true;
    RowLin L; unsigned char* ws;
    __device__ __forceinline__ void post(int row, int col, f32x4 v0, f32x4 v1, float*) const {
        const int which = col >> 10, cc = col & 1023;
        if (which == 0) { v0 = v0 * C2; v1 = v1 * C2; }
        const size_t off = which == 0 ? WS_Q : (row < NCTX ? (which == 1 ? WS_KC : WS_VC) : (which == 1 ? WS_K : WS_V));
        G_STU4((bf16*)(ws + off) + (size_t)row * D + cc, pack8(v0, v1));
    }
};
template <int MODE> struct EpiResT {
    const float *base_c, *base_l; bf16* XB; float* Xout; const float* gate; bf16* AN; const float* gn; const float* scn; float* RSout; float gs;
    static constexpr bool HAS_PRE = true, HAS_LIN = false, PRE_HALVES = false;
    struct PreB { u32x4 w; }; struct PreF { f32x4 b0, b1; };
    typedef typename std::conditional<MODE != 0, PreB, PreF>::type Pre;
    __device__ __forceinline__ Pre prefetch(int row, int col) const { Pre p;
        if constexpr (MODE != 0) p.w = G_LDU4(XB + (size_t)row * D + col);
        else { const float* bp = (row < NCTX ? base_c + (size_t)row * D : base_l + (size_t)(row - NCTX) * D) + col; p.b0 = G_LD4(bp); p.b1 = G_LD4(bp + 4); }
        return p; }
    __device__ __forceinline__ float stage_val(int kind, int ci, int col) const {
        return kind == 0 ? *(GAS const float*)(gate + (size_t)ci * 6144 + col) : *(GAS const float*)(gn + col) * (1.f + *(GAS const float*)(scn + (size_t)ci * 6144 + col)); }
    __device__ __forceinline__ void apply_pre(int row, int col, f32x4 v0, f32x4 v1, float* red, const Pre& p, const LAS float* st) const {
        f32x4 b0, b1;
        if constexpr (MODE != 0) { const u32x4 w = p.w; b0 = (f32x4){bflo(w.x), bfhi(w.x), bflo(w.y), bfhi(w.y)}; b1 = (f32x4){bflo(w.z), bfhi(w.z), bflo(w.w), bfhi(w.w)}; }
        else { b0 = p.b0; b1 = p.b1; }
        const f32x4 x0 = b0 + *(const LAS f32x4*)st * (v0 * gs), x1 = b1 + *(const LAS f32x4*)(st + 4) * (v1 * gs);
        if (MODE != 2) G_STU4(XB + (size_t)row * D + col, pack8(x0, x1));
        else { float* xo = Xout + (size_t)row * D + col; G_ST4(xo, x0); G_ST4(xo + 4, x1); }
        if (MODE != 2) { red[0] += ((x0.x * x0.x + x0.y * x0.y) + (x0.z * x0.z + x0.w * x0.w)) + ((x1.x * x1.x + x1.y * x1.y) + (x1.z * x1.z + x1.w * x1.w));
            const f32x4 a0 = x0 * *(const LAS f32x4*)(st + 512), a1 = x1 * *(const LAS f32x4*)(st + 516);
            G_STU4(AN + (size_t)row * D + col, pack8(a0, a1)); }
    }
    __device__ __forceinline__ bool want_red(int) const { return MODE != 2; }
    __device__ __forceinline__ void store_red(int row, int pn, const float* r) const { RSout[(size_t)row * 4 + pn] = r[0]; }
};
struct EpiFinal {
    const bf16* XB; float* Y; const float* gate; const float* gfin; float* RS4; unsigned* cnt; unsigned* tmo; float gs;
    static constexpr bool HAS_PRE = true, HAS_LIN = false, PRE_HALVES = false;
    struct Pre { u32x4 w; };
    __device__ __forceinline__ Pre prefetch(int row, int col) const { Pre p; p.w = G_LDU4(XB + (size_t)row * D + col); return p; }
    __device__ __forceinline__ float stage_val(int kind, int ci, int col) const { return kind == 0 ? *(GAS const float*)(gate + (size_t)ci * 6144 + col) : 0.f; }
    __device__ __forceinline__ void apply_pre(int row, int col, f32x4 v0, f32x4 v1, float* red, const Pre& p, const LAS float* st) const {
        const u32x4 w = p.w;
        v0 = (f32x4){bflo(w.x), bfhi(w.x), bflo(w.y), bfhi(w.y)} + *(const LAS f32x4*)st * (v0 * gs); v1 = (f32x4){bflo(w.z), bfhi(w.z), bflo(w.w), bfhi(w.w)} + *(const LAS f32x4*)(st + 4) * (v1 * gs);
        float* o = Y + (size_t)row * D + col; G_ST4(o, v0); G_ST4(o + 4, v1);
        red[0] += ((v0.x * v0.x + v0.y * v0.y) + (v0.z * v0.z + v0.w * v0.w)) + ((v1.x * v1.x + v1.y * v1.y) + (v1.z * v1.z + v1.w * v1.w));
    }
    __device__ __forceinline__ bool want_red(int) const { return true; }
    __device__ __forceinline__ void store_red(int row, int pn, const float* r) const { st4f_wt(RS4 + (size_t)row * 4 + pn, r[0]); }
    __device__ __forceinline__ float row_scale(int row) const { const f32x4 p = G_LD4(RS4 + (size_t)row * 4); return __builtin_amdgcn_rsqf(((p.x + p.y) + (p.z + p.w)) * (1.f / D) + EPS); }
};
namespace pg8 { template <> struct epi_is_final<EpiFinal> { static constexpr bool value = true; }; }
struct EpiIn { static constexpr bool HAS_PRE = false, HAS_LIN = true;
    RowLin L; bf16 *U, *VV; float* LNP;
    __device__ __forceinline__ void post(int row, int col, f32x4 v0, f32x4 v1, float* red) const {
#pragma unroll
        for (int e = 0; e < 4; ++e) { v0[e] = gelu_tanh_f(v0[e]); v1[e] = gelu_tanh_f(v1[e]); }
        if (col >= GE) { red[0] += ((v0.x + v0.y) + (v0.z + v0.w)) + ((v1.x + v1.y) + (v1.z + v1.w));
            red[1] += ((v0.x * v0.x + v0.y * v0.y) + (v0.z * v0.z + v0.w * v0.w)) + ((v1.x * v1.x + v1.y * v1.y) + (v1.z * v1.z + v1.w * v1.w)); }
        bf16* dst = col < GE ? U + (size_t)row * GE + col : VV + (size_t)row * GE + (col - GE);
        G_STU4(dst, pack8(v0, v1));
    }
    __device__ __forceinline__ bool want_red(int pn) const { return pn >= 8; }
    __device__ __forceinline__ void store_red(int row, int pn, const float* r) const { *(f32x2*)(LNP + (size_t)row * 16 + (pn - 8) * 2) = (f32x2){r[0], r[1]}; }
};


__device__ __forceinline__ float dpp_ror1(float x) { return __builtin_bit_cast(float, __builtin_amdgcn_update_dpp(0, __builtin_bit_cast(int, x), 0x121, 0xf, 0xf, false)); }
__device__ __forceinline__ float dpp_rol1(float x) { return __builtin_bit_cast(float, __builtin_amdgcn_update_dpp(0, __builtin_bit_cast(int, x), 0x12f, 0xf, 0xf, false)); }
__device__ __forceinline__ float bsel(unsigned m, float a, float b) { return __builtin_bit_cast(float, (__builtin_bit_cast(unsigned, a) & m) | (__builtin_bit_cast(unsigned, b) & ~m)); }
__device__ __forceinline__ float dpp_shr1(float old, float x) { return __builtin_bit_cast(float, __builtin_amdgcn_update_dpp(__builtin_bit_cast(int, old), __builtin_bit_cast(int, x), 0x111, 0xf, 0xf, false)); }
__device__ __forceinline__ float dpp_shl1(float old, float x) { return __builtin_bit_cast(float, __builtin_amdgcn_update_dpp(__builtin_bit_cast(int, old), __builtin_bit_cast(int, x), 0x101, 0xf, 0xf, false)); }
struct EpiUpConv {
    static constexpr bool PERM = true, AFTER_DRAIN = false;
    const float* RS; const float* SW; const float* wconv; const float* bconv; float* HALO; bf16* M; LAS float* EX; bool skip;
    __device__ __forceinline__ void operator()(f32x4 (&acc)[2][2][4][2], const pg8::Unit& u, int wr, int wc, int fr, int fq) const {
        if (skip) return;
        const int pm = u.pm, pn = u.pn, ci = pm < 32 ? 0 : 1 + ((pm - 32) >> 2);
        const int c32 = wc * 32 + 8 * fq;
        {   const float* sw = SW + (size_t)ci * FF2 + pn * 256 + c32;
            f32x4 s[2][2];
#pragma unroll
            for (int bj = 0; bj < 2; ++bj)
#pragma unroll
                for (int n = 0; n < 2; ++n) s[bj][n] = G_LD4(sw + bj * 128 + 4 * n);
            f32x4 pq[2][4];
#pragma unroll
            for (int ai = 0; ai < 2; ++ai)
#pragma unroll
                for (int m = 0; m < 4; ++m) pq[ai][m] = G_LD4(RS + (size_t)(pm * 256 + ai * 128 + wr * 64 + m * 16 + fr) * 4);
            __builtin_amdgcn_sched_barrier(0);
#pragma unroll
            for (int ai = 0; ai < 2; ++ai)
#pragma unroll
                for (int m = 0; m < 4; ++m) { const f32x4 p = pq[ai][m];
                    const float r = __builtin_amdgcn_rsqf(((p.x + p.y) + (p.z + p.w)) * (1.f / D) + EPS);
#pragma unroll
                    for (int bj = 0; bj < 2; ++bj)
#pragma unroll
                        for (int n = 0; n < 2; ++n) acc[ai][bj][m][n] = acc[ai][bj][m][n] * r + s[bj][n]; } }
#pragma unroll
        for (int ai = 0; ai < 2; ++ai) { const int sidx = 2 * ai + wr;
#pragma unroll
            for (int bj = 0; bj < 2; ++bj)
#pragma unroll
                for (int n = 0; n < 2; ++n) {
                    if (fr == 0) *(LAS f32x4*)(EX + ((sidx * 2 + 0) * 2 + bj) * 128 + c32 + 4 * n) = acc[ai][bj][0][n];
                    if (fr == 15) *(LAS f32x4*)(EX + ((sidx * 2 + 1) * 2 + bj) * 128 + c32 + 4 * n) = acc[ai][bj][3][n]; } }
        {   const int t = (wr * 4 + wc) * 64 + fq * 16 + fr; EX[8 * 256 + t] = 0.f; }
        if (pm >= 32) { float* hb = HALO + (size_t)(pm - 32) * 4 * FF2 + pn * 256 + c32;
#pragma unroll
            for (int bj = 0; bj < 2; ++bj)
#pragma unroll
                for (int n = 0; n < 2; ++n) {
                    if (wr == 0 && fr < 2) *(f32x4*)(hb + (size_t)fr * FF2 + bj * 128 + 4 * n) = acc[0][bj][0][n];
                    if (wr == 1 && fr >= 14) *(f32x4*)(hb + (size_t)(fr - 12) * FF2 + bj * 128 + 4 * n) = acc[1][bj][3][n]; } }
        const int j0 = pn * 128 + c32;
        f32x4 wq[4];
        { const float* wp = wconv + j0; wq[0] = G_LD4(wp); wq[1] = G_LD4(wp + FF2); wq[2] = G_LD4(wp + 2 * FF2); wq[3] = G_LD4(bconv + j0); }
        asm volatile("s_waitcnt lgkmcnt(0)" ::: "memory"); __builtin_amdgcn_s_barrier(); asm volatile("" ::: "memory");
#pragma unroll
        for (int bj = 0; bj < 2; ++bj)
#pragma unroll
            for (int n = 0; n < 2; ++n) {
                const f32x4 w0 = wq[0], w1 = wq[1], w2 = wq[2], bb = wq[3];
                if (bj * 2 + n < 3) { const int bj1 = (bj * 2 + n + 1) >> 1, n1 = (bj * 2 + n + 1) & 1; const float* wp = wconv + bj1 * FF + j0 + 4 * n1;
                    wq[0] = G_LD4(wp); wq[1] = G_LD4(wp + FF2); wq[2] = G_LD4(wp + 2 * FF2); wq[3] = G_LD4(bconv + bj1 * FF + j0 + 4 * n1); }
#pragma unroll
                for (int ai = 0; ai < 2; ++ai) { const int sidx = 2 * ai + wr;
                    const int xrow = fr == 15 ? (sidx < 3 ? (sidx + 1) * 2 : 9) : (sidx > 0 ? (sidx - 1) * 2 + 1 : 8);
                    const f32x4 X = *(const LAS f32x4*)(EX + (xrow * 2 + bj) * 128 + c32 + 4 * n);
                    f32x4 cur[4];
#pragma unroll
                    for (int m = 0; m < 4; ++m) cur[m] = acc[ai][bj][m][n];
#pragma unroll
                    for (int m = 0; m < 4; ++m) { f32x4 pv_, nx_;
#pragma unroll
                        for (int e = 0; e < 4; ++e) {
                            const float pa_ = m > 0 ? dpp_ror1(cur[m - 1][e]) : X[e], na_ = m < 3 ? dpp_rol1(cur[m + 1][e]) : X[e];
                            pv_[e] = dpp_shr1(pa_, cur[m][e]); nx_[e] = dpp_shl1(na_, cur[m][e]); }
                        acc[ai][bj][m][n] = (w0 * pv_ + w1 * cur[m]) + (w2 * nx_ + bb); }
                    __builtin_amdgcn_sched_barrier(0); } }
#pragma unroll
        for (int ai = 0; ai < 2; ++ai)
#pragma unroll
            for (int m = 0; m < 4; ++m) { const int row = pm * 256 + ai * 128 + wr * 64 + m * 16 + fr;
                f32x4 o0, o1;
#pragma unroll
                for (int e = 0; e < 4; ++e) { o0[e] = silu_f(acc[ai][0][m][0][e]) * acc[ai][1][m][0][e]; o1[e] = silu_f(acc[ai][0][m][1][e]) * acc[ai][1][m][1][e]; }
                G_STU4(M + (size_t)row * FF + j0, pack8(o0, o1)); }
    }
};
__device__ __forceinline__ void fix_halo_rows(const Frame& F, int row_lo, int row_hi, const float* HALO, const float* wconv, const float* bconv, bf16* M) {
    for (int T = row_lo >> 8; T <= (row_hi - 1) >> 8; ++T) {
        if (T < 32) continue;
        const int q = (T - 32) & 3;
#pragma unroll
        for (int which = 0; which < 2; ++which) {
            const int row = T * 256 + (which ? 255 : 0);
            if (!((which == 0 ? (q != 0) : (q != 3)) && row >= row_lo && row < row_hi)) continue;
            const float* own = HALO + (size_t)(T - 32) * 4 * FF2;
            const float* pr = which == 0 ? HALO + ((size_t)(T - 33) * 4 + 3) * FF2 : own + 2 * FF2;
            const float* cu = which == 0 ? own : own + 3 * FF2;
            const float* nx = which == 0 ? own + FF2 : HALO + (size_t)(T - 31) * 4 * FF2;
#pragma unroll
            for (int it = 0; it < 2; ++it) {
                const int j = 4 * (F.tid + it * NWAVES * 64);
                if (j < FF) {
                    const int gc = ((j >> 7) << 8) + (j & 127), vc = gc + 128;
                    const f32x4 g = (G_LD4(wconv + j) * G_LD4(pr + gc) + G_LD4(wconv + FF2 + j) * G_LD4(cu + gc)) + (G_LD4(wconv + 2 * FF2 + j) * G_LD4(nx + gc) + G_LD4(bconv + j));
                    const f32x4 v = (G_LD4(wconv + FF + j) * G_LD4(pr + vc) + G_LD4(wconv + FF2 + FF + j) * G_LD4(cu + vc)) + (G_LD4(wconv + 2 * FF2 + FF + j) * G_LD4(nx + vc) + G_LD4(bconv + FF + j));
                    u32x2 o; o.x = cvt_pk_bf16(silu_f(g.x) * v.x, silu_f(g.y) * v.y); o.y = cvt_pk_bf16(silu_f(g.z) * v.z, silu_f(g.w) * v.w);
                    *(GAS u32x2*)(M + (size_t)row * FF + j) = o; } }
        }
    }
    asm volatile("s_waitcnt vmcnt(0)" ::: "memory"); __syncthreads();
}
template <class Epi>
__device__ __forceinline__ void gemm_pg8_raw(const Frame& F, const bf16* A, const bf16* Bt, int Mrows, int N, int K, const Epi& E) {
    pg8::Gemm g{A, Bt, Mrows, N, K}; pg8::StaticOrder S; S.init(Mrows, N, F.G, F.bid);
    pg8::gemm_phase<Epi, pg8::StaticOrder, true, true>(F.lds + RING_OFF, g, S, E, F.tid);
}

#include <hip/hip_bf16.h>
namespace attn_body {
using bf16=__hip_bfloat16;
using bf16x8=__attribute__((ext_vector_type(8)))short;
using s16x4=__attribute__((ext_vector_type(4)))short;
using f32x16=__attribute__((ext_vector_type(16)))float;
using u32x4=__attribute__((ext_vector_type(4)))unsigned;
constexpr int NHEAD=16,D=64,DM=NHEAD*D;
constexpr int NW=8,QBLK=32,QB=QBLK*NW,KVBLK=64;
__device__ __forceinline__ int crow(int r,int hi){return (r&3)+8*(r>>2)+4*hi;}
#define SBAR() __builtin_amdgcn_sched_barrier(0)
constexpr int NSLOT=3, SLOTB=8192;
constexpr int LDS_K=0, LDS_V=NSLOT*SLOTB, LDS_WS=2*NSLOT*SLOTB, LDS_OST=LDS_WS+NW*64*4, LDS_TAB=LDS_OST+NW*4096, LDS_BYTES=LDS_TAB+(3+15)*128*4;
constexpr float C2=0.125f*1.4426950408889634f;
__device__ __forceinline__ void glds16(const void*gsrc,unsigned lds_dst){unsigned keep;
  asm volatile("s_mov_b32 %0, m0\n\ts_mov_b32 m0, %2\n\ts_nop 0\n\tglobal_load_lds_dwordx4 %1, off\n\ts_mov_b32 m0, %0":"=&s"(keep):"v"(gsrc),"s"(lds_dst):"memory");}
__device__ __forceinline__ float max3f(float a,float b,float c){float r;asm("v_max3_f32 %0, %1, %2, %3":"=v"(r):"v"(a),"v"(b),"v"(c));return r;}
__device__ __forceinline__ float max2f(float a,float b){float r;asm("v_max_f32_e32 %0, %1, %2":"=v"(r):"v"(a),"v"(b));return r;}
__device__ __forceinline__ float fadd_s(float a,float b){float r;asm("v_add_f32_e32 %0, %1, %2":"=v"(r):"v"(a),"v"(b));return r;}
__device__ __forceinline__ float fsub_s(float a,float b){float r;asm("v_sub_f32_e32 %0, %1, %2":"=v"(r):"v"(a),"v"(b));return r;}
typedef float f32x2_t __attribute__((ext_vector_type(2))); typedef __bf16 bf16x2_t __attribute__((ext_vector_type(2)));
__device__ __forceinline__ unsigned cvtpk_s(float lo,float hi){f32x2_t v={lo,hi};bf16x2_t b=__builtin_convertvector(v,bf16x2_t);return __builtin_bit_cast(unsigned,b);}
#define WAIT_BAR(N) asm volatile("s_waitcnt vmcnt(" #N ") lgkmcnt(0)\n\ts_barrier":::"memory")

__device__ __forceinline__ void qkt(f32x16&p0,f32x16&p1,const char*Kslot,const bf16x8*qr,const f32x16&negm,int r32,int hi){
  const char*kb=Kslot+hi*1024+r32*16;
  #pragma unroll
  for(int d0=0;d0<4;++d0){
    const bf16x8 b0=*reinterpret_cast<const bf16x8*>(kb+d0*2048);
    const bf16x8 b1=*reinterpret_cast<const bf16x8*>(kb+d0*2048+512);
    if(d0==0){p0=__builtin_amdgcn_mfma_f32_32x32x16_bf16(b0,qr[0],negm,0,0,0);p1=__builtin_amdgcn_mfma_f32_32x32x16_bf16(b1,qr[0],negm,0,0,0);}
    else{p0=__builtin_amdgcn_mfma_f32_32x32x16_bf16(b0,qr[d0],p0,0,0,0);p1=__builtin_amdgcn_mfma_f32_32x32x16_bf16(b1,qr[d0],p1,0,0,0);}}
}
typedef __attribute__((address_space(3))) const char* lds_cptr;
typedef short v4i16_t __attribute__((ext_vector_type(4)));
__device__ __forceinline__ void kload8(bf16x8*kf,lds_cptr kp){
  kf[0]=*(const __attribute__((address_space(3))) bf16x8*)(kp);      kf[1]=*(const __attribute__((address_space(3))) bf16x8*)(kp+512);
  kf[2]=*(const __attribute__((address_space(3))) bf16x8*)(kp+2048); kf[3]=*(const __attribute__((address_space(3))) bf16x8*)(kp+2560);
  kf[4]=*(const __attribute__((address_space(3))) bf16x8*)(kp+4096); kf[5]=*(const __attribute__((address_space(3))) bf16x8*)(kp+4608);
  kf[6]=*(const __attribute__((address_space(3))) bf16x8*)(kp+6144); kf[7]=*(const __attribute__((address_space(3))) bf16x8*)(kp+6656);
}
__device__ __forceinline__ void kload2(bf16x8*kf,lds_cptr kp,int j){ kf[2*j]=*(const __attribute__((address_space(3))) bf16x8*)(kp+j*2048); kf[2*j+1]=*(const __attribute__((address_space(3))) bf16x8*)(kp+j*2048+512); }
__device__ __forceinline__ s16x4 vtr(lds_cptr p){ return __builtin_bit_cast(s16x4,__builtin_amdgcn_ds_read_tr16_b64_v4i16((__attribute__((address_space(3))) v4i16_t*)p)); }
__device__ __forceinline__ float rowmax(const f32x16&p0,const f32x16&p1){
  float a=max3f(p0[0],p0[1],p1[0]),b=max3f(p0[2],p0[3],p1[1]);a=max3f(a,p1[2],p1[3]);
  #pragma unroll
  for(int r=4;r<16;r+=4){a=max3f(a,p0[r],p0[r+1]);b=max3f(b,p0[r+2],p0[r+3]);a=max3f(a,p1[r],p1[r+1]);b=max3f(b,p1[r+2],p1[r+3]);}
  const float m=max2f(a,b);
  auto rr=__builtin_amdgcn_permlane32_swap(__float_as_uint(m),__float_as_uint(m),false,false);
  return max2f(__uint_as_float(rr[0]),__uint_as_float(rr[1]));
}
__device__ __forceinline__ void pv(f32x16*o,int vb,bf16x8 pa0,bf16x8 pa1,bf16x8 pa2,bf16x8 pa3){
  #pragma unroll
  for(int d0=0;d0<2;++d0){s16x4 lo[4],hi[4];
    #pragma unroll
    for(int ks=0;ks<4;++ks){
      asm volatile("ds_read_b64_tr_b16 %0,%1 offset:%c2":"=&v"(lo[ks]):"v"(vb),"i"(d0*4096+ks*1024):"memory");
      asm volatile("ds_read_b64_tr_b16 %0,%1 offset:%c2":"=&v"(hi[ks]):"v"(vb),"i"(d0*4096+ks*1024+512):"memory");}
    asm volatile("s_waitcnt lgkmcnt(0)":::"memory");SBAR();
    #define PK(k) (bf16x8){lo[k][0],lo[k][1],lo[k][2],lo[k][3],hi[k][0],hi[k][1],hi[k][2],hi[k][3]}
    o[d0]=__builtin_amdgcn_mfma_f32_32x32x16_bf16(pa0,PK(0),o[d0],0,0,0);
    o[d0]=__builtin_amdgcn_mfma_f32_32x32x16_bf16(pa1,PK(1),o[d0],0,0,0);
    o[d0]=__builtin_amdgcn_mfma_f32_32x32x16_bf16(pa2,PK(2),o[d0],0,0,0);
    o[d0]=__builtin_amdgcn_mfma_f32_32x32x16_bf16(pa3,PK(3),o[d0],0,0,0);
    #undef PK
  }
}

#ifndef ATTN_STORE16
#define ATTN_STORE16(p,v) (*(__attribute__((address_space(1))) u32x4*)(p)=(v))
#endif
template<int THRL,bool LAT> __device__ __forceinline__ void attn_unit(const int tid,bf16*Qw0,const bf16*K0,const long dV0,const int n0,const bf16*K1,const long dV1,const int NT,char*shm,const int rq0,const int wlo,const float*rpb_h){
  bf16*const Ow0=Qw0;
  const int lane=tid&63,r32=lane&31,hi=lane>>5; const int wid=__builtin_amdgcn_readfirstlane(tid>>6);
  const bf16*Qw=Qw0+(long)(wid*QBLK)*DM;
  const unsigned lds0=(unsigned)(uintptr_t)shm;
  float*wsf=(float*)(shm+LDS_WS)+wid*64;
  typedef __attribute__((address_space(3))) const float* lds_fptr;
  float*tab=(float*)(shm+LDS_TAB);
  if(LAT){ for(int i=tid;i<15*128;i+=NW*64){const int rr=i>>7,cc=i&127; tab[384+i]=(cc>=48&&cc<79)?rpb_h[rr*31+cc-48]*1.4426950408889634f:0.f;}
    if(tid<384)tab[tid]=(tid<128||(tid>=256+48&&tid<256+64))?0.f:-INFINITY; }
  const int rq=rq0+(wid>>1), rs=min(max(rq-4,0),8);
  lds_fptr tb_=(lds_fptr)tab, tv_=(lds_fptr)tab;
  #define CSEL(t) do{ if(LAT){ const int cq_=32*(wid&1)+r32; const bool w_=(t)>=n0; const int ia_=wlo+((t)-n0); const bool ok_=w_&&(ia_>=rs)&&(ia_<rs+8); \
      tb_=(lds_fptr)tab+(63-cq_+4*hi)+(ok_?384+(ia_-rq+7)*128:0); tv_=(lds_fptr)tab+(48-min(max(cq_-8,0),48)+4*hi)+(w_?(ok_?256:128):0); } }while(0)
  #define CINIT(C,KO) do{ if(LAT){ _Pragma("unroll") for(int r=0;r<16;++r){const int k0_=(r&3)+8*(r>>2)+(KO); C[r]=(tb_[k0_]+tv_[k0_])-mhat;} } }while(0)
  #define CSRC(C) (LAT?C:negm)
  const int koff=lane*DM+wid*8;
  const int voff=(16*(wid&3)+(lane>>2))*DM+(wid>>2)*32+(lane&3)*8;
  const unsigned kdst=lds0+LDS_K+wid*1024, vdst=lds0+LDS_V+wid*1024;
  #define KSRC(t) (((t)<n0?K0+(long)(t)*KVBLK*DM:K1+(long)((t)-n0)*KVBLK*DM)+koff)
  #define VSRC(t) (((t)<n0?K0+dV0+(long)(t)*KVBLK*DM:K1+dV1+(long)((t)-n0)*KVBLK*DM)+voff)
  #define DMA_K(t,slot) glds16(KSRC(t),(unsigned)__builtin_amdgcn_readfirstlane(kdst+(slot)))
  #define DMA_V(t,slot) glds16(VSRC(t),(unsigned)__builtin_amdgcn_readfirstlane(vdst+(slot)))
  const int vb0=(int)(lds0+LDS_V)+((lane>>4)&1)*32+(lane&3)*8+(4*hi+((lane&15)>>2))*64;
  const char*Kbase=shm+LDS_K; bf16x8 kf[8];
  const lds_cptr shm3=(lds_cptr)shm; const lds_cptr kp0=shm3+LDS_K+hi*1024+r32*16; const lds_cptr vp0=shm3+LDS_V+((lane>>4)&1)*32+(lane&3)*8+(4*hi+((lane&15)>>2))*64;

  DMA_K(0,0);DMA_V(0,0);DMA_K(1,SLOTB);
  bf16x8 qr[4];
  #pragma unroll
  for(int d0=0;d0<4;++d0)qr[d0]=*(const __attribute__((address_space(1))) bf16x8*)(&Qw[(long)r32*DM+d0*16+hi*8]);
  float mhat=0.f,l_reg=0.f;f32x16 o[2];o[0]=f32x16{};o[1]=f32x16{};float z_=0.f;asm volatile("":"+v"(z_));f32x16 negm;
  _Pragma("unroll") for(int r=0;r<16;++r)negm[r]=z_;
  if(!LAT)asm volatile("":"+v"(negm));
  #define CMASK(P0,P1,t) do{}while(0)
  bool resc=false;
  #define START(P0,P1) do{ const float rm=rowmax(P0,P1); resc=false; \
    { const float dl=rm; mhat=fadd_s(mhat,dl); \
      _Pragma("unroll") for(int r=0;r<16;++r){P0[r]=fsub_s(P0[r],dl);P1[r]=fsub_s(P1[r],dl);} \
      if(!LAT){ _Pragma("unroll") for(int r=0;r<16;++r)negm[r]=-mhat; asm volatile("":"+v"(negm)); } } \
    _Pragma("unroll") for(int r=0;r<16;++r)P0[r]=__builtin_amdgcn_exp2f(P0[r]); }while(0)
  #define RESC() do{ if(resc){ asm volatile("s_waitcnt lgkmcnt(0)":::"memory"); \
      _Pragma("unroll") for(int d_=0;d_<2;++d_) _Pragma("unroll") for(int r=0;r<16;++r)o[d_][r]*=wsf[crow(r,hi)]; } }while(0)
  f32x16 pA0,pA1,pB0,pB1;
  int sl_prev=0,sl_cur=0,sl_next=SLOTB;
  #define ROT() do{sl_prev=sl_cur;sl_cur=sl_next;sl_next=(sl_next==(NSLOT-1)*SLOTB)?0:sl_next+SLOTB;}while(0)
  DMA_K(2,2*SLOTB);
  WAIT_BAR(3);
  qkt(pA0,pA1,Kbase,qr,negm,r32,hi);asm volatile("s_nop 15\n\ts_nop 7":"+v"(pA0),"+v"(pA1));CMASK(pA0,pA1,0);
  START(pA0,pA1);
  _Pragma("unroll") for(int r=0;r<16;++r)pA1[r]=__builtin_amdgcn_exp2f(pA1[r]);
  WAIT_BAR(0);
  DMA_K(3,0);DMA_V(1,SLOTB);
  ROT();
  kload8(kf,kp0+sl_cur);
  WAIT_BAR(2);
  s16x4 vlo[8],vhi[8]; u32x4 pw0,pw1,pw2,pw3;
  #define PKW(P,B) cvtpk_s(P[B],P[B+1])
  #define PAF(k) __builtin_bit_cast(bf16x8,pw##k)
  #define VFR(i) (bf16x8){vlo[i][0],vlo[i][1],vlo[i][2],vlo[i][3],vhi[i][0],vhi[i][1],vhi[i][2],vhi[i][3]}
  #define PIN(x) asm volatile("":"+v"(x))
  #define MX3(a,b,c) __builtin_fmaxf(__builtin_fmaxf((a),(b)),(c))
  #define GAPA(MF,A0,A1,A2,A3,W0,W1,PW) do{ MF; sacc+=A0; sacc+=A1; sacc+=A2; sacc+=A3; PIN(sacc); W0; W1; PIN(PW); SBAR(); }while(0)
  #define EX(v) __builtin_amdgcn_exp2f(v)
  #define GAPB(MF,X,B,KO) do{ MF; X[B]=EX(X[B]); X[B+1]=EX(X[B+1]); X[B+2]=EX(X[B+2]); X[B+3]=EX(X[B+3]); PIN(X); SBAR(); }while(0)
  #define VRD(i) do{ vlo[i]=vtr(vp_+(((i)>>2)*4096+((i)&3)*1024)); vhi[i]=vtr(vp_+(((i)>>2)*4096+((i)&3)*1024+512)); }while(0)
  #define KRD(G,j) do{ if(G){ kload2(kf,kp0+sl_next,j); SBAR(); } }while(0)
  #define STEP(C0,C1,P0,P1,t,GK,GV,GL) do{ SBAR(); CSEL(t); CINIT(C0,0); SBAR(); \
    const lds_cptr vp_=vp0+sl_prev; \
    VRD(0); SBAR(); float sacc=(P0[0]+P0[1]); \
    GAPA(C0=__builtin_amdgcn_mfma_f32_32x32x16_bf16(kf[0],qr[0],CSRC(C0),0,0,0), P0[2],P0[3],P0[4],P0[5],     pw0[0]=PKW(P0,0), pw0[1]=PKW(P0,2), pw0); \
    CINIT(C1,32); VRD(4); SBAR(); GAPA(C1=__builtin_amdgcn_mfma_f32_32x32x16_bf16(kf[1],qr[0],CSRC(C1),0,0,0), P0[6],P0[7],P0[8],P0[9],     pw0[2]=PKW(P0,4), pw0[3]=PKW(P0,6), pw0); \
    VRD(1); SBAR(); GAPA(C0=__builtin_amdgcn_mfma_f32_32x32x16_bf16(kf[2],qr[1],C0,0,0,0),   P0[10],P0[11],P0[12],P0[13], pw1[0]=PKW(P0,8), pw1[1]=PKW(P0,10), pw1); \
    VRD(5); SBAR(); GAPA(C1=__builtin_amdgcn_mfma_f32_32x32x16_bf16(kf[3],qr[1],C1,0,0,0),   P0[14],P0[15],P1[0],P1[1],   pw1[2]=PKW(P0,12),pw1[3]=PKW(P0,14), pw1); \
    VRD(2); SBAR(); GAPA(C0=__builtin_amdgcn_mfma_f32_32x32x16_bf16(kf[4],qr[2],C0,0,0,0),   P1[2],P1[3],P1[4],P1[5],     pw2[0]=PKW(P1,0), pw2[1]=PKW(P1,2), pw2); \
    VRD(6); SBAR(); GAPA(C1=__builtin_amdgcn_mfma_f32_32x32x16_bf16(kf[5],qr[2],C1,0,0,0),   P1[6],P1[7],P1[8],P1[9],     pw2[2]=PKW(P1,4), pw2[3]=PKW(P1,6), pw2); \
    VRD(3); SBAR(); GAPA(C0=__builtin_amdgcn_mfma_f32_32x32x16_bf16(kf[6],qr[3],C0,0,0,0),   P1[10],P1[11],P1[12],P1[13], pw3[0]=PKW(P1,8), pw3[1]=PKW(P1,10), pw3); \
    VRD(7); SBAR(); GAPA(C1=__builtin_amdgcn_mfma_f32_32x32x16_bf16(kf[7],qr[3],C1,0,0,0),   P1[14],P1[15],0.f,0.f,       pw3[2]=PKW(P1,12),pw3[3]=PKW(P1,14), pw3); \
    l_reg+=sacc; \
    if(GK){DMA_K((t)+3,sl_cur);} if(GV){DMA_V((t)+1,sl_next);} \
    CMASK(C0,C1,t); \
    { float a=MX3(C0[0],C0[1],C1[0]),b=MX3(C0[2],C0[3],C1[1]); a=MX3(a,C1[2],C1[3]); \
      _Pragma("unroll") for(int r=4;r<16;r+=4){a=MX3(a,C0[r],C0[r+1]);b=MX3(b,C0[r+2],C0[r+3]);a=MX3(a,C1[r],C1[r+1]);b=MX3(b,C1[r+2],C1[r+3]);} \
      float rm=__builtin_fmaxf(a,b); { auto rr=__builtin_amdgcn_permlane32_swap(__float_as_uint(rm),__float_as_uint(rm),false,false); rm=__builtin_fmaxf(__uint_as_float(rr[0]),__uint_as_float(rr[1])); } \
      resc=false; \
      if(__builtin_expect(__any(rm>(float)THRL),0)){ const float dl=__builtin_fmaxf(rm,0.f); mhat+=dl; \
        _Pragma("unroll") for(int r=0;r<16;++r){C0[r]-=dl;C1[r]-=dl;} \
        if(!LAT){ _Pragma("unroll") for(int r=0;r<16;++r)negm[r]=-mhat; asm volatile("":"+v"(negm)); } \
        const float f=__builtin_amdgcn_exp2f(-dl); l_reg*=f; if(hi==0)wsf[r32]=f; resc=true; } } \
    SBAR(); \
    GAPB(o[0]=__builtin_amdgcn_mfma_f32_32x32x16_bf16(PAF(0),VFR(0),o[0],0,0,0), C0,0,0); \
    GAPB(o[1]=__builtin_amdgcn_mfma_f32_32x32x16_bf16(PAF(0),VFR(4),o[1],0,0,0), C0,4,0); \
    KRD(GL,0); GAPB(o[0]=__builtin_amdgcn_mfma_f32_32x32x16_bf16(PAF(1),VFR(1),o[0],0,0,0), C0,8,0); \
    KRD(GL,1); GAPB(o[1]=__builtin_amdgcn_mfma_f32_32x32x16_bf16(PAF(1),VFR(5),o[1],0,0,0), C0,12,0); \
    KRD(GL,2); GAPB(o[0]=__builtin_amdgcn_mfma_f32_32x32x16_bf16(PAF(2),VFR(2),o[0],0,0,0), C1,0,32); \
    KRD(GL,3); GAPB(o[1]=__builtin_amdgcn_mfma_f32_32x32x16_bf16(PAF(2),VFR(6),o[1],0,0,0), C1,4,32); \
    GAPB(o[0]=__builtin_amdgcn_mfma_f32_32x32x16_bf16(PAF(3),VFR(3),o[0],0,0,0), C1,8,32); \
    GAPB(o[1]=__builtin_amdgcn_mfma_f32_32x32x16_bf16(PAF(3),VFR(7),o[1],0,0,0), C1,12,32); \
    }while(0)
  int t=1;
  for(;t+5<NT;t+=2){
    STEP(pB0,pB1,pA0,pA1,t,true,true,true);     WAIT_BAR(2); RESC(); ROT();
    STEP(pA0,pA1,pB0,pB1,t+1,true,true,true);   WAIT_BAR(2); RESC(); ROT();
  }
  #define ENDW(tt) do{ if((tt)+3<NT){WAIT_BAR(2);} else if((tt)+2<NT){WAIT_BAR(1);} else {WAIT_BAR(0);} }while(0)
  for(;t+1<NT;t+=2){
    STEP(pB0,pB1,pA0,pA1,t,(t+3<NT),(t+1<NT),(t+1<NT));       ENDW(t);   RESC(); ROT();
    STEP(pA0,pA1,pB0,pB1,t+1,(t+4<NT),(t+2<NT),(t+2<NT));     ENDW(t+1); RESC(); ROT();
  }
  STEP(pB0,pB1,pA0,pA1,NT-1,false,false,false); RESC();
  { float sacc=pB0[0]+pB0[1]; _Pragma("unroll") for(int r=2;r<16;++r)sacc+=pB0[r]; _Pragma("unroll") for(int r=0;r<16;++r)sacc+=pB1[r]; l_reg+=sacc;
    pw0=(u32x4){PKW(pB0,0),PKW(pB0,2),PKW(pB0,4),PKW(pB0,6)};pw1=(u32x4){PKW(pB0,8),PKW(pB0,10),PKW(pB0,12),PKW(pB0,14)};pw2=(u32x4){PKW(pB1,0),PKW(pB1,2),PKW(pB1,4),PKW(pB1,6)};pw3=(u32x4){PKW(pB1,8),PKW(pB1,10),PKW(pB1,12),PKW(pB1,14)};
    SBAR(); pv(o,vb0+sl_cur,PAF(0),PAF(1),PAF(2),PAF(3)); }
  #undef PKW
  #undef PAF
  #undef VFR
  #undef PIN
  #undef MX3
  #undef GAPA
  #undef GAPB
  #undef EX
  #undef VRD
  #undef KRD
  #undef STEP
  #undef ENDW
  {auto rr=__builtin_amdgcn_permlane32_swap(__float_as_uint(l_reg),__float_as_uint(l_reg),false,false);l_reg=__uint_as_float(rr[0])+__uint_as_float(rr[1]);}
  if(hi==0)wsf[32+r32]=l_reg;asm volatile("s_waitcnt lgkmcnt(0)":::"memory");
  float rli[16];
  #pragma unroll
  for(int r=0;r<16;++r)rli[r]=__builtin_amdgcn_rcpf(wsf[32+crow(r,hi)]);
  bf16*Ow=Ow0+(long)(wid*QBLK)*DM;
  { bf16*stg=(bf16*)(shm+LDS_OST)+wid*2048;
    #pragma unroll
    for(int r=0;r<16;++r){const int orow=crow(r,hi);
      #pragma unroll
      for(int d0=0;d0<2;++d0)stg[orow*64+d0*32+r32]=__float2bfloat16(o[d0][r]*rli[r]);}
    asm volatile("s_waitcnt lgkmcnt(0)":::"memory");
    #pragma unroll
    for(int i=0;i<4;++i){const int row=i*8+(lane>>3),ch=lane&7; const u32x4 v=*(const u32x4*)(stg+row*64+ch*8); ATTN_STORE16(Ow+(long)row*DM+ch*8,v);} }
  asm volatile("s_waitcnt lgkmcnt(0)\n\ts_barrier":::"memory");
  #undef DMA_K
  #undef DMA_V
  #undef KSRC
  #undef VSRC
  #undef CMASK
  #undef CSEL
  #undef CINIT
  #undef CSRC
  #undef START
  #undef RESC
  #undef ROT
}

constexpr int MIX_STAT=0, MIX_V=2048, MIX_WS=MIX_V+8*8192, MIX_STG=MIX_WS+NW*64*4, MIX_SROW=36, MIX_LDS_BYTES=MIX_STG+NW*32*MIX_SROW*4;
__device__ __forceinline__ void mix_pair(const int tid,const int uA,const int uB,const bf16*VV,bf16*U,const bf16*WSb,const float*LNP,const float*gv,const float*bs,char*shm){
  const int lane=tid&63,r32=lane&31,hi=lane>>5; const int wid=__builtin_amdgcn_readfirstlane(tid>>6);
  const int grp=wid>>2,pb=wid&3,u=grp?uB:uA; const bool valid=u>=0; const int chunk=u>>4,g=u&15;
  const unsigned lds0=(unsigned)(uintptr_t)shm;
  float*stat=(float*)(shm+MIX_STAT)+grp*256;
  float*wsf=(float*)(shm+MIX_WS)+wid*64;
  float*stg=(float*)(shm+MIX_STG)+wid*32*MIX_SROW;
  const int vbase=MIX_V+grp*32768;
  asm volatile("s_waitcnt vmcnt(0)":::"memory");
  if(valid){
    #pragma unroll
    for(int k=0;k<2;++k){ const int pi=2*pb+k; const bf16*vsrc=VV+(long)(chunk*128+16*(pi&3)+(lane>>2))*2048+g*128+(pi>>2)*32+(lane&3)*8;
      #pragma unroll
      for(int s=0;s<4;++s) glds16(vsrc+(long)((s>>1)*64)*2048+(s&1)*64,(unsigned)__builtin_amdgcn_readfirstlane(lds0+vbase+s*8192+pi*1024)); }
    const int tg=tid&255;
    if(tg<128){ const __attribute__((address_space(1))) float*p=(const __attribute__((address_space(1))) float*)(LNP+(long)(chunk*128+tg)*16); float s=0.f,q=0.f;
      #pragma unroll
      for(int k=0;k<8;++k){s+=p[2*k];q+=p[2*k+1];}
      const float mean=s*(1.f/2048.f),var=q*(1.f/2048.f)-mean*mean; stat[2*tg]=mean; stat[2*tg+1]=__builtin_amdgcn_rsqf(var+1e-6f); } }
  asm volatile("s_waitcnt vmcnt(0) lgkmcnt(0)\n\ts_barrier":::"memory");
  if(valid){
    bf16x8 pa[2][4]; float corr=0.f;
    #pragma unroll
    for(int qt=0;qt<2;++qt)
      #pragma unroll
      for(int ks=0;ks<4;++ks){ const int qa=64*qt+16*ks+4*hi;
        const __attribute__((address_space(1))) unsigned* wp=(const __attribute__((address_space(1))) unsigned*)(WSb+((long)g*128+32*pb+r32)*128+qa);
        const unsigned w0=wp[0],w1=wp[1],w2=wp[4],w3=wp[5];
        const f32x4 s0=*(const f32x4*)(stat+2*qa), s1=*(const f32x4*)(stat+2*qa+4), s2=*(const f32x4*)(stat+2*qa+16), s3=*(const f32x4*)(stat+2*qa+20);
        const float a0=__uint_as_float(w0<<16)*s0.y,a1=__uint_as_float(w0&0xffff0000u)*s0.w,a2=__uint_as_float(w1<<16)*s1.y,a3=__uint_as_float(w1&0xffff0000u)*s1.w;
        const float a4=__uint_as_float(w2<<16)*s2.y,a5=__uint_as_float(w2&0xffff0000u)*s2.w,a6=__uint_as_float(w3<<16)*s3.y,a7=__uint_as_float(w3&0xffff0000u)*s3.w;
        u32x4 pk; pk.x=cvtpk_s(a0,a1); pk.y=cvtpk_s(a2,a3); pk.z=cvtpk_s(a4,a5); pk.w=cvtpk_s(a6,a7);
        corr+=(__uint_as_float(pk.x<<16)*s0.x+__uint_as_float(pk.x&0xffff0000u)*s0.z)+(__uint_as_float(pk.y<<16)*s1.x+__uint_as_float(pk.y&0xffff0000u)*s1.z)
             +(__uint_as_float(pk.z<<16)*s2.x+__uint_as_float(pk.z&0xffff0000u)*s2.z)+(__uint_as_float(pk.w<<16)*s3.x+__uint_as_float(pk.w&0xffff0000u)*s3.z);
        pa[qt][ks]=__builtin_bit_cast(bf16x8,pk); }
    {auto rr=__builtin_amdgcn_permlane32_swap(__float_as_uint(corr),__float_as_uint(corr),false,false);corr=__uint_as_float(rr[0])+__uint_as_float(rr[1]);}
    if(hi==0)wsf[r32]=corr; asm volatile("s_waitcnt lgkmcnt(0)":::"memory");
    const int vb=(int)(lds0+vbase)+((lane>>4)&1)*32+(lane&3)*8+(4*hi+((lane&15)>>2))*64;
    #pragma unroll
    for(int ch=0;ch<2;++ch){
      f32x16 o[2]; o[0]=f32x16{}; o[1]=f32x16{};
      SBAR(); pv(o,vb+ch*8192,pa[0][0],pa[0][1],pa[0][2],pa[0][3]);
      SBAR(); pv(o,vb+(2+ch)*8192,pa[1][0],pa[1][1],pa[1][2],pa[1][3]);
      #pragma unroll
      for(int d0=0;d0<2;++d0){
        #pragma unroll
        for(int r=0;r<16;++r){const int orow=crow(r,hi); stg[orow*MIX_SROW+r32]=o[d0][r]-wsf[orow];}
        asm volatile("s_waitcnt lgkmcnt(0)":::"memory");
        #pragma unroll
        for(int i=0;i<2;++i){const int row=i*16+(lane>>2),c8=(lane&3)*8; const int p=32*pb+row, e=g*128+ch*64+d0*32+c8;
          const f32x4 m0=*(const f32x4*)(stg+row*MIX_SROW+c8), m1=*(const f32x4*)(stg+row*MIX_SROW+c8+4);
          const f32x4 g0=*(const __attribute__((address_space(1))) f32x4*)(gv+e), g1=*(const __attribute__((address_space(1))) f32x4*)(gv+e+4); const float b=*(const __attribute__((address_space(1))) float*)(bs+g*128+p);
          bf16*up=U+(long)(chunk*128+p)*2048+e; const u32x4 uw=*(const __attribute__((address_space(1))) u32x4*)up;
          u32x4 ow;
          ow.x=cvtpk_s(__uint_as_float(uw.x<<16)*(g0.x*m0.x+b),__uint_as_float(uw.x&0xffff0000u)*(g0.y*m0.y+b));
          ow.y=cvtpk_s(__uint_as_float(uw.y<<16)*(g0.z*m0.z+b),__uint_as_float(uw.y&0xffff0000u)*(g0.w*m0.w+b));
          ow.z=cvtpk_s(__uint_as_float(uw.z<<16)*(g1.x*m1.x+b),__uint_as_float(uw.z&0xffff0000u)*(g1.y*m1.y+b));
          ow.w=cvtpk_s(__uint_as_float(uw.w<<16)*(g1.z*m1.z+b),__uint_as_float(uw.w&0xffff0000u)*(g1.w*m1.w+b));
          *(__attribute__((address_space(1))) u32x4*)up=ow; }
        asm volatile("s_waitcnt lgkmcnt(0)":::"memory"); }
    } }
  asm volatile("s_waitcnt lgkmcnt(0)\n\ts_barrier":::"memory");
}
constexpr int ATTN_LDS_BYTES=LDS_BYTES;
#undef SBAR
#undef WAIT_BAR
}

#ifndef LATUNIT
#define LATUNIT attn_body::attn_unit<8, true>
#endif
__device__ __forceinline__ void attn_fast(const Frame& F, const Args& args) {
    typedef attn_body::bf16 abf;
    unsigned char* ws = wsb(args);
    abf* Q = (abf*)(ws + WS_Q); const abf* K = (const abf*)(ws + WS_K);
    const abf* CKp = (const abf*)(ws + WS_CK); const abf* KCp = (const abf*)(ws + WS_KC); const float* rpb = inp(args, I_RPB);
    char* shm = (char*)(unsigned char*)F.lds + RING_OFF;
    const int vcu = (F.G % 8 == 0) ? (F.bid % 8) * (F.G / 8) + F.bid / 8 : F.bid;
    for (int u = vcu; u < 4 * NH * 4; u += F.G) {
        const int b = u >> 6, h = (u >> 2) & 15, qb = u & 3;
        const int wlo = qb < 2 ? 0 : (qb == 2 ? 4 : 8), nwin = (qb == 0 || qb == 3) ? 8 : 12;
        const long qoff = ((long)(NCTX + b * SEQ_L + qb * 256)) * D + h * HD, woff = ((long)(NCTX + b * SEQ_L + wlo * 64)) * D + h * HD, coff = ((long)(b * PAST)) * D + h * HD;
        LATUNIT(F.tid, Q + qoff, CKp + coff, (long)((WS_CV - WS_CK) / 2), 8, K + woff, (long)((WS_V - WS_K) / 2), 8 + nwin, shm, 4 * qb, wlo, rpb + h * 465);
    }
    for (int u = vcu; u < 32 * NH; u += F.G) {
        const int b = u >> 4, h = u & 15;
        const long qoff = ((long)(b * SEQ_C)) * D + h * HD;
        attn_body::attn_unit<8, false>(F.tid, Q + qoff, KCp + qoff, (long)((WS_VC - WS_KC) / 2), 4, KCp + qoff, (long)((WS_VC - WS_KC) / 2), 4, shm, 0, 0, rpb);
    }
    if (F.G % 4 == 0 && (4 * NH * 4) % F.G == 0) { const int qb = vcu & 3;
        if (qb == 0 || qb == 3) p1_sw_items(F, args, SWI_QKV, SWI_QKV + FF2 / 16, ((vcu >> 2) * 2 + (qb == 3)) * NWAVES + F.wave, (F.G / 2) * NWAVES); }
    else p1_sw_items(F, args, SWI_QKV, SWI_QKV + FF2 / 16, F.bid * NWAVES + F.wave, F.G * NWAVES);
}


__device__ __forceinline__ void mix_fast(const Frame& F, const Args& args) {
    typedef attn_body::bf16 abf;
    unsigned char* ws = wsb(args);
    const abf* VV = (const abf*)(ws + WS_VV); abf* U = (abf*)(ws + WS_U); const abf* WSb = (const abf*)(ws + WS_WSB); const float* LNP = (const float*)(ws + WS_LNP);
    const float* gv = inp(args, I_GV); const float* bs = inp(args, I_BSP);
    char* shm = (char*)(unsigned char*)F.lds + RING_OFF;
    const int vcu = (F.G % 8 == 0) ? (F.bid % 8) * (F.G / 8) + F.bid / 8 : F.bid;
    for (int u = 2 * vcu; u < 96 * 16; u += 2 * F.G) attn_body::mix_pair(F.tid, u, u + 1 < 96 * 16 ? u + 1 : -1, VV, U, WSb, LNP, gv, bs, shm);
}
#ifndef ATTN
#define ATTN attn_fast
#endif
#ifndef MIX
#define MIX mix_fast
#endif
enum Steps { S_P0 = 0, S_QKV, S_ATT, S_WO, S_UP0, S_DN0, S_IN, S_MIX, S_OUT, S_UP1, S_DN1, NSTEPS };

#ifndef STEPMASK
#define STEPMASK 0xffffffffu
#endif
#define ON(s) ((STEPMASK >> (s)) & 1u)
__device__ __forceinline__ void run_step(const Frame& F0, const Args& args, int s) {
    Frame F = F0; asm volatile("" : "+v"(F.tid)); asm volatile("" : "+s"(F.bid)); asm volatile("" : "+s"(F.G)); F.lane = F.tid & 63; F.wave = __builtin_amdgcn_readfirstlane(F.tid >> 6);
    unsigned char* ws = wsb(args);
    const float* MOD0 = (const float*)(ws + WS_MOD); const float* MOD1 = MOD0 + 5 * 6144;
    float* SW = (float*)(ws + WS_SW);
    float* RS0 = (float*)(ws + WS_RS); float* RS1 = RS0 + (size_t)MT * 4; float* RS2 = RS0 + (size_t)MT * 8; float* RS3 = RS0 + (size_t)MT * 12;
    bf16* AN = (bf16*)(ws + WS_AN);
    if (ON(S_P0) && s == S_P0) {
        unsigned* cnt = (unsigned*)ws + CW_CNT + 8192;
        for (int u = F.bid; u < ADA_UNITS; u += F.G) { p0_adaln_unit(F, args, u);
            const int jb = u % 24; if (u < 96 && jb < 8) wave_publish(cnt + (jb < 4 ? 0 : 64)); }
        const int rot = (F.bid + F.G - ADA_UNITS % F.G) % F.G;
        p0_items(F, args, 0, PI_FIRST, rot * NWAVES + F.wave, F.G * NWAVES);
        constexpr int SWU_QKV = (NQKV / 256) * 4;
        if (rot < SWU_QKV) {
            if (F.wave == 0) { wave_wait_ge(cnt, 16 * NWAVES, (unsigned*)ws + CW_TMO); __builtin_amdgcn_fence(__ATOMIC_ACQUIRE, "agent"); }
            __syncthreads();
            for (int u = rot; u < SWU_QKV; u += F.G) sw_unit_f32(F, inp(args, I_WQKV), NQKV, MOD0, SW + SW_QKV, false, u); }
        if (F.wave == 0) { wave_wait_ge(cnt + 64, 16 * NWAVES, (unsigned*)ws + CW_TMO); __builtin_amdgcn_fence(__ATOMIC_ACQUIRE, "agent"); }
        __syncthreads();
        p1_rows(F, args, rot * NWAVES + F.wave, (SWU_QKV < F.G ? SWU_QKV : 0) * NWAVES); }
    else if (ON(S_QKV) && s == S_QKV) { float* out = outb(args);
        EpiQKV E{{RS0, SW + SW_QKV, NQKV}, ws};
        int fw = 0, nfw = 1; const bool fil = filler_slot(F, (MT / 256) * (NQKV / 256), fw, nfw), first = fil && (F.bid & 8);
        if (first) { p0_items(F, args, PI_FIRST, PI_SECOND, fw, nfw); __syncthreads(); }
        gemm_pg8<0>(F, AN, (const bf16*)(ws + WS_WQKV), 0, MT, NQKV, D, E);
        if (fil && !first) p0_items(F, args, PI_FIRST, PI_SECOND, fw, nfw); }
    else if (ON(S_ATT) && s == S_ATT) ATTN(F, args);
    else if (ON(S_WO) && s == S_WO) { float* X = outb(args);
        EpiResT<0> E{inp(args, I_XP), inp(args, I_XS), (bf16*)(ws + WS_XB), nullptr, MOD0 + 2048, AN, inp(args, I_NFFN), MOD0 + 4096, RS1, 1.f};
        gemm_pg8<1, EpiResT<0>, 3>(F, (const bf16*)(ws + WS_Q), (const bf16*)(ws + WS_WO), 0, MT, D, D, E);
    }
    else if (ON(S_UP0) && s == S_UP0) { EpiUpConv E{RS1, SW + SW_UP0, inp(args, I_WCONV), inp(args, I_BCONV), (float*)(ws + WS_HALO), (bf16*)(ws + WS_M), (LAS float*)(F.lds + EPI_OFF), F.skip_epi};
        int fw = 0, nfw = 1; const bool fil = filler_slot(F, (MT / 256) * (FF2 / 256), fw, nfw), first = fil && (F.bid & 8);
        if (first) { p0_items(F, args, PI_SECOND, PI_ALL, fw, nfw); sw_units_f32(F, args, fw / NWAVES, nfw / NWAVES); __syncthreads(); }
        gemm_pg8_raw(F, AN, (const bf16*)(ws + WS_WUP), MT, FF2, D, E);
        if (fil && !first) { p0_items(F, args, PI_SECOND, PI_ALL, fw, nfw); sw_units_f32(F, args, fw / NWAVES, nfw / NWAVES); } }
    else if (ON(S_DN0) && s == S_DN0) { float* X = outb(args);
        { pg8::StaticOrder S0; S0.init(MT, D, F.G, F.bid, 192); pg8::Unit u0; for (int i = 0; S0.next(i, u0); ++i) fix_halo_rows(F, u0.pm * 192, u0.pm * 192 + 224, (const float*)(ws + WS_HALO), inp(args, I_WCONV), inp(args, I_BCONV), (bf16*)(ws + WS_M)); }
        EpiResT<1> E{nullptr, nullptr, (bf16*)(ws + WS_XB), nullptr, MOD0 + 5120, AN, inp(args, I_NMIX) + D, MOD1 + 1024, RS2, F.scale};
        gemm_pg8<1, EpiResT<1>, 3>(F, (const bf16*)(ws + WS_M), (const bf16*)(ws + WS_WDN), 0, MT, D, FF, E);
    }
    else if (ON(S_IN) && s == S_IN) { EpiIn E{{RS2, SW + SW_IN, GE2}, (bf16*)(ws + WS_U), (bf16*)(ws + WS_VV), (float*)(ws + WS_LNP)}; gemm_pg8<2>(F, AN, (const bf16*)(ws + WS_WIN), 0, MT, GE2, D, E); }
    else if (ON(S_MIX) && s == S_MIX) MIX(F, args);
    else if (ON(S_OUT) && s == S_OUT) { float* X = outb(args);
        EpiResT<1> E{nullptr, nullptr, (bf16*)(ws + WS_XB), nullptr, MOD1 + 2048, AN, inp(args, I_NFFN) + D, MOD1 + 4096, RS3, F.scale};
        gemm_pg8<1, EpiResT<1>, 3>(F, (const bf16*)(ws + WS_U), (const bf16*)(ws + WS_WOUT), 0, MT, D, GE, E); }
    else if (ON(S_UP1) && s == S_UP1) { EpiUpConv E{RS3, SW + SW_UP1, inp(args, I_WCONV) + (size_t)3 * FF2, inp(args, I_BCONV) + FF2, (float*)(ws + WS_HALO), (bf16*)(ws + WS_M), (LAS float*)(F.lds + EPI_OFF), F.skip_epi};
        int fw = 0, nfw = 1; const bool fil = filler_slot(F, (MT / 256) * (FF2 / 256), fw, nfw), first = fil && (F.bid & 8);
        if (first) state_items(F, args, fw, nfw);
        gemm_pg8_raw(F, AN, (const bf16*)(ws + WS_WUP) + (size_t)FF2 * D, MT, FF2, D, E);
        if (fil && !first) state_items(F, args, fw, nfw); }
    else if (ON(S_DN1) && s == S_DN1) { float* X = outb(args);
        { pg8::StaticOrder S0; S0.init(MT, D, F.G, F.bid, 192); pg8::Unit u0; for (int i = 0; S0.next(i, u0); ++i) fix_halo_rows(F, u0.pm * 192, u0.pm * 192 + 224, (const float*)(ws + WS_HALO), inp(args, I_WCONV) + (size_t)3 * FF2, inp(args, I_BCONV) + FF2, (bf16*)(ws + WS_M)); }
        EpiFinal E{(const bf16*)(ws + WS_XB), X, MOD1 + 5120, inp(args, I_NFIN), RS0 + (size_t)MT * 16, (unsigned*)ws + CW_CNT, (unsigned*)ws + CW_TMO, F.scale};
        gemm_pg8<1, EpiFinal, 3>(F, (const bf16*)(ws + WS_M), (const bf16*)(ws + WS_WDN) + (size_t)D * FF, 0, MT, D, FF, E); }
}

__global__ void __launch_bounds__(NWAVES * 64, 2) mk_fwd(Args args) {
    extern __shared__ __attribute__((aligned(16))) unsigned char lds[];
    Frame F;
    F.lds = (LAS unsigned char*)lds;
    F.MISC = (volatile LAS unsigned*)(F.lds + MISC_OFF);
    F.tid = threadIdx.x; F.lane = F.tid & 63; F.wave = __builtin_amdgcn_readfirstlane(F.tid >> 6);
    F.G = gridDim.x; F.bid = blockIdx.x; F.scale = 1.f; F.skip_epi = false;
    for (int u = F.tid; u < (LDS_BYTES - LDSCTL_OFF) / 4; u += NWAVES * 64) ((LAS unsigned*)(F.lds + LDSCTL_OFF))[u] = 0u;
    __syncthreads();
    XcdBarrier bar = xcd_barrier_post((unsigned*)(args.ws + WS_CTL) + CW_BAR, F.MISC + 8);
    for (int q = 0; q < args.nseq; ++q) {
        const int sq = args.seq[q]; F.scale = (sq & 32) ? 0.f : 1.f; F.skip_epi = (sq & 64) != 0;
        run_step(F, args, sq & 31);
        if (q + 1 < args.nseq) xcd_barrier(bar);
    }
}

extern "C" void kernel_launch(void* const* d_in, const int* in_sizes, int n_in, void* d_out, int out_size, void* d_ws, size_t ws_size, hipStream_t stream) {
    static int grid = 0;
    if (grid == 0) {
        if (n_in != 23 || ws_size < WS_END) { fprintf(stderr, "kernel_launch: unexpected n_in %d / ws %zu\n", n_in, ws_size); grid = -1; return; }
        int dev = 0, cus = 0, per_cu = 0;
        if (hipGetDevice(&dev) != hipSuccess || hipDeviceGetAttribute(&cus, hipDeviceAttributeMultiprocessorCount, dev) != hipSuccess) { grid = -1; return; }
        if (hipFuncSetAttribute((const void*)mk_fwd, hipFuncAttributeMaxDynamicSharedMemorySize, LDS_BYTES) != hipSuccess) { fprintf(stderr, "kernel_launch: hipFuncSetAttribute failed\n"); grid = -1; return; }
        if (hipOccupancyMaxActiveBlocksPerMultiprocessor(&per_cu, (const void*)mk_fwd, NWAVES * 64, LDS_BYTES) != hipSuccess || per_cu < 1) { fprintf(stderr, "kernel_launch: occupancy query says %d blocks per CU\n", per_cu); per_cu = 1; }
        (void)hipGetLastError();
        grid = cus;
    }
    if (grid < 0) return;
    if (hipMemsetAsync((char*)d_ws + WS_CTL, 0, CTL_ZERO_BYTES, stream) != hipSuccess) { fprintf(stderr, "kernel_launch: memset failed\n"); return; }
    Args a{};
    for (int i = 0; i < 23; ++i) a.in[i] = (const float*)d_in[i];
    a.out = (float*)d_out; a.ws = (unsigned char*)d_ws;
#ifndef DUP_FLAGS
#define DUP_FLAGS 0
#endif
#ifndef DUP_STEP
    a.nseq = NSTEPS; for (int s = 0; s < NSTEPS; ++s) a.seq[s] = (unsigned char)s;
#else
#ifndef DUP_STEP_HI
#define DUP_STEP_HI DUP_STEP
#endif
    a.nseq = 0; for (int s = 0; s < NSTEPS; ++s) { a.seq[a.nseq++] = (unsigned char)s; if (s == DUP_STEP_HI) for (int r = DUP_STEP; r <= DUP_STEP_HI; ++r) a.seq[a.nseq++] = (unsigned char)(r | 32 | DUP_FLAGS); }
#endif
    hipLaunchKernelGGL(mk_fwd, dim3(grid), dim3(NWAVES * 64), LDS_BYTES, stream, a);
    const hipError_t le = hipPeekAtLastError();
    if (le != hipSuccess) fprintf(stderr, "kernel_launch: launch failed: %s\n", hipGetErrorName(le));
}
```

```cpp
#include <hip/hip_runtime.h>
#include <cstdio>
#include <cstdint>
#include <type_traits>


#define GAS __attribute__((address_space(1)))
#define LAS __attribute__((address_space(3)))
typedef unsigned short bf16;
typedef short bf16x8 __attribute__((ext_vector_type(8)));
typedef float f32x4 __attribute__((ext_vector_type(4)));
typedef float f32x2 __attribute__((ext_vector_type(2)));
typedef unsigned u32x4 __attribute__((ext_vector_type(4)));
typedef unsigned u32x2 __attribute__((ext_vector_type(2)));
typedef GAS unsigned gu32;

constexpr int D = 1024, NCTX = 8192, NLAT = 4096, MT = 12288, NH = 16, HD = 64, FF = 2816, FF2 = 5632, GE = 2048, GE2 = 4096, NQKV = 3072;
constexpr int SEQ_C = 256, SEQ_L = 1024, PAST = 512;
constexpr float EPS = 1e-6f, LOG2E = 1.4426950408889634f, C2 = 0.125f * 1.4426950408889634f;
constexpr int NWAVES = 8;

constexpr size_t MiB = 1u << 20;
constexpr size_t WS_CTL = 0, CTL_ZERO_BYTES = 1 * MiB + 512 * 1024;
constexpr size_t WS_MOD = 512 * 1024;
constexpr size_t WS_TS = 800 * 1024;
constexpr size_t WS_SW = 1 * MiB;
constexpr size_t WS_HALO = 1 * MiB + 512 * 1024;
constexpr size_t WS_RS = 3 * MiB;
constexpr size_t WS_LNP = 4 * MiB;
constexpr size_t WS_WQKV = 5 * MiB, WS_WO = 11 * MiB, WS_WIN = 13 * MiB, WS_WOUT = 21 * MiB, WS_WUP = 25 * MiB, WS_WDN = 47 * MiB;
constexpr size_t WUP_BYTES = 11 * MiB, WDN_BYTES = (size_t)1024 * 2816 * 2;
constexpr size_t WS_WSB = 58 * MiB;
constexpr size_t WS_CK = 59 * MiB, WS_CV = 63 * MiB;
constexpr size_t WS_AN = 67 * MiB;
constexpr size_t WS_BIG = 91 * MiB;
constexpr size_t WS_Q = WS_BIG, WS_K = WS_BIG + 24 * MiB, WS_V = WS_BIG + 48 * MiB;
constexpr size_t WS_M = WS_BIG, WS_ARAW = WS_BIG + 66 * MiB;
constexpr size_t WS_U = WS_BIG, WS_VV = WS_BIG + 48 * MiB;
constexpr size_t WS_XB = 200 * MiB;
constexpr size_t WS_KC = 224 * MiB, WS_VC = 240 * MiB;
constexpr size_t WS_END = 256 * MiB;
static_assert(WS_HALO + (size_t)16 * 4 * 5632 * 4 <= WS_RS && WS_SW + 5 * (3072 + 5632 + 4096 + 5632) * 4 <= CTL_ZERO_BYTES, "zeroed region / halo");
static_assert(WS_ARAW + (size_t)4096 * 5632 * 2 <= WS_END && WS_WDN + 2 * WDN_BYTES <= WS_CK && WS_VV + 48 * MiB <= WS_END, "ws map");
constexpr int SW_QKV = 0, SW_UP0 = 5 * NQKV, SW_IN = SW_UP0 + 5 * FF2, SW_UP1 = SW_IN + 5 * GE2;
constexpr int CW_TMO = 0, CW_CODE = 1, CW_BAR = 4096;

#define RLX_AGENT __ATOMIC_RELAXED, __HIP_MEMORY_SCOPE_AGENT
#define LDS_WAIT() asm volatile("s_waitcnt lgkmcnt(0)" ::: "memory")
#define VM_WAIT() asm volatile("s_waitcnt vmcnt(0)" ::: "memory")
__device__ __forceinline__ unsigned cvt_pk_bf16(float lo, float hi) { unsigned r; asm volatile("v_cvt_pk_bf16_f32 %0, %1, %2" : "=v"(r) : "v"(lo), "v"(hi)); return r; }
__device__ __forceinline__ float bf2f(unsigned short u) { return __uint_as_float((unsigned)u << 16); }
__device__ __forceinline__ float bflo(unsigned w) { return __uint_as_float(w << 16); }
__device__ __forceinline__ float bfhi(unsigned w) { return __uint_as_float(w & 0xffff0000u); }
__device__ __forceinline__ u32x4 pack8(f32x4 a, f32x4 b) { u32x4 w; w.x = cvt_pk_bf16(a[0], a[1]); w.y = cvt_pk_bf16(a[2], a[3]); w.z = cvt_pk_bf16(b[0], b[1]); w.w = cvt_pk_bf16(b[2], b[3]); return w; }
__device__ __forceinline__ float wave_sum(float v) {
#pragma unroll
    for (int o = 1; o < 64; o <<= 1) v += __shfl_xor(v, o);
    return v;
}
__device__ __forceinline__ float silu_f(float x) { return x * __builtin_amdgcn_rcpf(1.f + __builtin_amdgcn_exp2f(-x * LOG2E)); }
__device__ __forceinline__ float gelu_tanh_f(float x) { const float u = (-1.5957691216057308f * LOG2E) * (x + 0.044715f * x * x * x); return x * __builtin_amdgcn_rcpf(1.f + __builtin_amdgcn_exp2f(u)); }
__device__ __forceinline__ int ci_of(int row) { return row < NCTX ? 0 : 1 + ((row - NCTX) >> 10); }


__device__ __forceinline__ void st4f_wt(float* p, float v) { __hip_atomic_store((unsigned*)p, __float_as_uint(v), __ATOMIC_RELAXED, __HIP_MEMORY_SCOPE_AGENT); }
__device__ __forceinline__ void wave_publish(unsigned* cnt) {
    asm volatile("s_waitcnt vmcnt(0)" ::: "memory");
    if ((threadIdx.x & 63) == 0) __hip_atomic_fetch_add(cnt, 1u, __ATOMIC_RELAXED, __HIP_MEMORY_SCOPE_AGENT);
}
__device__ __forceinline__ void wave_wait_ge(unsigned* cnt, unsigned need, unsigned* tmo) {
    unsigned sp = 0;
    while ((unsigned)__builtin_amdgcn_readfirstlane(__hip_atomic_load(cnt, __ATOMIC_RELAXED, __HIP_MEMORY_SCOPE_AGENT)) < need) {
        __builtin_amdgcn_s_sleep(2);
        if (++sp > (1u << 22)) { if ((threadIdx.x & 63) == 0) __hip_atomic_store(tmo, 1u, __ATOMIC_RELAXED, __HIP_MEMORY_SCOPE_AGENT); break; } }
}
constexpr int CW_CNT = 16384;
#define XB_TMO      128
#define XB_XCNT(j)  (256  + 64 * (j))
#define XB_XSUB(j)  (1280 + 64 * (j))
#define XB_XGEN(j)  (2304 + 64 * (j))
#define XB_TOP      3328
#define XB_TOPGEN   3392
#define XCD_BAR_WORDS 3456
#define XB_SPIN_CAP (1u << 18)
__device__ __forceinline__ unsigned xb_ld(unsigned* p)              { return __hip_atomic_load(p, __ATOMIC_RELAXED, __HIP_MEMORY_SCOPE_AGENT); }
__device__ __forceinline__ unsigned xb_add(unsigned* p, unsigned v) { return __hip_atomic_fetch_add(p, v, __ATOMIC_RELAXED, __HIP_MEMORY_SCOPE_AGENT); }
__device__ __forceinline__ unsigned xb_xcc_id() { return (unsigned)__builtin_amdgcn_s_getreg((3 << 11) | 20) & 0xFu; }
#define XB_SPIN(cond, bar) do { unsigned _sp = 0; while (cond) { __builtin_amdgcn_s_sleep(1); \
    if ((++_sp & 255u) == 0u) { if (xb_ld(&(bar)[XB_TMO])) break; if (_sp > XB_SPIN_CAP) { atomicAdd(&(bar)[XB_TMO], 1u); break; } } } } while (0)
struct XcdBarrier { unsigned* bar; unsigned x; volatile LAS unsigned* st; };
__device__ __forceinline__ XcdBarrier xcd_barrier_post(unsigned* bar, volatile LAS unsigned* st) {
    XcdBarrier b; b.bar = bar; b.x = xb_xcc_id(); b.st = st;
    if (threadIdx.x == 0) (void)xb_add(&bar[XB_XCNT(b.x)], 1u);
    return b;
}
__device__ __forceinline__ void xcd_barrier_complete(unsigned* bar, unsigned x, unsigned& nloc, unsigned& nx) {
    const unsigned G = gridDim.x * gridDim.y * gridDim.z;
    unsigned sum, cnt, mine, sp = 0u;
    for (;;) {
        sum = 0u; cnt = 0u; mine = 0u;
#pragma unroll
        for (unsigned j = 0; j < 16; ++j) { const unsigned c = xb_ld(&bar[XB_XCNT(j)]); sum += c; cnt += (c > 0u) ? 1u : 0u; mine = (j == x) ? c : mine; }
        if (sum == G) break;
        __builtin_amdgcn_s_sleep(1);
        if ((++sp & 255u) == 0u) { if (xb_ld(&bar[XB_TMO])) break; if (sp > XB_SPIN_CAP) { atomicAdd(&bar[XB_TMO], 1u); break; } }
    }
    nloc = mine > 0u ? mine : 1u; nx = cnt > 0u ? cnt : 1u;
}
__device__ __forceinline__ void xcd_barrier(const XcdBarrier& b) {
    asm volatile("s_waitcnt vmcnt(0)" ::: "memory");
    __syncthreads();
    if (threadIdx.x == 0) {
        unsigned* bar = b.bar;
        __builtin_amdgcn_s_waitcnt(0);
        unsigned nloc = b.st[0], nx = b.st[1];
        if (nloc == 0u) { xcd_barrier_complete(bar, b.x, nloc, nx); b.st[0] = nloc; b.st[1] = nx; }
        const unsigned old = xb_add(&bar[XB_XSUB(b.x)], 1u);
        const unsigned gen = old / nloc;
        if (old + 1u == (gen + 1u) * nloc) {
            __builtin_amdgcn_fence(__ATOMIC_RELEASE, "agent");
            asm volatile("s_waitcnt vmcnt(0)" ::: "memory");
            const unsigned og = xb_add(&bar[XB_TOP], 1u);
            const unsigned tg = og / nx;
            if (og + 1u == (tg + 1u) * nx) xb_add(&bar[XB_TOPGEN], 1u);
            else XB_SPIN(xb_ld(&bar[XB_TOPGEN]) == tg, bar);
            __builtin_amdgcn_fence(__ATOMIC_ACQUIRE, "agent");
            xb_add(&bar[XB_XGEN(b.x)], 1u);
            asm volatile("s_waitcnt vmcnt(0)" ::: "memory");
        } else {
            XB_SPIN(xb_ld(&bar[XB_XGEN(b.x)]) == gen, bar);
            __builtin_amdgcn_fence(__ATOMIC_ACQUIRE, "agent");
            asm volatile("s_waitcnt vmcnt(0)" ::: "memory");
        }
    }
    __syncthreads();
}

constexpr int RING_OFF = 0, RING_BYTES = 131072;
constexpr int LDSCTL_OFF = RING_BYTES, MISC_OFF = LDSCTL_OFF + 320;
constexpr int LDS_BYTES = 147456;

struct Frame {
    LAS unsigned char* lds;
    volatile LAS unsigned* MISC;
    int tid, lane, wave, G, bid;
    bool skip_epi;
    float scale;
};
struct Args { const float* in[23]; float* out; unsigned char* ws; int nseq, pad; unsigned char seq[32]; };
#define ASSUME_GLOBAL(p) __builtin_assume(!__builtin_amdgcn_is_shared((const void*)(p)) && !__builtin_amdgcn_is_private((const void*)(p)))
__device__ __forceinline__ const float* inp(const Args& a, int i) { asm volatile("" : "+s"(i)); const float* p = a.in[i]; return (const float*)(const GAS float*)p; }
__device__ __forceinline__ unsigned char* wsb(const Args& a) { unsigned char* p = a.ws; asm volatile("" : "+s"(p)); return (unsigned char*)(GAS unsigned char*)p; }
__device__ __forceinline__ float* outb(const Args& a) { float* p = a.out; asm volatile("" : "+s"(p)); return (float*)(GAS float*)p; }
enum InIdx { I_XP = 0, I_XS, I_CK, I_CV, I_C, I_CCTX, I_WADA, I_BADA, I_NMIX, I_NFFN, I_NFIN, I_WQKV, I_WO, I_RPB, I_WIN, I_GV, I_WSP, I_BSP, I_WOUT, I_WUP, I_WCONV, I_BCONV, I_WDN };


#define G_LD4(p)   (*(const GAS f32x4*)(p))
#define G_LDU4(p)  (*(const GAS u32x4*)(p))
#define G_ST4(p,v) (*(GAS f32x4*)(p) = (v))
#define G_STU4(p,v) (*(GAS u32x4*)(p) = (v))

__device__ __forceinline__ int upmap(int n) { return n < FF ? ((n >> 7) << 8) + (n & 127) : (((n - FF) >> 7) << 8) + 128 + ((n - FF) & 127); }
constexpr int ADA_UNITS = 2 * 24 * 4;
__device__ __forceinline__ void p0_adaln_unit(const Frame& F, const Args& args, int u) {
    const float* w_ada = inp(args, I_WADA); const float* c_ctx = inp(args, I_CCTX); const float* cc = inp(args, I_C);
    float* MOD = (float*)(wsb(args) + WS_MOD);
    const int jb = u % 24, kq = (u / 24) & 3, l = u / 96;
    const int k0 = kq * 256 + F.wave * 32;
    const float* W = w_ada + ((size_t)l * D + k0) * 6144 + jb * 256 + F.lane * 4;
    f32x4 acc[5];
#pragma unroll
    for (int q = 0; q < 5; ++q) acc[q] = (f32x4){0.f, 0.f, 0.f, 0.f};
    for (int i0 = 0; i0 < 32; i0 += 16) {
        f32x4 w[16];
#pragma unroll
        for (int i = 0; i < 16; ++i) w[i] = G_LD4(W + (size_t)(i0 + i) * 6144);
#pragma unroll
        for (int i = 0; i < 16; ++i) { const int k = k0 + i0 + i;
            acc[0] += silu_f(c_ctx[k]) * w[i];
#pragma unroll
            for (int b = 0; b < 4; ++b) acc[1 + b] += silu_f(cc[b * D + k]) * w[i]; }
    }
    LAS f32x4* red = (LAS f32x4*)(F.lds + RING_OFF);
#pragma unroll
    for (int q = 0; q < 5; ++q) red[(F.wave * 5 + q) * 64 + F.lane] = acc[q];
    __syncthreads();
    const LAS float* redf = (const LAS float*)red;
    for (int o = F.tid; o < 5 * 256; o += NWAVES * 64) { const int q = o >> 8, c = o & 255;
        float s = 0.f;
#pragma unroll
        for (int w = 0; w < NWAVES; ++w) s += redf[(w * 5 + q) * 256 + c];
        if (kq == 0) s += inp(args, I_BADA)[l * 6144 + jb * 256 + c];
        atomicAdd(MOD + (size_t)(l * 5 + q) * 6144 + jb * 256 + c, s * F.scale); }
    __syncthreads();
}
constexpr int PI_QKV = (D / 64) * (NQKV / 32), PI_FIRST = PI_QKV;
constexpr int PI_CACHE = 4096, PI_WSP = 512, PI_O = (D / 64) * (D / 32), PI_IN = (D / 64) * (GE2 / 32), PI_OUT = (GE / 64) * (D / 32), PI_UP = (D / 64) * (FF2 / 32), PI_DN = (FF / 64) * (D / 32);
constexpr int PI_SECOND = PI_FIRST + PI_CACHE + PI_WSP + PI_O + PI_UP + PI_DN, PI_ALL = PI_SECOND + PI_UP + PI_DN + PI_IN + PI_OUT;
__device__ __forceinline__ void p0_transpose_seg(const float* W, int K, int N, bf16* WT, bool upperm, LAS float* scr, int it, int end, int stride, int lane) {
    if (it >= end) return;
    const int nblk = N / 32;
    f32x4 v[8];
    { const int k0 = 64 * (it / nblk), n0 = 32 * (it % nblk);
#pragma unroll
      for (int i = 0; i < 8; ++i) v[i] = G_LD4(W + (size_t)(k0 + 8 * i + (lane >> 3)) * N + n0 + 4 * (lane & 7)); }
    for (; it < end; it += stride) {
        const int k0 = 64 * (it / nblk), n0 = 32 * (it % nblk), nm0 = upperm ? upmap(n0) : n0;
#pragma unroll
        for (int i = 0; i < 8; ++i) { LAS float* d = scr + (8 * i + (lane >> 3)) * 33 + 4 * (lane & 7); d[0] = v[i].x; d[1] = v[i].y; d[2] = v[i].z; d[3] = v[i].w; }
        const int itn = it + stride;
        if (itn < end) { const int k1 = 64 * (itn / nblk), n1 = 32 * (itn % nblk);
#pragma unroll
            for (int i = 0; i < 8; ++i) v[i] = G_LD4(W + (size_t)(k1 + 8 * i + (lane >> 3)) * N + n1 + 4 * (lane & 7)); }
        LDS_WAIT(); asm volatile("" ::: "memory");
        const int c = lane & 7;
#pragma unroll
        for (int j = 0; j < 4; ++j) { const int n = (lane >> 3) + 8 * j; const LAS float* s = scr + (8 * c) * 33 + n;
            u32x4 o; o.x = cvt_pk_bf16(s[0 * 33], s[1 * 33]); o.y = cvt_pk_bf16(s[2 * 33], s[3 * 33]); o.z = cvt_pk_bf16(s[4 * 33], s[5 * 33]); o.w = cvt_pk_bf16(s[6 * 33], s[7 * 33]);
            G_STU4(WT + (size_t)(nm0 + n) * K + k0 + 8 * c, o); }
        LDS_WAIT(); asm volatile("" ::: "memory");
    }
}
__device__ __forceinline__ void p0_cache_seg(const Args& args, int it, int end, int stride, int lane) {
    if (it >= end) return;
    f32x4 a[4];
    { const int which = it >> 11, r = it & 2047, cg = r & 31, h = (r >> 5) & 15, b = r >> 9;
      const float* s = inp(args, which ? I_CV : I_CK) + (((size_t)b * NH + h) * PAST + cg * 16 + (lane >> 2)) * HD + (lane & 3) * 16;
#pragma unroll
      for (int i = 0; i < 4; ++i) a[i] = G_LD4(s + 4 * i); }
    for (; it < end; it += stride) {
        const int which = it >> 11, r = it & 2047, cg = r & 31, h = (r >> 5) & 15, b = r >> 9;
        bf16* d = (bf16*)(wsb(args) + (which ? WS_CV : WS_CK)) + ((size_t)b * PAST + cg * 16 + (lane >> 2)) * D + h * HD + (lane & 3) * 16;
        const u32x4 o0 = pack8(a[0], a[1]), o1 = pack8(a[2], a[3]);
        const int itn = it + stride;
        if (itn < end) { const int w1 = itn >> 11, r1 = itn & 2047, cg1 = r1 & 31, h1 = (r1 >> 5) & 15, b1 = r1 >> 9;
            const float* s = inp(args, w1 ? I_CV : I_CK) + (((size_t)b1 * NH + h1) * PAST + cg1 * 16 + (lane >> 2)) * HD + (lane & 3) * 16;
#pragma unroll
            for (int i = 0; i < 4; ++i) a[i] = G_LD4(s + 4 * i); }
        G_STU4(d, o0); G_STU4(d + 8, o1);
    }
}
__device__ __forceinline__ int first_from(int start, int stride, int s0) { return start >= s0 ? start : start + (s0 - start + stride - 1) / stride * stride; }
__device__ __forceinline__ void p0_items(const Frame& F, const Args& args, int lo, int hi, int fw, int nfw) {
    LAS float* scr = (LAS float*)(F.lds + RING_OFF + F.wave * 16384);
    unsigned char* ws = wsb(args);
    int base = 0;
#define P0_SEG(n, s0v, itv, endv) const int s0v = base; base += (n); const int endv = (hi < base ? hi : base) - s0v, itv = first_from(lo + fw, nfw, s0v) - s0v;
    { P0_SEG(PI_QKV, s0, it, end) p0_transpose_seg(inp(args, I_WQKV), D, NQKV, (bf16*)(ws + WS_WQKV), false, scr, it, end, nfw, F.lane); }
    if (hi <= base) return;
    { P0_SEG(PI_CACHE, s0, it, end) p0_cache_seg(args, it, end, nfw, F.lane); }
    { P0_SEG(PI_WSP, s0, it, end) for (int r = it; r < end; r += nfw) { const float* s = inp(args, I_WSP) + (size_t)r * 512 + F.lane * 8; const f32x4 a0 = *(const f32x4*)s, a1 = *(const f32x4*)(s + 4); *(u32x4*)((bf16*)(ws + WS_WSB) + (size_t)r * 512 + F.lane * 8) = pack8(a0, a1); } }
    { P0_SEG(PI_O, s0, it, end) p0_transpose_seg(inp(args, I_WO), D, D, (bf16*)(ws + WS_WO), false, scr, it, end, nfw, F.lane); }
    { P0_SEG(PI_UP, s0, it, end) p0_transpose_seg(inp(args, I_WUP), D, FF2, (bf16*)(ws + WS_WUP), true, scr, it, end, nfw, F.lane); }
    { P0_SEG(PI_DN, s0, it, end) p0_transpose_seg(inp(args, I_WDN), FF, D, (bf16*)(ws + WS_WDN), false, scr, it, end, nfw, F.lane); }
    if (hi <= base) return;
    { P0_SEG(PI_UP, s0, it, end) p0_transpose_seg(inp(args, I_WUP) + (size_t)D * FF2, D, FF2, (bf16*)(ws + WS_WUP) + (size_t)FF2 * D, true, scr, it, end, nfw, F.lane); }
    { P0_SEG(PI_DN, s0, it, end) p0_transpose_seg(inp(args, I_WDN) + (size_t)FF * D, FF, D, (bf16*)(ws + WS_WDN) + (size_t)D * FF, false, scr, it, end, nfw, F.lane); }
    { P0_SEG(PI_IN, s0, it, end) p0_transpose_seg(inp(args, I_WIN), D, GE2, (bf16*)(ws + WS_WIN), false, scr, it, end, nfw, F.lane); }
    { P0_SEG(PI_OUT, s0, it, end) p0_transpose_seg(inp(args, I_WOUT), GE, D, (bf16*)(ws + WS_WOUT), false, scr, it, end, nfw, F.lane); }
#undef P0_SEG
}
constexpr int ST_ITEMS = 2 * 32 * NH * (SEQ_C / 16);
__device__ __forceinline__ void state_items(const Frame& F, const Args& args, int fw, int nfw) {
    unsigned char* ws = wsb(args); float* out = outb(args);
    for (int it = fw; it < ST_ITEMS; it += nfw) {
        const int tg = it & 15, h = (it >> 4) & 15, b = (it >> 8) & 31, which = it >> 13;
        const bf16* src = (const bf16*)(ws + (which ? WS_VC : WS_KC)) + (size_t)(b * SEQ_C + tg * 16 + (F.lane >> 2)) * D + h * HD + (F.lane & 3) * 16;
        const u32x4 w0 = G_LDU4(src), w1 = G_LDU4(src + 8);
        float* dst = out + (size_t)MT * D + (size_t)which * NCTX * D + (((size_t)b * NH + h) * SEQ_C + tg * 16 + (F.lane >> 2)) * HD + (F.lane & 3) * 16;
        f32x4 o0, o1, o2, o3;
        o0.x = bflo(w0.x); o0.y = bfhi(w0.x); o0.z = bflo(w0.y); o0.w = bfhi(w0.y); o1.x = bflo(w0.z); o1.y = bfhi(w0.z); o1.z = bflo(w0.w); o1.w = bfhi(w0.w);
        o2.x = bflo(w1.x); o2.y = bfhi(w1.x); o2.z = bflo(w1.y); o2.w = bfhi(w1.y); o3.x = bflo(w1.z); o3.y = bfhi(w1.z); o3.z = bflo(w1.w); o3.w = bfhi(w1.w);
        G_ST4(dst, o0); G_ST4(dst + 4, o1); G_ST4(dst + 8, o2); G_ST4(dst + 12, o3);
    }
}
__device__ __forceinline__ bool filler_slot(const Frame& F, int nunits, int& fw, int& nfw) {
    const int rem = nunits % F.G, first = rem, nblk = F.G - rem;
    if (F.bid < first) return false;
    fw = (F.bid - first) * NWAVES + F.wave; nfw = nblk * NWAVES; return true;
}

__device__ __forceinline__ void p1_rows(const Frame& F, const Args& args, const int gw, const int nbusy) {
    const int NGW = F.G * NWAVES, lane = F.lane;
    const float* xp = inp(args, I_XP); const float* xs = inp(args, I_XS); const float* gmix = inp(args, I_NMIX);
    unsigned char* ws = wsb(args);
    const float* MOD = (const float*)(ws + WS_MOD); float* RS = (float*)(ws + WS_RS); bf16* AN = (bf16*)(ws + WS_AN);
    const int nshort = NGW > 2 * nbusy ? nbusy : 0; const bool busy = gw < nshort;
    int m = busy ? gw : 3 * nshort + (gw - nshort); const int mstep = busy ? nshort : NGW - nshort, mend = busy ? 3 * nshort : MT;
    f32x4 g[4], v[4];
#pragma unroll
    for (int j = 0; j < 4; ++j) g[j] = G_LD4(gmix + 4 * lane + 256 * j);
    if (m < mend) { const float* xr = (m < NCTX) ? xp + (size_t)m * D : xs + (size_t)(m - NCTX) * D;
#pragma unroll
        for (int j = 0; j < 4; ++j) v[j] = G_LD4((const f32x4*)xr + lane + 64 * j); }
    for (; m < mend; m += mstep) {
        const float* sc = MOD + (size_t)ci_of(m) * 6144 + 1024;
        f32x4 cs[4], vn[4];
#pragma unroll
        for (int j = 0; j < 4; ++j) cs[j] = G_LD4(sc + 4 * lane + 256 * j);
        const int mn = m + mstep;
        if (mn < mend) { const float* xr = (mn < NCTX) ? xp + (size_t)mn * D : xs + (size_t)(mn - NCTX) * D;
#pragma unroll
            for (int j = 0; j < 4; ++j) vn[j] = G_LD4((const f32x4*)xr + lane + 64 * j); }
        float s = 0.f;
#pragma unroll
        for (int j = 0; j < 4; ++j) s += (v[j].x * v[j].x + v[j].y * v[j].y) + (v[j].z * v[j].z + v[j].w * v[j].w);
        s = wave_sum(s);
        if (lane == 0) G_ST4(RS + (size_t)m * 4, ((f32x4){s, 0.f, 0.f, 0.f}));
#pragma unroll
        for (int j = 0; j < 4; ++j) { const int col = 4 * lane + 256 * j;
            const f32x4 o = v[j] * g[j] * (1.f + cs[j]);
            u32x2 w; w.x = cvt_pk_bf16(o[0], o[1]); w.y = cvt_pk_bf16(o[2], o[3]);
            *(GAS u32x2*)(AN + (size_t)m * D + col) = w; }
#pragma unroll
        for (int j = 0; j < 4; ++j) v[j] = vn[j];
    }
}
namespace pg8 {
#define PG8_LAS __attribute__((address_space(3)))
typedef unsigned short bf16_t;
typedef short bf16x8 __attribute__((ext_vector_type(8)));
typedef float f32x4 __attribute__((ext_vector_type(4)));
typedef unsigned u32x4 __attribute__((ext_vector_type(4)));
constexpr int BM = 256, BK = 64, HALF = 128, HTB = HALF * BK * 2  , STAGE_BYTES = 8 * HTB, NXCD = 8, WGM = 8;

__host__ __device__ __forceinline__ int lds_byte(int r, int c) { const int st = (r >> 4) * 2 + (c >> 5), rr = r & 15, cc = c & 31, ob = rr * 64 + cc * 2; return st * 1024 + (ob ^ (((ob >> 9) & 1) << 5)); }
__host__ __device__ __forceinline__ void stage_rc(int b, int& R, int& C) { const int st = b / 1024, sb = b % 1024, swz = sb ^ (((sb >> 9) & 1) << 5); R = (st >> 1) * 16 + swz / 64; C = (st & 1) * 32 + (swz % 64) / 2; }
__host__ __device__ __forceinline__ int perm32(int rho) { const int n = rho >> 4, i = rho & 15; return 8 * (i >> 2) + 4 * n + (i & 3); }

struct Unit { int pm, pn; };
struct Gemm { const bf16_t* A; const bf16_t* Bt; int M, N, K; };

struct StaticOrder {
    int nM, nN, nwg, G, c;
    __host__ __device__ void init(int M, int N, int G_, int c_, int bmr = BM) { nM = M / bmr; nN = N / BM; nwg = nM * nN; G = G_; c = c_; }
    __host__ __device__ bool next(int i, Unit& u) const {
        const long L = (long)i * G + c; if (L >= nwg) return false;
        int wgid = (int)L; { const int q = nwg / NXCD, r = nwg % NXCD, xcd = wgid % NXCD, off = wgid / NXCD; wgid = (xcd < r ? xcd * (q + 1) : r * (q + 1) + (xcd - r) * q) + off; }
        const int nig = WGM * nN, gid = wgid / nig, fm = gid * WGM, gsz = (nM - fm) < WGM ? (nM - fm) : WGM;
        u.pm = fm + ((wgid % nig) % gsz); u.pn = (wgid % nig) / gsz; return true;
    }
    __device__ __forceinline__ void a_ready(const Unit&) const {}
    __device__ __forceinline__ void done(const Unit&) const {}
};

template <class E> struct epi_is_final { static constexpr bool value = false; };
template <class E, int NRED, int MB = 4> struct EpiAdapt {
    static constexpr bool PERM = true, AFTER_DRAIN = false, HAS_UPF = E::HAS_LIN; static constexpr int BMR = 64 * MB;
    static constexpr int STL_OFF = 2560;
    __device__ __forceinline__ void unit_prefetch(const Unit& u, int wid, int lane) const {
        if constexpr (E::HAS_LIN) {
            if (wid < 4) __builtin_amdgcn_global_load_lds((const unsigned*)(e.L.RS + (size_t)(row0 + u.pm * BMR + wid * 64 + lane) * 4), (PG8_LAS unsigned*)(P + STL_OFF + wid * 256), 16, 0, 0);
            else if (wid == 4) __builtin_amdgcn_global_load_lds((const unsigned*)(e.L.SW + (size_t)ci_of(row0 + u.pm * BMR) * e.L.N + u.pn * BM + lane * 4), (PG8_LAS unsigned*)(P + STL_OFF + 1024), 16, 0, 0);
        }
    }
    __device__ __forceinline__ void fused(f32x4 (&acc)[2][2][MB][2], const Unit& u, int wr, int wc, int fr, int fq, PG8_LAS unsigned char*, int, int) const { (*this)(acc, u, wr, wc, fr, fq); }
    E e; int row0; PG8_LAS float* P; bool skip;
    __device__ __forceinline__ void operator()(f32x4 (&acc)[2][2][MB][2], const Unit& u, int wr, int wc, int fr, int fq) const {
        if (skip) return;
        asm volatile("" : "+v"(fr), "+v"(fq));
        const int rl = wr * 16 * MB + fr, rbase = row0 + u.pm * BMR + rl, cbase = u.pn * BM + wc * 32 + 8 * fq;
        float red[2][MB][NRED > 0 ? NRED : 1];
#pragma unroll
        for (int ai = 0; ai < 2; ++ai)
#pragma unroll
            for (int m = 0; m < MB; ++m)
#pragma unroll
                for (int k = 0; k < (NRED > 0 ? NRED : 1); ++k) red[ai][m][k] = 0.f;
        if constexpr (E::HAS_LIN) {
            static_assert(MB == 4, "HAS_LIN epilogues run on 256-row tiles");
            f32x4 p[2][MB], sw[2][2];
#pragma unroll
            for (int ai = 0; ai < 2; ++ai)
#pragma unroll
                for (int m = 0; m < MB; ++m) p[ai][m] = *(const PG8_LAS f32x4*)(P + STL_OFF + (rl + ai * (BMR / 2) + m * 16) * 4);
            { const PG8_LAS float* s = P + STL_OFF + 1024 + wc * 32 + 8 * fq;
#pragma unroll
              for (int bj = 0; bj < 2; ++bj) { sw[bj][0] = *(const PG8_LAS f32x4*)(s + bj * HALF); sw[bj][1] = *(const PG8_LAS f32x4*)(s + bj * HALF + 4); } }
            asm volatile("s_waitcnt lgkmcnt(0)" ::: "memory"); __builtin_amdgcn_s_barrier(); asm volatile("" ::: "memory");
#pragma unroll
            for (int ai = 0; ai < 2; ++ai)
#pragma unroll
                for (int m = 0; m < MB; ++m) { const f32x4 q = p[ai][m];
                    const float r = __builtin_amdgcn_rsqf(((q.x + q.y) + (q.z + q.w)) * (1.f / D) + EPS);
#pragma unroll
                    for (int bj = 0; bj < 2; ++bj) e.post(rbase + ai * (BMR / 2) + m * 16, cbase + bj * HALF, acc[ai][bj][m][0] * r + sw[bj][0], acc[ai][bj][m][1] * r + sw[bj][1], red[ai][m]); }
        } else if constexpr (E::HAS_PRE) {
            PG8_LAS float* ST = P + 2048;
            const int ci_lo = ci_of(row0 + u.pm * BMR), ci_hi = ci_of(row0 + u.pm * BMR + BMR - 1);
            { const int t = (wr * 4 + wc) * 64 + fq * 16 + fr;
              float sv[2];
#pragma unroll
              for (int k = 0; k < 2; ++k) { const int idx = t + 512 * k; sv[k] = e.stage_val(idx >> 9, ((idx >> 8) & 1) ? ci_hi : ci_lo, u.pn * BM + (idx & 255)); }
#pragma unroll
              for (int k = 0; k < 2; ++k) ST[t + 512 * k] = sv[k]; }
#define PG8_STP(row, col) (ST + (ci_of(row) != ci_lo ? 256 : 0) + ((col) - u.pn * BM))
            if constexpr (E::PRE_HALVES) {
#pragma unroll
                for (int ai = 0; ai < 2; ++ai) {
                    typename E::Pre pre[MB][2];
#pragma unroll
                    for (int m = 0; m < MB; ++m)
#pragma unroll
                        for (int bj = 0; bj < 2; ++bj) pre[m][bj] = e.prefetch(rbase + ai * (BMR / 2) + m * 16, cbase + bj * HALF);
                    __builtin_amdgcn_sched_barrier(0);
                    if (ai == 0) { asm volatile("s_waitcnt lgkmcnt(0)" ::: "memory"); __builtin_amdgcn_s_barrier(); asm volatile("" ::: "memory"); }
#pragma unroll
                    for (int m = 0; m < MB; ++m)
#pragma unroll
                        for (int bj = 0; bj < 2; ++bj) e.apply_pre(rbase + ai * (BMR / 2) + m * 16, cbase + bj * HALF, acc[ai][bj][m][0], acc[ai][bj][m][1], red[ai][m], pre[m][bj], PG8_STP(rbase + ai * (BMR / 2) + m * 16, cbase + bj * HALF));
                    __builtin_amdgcn_sched_barrier(0); }
            } else {
            typename E::Pre pre[2][MB][2];
#pragma unroll
            for (int ai = 0; ai < 2; ++ai)
#pragma unroll
                for (int m = 0; m < MB; ++m)
#pragma unroll
                    for (int bj = 0; bj < 2; ++bj) pre[ai][m][bj] = e.prefetch(rbase + ai * (BMR / 2) + m * 16, cbase + bj * HALF);
            __builtin_amdgcn_sched_barrier(0);
            asm volatile("s_waitcnt lgkmcnt(0)" ::: "memory"); __builtin_amdgcn_s_barrier(); asm volatile("" ::: "memory");
#pragma unroll
            for (int ai = 0; ai < 2; ++ai)
#pragma unroll
                for (int m = 0; m < MB; ++m)
#pragma unroll
                    for (int bj = 0; bj < 2; ++bj) e.apply_pre(rbase + ai * (BMR / 2) + m * 16, cbase + bj * HALF, acc[ai][bj][m][0], acc[ai][bj][m][1], red[ai][m], pre[ai][m][bj], PG8_STP(rbase + ai * (BMR / 2) + m * 16, cbase + bj * HALF));
            }
        } else {
#pragma unroll
        for (int ai = 0; ai < 2; ++ai)
#pragma unroll
            for (int m = 0; m < MB; ++m)
#pragma unroll
                for (int bj = 0; bj < 2; ++bj) e.apply(rbase + ai * (BMR / 2) + m * 16, cbase + bj * HALF, acc[ai][bj][m][0], acc[ai][bj][m][1], red[ai][m]);
        }
        if constexpr (NRED > 0) {
            if (e.want_red(u.pn)) {
#pragma unroll
                for (int ai = 0; ai < 2; ++ai)
#pragma unroll
                    for (int m = 0; m < MB; ++m)
#pragma unroll
                        for (int k = 0; k < NRED; ++k) { float s = red[ai][m][k]; s += __shfl_xor(s, 16); s += __shfl_xor(s, 32); if (fq == 0) P[((ai * (BMR / 2) + rl + m * 16) * 4 + wc) * 2 + k] = s; }
                asm volatile("s_waitcnt lgkmcnt(0)" ::: "memory"); __builtin_amdgcn_s_barrier(); asm volatile("" ::: "memory");
                const int t = (wr * 4 + wc) * 64 + fq * 16 + fr;
                if (t < BMR) { float r[NRED];
#pragma unroll
                    for (int k = 0; k < NRED; ++k) r[k] = (P[(t * 4 + 0) * 2 + k] + P[(t * 4 + 1) * 2 + k]) + (P[(t * 4 + 2) * 2 + k] + P[(t * 4 + 3) * 2 + k]);
                    e.store_red(row0 + u.pm * BMR + t, u.pn, r); }
                if constexpr (epi_is_final<E>::value) {
                    wave_publish(e.cnt + 64 * u.pm);
                    if (wr == 0 && wc == 0) { wave_wait_ge(e.cnt + 64 * u.pm, 4 * 8, e.tmo); __builtin_amdgcn_fence(__ATOMIC_ACQUIRE, "agent"); }
                    asm volatile("s_waitcnt vmcnt(0) lgkmcnt(0)" ::: "memory"); __builtin_amdgcn_s_barrier(); asm volatile("" ::: "memory");
                    if (t < BMR) P[t] = e.row_scale(row0 + u.pm * BMR + t);
                    asm volatile("s_waitcnt lgkmcnt(0)" ::: "memory"); __builtin_amdgcn_s_barrier(); asm volatile("" ::: "memory");
                    f32x4 xq[2][MB][2][2], gf[2][2];
#pragma unroll
                    for (int bj = 0; bj < 2; ++bj) { gf[bj][0] = G_LD4(e.gfin + cbase + bj * HALF); gf[bj][1] = G_LD4(e.gfin + cbase + bj * HALF + 4); }
#pragma unroll
                    for (int ai = 0; ai < 2; ++ai)
#pragma unroll
                        for (int m = 0; m < MB; ++m)
#pragma unroll
                            for (int bj = 0; bj < 2; ++bj) { const float* o = e.Y + (size_t)(rbase + ai * (BMR / 2) + m * 16) * D + cbase + bj * HALF; xq[ai][m][bj][0] = G_LD4(o); xq[ai][m][bj][1] = G_LD4(o + 4); }
                    __builtin_amdgcn_sched_barrier(0);
#pragma unroll
                    for (int ai = 0; ai < 2; ++ai)
#pragma unroll
                        for (int m = 0; m < MB; ++m) { const float rs = P[ai * (BMR / 2) + rl + m * 16];
#pragma unroll
                            for (int bj = 0; bj < 2; ++bj) { float* o = e.Y + (size_t)(rbase + ai * (BMR / 2) + m * 16) * D + cbase + bj * HALF;
                                G_ST4(o, xq[ai][m][bj][0] * rs * gf[bj][0]); G_ST4(o + 4, xq[ai][m][bj][1] * rs * gf[bj][1]); } }
                }
            }
        }
    }
};
template <class Epi, class Sched, bool ALIGN_EPI = false, bool SP2 = false, int MB = 4>
__device__ __forceinline__ void gemm_phase(PG8_LAS unsigned char* lds, const Gemm g, const Sched& S, const Epi& E, const int tid) {
    const int wid = __builtin_amdgcn_readfirstlane(tid >> 6), lane = tid & 63, wr = wid >> 2, wc = wid & 3, fr = lane & 15, fq = lane >> 4;
    const int K = g.K, nt = K / BK;
    unsigned voffA[2], voffB[2];
#pragma unroll
    for (int i = 0; i < 2; ++i) { int R, C; stage_rc(tid * 16 + i * 8192, R, C); const int Rb = Epi::PERM ? ((R & ~31) + perm32(R & 31)) : R;
        voffA[i] = (unsigned)((R < 32 * MB ? R : 0) * K + C) * 2u; voffB[i] = (unsigned)(Rb * K + C) * 2u; }
    const size_t kstep = (size_t)(BK * 2);
    const size_t hstep = (size_t)HALF * K * 2;
    const size_t tstep = 2 * hstep;
    const size_t hstepA = (size_t)(32 * MB) * K * 2, tstepA = 2 * hstepA;
    const unsigned ldsw = (unsigned)wid * 1024u;
    const int aoff = lds_byte(wr * 16 * MB + fr, fq * 8), boff = lds_byte(wc * 32 + fr, fq * 8);
#define PG8_SA(b, h) (((b) * 2 + (h)) * HTB)
#define PG8_SB(b, h) ((4 + (b) * 2 + (h)) * HTB)
#define PG8_STAGE(bufoff, gbase, voff) do { _Pragma("unroll") for (int _i = 0; _i < 2; ++_i) \
        __builtin_amdgcn_global_load_lds((const unsigned*)((const char*)(gbase) + (voff)[_i]), (PG8_LAS unsigned*)(lds + (bufoff) + ldsw + _i * 8192), 16, 0, 0); } while (0)
#define PG8_LDA(dst, b, h) do { _Pragma("unroll") for (int m = 0; m < MB; ++m) _Pragma("unroll") for (int k = 0; k < 2; ++k) dst[m][k] = *(const PG8_LAS bf16x8*)(lds + PG8_SA(b, h) + aoff + m * 2048 + k * 1024); } while (0)
#define PG8_LDB(dst, b, h) do { _Pragma("unroll") for (int n = 0; n < 2; ++n) _Pragma("unroll") for (int k = 0; k < 2; ++k) dst[n][k] = *(const PG8_LAS bf16x8*)(lds + PG8_SB(b, h) + boff + n * 2048 + k * 1024); } while (0)
#define PG8_MMA(ai, bj, At, Bt) do { __builtin_amdgcn_s_setprio(1); _Pragma("unroll") for (int m = 0; m < MB; ++m) _Pragma("unroll") for (int n = 0; n < 2; ++n) _Pragma("unroll") for (int k = 0; k < 2; ++k) \
        acc[ai][bj][m][n] = __builtin_amdgcn_mfma_f32_16x16x32_bf16(Bt[n][k], At[m][k], acc[ai][bj][m][n], 0, 0, 0); __builtin_amdgcn_s_setprio(0); } while (0)
#define PG8_WAIT_V(n) asm volatile("s_waitcnt vmcnt(" #n ")" ::: "memory")
#define PG8_WAIT_L(n) asm volatile("s_waitcnt lgkmcnt(" #n ")" ::: "memory")
#define PG8_BAR __builtin_amdgcn_s_barrier()
#define PG8_SCHED __builtin_amdgcn_sched_barrier(0)
    Unit cur, nxt; int ui = 0;
    if (!S.next(0, cur)) return;
    f32x4 acc[2][2][MB][2];
#pragma unroll
    for (int a = 0; a < 2; ++a)
#pragma unroll
        for (int b = 0; b < 2; ++b)
#pragma unroll
            for (int m = 0; m < MB; ++m)
#pragma unroll
                for (int n = 0; n < 2; ++n) acc[a][b][m][n] = (f32x4){0.f, 0.f, 0.f, 0.f};
    bf16x8 At[MB][2], B0[2][2], B1[2][2];
    const char* cA = (const char*)g.A + (size_t)cur.pm * tstepA; const char* cB = (const char*)g.Bt + (size_t)cur.pn * tstep;
    S.a_ready(cur);
    if constexpr (SP2) {
        PG8_STAGE(PG8_SB(0, 0), cB, voffB); PG8_STAGE(PG8_SB(0, 1), cB + hstep, voffB); PG8_STAGE(PG8_SA(0, 0), cA, voffA); PG8_STAGE(PG8_SA(0, 1), cA + hstepA, voffA);
        if (wr == 1) PG8_BAR;
        PG8_WAIT_V(2); PG8_BAR;
        PG8_STAGE(PG8_SB(1, 0), cB + kstep, voffB); PG8_STAGE(PG8_SA(1, 0), cA + kstep, voffA); PG8_STAGE(PG8_SB(1, 1), cB + hstep + kstep, voffB);
        PG8_WAIT_V(6); PG8_BAR;
    } else {
        PG8_STAGE(PG8_SB(0, 0), cB, voffB); PG8_STAGE(PG8_SA(0, 0), cA, voffA); PG8_STAGE(PG8_SB(0, 1), cB + hstep, voffB); PG8_STAGE(PG8_SA(0, 1), cA + hstepA, voffA);
        if (wr == 1) PG8_BAR;
        PG8_WAIT_V(4); PG8_BAR;
        PG8_STAGE(PG8_SB(1, 0), cB + kstep, voffB); PG8_STAGE(PG8_SA(1, 0), cA + kstep, voffA); PG8_STAGE(PG8_SB(1, 1), cB + hstep + kstep, voffB);
        PG8_WAIT_V(6); PG8_BAR;
    }
    for (;;) {
        const bool has_next = S.next(ui + 1, nxt);
        const char* nA = has_next ? (const char*)g.A + (size_t)nxt.pm * tstepA : cA; const char* nB = has_next ? (const char*)g.Bt + (size_t)nxt.pn * tstep : cB;
        if constexpr (Epi::HAS_UPF) E.unit_prefetch(cur, wid, lane);
        for (int t = 0; t < nt; t += 2) {
            const bool last = (t == nt - 2);
            const char* a1 = cA + (size_t)(t + 1) * kstep;
            const char* a2 = last ? nA : cA + (size_t)(t + 2) * kstep; const char* b2 = last ? nB : cB + (size_t)(t + 2) * kstep;
            const char* a3 = a2 + kstep; const char* b3 = b2 + kstep;
            if (last && has_next) S.a_ready(nxt);
            if constexpr (SP2) {
            PG8_LDB(B0, 0, 0); PG8_LDB(B1, 0, 1); PG8_SCHED; PG8_LDA(At, 0, 0); PG8_STAGE(PG8_SA(1, 1), a1 + hstepA, voffA);
            PG8_WAIT_V(8); PG8_WAIT_L(0); PG8_BAR; PG8_MMA(0, 0, At, B0); PG8_MMA(0, 1, At, B1); PG8_BAR; PG8_SCHED;
            PG8_LDA(At, 0, 1); PG8_STAGE(PG8_SB(0, 0), b2, voffB); PG8_STAGE(PG8_SB(0, 1), b2 + hstep, voffB); PG8_STAGE(PG8_SA(0, 0), a2, voffA);
            PG8_WAIT_V(8); PG8_WAIT_L(0); PG8_BAR; PG8_MMA(1, 0, At, B0); PG8_MMA(1, 1, At, B1); PG8_BAR; PG8_SCHED;
            PG8_LDB(B0, 1, 0); PG8_LDB(B1, 1, 1); PG8_SCHED; PG8_LDA(At, 1, 0); PG8_STAGE(PG8_SA(0, 1), a2 + hstepA, voffA);
            PG8_WAIT_V(8); PG8_WAIT_L(0); PG8_BAR; PG8_MMA(0, 0, At, B0); PG8_MMA(0, 1, At, B1); PG8_BAR; PG8_SCHED;
            PG8_LDA(At, 1, 1); PG8_STAGE(PG8_SB(1, 0), b3, voffB); PG8_STAGE(PG8_SB(1, 1), b3 + hstep, voffB); PG8_STAGE(PG8_SA(1, 0), a3, voffA);
            PG8_WAIT_V(8); PG8_WAIT_L(0); PG8_BAR; PG8_MMA(1, 0, At, B0); PG8_MMA(1, 1, At, B1); PG8_BAR; PG8_SCHED;
            } else {
            PG8_LDB(B0, 0, 0); PG8_SCHED; PG8_LDA(At, 0, 0); PG8_STAGE(PG8_SA(1, 1), a1 + hstepA, voffA);
            PG8_WAIT_L(8); PG8_BAR; PG8_WAIT_L(0); PG8_MMA(0, 0, At, B0); PG8_BAR; PG8_SCHED;
            PG8_LDB(B1, 0, 1); PG8_STAGE(PG8_SB(0, 0), b2, voffB);
            PG8_BAR; PG8_WAIT_L(0); PG8_MMA(0, 1, At, B1); PG8_BAR;
            PG8_LDA(At, 0, 1); PG8_STAGE(PG8_SA(0, 0), a2, voffA);
            PG8_BAR; PG8_WAIT_L(0); PG8_MMA(1, 0, At, B0); PG8_BAR; PG8_SCHED;
            PG8_STAGE(PG8_SB(0, 1), b2 + hstep, voffB);
            PG8_WAIT_V(6); PG8_BAR; PG8_MMA(1, 1, At, B1); PG8_BAR;
            PG8_LDB(B0, 1, 0); PG8_SCHED; PG8_LDA(At, 1, 0); PG8_STAGE(PG8_SA(0, 1), a2 + hstepA, voffA);
            PG8_WAIT_L(8); PG8_BAR; PG8_WAIT_L(0); PG8_MMA(0, 0, At, B0); PG8_BAR; PG8_SCHED;
            PG8_LDB(B1, 1, 1); PG8_STAGE(PG8_SB(1, 0), b3, voffB);
            PG8_BAR; PG8_WAIT_L(0); PG8_MMA(0, 1, At, B1); PG8_BAR;
            PG8_LDA(At, 1, 1); PG8_STAGE(PG8_SA(1, 0), a3, voffA);
            PG8_BAR; PG8_WAIT_L(0); PG8_MMA(1, 0, At, B0); PG8_BAR; PG8_SCHED;
            PG8_STAGE(PG8_SB(1, 1), b3 + hstep, voffB);
            PG8_WAIT_V(6); PG8_BAR; PG8_MMA(1, 1, At, B1); PG8_BAR;
            }
        }
        if constexpr (ALIGN_EPI) { if (wr == 0) PG8_BAR; }
        if constexpr (!Epi::AFTER_DRAIN) { E(acc, cur, wr, wc, fr, fq); S.done(cur); }
        if (!has_next) break;
#pragma unroll
        for (int a = 0; a < 2; ++a)
#pragma unroll
            for (int b = 0; b < 2; ++b)
#pragma unroll
                for (int m = 0; m < 4; ++m)
#pragma unroll
                    for (int n = 0; n < 2; ++n) acc[a][b][m][n] = (f32x4){0.f, 0.f, 0.f, 0.f};
        cur = nxt; cA = nA; cB = nB; ++ui;
        if constexpr (ALIGN_EPI) { if (wr == 1) PG8_BAR; }
    }
    PG8_WAIT_V(0);
    if constexpr (!ALIGN_EPI) { if (wr == 0) PG8_BAR; }
    PG8_BAR;
    if constexpr (Epi::AFTER_DRAIN) { E.fused(acc, cur, wr, wc, fr, fq, lds, wid, lane); S.done(cur); }
#undef PG8_SA
#undef PG8_SB
#undef PG8_STAGE
#undef PG8_LDA
#undef PG8_LDB
#undef PG8_MMA
#undef PG8_WAIT_V
#undef PG8_WAIT_L
#undef PG8_BAR
#undef PG8_SCHED
}
}

__device__ __forceinline__ void p1_sw_item(const bf16* WT, int N, const float* shift  , float* out, int item, int lane, float scale) {
    const int fr = lane & 15, fq = lane >> 4, n0 = (item >> 2) * 64, kq = (item & 3) * 256;
    f32x4 acc[4];
#pragma unroll
    for (int j = 0; j < 4; ++j) acc[j] = (f32x4){0.f, 0.f, 0.f, 0.f};
    const float* sp = shift + (size_t)(fr < 5 ? fr : 0) * 6144 + kq + fq * 8;
    const bf16* bp = WT + (size_t)(n0 + 8 * (fr >> 2) + (fr & 3)) * D + kq + fq * 8;
#pragma unroll
    for (int k0 = 0; k0 < 256; k0 += 128) {
        bf16x8 a[4], b[4][4];
#pragma unroll
        for (int ks = 0; ks < 4; ++ks) { const f32x4 s0 = *(const f32x4*)(sp + k0 + 32 * ks), s1 = *(const f32x4*)(sp + k0 + 32 * ks + 4);
            a[ks] = __builtin_bit_cast(bf16x8, pack8(s0, s1));
#pragma unroll
            for (int nj = 0; nj < 4; ++nj) b[ks][nj] = *(const bf16x8*)(bp + (size_t)(32 * (nj >> 1) + 4 * (nj & 1)) * D + k0 + 32 * ks); }
#pragma unroll
        for (int ks = 0; ks < 4; ++ks)
#pragma unroll
            for (int nj = 0; nj < 4; ++nj) acc[nj] = __builtin_amdgcn_mfma_f32_16x16x32_bf16(b[ks][nj], a[ks], acc[nj], 0, 0, 0);
    }
    if (fr < 5) {
#pragma unroll
        for (int nj = 0; nj < 4; ++nj)
#pragma unroll
            for (int e = 0; e < 4; ++e) atomicAdd(out + (size_t)fr * N + n0 + 32 * (nj >> 1) + 8 * fq + 4 * (nj & 1) + e, acc[nj][e] * scale); }
}
constexpr int SWI_QKV = NQKV / 16, SWI_ALL = NQKV / 16 + FF2 / 16 + GE2 / 16 + FF2 / 16;
__device__ __forceinline__ void p1_sw_items(const Frame& F, const Args& args, int lo, int hi, int fw, int nfw) {
    unsigned char* ws = wsb(args); const float* MOD0 = (const float*)(ws + WS_MOD); const float* MOD1 = MOD0 + 5 * 6144; float* SW = (float*)(ws + WS_SW);
    constexpr int I0 = NQKV / 16, I1 = FF2 / 16, I2 = GE2 / 16;
    for (int it = lo + fw; it < hi; it += nfw) { int r = it;
        if (r < I0) { p1_sw_item((const bf16*)(ws + WS_WQKV), NQKV, MOD0 + 0, SW + SW_QKV, r, F.lane, F.scale); continue; } r -= I0;
        if (r < I1) { p1_sw_item((const bf16*)(ws + WS_WUP), FF2, MOD0 + 3072, SW + SW_UP0, r, F.lane, F.scale); continue; } r -= I1;
        if (r < I2) { p1_sw_item((const bf16*)(ws + WS_WIN), GE2, MOD1 + 0, SW + SW_IN, r, F.lane, F.scale); continue; } r -= I2;
        p1_sw_item((const bf16*)(ws + WS_WUP) + (size_t)FF2 * D, FF2, MOD1 + 3072, SW + SW_UP1, r, F.lane, F.scale); }
}

constexpr int SWU_IN = (GE2 / 256) * 4, SWU_ALL = SWU_IN + (FF2 / 256) * 4;
__device__ __forceinline__ void sw_unit_f32(const Frame& F, const float* W, int N, const float* shift  , float* out, bool upperm, int u) {
    const int nblk = N / 256, nb = u % nblk, kq = u / nblk;
    const int k0 = kq * 256 + F.wave * 32;
    const float* Wp = W + (size_t)k0 * N + nb * 256 + F.lane * 4;
    float sh[5];
#pragma unroll
    for (int q = 0; q < 5; ++q) sh[q] = *(GAS const float*)(shift + (size_t)q * 6144 + k0 + (F.lane & 31));
    f32x4 acc[5];
#pragma unroll
    for (int q = 0; q < 5; ++q) acc[q] = (f32x4){0.f, 0.f, 0.f, 0.f};
#pragma unroll
    for (int i0 = 0; i0 < 32; i0 += 16) {
        f32x4 w[16];
#pragma unroll
        for (int i = 0; i < 16; ++i) w[i] = G_LD4(Wp + (size_t)(i0 + i) * N);
#pragma unroll
        for (int i = 0; i < 16; ++i)
#pragma unroll
            for (int q = 0; q < 5; ++q) acc[q] += __builtin_bit_cast(float, __builtin_amdgcn_readlane(__builtin_bit_cast(int, sh[q]), i0 + i)) * w[i];
    }
    LAS f32x4* red = (LAS f32x4*)(F.lds + RING_OFF);
    __syncthreads();
#pragma unroll
    for (int q = 0; q < 5; ++q) red[(F.wave * 5 + q) * 64 + F.lane] = acc[q];
    __syncthreads();
    const LAS float* redf = (const LAS float*)red;
    for (int o = F.tid; o < 5 * 256; o += NWAVES * 64) { const int q = o >> 8, n = nb * 256 + (o & 255);
        float s = 0.f;
#pragma unroll
        for (int w = 0; w < NWAVES; ++w) s += redf[(w * 5 + q) * 256 + (o & 255)];
        atomicAdd(out + (size_t)q * N + (upperm ? upmap(n) : n), s * F.scale); }
    __syncthreads();
}
__device__ __forceinline__ void sw_units_f32(const Frame& F, const Args& args, int fb, int nfb) {
    const float* MOD1 = (const float*)(wsb(args) + WS_MOD) + 5 * 6144; float* SW = (float*)(wsb(args) + WS_SW);
    for (int u = fb; u < SWU_ALL; u += nfb) {
        if (u < SWU_IN) sw_unit_f32(F, inp(args, I_WIN), GE2, MOD1 + 0, SW + SW_IN, false, u);
        else sw_unit_f32(F, inp(args, I_WUP) + (size_t)D * FF2, FF2, MOD1 + 3072, SW + SW_UP1, true, u - SWU_IN); }
}

constexpr int EPI_OFF = 132096;
template <int NRED, class Epi, int MB = 4>
__device__ __forceinline__ void gemm_pg8(const Frame& F, const bf16* A, const bf16* Bt, int row0, int Mrows, int N, int K, const Epi& E) {
    pg8::Gemm g{A + (size_t)row0 * K, Bt, Mrows, N, K}; pg8::StaticOrder S; S.init(Mrows, N, F.G, F.bid, 64 * MB);
    pg8::EpiAdapt<Epi, NRED, MB> EA{E, row0, (LAS float*)(F.lds + EPI_OFF), F.skip_epi};
    pg8::gemm_phase<pg8::EpiAdapt<Epi, NRED, MB>, pg8::StaticOrder, true, true, MB>(F.lds + RING_OFF, g, S, EA, F.tid);
}


struct RowLin {
    const float* RS; const float* SW; int N;
};
struct EpiQKV { static constexpr bool HAS_PRE = false, HAS_LIN = true;
    RowLin L; unsigned char* ws;
    __device__ __forceinline__ void post(int row, int col, f32x4 v0, f32x4 v1, float*) const {
        const int which = col >> 10, cc = col & 1023;
        if (which == 0) { v0 = v0 * C2; v1 = v1 * C2; }
        const size_t off = which == 0 ? WS_Q : (row < NCTX ? (which == 1 ? WS_KC : WS_VC) : (which == 1 ? WS_K : WS_V));
        G_STU4((bf16*)(ws + off) + (size_t)row * D + cc, pack8(v0, v1));
    }
};
template <int MODE> struct EpiResT {
    const float *base_c, *base_l; bf16* XB; float* Xout; const float* gate; bf16* AN; const float* gn; const float* scn; float* RSout; float gs;
    static constexpr bool HAS_PRE = true, HAS_LIN = false, PRE_HALVES = false;
    struct PreB { u32x4 w; }; struct PreF { f32x4 b0, b1; };
    typedef typename std::conditional<MODE != 0, PreB, PreF>::type Pre;
    __device__ __forceinline__ Pre prefetch(int row, int col) const { Pre p;
        if constexpr (MODE != 0) p.w = G_LDU4(XB + (size_t)row * D + col);
        else { const float* bp = (row < NCTX ? base_c + (size_t)row * D : base_l + (size_t)(row - NCTX) * D) + col; p.b0 = G_LD4(bp); p.b1 = G_LD4(bp + 4); }
        return p; }
    __device__ __forceinline__ float stage_val(int kind, int ci, int col) const {
        return kind == 0 ? *(GAS const float*)(gate + (size_t)ci * 6144 + col) : *(GAS const float*)(gn + col) * (1.f + *(GAS const float*)(scn + (size_t)ci * 6144 + col)); }
    __device__ __forceinline__ void apply_pre(int row, int col, f32x4 v0, f32x4 v1, float* red, const Pre& p, const LAS float* st) const {
        f32x4 b0, b1;
        if constexpr (MODE != 0) { const u32x4 w = p.w; b0 = (f32x4){bflo(w.x), bfhi(w.x), bflo(w.y), bfhi(w.y)}; b1 = (f32x4){bflo(w.z), bfhi(w.z), bflo(w.w), bfhi(w.w)}; }
        else { b0 = p.b0; b1 = p.b1; }
        const f32x4 x0 = b0 + *(const LAS f32x4*)st * (v0 * gs), x1 = b1 + *(const LAS f32x4*)(st + 4) * (v1 * gs);
        if (MODE != 2) G_STU4(XB + (size_t)row * D + col, pack8(x0, x1));
        else { float* xo = Xout + (size_t)row * D + col; G_ST4(xo, x0); G_ST4(xo + 4, x1); }
        if (MODE != 2) { red[0] += ((x0.x * x0.x + x0.y * x0.y) + (x0.z * x0.z + x0.w * x0.w)) + ((x1.x * x1.x + x1.y * x1.y) + (x1.z * x1.z + x1.w * x1.w));
            const f32x4 a0 = x0 * *(const LAS f32x4*)(st + 512), a1 = x1 * *(const LAS f32x4*)(st + 516);
            G_STU4(AN + (size_t)row * D + col, pack8(a0, a1)); }
    }
    __device__ __forceinline__ bool want_red(int) const { return MODE != 2; }
    __device__ __forceinline__ void store_red(int row, int pn, const float* r) const { RSout[(size_t)row * 4 + pn] = r[0]; }
};
struct EpiFinal {
    const bf16* XB; float* Y; const float* gate; const float* gfin; float* RS4; unsigned* cnt; unsigned* tmo; float gs;
    static constexpr bool HAS_PRE = true, HAS_LIN = false, PRE_HALVES = false;
    struct Pre { u32x4 w; };
    __device__ __forceinline__ Pre prefetch(int row, int col) const { Pre p; p.w = G_LDU4(XB + (size_t)row * D + col); return p; }
    __device__ __forceinline__ float stage_val(int kind, int ci, int col) const { return kind == 0 ? *(GAS const float*)(gate + (size_t)ci * 6144 + col) : 0.f; }
    __device__ __forceinline__ void apply_pre(int row, int col, f32x4 v0, f32x4 v1, float* red, const Pre& p, const LAS float* st) const {
        const u32x4 w = p.w;
        v0 = (f32x4){bflo(w.x), bfhi(w.x), bflo(w.y), bfhi(w.y)} + *(const LAS f32x4*)st * (v0 * gs); v1 = (f32x4){bflo(w.z), bfhi(w.z), bflo(w.w), bfhi(w.w)} + *(const LAS f32x4*)(st + 4) * (v1 * gs);
        float* o = Y + (size_t)row * D + col; G_ST4(o, v0); G_ST4(o + 4, v1);
        red[0] += ((v0.x * v0.x + v0.y * v0.y) + (v0.z * v0.z + v0.w * v0.w)) + ((v1.x * v1.x + v1.y * v1.y) + (v1.z * v1.z + v1.w * v1.w));
    }
    __device__ __forceinline__ bool want_red(int) const { return true; }
    __device__ __forceinline__ void store_red(int row, int pn, const float* r) const { st4f_wt(RS4 + (size_t)row * 4 + pn, r[0]); }
    __device__ __forceinline__ float row_scale(int row) const { const f32x4 p = G_LD4(RS4 + (size_t)row * 4); return __builtin_amdgcn_rsqf(((p.x + p.y) + (p.z + p.w)) * (1.f / D) + EPS); }
};
namespace pg8 { template <> struct epi_is_final<EpiFinal> { static constexpr bool value = true; }; }
struct EpiIn { static constexpr bool HAS_PRE = false, HAS_LIN = true;
    RowLin L; bf16 *U, *VV; float* LNP;
    __device__ __forceinline__ void post(int row, int col, f32x4 v0, f32x4 v1, float* red) const {
#pragma unroll
        for (int e = 0; e < 4; ++e) { v0[e] = gelu_tanh_f(v0[e]); v1[e] = gelu_tanh_f(v1[e]); }
        if (col >= GE) { red[0] += ((v0.x + v0.y) + (v0.z + v0.w)) + ((v1.x + v1.y) + (v1.z + v1.w));
            red[1] += ((v0.x * v0.x + v0.y * v0.y) + (v0.z * v0.z + v0.w * v0.w)) + ((v1.x * v1.x + v1.y * v1.y) + (v1.z * v1.z + v1.w * v1.w)); }
        bf16* dst = col < GE ? U + (size_t)row * GE + col : VV + (size_t)row * GE + (col - GE);
        G_STU4(dst, pack8(v0, v1));
    }
    __device__ __forceinline__ bool want_red(int pn) const { return pn >= 8; }
    __device__ __forceinline__ void store_red(int row, int pn, const float* r) const { *(f32x2*)(LNP + (size_t)row * 16 + (pn - 8) * 2) = (f32x2){r[0], r[1]}; }
};


__device__ __forceinline__ float dpp_ror1(float x) { return __builtin_bit_cast(float, __builtin_amdgcn_update_dpp(0, __builtin_bit_cast(int, x), 0x121, 0xf, 0xf, false)); }
__device__ __forceinline__ float dpp_rol1(float x) { return __builtin_bit_cast(float, __builtin_amdgcn_update_dpp(0, __builtin_bit_cast(int, x), 0x12f, 0xf, 0xf, false)); }
__device__ __forceinline__ float bsel(unsigned m, float a, float b) { return __builtin_bit_cast(float, (__builtin_bit_cast(unsigned, a) & m) | (__builtin_bit_cast(unsigned, b) & ~m)); }
__device__ __forceinline__ float dpp_shr1(float old, float x) { return __builtin_bit_cast(float, __builtin_amdgcn_update_dpp(__builtin_bit_cast(int, old), __builtin_bit_cast(int, x), 0x111, 0xf, 0xf, false)); }
__device__ __forceinline__ float dpp_shl1(float old, float x) { return __builtin_bit_cast(float, __builtin_amdgcn_update_dpp(__builtin_bit_cast(int, old), __builtin_bit_cast(int, x), 0x101, 0xf, 0xf, false)); }
struct EpiUpConv {
    static constexpr bool PERM = true, AFTER_DRAIN = false, HAS_UPF = true;
    static constexpr int STL_OFF = 2560;
    const float* RS; const float* SW; const float* wconv; const float* bconv; float* HALO; bf16* M; LAS float* EX; bool skip;
    __device__ __forceinline__ void unit_prefetch(const pg8::Unit& u, int wid, int lane) const {
        const int ci = u.pm < 32 ? 0 : 1 + ((u.pm - 32) >> 2);
        if (wid < 4) __builtin_amdgcn_global_load_lds((const unsigned*)(RS + (size_t)(u.pm * 256 + wid * 64 + lane) * 4), (LAS unsigned*)(EX + STL_OFF + wid * 256), 16, 0, 0);
        else if (wid == 4) __builtin_amdgcn_global_load_lds((const unsigned*)(SW + (size_t)ci * FF2 + u.pn * 256 + lane * 4), (LAS unsigned*)(EX + STL_OFF + 1024), 16, 0, 0);
    }
    __device__ __forceinline__ void operator()(f32x4 (&acc)[2][2][4][2], const pg8::Unit& u, int wr, int wc, int fr, int fq) const {
        if (skip) return;
        const int pm = u.pm, pn = u.pn, ci = pm < 32 ? 0 : 1 + ((pm - 32) >> 2);
        const int c32 = wc * 32 + 8 * fq;
        {   const LAS float* sw = EX + STL_OFF + 1024 + c32;
            f32x4 s[2][2];
#pragma unroll
            for (int bj = 0; bj < 2; ++bj)
#pragma unroll
                for (int n = 0; n < 2; ++n) s[bj][n] = *(const LAS f32x4*)(sw + bj * 128 + 4 * n);
            f32x4 pq[2][4];
#pragma unroll
            for (int ai = 0; ai < 2; ++ai)
#pragma unroll
                for (int m = 0; m < 4; ++m) pq[ai][m] = *(const LAS f32x4*)(EX + STL_OFF + (ai * 128 + wr * 64 + m * 16 + fr) * 4);
#pragma unroll
            for (int ai = 0; ai < 2; ++ai)
#pragma unroll
                for (int m = 0; m < 4; ++m) { const f32x4 p = pq[ai][m];
                    const float r = __builtin_amdgcn_rsqf(((p.x + p.y) + (p.z + p.w)) * (1.f / D) + EPS);
#pragma unroll
                    for (int bj = 0; bj < 2; ++bj)
#pragma unroll
                        for (int n = 0; n < 2; ++n) acc[ai][bj][m][n] = acc[ai][bj][m][n] * r + s[bj][n]; } }
#pragma unroll
        for (int ai = 0; ai < 2; ++ai) { const int sidx = 2 * ai + wr;
#pragma unroll
            for (int bj = 0; bj < 2; ++bj)
#pragma unroll
                for (int n = 0; n < 2; ++n) {
                    if (fr == 0) *(LAS f32x4*)(EX + ((sidx * 2 + 0) * 2 + bj) * 128 + c32 + 4 * n) = acc[ai][bj][0][n];
                    if (fr == 15) *(LAS f32x4*)(EX + ((sidx * 2 + 1) * 2 + bj) * 128 + c32 + 4 * n) = acc[ai][bj][3][n]; } }
        {   const int t = (wr * 4 + wc) * 64 + fq * 16 + fr; EX[8 * 256 + t] = 0.f; }
        if (pm >= 32) { float* hb = HALO + (size_t)(pm - 32) * 4 * FF2 + pn * 256 + c32;
#pragma unroll
            for (int bj = 0; bj < 2; ++bj)
#pragma unroll
                for (int n = 0; n < 2; ++n) {
                    if (wr == 0 && fr < 2) *(f32x4*)(hb + (size_t)fr * FF2 + bj * 128 + 4 * n) = acc[0][bj][0][n];
                    if (wr == 1 && fr >= 14) *(f32x4*)(hb + (size_t)(fr - 12) * FF2 + bj * 128 + 4 * n) = acc[1][bj][3][n]; } }
        const int j0 = pn * 128 + c32;
        f32x4 wq[4];
        { const float* wp = wconv + j0; wq[0] = G_LD4(wp); wq[1] = G_LD4(wp + FF2); wq[2] = G_LD4(wp + 2 * FF2); wq[3] = G_LD4(bconv + j0); }
        asm volatile("s_waitcnt lgkmcnt(0)" ::: "memory"); __builtin_amdgcn_s_barrier(); asm volatile("" ::: "memory");
#pragma unroll
        for (int bj = 0; bj < 2; ++bj)
#pragma unroll
            for (int n = 0; n < 2; ++n) {
                const f32x4 w0 = wq[0], w1 = wq[1], w2 = wq[2], bb = wq[3];
                if (bj * 2 + n < 3) { const int bj1 = (bj * 2 + n + 1) >> 1, n1 = (bj * 2 + n + 1) & 1; const float* wp = wconv + bj1 * FF + j0 + 4 * n1;
                    wq[0] = G_LD4(wp); wq[1] = G_LD4(wp + FF2); wq[2] = G_LD4(wp + 2 * FF2); wq[3] = G_LD4(bconv + bj1 * FF + j0 + 4 * n1); }
#pragma unroll
                for (int ai = 0; ai < 2; ++ai) { const int sidx = 2 * ai + wr;
                    const int xrow = fr == 15 ? (sidx < 3 ? (sidx + 1) * 2 : 9) : (sidx > 0 ? (sidx - 1) * 2 + 1 : 8);
                    const f32x4 X = *(const LAS f32x4*)(EX + (xrow * 2 + bj) * 128 + c32 + 4 * n);
                    f32x4 cur[4];
#pragma unroll
                    for (int m = 0; m < 4; ++m) cur[m] = acc[ai][bj][m][n];
#pragma unroll
                    for (int m = 0; m < 4; ++m) { f32x4 pv_, nx_;
#pragma unroll
                        for (int e = 0; e < 4; ++e) {
                            const float pa_ = m > 0 ? dpp_ror1(cur[m - 1][e]) : X[e], na_ = m < 3 ? dpp_rol1(cur[m + 1][e]) : X[e];
                            pv_[e] = dpp_shr1(pa_, cur[m][e]); nx_[e] = dpp_shl1(na_, cur[m][e]); }
                        acc[ai][bj][m][n] = (w0 * pv_ + w1 * cur[m]) + (w2 * nx_ + bb); }
                    __builtin_amdgcn_sched_barrier(0); } }
#pragma unroll
        for (int ai = 0; ai < 2; ++ai)
#pragma unroll
            for (int m = 0; m < 4; ++m) { const int row = pm * 256 + ai * 128 + wr * 64 + m * 16 + fr;
                f32x4 o0, o1;
#pragma unroll
                for (int e = 0; e < 4; ++e) { o0[e] = silu_f(acc[ai][0][m][0][e]) * acc[ai][1][m][0][e]; o1[e] = silu_f(acc[ai][0][m][1][e]) * acc[ai][1][m][1][e]; }
                G_STU4(M + (size_t)row * FF + j0, pack8(o0, o1)); }
    }
};
__device__ __forceinline__ void fix_halo_rows(const Frame& F, int row_lo, int row_hi, const float* HALO, const float* wconv, const float* bconv, bf16* M) {
    for (int T = row_lo >> 8; T <= (row_hi - 1) >> 8; ++T) {
        if (T < 32) continue;
        const int q = (T - 32) & 3;
#pragma unroll
        for (int which = 0; which < 2; ++which) {
            const int row = T * 256 + (which ? 255 : 0);
            if (!((which == 0 ? (q != 0) : (q != 3)) && row >= row_lo && row < row_hi)) continue;
            const float* own = HALO + (size_t)(T - 32) * 4 * FF2;
            const float* pr = which == 0 ? HALO + ((size_t)(T - 33) * 4 + 3) * FF2 : own + 2 * FF2;
            const float* cu = which == 0 ? own : own + 3 * FF2;
            const float* nx = which == 0 ? own + FF2 : HALO + (size_t)(T - 31) * 4 * FF2;
#pragma unroll
            for (int it = 0; it < 2; ++it) {
                const int j = 4 * (F.tid + it * NWAVES * 64);
                if (j < FF) {
                    const int gc = ((j >> 7) << 8) + (j & 127), vc = gc + 128;
                    const f32x4 g = (G_LD4(wconv + j) * G_LD4(pr + gc) + G_LD4(wconv + FF2 + j) * G_LD4(cu + gc)) + (G_LD4(wconv + 2 * FF2 + j) * G_LD4(nx + gc) + G_LD4(bconv + j));
                    const f32x4 v = (G_LD4(wconv + FF + j) * G_LD4(pr + vc) + G_LD4(wconv + FF2 + FF + j) * G_LD4(cu + vc)) + (G_LD4(wconv + 2 * FF2 + FF + j) * G_LD4(nx + vc) + G_LD4(bconv + FF + j));
                    u32x2 o; o.x = cvt_pk_bf16(silu_f(g.x) * v.x, silu_f(g.y) * v.y); o.y = cvt_pk_bf16(silu_f(g.z) * v.z, silu_f(g.w) * v.w);
                    *(GAS u32x2*)(M + (size_t)row * FF + j) = o; } }
        }
    }
    asm volatile("s_waitcnt vmcnt(0)" ::: "memory"); __syncthreads();
}
template <class Epi>
__device__ __forceinline__ void gemm_pg8_raw(const Frame& F, const bf16* A, const bf16* Bt, int Mrows, int N, int K, const Epi& E) {
    pg8::Gemm g{A, Bt, Mrows, N, K}; pg8::StaticOrder S; S.init(Mrows, N, F.G, F.bid);
    pg8::gemm_phase<Epi, pg8::StaticOrder, true, true>(F.lds + RING_OFF, g, S, E, F.tid);
}

#include <hip/hip_bf16.h>
namespace attn_body {
using bf16=__hip_bfloat16;
using bf16x8=__attribute__((ext_vector_type(8)))short;
using s16x4=__attribute__((ext_vector_type(4)))short;
using f32x16=__attribute__((ext_vector_type(16)))float;
using u32x4=__attribute__((ext_vector_type(4)))unsigned;
constexpr int NHEAD=16,D=64,DM=NHEAD*D;
constexpr int NW=8,QBLK=32,QB=QBLK*NW,KVBLK=64;
__device__ __forceinline__ int crow(int r,int hi){return (r&3)+8*(r>>2)+4*hi;}
#define SBAR() __builtin_amdgcn_sched_barrier(0)
constexpr int NSLOT=3, SLOTB=8192;
constexpr int LDS_K=0, LDS_V=NSLOT*SLOTB, LDS_WS=2*NSLOT*SLOTB, LDS_OST=LDS_WS+NW*64*4, LDS_TAB=LDS_OST+NW*4096, LDS_BYTES=LDS_TAB+(3+15)*128*4;
constexpr float C2=0.125f*1.4426950408889634f;
__device__ __forceinline__ void glds16(const void*gsrc,unsigned lds_dst){unsigned keep;
  asm volatile("s_mov_b32 %0, m0\n\ts_mov_b32 m0, %2\n\ts_nop 0\n\tglobal_load_lds_dwordx4 %1, off\n\ts_mov_b32 m0, %0":"=&s"(keep):"v"(gsrc),"s"(lds_dst):"memory");}
__device__ __forceinline__ float max3f(float a,float b,float c){float r;asm("v_max3_f32 %0, %1, %2, %3":"=v"(r):"v"(a),"v"(b),"v"(c));return r;}
__device__ __forceinline__ float max2f(float a,float b){float r;asm("v_max_f32_e32 %0, %1, %2":"=v"(r):"v"(a),"v"(b));return r;}
__device__ __forceinline__ float fadd_s(float a,float b){float r;asm("v_add_f32_e32 %0, %1, %2":"=v"(r):"v"(a),"v"(b));return r;}
__device__ __forceinline__ float fsub_s(float a,float b){float r;asm("v_sub_f32_e32 %0, %1, %2":"=v"(r):"v"(a),"v"(b));return r;}
typedef float f32x2_t __attribute__((ext_vector_type(2))); typedef __bf16 bf16x2_t __attribute__((ext_vector_type(2)));
__device__ __forceinline__ unsigned cvtpk_s(float lo,float hi){f32x2_t v={lo,hi};bf16x2_t b=__builtin_convertvector(v,bf16x2_t);return __builtin_bit_cast(unsigned,b);}
#define WAIT_BAR(N) asm volatile("s_waitcnt vmcnt(" #N ") lgkmcnt(0)\n\ts_barrier":::"memory")

__device__ __forceinline__ void qkt(f32x16&p0,f32x16&p1,const char*Kslot,const bf16x8*qr,const f32x16&negm,int r32,int hi){
  const char*kb=Kslot+hi*1024+r32*16;
  #pragma unroll
  for(int d0=0;d0<4;++d0){
    const bf16x8 b0=*reinterpret_cast<const bf16x8*>(kb+d0*2048);
    const bf16x8 b1=*reinterpret_cast<const bf16x8*>(kb+d0*2048+512);
    if(d0==0){p0=__builtin_amdgcn_mfma_f32_32x32x16_bf16(b0,qr[0],negm,0,0,0);p1=__builtin_amdgcn_mfma_f32_32x32x16_bf16(b1,qr[0],negm,0,0,0);}
    else{p0=__builtin_amdgcn_mfma_f32_32x32x16_bf16(b0,qr[d0],p0,0,0,0);p1=__builtin_amdgcn_mfma_f32_32x32x16_bf16(b1,qr[d0],p1,0,0,0);}}
}
typedef __attribute__((address_space(3))) const char* lds_cptr;
typedef short v4i16_t __attribute__((ext_vector_type(4)));
__device__ __forceinline__ void kload8(bf16x8*kf,lds_cptr kp){
  kf[0]=*(const __attribute__((address_space(3))) bf16x8*)(kp);      kf[1]=*(const __attribute__((address_space(3))) bf16x8*)(kp+512);
  kf[2]=*(const __attribute__((address_space(3))) bf16x8*)(kp+2048); kf[3]=*(const __attribute__((address_space(3))) bf16x8*)(kp+2560);
  kf[4]=*(const __attribute__((address_space(3))) bf16x8*)(kp+4096); kf[5]=*(const __attribute__((address_space(3))) bf16x8*)(kp+4608);
  kf[6]=*(const __attribute__((address_space(3))) bf16x8*)(kp+6144); kf[7]=*(const __attribute__((address_space(3))) bf16x8*)(kp+6656);
}
__device__ __forceinline__ void kload2(bf16x8*kf,lds_cptr kp,int j){ kf[2*j]=*(const __attribute__((address_space(3))) bf16x8*)(kp+j*2048); kf[2*j+1]=*(const __attribute__((address_space(3))) bf16x8*)(kp+j*2048+512); }
__device__ __forceinline__ s16x4 vtr(lds_cptr p){ return __builtin_bit_cast(s16x4,__builtin_amdgcn_ds_read_tr16_b64_v4i16((__attribute__((address_space(3))) v4i16_t*)p)); }
__device__ __forceinline__ float rowmax(const f32x16&p0,const f32x16&p1){
  float a=max3f(p0[0],p0[1],p1[0]),b=max3f(p0[2],p0[3],p1[1]);a=max3f(a,p1[2],p1[3]);
  #pragma unroll
  for(int r=4;r<16;r+=4){a=max3f(a,p0[r],p0[r+1]);b=max3f(b,p0[r+2],p0[r+3]);a=max3f(a,p1[r],p1[r+1]);b=max3f(b,p1[r+2],p1[r+3]);}
  const float m=max2f(a,b);
  auto rr=__builtin_amdgcn_permlane32_swap(__float_as_uint(m),__float_as_uint(m),false,false);
  return max2f(__uint_as_float(rr[0]),__uint_as_float(rr[1]));
}
__device__ __forceinline__ void pv(f32x16*o,int vb,bf16x8 pa0,bf16x8 pa1,bf16x8 pa2,bf16x8 pa3){
  #pragma unroll
  for(int d0=0;d0<2;++d0){s16x4 lo[4],hi[4];
    #pragma unroll
    for(int ks=0;ks<4;++ks){
      asm volatile("ds_read_b64_tr_b16 %0,%1 offset:%c2":"=&v"(lo[ks]):"v"(vb),"i"(d0*4096+ks*1024):"memory");
      asm volatile("ds_read_b64_tr_b16 %0,%1 offset:%c2":"=&v"(hi[ks]):"v"(vb),"i"(d0*4096+ks*1024+512):"memory");}
    asm volatile("s_waitcnt lgkmcnt(0)":::"memory");SBAR();
    #define PK(k) (bf16x8){lo[k][0],lo[k][1],lo[k][2],lo[k][3],hi[k][0],hi[k][1],hi[k][2],hi[k][3]}
    o[d0]=__builtin_amdgcn_mfma_f32_32x32x16_bf16(pa0,PK(0),o[d0],0,0,0);
    o[d0]=__builtin_amdgcn_mfma_f32_32x32x16_bf16(pa1,PK(1),o[d0],0,0,0);
    o[d0]=__builtin_amdgcn_mfma_f32_32x32x16_bf16(pa2,PK(2),o[d0],0,0,0);
    o[d0]=__builtin_amdgcn_mfma_f32_32x32x16_bf16(pa3,PK(3),o[d0],0,0,0);
    #undef PK
  }
}

#ifndef ATTN_STORE16
#define ATTN_STORE16(p,v) (*(__attribute__((address_space(1))) u32x4*)(p)=(v))
#endif
template<int THRL,bool LAT> __device__ __forceinline__ void attn_unit(const int tid,bf16*Qw0,const bf16*K0,const long dV0,const int n0,const bf16*K1,const long dV1,const int NT,char*shm,const int rq0,const int wlo,const float*rpb_h){
  bf16*const Ow0=Qw0;
  const int lane=tid&63,r32=lane&31,hi=lane>>5; const int wid=__builtin_amdgcn_readfirstlane(tid>>6);
  const bf16*Qw=Qw0+(long)(wid*QBLK)*DM;
  const unsigned lds0=(unsigned)(uintptr_t)shm;
  float*wsf=(float*)(shm+LDS_WS)+wid*64;
  typedef __attribute__((address_space(3))) const float* lds_fptr;
  float*tab=(float*)(shm+LDS_TAB);
  if(LAT){ for(int i=tid;i<15*128;i+=NW*64){const int rr=i>>7,cc=i&127; tab[384+i]=(cc>=48&&cc<79)?rpb_h[rr*31+cc-48]*1.4426950408889634f:0.f;}
    if(tid<384)tab[tid]=(tid<128||(tid>=256+48&&tid<256+64))?0.f:-INFINITY; }
  const int rq=rq0+(wid>>1), rs=min(max(rq-4,0),8);
  lds_fptr tb_=(lds_fptr)tab, tv_=(lds_fptr)tab;
  #define CSEL(t) do{ if(LAT){ const int cq_=32*(wid&1)+r32; const bool w_=(t)>=n0; const int ia_=wlo+((t)-n0); const bool ok_=w_&&(ia_>=rs)&&(ia_<rs+8); \
      tb_=(lds_fptr)tab+(63-cq_+4*hi)+(ok_?384+(ia_-rq+7)*128:0); tv_=(lds_fptr)tab+(48-min(max(cq_-8,0),48)+4*hi)+(w_?(ok_?256:128):0); } }while(0)
  #define CINIT(C,KO) do{ if(LAT){ _Pragma("unroll") for(int r=0;r<16;++r){const int k0_=(r&3)+8*(r>>2)+(KO); C[r]=(tb_[k0_]+tv_[k0_])-mhat;} } }while(0)
  #define CSRC(C) (LAT?C:negm)
  const int koff=lane*DM+wid*8;
  const int voff=(16*(wid&3)+(lane>>2))*DM+(wid>>2)*32+(lane&3)*8;
  const unsigned kdst=lds0+LDS_K+wid*1024, vdst=lds0+LDS_V+wid*1024;
  #define KSRC(t) (((t)<n0?K0+(long)(t)*KVBLK*DM:K1+(long)((t)-n0)*KVBLK*DM)+koff)
  #define VSRC(t) (((t)<n0?K0+dV0+(long)(t)*KVBLK*DM:K1+dV1+(long)((t)-n0)*KVBLK*DM)+voff)
  #define DMA_K(t,slot) glds16(KSRC(t),(unsigned)__builtin_amdgcn_readfirstlane(kdst+(slot)))
  #define DMA_V(t,slot) glds16(VSRC(t),(unsigned)__builtin_amdgcn_readfirstlane(vdst+(slot)))
  const int vb0=(int)(lds0+LDS_V)+((lane>>4)&1)*32+(lane&3)*8+(4*hi+((lane&15)>>2))*64;
  const char*Kbase=shm+LDS_K; bf16x8 kf[8];
  const lds_cptr shm3=(lds_cptr)shm; const lds_cptr kp0=shm3+LDS_K+hi*1024+r32*16; const lds_cptr vp0=shm3+LDS_V+((lane>>4)&1)*32+(lane&3)*8+(4*hi+((lane&15)>>2))*64;

  DMA_K(0,0);DMA_V(0,0);DMA_K(1,SLOTB);
  bf16x8 qr[4];
  #pragma unroll
  for(int d0=0;d0<4;++d0)qr[d0]=*(const __attribute__((address_space(1))) bf16x8*)(&Qw[(long)r32*DM+d0*16+hi*8]);
  float mhat=0.f,l_reg=0.f;f32x16 o[2];o[0]=f32x16{};o[1]=f32x16{};float z_=0.f;asm volatile("":"+v"(z_));f32x16 negm;
  _Pragma("unroll") for(int r=0;r<16;++r)negm[r]=z_;
  if(!LAT)asm volatile("":"+v"(negm));
  #define CMASK(P0,P1,t) do{}while(0)
  bool resc=false;
  #define START(P0,P1) do{ const float rm=rowmax(P0,P1); resc=false; \
    { const float dl=rm; mhat=fadd_s(mhat,dl); \
      _Pragma("unroll") for(int r=0;r<16;++r){P0[r]=fsub_s(P0[r],dl);P1[r]=fsub_s(P1[r],dl);} \
      if(!LAT){ _Pragma("unroll") for(int r=0;r<16;++r)negm[r]=-mhat; asm volatile("":"+v"(negm)); } } \
    _Pragma("unroll") for(int r=0;r<16;++r)P0[r]=__builtin_amdgcn_exp2f(P0[r]); }while(0)
  #define RESC() do{ if(resc){ asm volatile("s_waitcnt lgkmcnt(0)":::"memory"); \
      _Pragma("unroll") for(int d_=0;d_<2;++d_) _Pragma("unroll") for(int r=0;r<16;++r)o[d_][r]*=wsf[crow(r,hi)]; } }while(0)
  f32x16 pA0,pA1,pB0,pB1;
  int sl_prev=0,sl_cur=0,sl_next=SLOTB;
  #define ROT() do{sl_prev=sl_cur;sl_cur=sl_next;sl_next=(sl_next==(NSLOT-1)*SLOTB)?0:sl_next+SLOTB;}while(0)
  DMA_K(2,2*SLOTB);
  WAIT_BAR(3);
  qkt(pA0,pA1,Kbase,qr,negm,r32,hi);asm volatile("s_nop 15\n\ts_nop 7":"+v"(pA0),"+v"(pA1));CMASK(pA0,pA1,0);
  START(pA0,pA1);
  _Pragma("unroll") for(int r=0;r<16;++r)pA1[r]=__builtin_amdgcn_exp2f(pA1[r]);
  WAIT_BAR(0);
  DMA_K(3,0);DMA_V(1,SLOTB);
  ROT();
  kload8(kf,kp0+sl_cur);
  WAIT_BAR(2);
  s16x4 vlo[8],vhi[8]; u32x4 pw0,pw1,pw2,pw3;
  #define PKW(P,B) cvtpk_s(P[B],P[B+1])
  #define PAF(k) __builtin_bit_cast(bf16x8,pw##k)
  #define VFR(i) (bf16x8){vlo[i][0],vlo[i][1],vlo[i][2],vlo[i][3],vhi[i][0],vhi[i][1],vhi[i][2],vhi[i][3]}
  #define PIN(x) asm volatile("":"+v"(x))
  #define MX3(a,b,c) __builtin_fmaxf(__builtin_fmaxf((a),(b)),(c))
  #define GAPA(MF,A0,A1,A2,A3,W0,W1,PW) do{ MF; sacc+=A0; sacc+=A1; sacc+=A2; sacc+=A3; PIN(sacc); W0; W1; PIN(PW); SBAR(); }while(0)
  #define EX(v) __builtin_amdgcn_exp2f(v)
  #define GAPB(MF,X,B,KO) do{ MF; X[B]=EX(X[B]); X[B+1]=EX(X[B+1]); X[B+2]=EX(X[B+2]); X[B+3]=EX(X[B+3]); PIN(X); SBAR(); }while(0)
  #define VRD(i) do{ vlo[i]=vtr(vp_+(((i)>>2)*4096+((i)&3)*1024)); vhi[i]=vtr(vp_+(((i)>>2)*4096+((i)&3)*1024+512)); }while(0)
  #define KRD(G,j) do{ if(G){ kload2(kf,kp0+sl_next,j); SBAR(); } }while(0)
  #define STEP(C0,C1,P0,P1,t,GK,GV,GL) do{ SBAR(); CSEL(t); CINIT(C0,0); SBAR(); \
    const lds_cptr vp_=vp0+sl_prev; \
    VRD(0); SBAR(); float sacc=(P0[0]+P0[1]); \
    GAPA(C0=__builtin_amdgcn_mfma_f32_32x32x16_bf16(kf[0],qr[0],CSRC(C0),0,0,0), P0[2],P0[3],P0[4],P0[5],     pw0[0]=PKW(P0,0), pw0[1]=PKW(P0,2), pw0); \
    CINIT(C1,32); VRD(4); SBAR(); GAPA(C1=__builtin_amdgcn_mfma_f32_32x32x16_bf16(kf[1],qr[0],CSRC(C1),0,0,0), P0[6],P0[7],P0[8],P0[9],     pw0[2]=PKW(P0,4), pw0[3]=PKW(P0,6), pw0); \
    VRD(1); SBAR(); GAPA(C0=__builtin_amdgcn_mfma_f32_32x32x16_bf16(kf[2],qr[1],C0,0,0,0),   P0[10],P0[11],P0[12],P0[13], pw1[0]=PKW(P0,8), pw1[1]=PKW(P0,10), pw1); \
    VRD(5); SBAR(); GAPA(C1=__builtin_amdgcn_mfma_f32_32x32x16_bf16(kf[3],qr[1],C1,0,0,0),   P0[14],P0[15],P1[0],P1[1],   pw1[2]=PKW(P0,12),pw1[3]=PKW(P0,14), pw1); \
    VRD(2); SBAR(); GAPA(C0=__builtin_amdgcn_mfma_f32_32x32x16_bf16(kf[4],qr[2],C0,0,0,0),   P1[2],P1[3],P1[4],P1[5],     pw2[0]=PKW(P1,0), pw2[1]=PKW(P1,2), pw2); \
    VRD(6); SBAR(); GAPA(C1=__builtin_amdgcn_mfma_f32_32x32x16_bf16(kf[5],qr[2],C1,0,0,0),   P1[6],P1[7],P1[8],P1[9],     pw2[2]=PKW(P1,4), pw2[3]=PKW(P1,6), pw2); \
    VRD(3); SBAR(); GAPA(C0=__builtin_amdgcn_mfma_f32_32x32x16_bf16(kf[6],qr[3],C0,0,0,0),   P1[10],P1[11],P1[12],P1[13], pw3[0]=PKW(P1,8), pw3[1]=PKW(P1,10), pw3); \
    VRD(7); SBAR(); GAPA(C1=__builtin_amdgcn_mfma_f32_32x32x16_bf16(kf[7],qr[3],C1,0,0,0),   P1[14],P1[15],0.f,0.f,       pw3[2]=PKW(P1,12),pw3[3]=PKW(P1,14), pw3); \
    l_reg+=sacc; \
    if(GK){DMA_K((t)+3,sl_cur);} if(GV){DMA_V((t)+1,sl_next);} \
    CMASK(C0,C1,t); \
    { float a=MX3(C0[0],C0[1],C1[0]),b=MX3(C0[2],C0[3],C1[1]); a=MX3(a,C1[2],C1[3]); \
      _Pragma("unroll") for(int r=4;r<16;r+=4){a=MX3(a,C0[r],C0[r+1]);b=MX3(b,C0[r+2],C0[r+3]);a=MX3(a,C1[r],C1[r+1]);b=MX3(b,C1[r+2],C1[r+3]);} \
      float rm=__builtin_fmaxf(a,b); { auto rr=__builtin_amdgcn_permlane32_swap(__float_as_uint(rm),__float_as_uint(rm),false,false); rm=__builtin_fmaxf(__uint_as_float(rr[0]),__uint_as_float(rr[1])); } \
      resc=false; \
      if(__builtin_expect(__any(rm>(float)THRL),0)){ const float dl=__builtin_fmaxf(rm,0.f); mhat+=dl; \
        _Pragma("unroll") for(int r=0;r<16;++r){C0[r]-=dl;C1[r]-=dl;} \
        if(!LAT){ _Pragma("unroll") for(int r=0;r<16;++r)negm[r]=-mhat; asm volatile("":"+v"(negm)); } \
        const float f=__builtin_amdgcn_exp2f(-dl); l_reg*=f; if(hi==0)wsf[r32]=f; resc=true; } } \
    SBAR(); \
    GAPB(o[0]=__builtin_amdgcn_mfma_f32_32x32x16_bf16(PAF(0),VFR(0),o[0],0,0,0), C0,0,0); \
    GAPB(o[1]=__builtin_amdgcn_mfma_f32_32x32x16_bf16(PAF(0),VFR(4),o[1],0,0,0), C0,4,0); \
    KRD(GL,0); GAPB(o[0]=__builtin_amdgcn_mfma_f32_32x32x16_bf16(PAF(1),VFR(1),o[0],0,0,0), C0,8,0); \
    KRD(GL,1); GAPB(o[1]=__builtin_amdgcn_mfma_f32_32x32x16_bf16(PAF(1),VFR(5),o[1],0,0,0), C0,12,0); \
    KRD(GL,2); GAPB(o[0]=__builtin_amdgcn_mfma_f32_32x32x16_bf16(PAF(2),VFR(2),o[0],0,0,0), C1,0,32); \
    KRD(GL,3); GAPB(o[1]=__builtin_amdgcn_mfma_f32_32x32x16_bf16(PAF(2),VFR(6),o[1],0,0,0), C1,4,32); \
    GAPB(o[0]=__builtin_amdgcn_mfma_f32_32x32x16_bf16(PAF(3),VFR(3),o[0],0,0,0), C1,8,32); \
    GAPB(o[1]=__builtin_amdgcn_mfma_f32_32x32x16_bf16(PAF(3),VFR(7),o[1],0,0,0), C1,12,32); \
    }while(0)
  int t=1;
  for(;t+5<NT;t+=2){
    STEP(pB0,pB1,pA0,pA1,t,true,true,true);     WAIT_BAR(2); RESC(); ROT();
    STEP(pA0,pA1,pB0,pB1,t+1,true,true,true);   WAIT_BAR(2); RESC(); ROT();
  }
  #define ENDW(tt) do{ if((tt)+3<NT){WAIT_BAR(2);} else if((tt)+2<NT){WAIT_BAR(1);} else {WAIT_BAR(0);} }while(0)
  for(;t+1<NT;t+=2){
    STEP(pB0,pB1,pA0,pA1,t,(t+3<NT),(t+1<NT),(t+1<NT));       ENDW(t);   RESC(); ROT();
    STEP(pA0,pA1,pB0,pB1,t+1,(t+4<NT),(t+2<NT),(t+2<NT));     ENDW(t+1); RESC(); ROT();
  }
  STEP(pB0,pB1,pA0,pA1,NT-1,false,false,false); RESC();
  { float sacc=pB0[0]+pB0[1]; _Pragma("unroll") for(int r=2;r<16;++r)sacc+=pB0[r]; _Pragma("unroll") for(int r=0;r<16;++r)sacc+=pB1[r]; l_reg+=sacc;
    pw0=(u32x4){PKW(pB0,0),PKW(pB0,2),PKW(pB0,4),PKW(pB0,6)};pw1=(u32x4){PKW(pB0,8),PKW(pB0,10),PKW(pB0,12),PKW(pB0,14)};pw2=(u32x4){PKW(pB1,0),PKW(pB1,2),PKW(pB1,4),PKW(pB1,6)};pw3=(u32x4){PKW(pB1,8),PKW(pB1,10),PKW(pB1,12),PKW(pB1,14)};
    SBAR(); pv(o,vb0+sl_cur,PAF(0),PAF(1),PAF(2),PAF(3)); }
  #undef PKW
  #undef PAF
  #undef VFR
  #undef PIN
  #undef MX3
  #undef GAPA
  #undef GAPB
  #undef EX
  #undef VRD
  #undef KRD
  #undef STEP
  #undef ENDW
  {auto rr=__builtin_amdgcn_permlane32_swap(__float_as_uint(l_reg),__float_as_uint(l_reg),false,false);l_reg=__uint_as_float(rr[0])+__uint_as_float(rr[1]);}
  if(hi==0)wsf[32+r32]=l_reg;asm volatile("s_waitcnt lgkmcnt(0)":::"memory");
  float rli[16];
  #pragma unroll
  for(int r=0;r<16;++r)rli[r]=__builtin_amdgcn_rcpf(wsf[32+crow(r,hi)]);
  bf16*Ow=Ow0+(long)(wid*QBLK)*DM;
  { bf16*stg=(bf16*)(shm+LDS_OST)+wid*2048;
    #pragma unroll
    for(int r=0;r<16;++r){const int orow=crow(r,hi);
      #pragma unroll
      for(int d0=0;d0<2;++d0)stg[orow*64+d0*32+r32]=__float2bfloat16(o[d0][r]*rli[r]);}
    asm volatile("s_waitcnt lgkmcnt(0)":::"memory");
    #pragma unroll
    for(int i=0;i<4;++i){const int row=i*8+(lane>>3),ch=lane&7; const u32x4 v=*(const u32x4*)(stg+row*64+ch*8); ATTN_STORE16(Ow+(long)row*DM+ch*8,v);} }
  asm volatile("s_waitcnt lgkmcnt(0)\n\ts_barrier":::"memory");
  #undef DMA_K
  #undef DMA_V
  #undef KSRC
  #undef VSRC
  #undef CMASK
  #undef CSEL
  #undef CINIT
  #undef CSRC
  #undef START
  #undef RESC
  #undef ROT
}

constexpr int MIX_STAT=0, MIX_V=2048, MIX_WS=MIX_V+8*8192, MIX_STG=MIX_WS+NW*64*4, MIX_SROW=36, MIX_LDS_BYTES=MIX_STG+NW*32*MIX_SROW*4;
__device__ __forceinline__ void mix_pair(const int tid,const int uA,const int uB,const bf16*VV,bf16*U,const bf16*WSb,const float*LNP,const float*gv,const float*bs,char*shm){
  const int lane=tid&63,r32=lane&31,hi=lane>>5; const int wid=__builtin_amdgcn_readfirstlane(tid>>6);
  const int grp=wid>>2,pb=wid&3,u=grp?uB:uA; const bool valid=u>=0; const int chunk=u>>4,g=u&15;
  const unsigned lds0=(unsigned)(uintptr_t)shm;
  float*stat=(float*)(shm+MIX_STAT)+grp*256;
  float*wsf=(float*)(shm+MIX_WS)+wid*64;
  float*stg=(float*)(shm+MIX_STG)+wid*32*MIX_SROW;
  const int vbase=MIX_V+grp*32768;
  asm volatile("s_waitcnt vmcnt(0)":::"memory");
  if(valid){
    #pragma unroll
    for(int k=0;k<2;++k){ const int pi=2*pb+k; const bf16*vsrc=VV+(long)(chunk*128+16*(pi&3)+(lane>>2))*2048+g*128+(pi>>2)*32+(lane&3)*8;
      #pragma unroll
      for(int s=0;s<4;++s) glds16(vsrc+(long)((s>>1)*64)*2048+(s&1)*64,(unsigned)__builtin_amdgcn_readfirstlane(lds0+vbase+s*8192+pi*1024)); }
    const int tg=tid&255;
    if(tg<128){ const __attribute__((address_space(1))) float*p=(const __attribute__((address_space(1))) float*)(LNP+(long)(chunk*128+tg)*16); float s=0.f,q=0.f;
      #pragma unroll
      for(int k=0;k<8;++k){s+=p[2*k];q+=p[2*k+1];}
      const float mean=s*(1.f/2048.f),var=q*(1.f/2048.f)-mean*mean; stat[2*tg]=mean; stat[2*tg+1]=__builtin_amdgcn_rsqf(var+1e-6f); } }
  asm volatile("s_waitcnt vmcnt(0) lgkmcnt(0)\n\ts_barrier":::"memory");
  if(valid){
    bf16x8 pa[2][4]; float corr=0.f;
    #pragma unroll
    for(int qt=0;qt<2;++qt)
      #pragma unroll
      for(int ks=0;ks<4;++ks){ const int qa=64*qt+16*ks+4*hi;
        const __attribute__((address_space(1))) unsigned* wp=(const __attribute__((address_space(1))) unsigned*)(WSb+((long)g*128+32*pb+r32)*128+qa);
        const unsigned w0=wp[0],w1=wp[1],w2=wp[4],w3=wp[5];
        const f32x4 s0=*(const f32x4*)(stat+2*qa), s1=*(const f32x4*)(stat+2*qa+4), s2=*(const f32x4*)(stat+2*qa+16), s3=*(const f32x4*)(stat+2*qa+20);
        const float a0=__uint_as_float(w0<<16)*s0.y,a1=__uint_as_float(w0&0xffff0000u)*s0.w,a2=__uint_as_float(w1<<16)*s1.y,a3=__uint_as_float(w1&0xffff0000u)*s1.w;
        const float a4=__uint_as_float(w2<<16)*s2.y,a5=__uint_as_float(w2&0xffff0000u)*s2.w,a6=__uint_as_float(w3<<16)*s3.y,a7=__uint_as_float(w3&0xffff0000u)*s3.w;
        u32x4 pk; pk.x=cvtpk_s(a0,a1); pk.y=cvtpk_s(a2,a3); pk.z=cvtpk_s(a4,a5); pk.w=cvtpk_s(a6,a7);
        corr+=(__uint_as_float(pk.x<<16)*s0.x+__uint_as_float(pk.x&0xffff0000u)*s0.z)+(__uint_as_float(pk.y<<16)*s1.x+__uint_as_float(pk.y&0xffff0000u)*s1.z)
             +(__uint_as_float(pk.z<<16)*s2.x+__uint_as_float(pk.z&0xffff0000u)*s2.z)+(__uint_as_float(pk.w<<16)*s3.x+__uint_as_float(pk.w&0xffff0000u)*s3.z);
        pa[qt][ks]=__builtin_bit_cast(bf16x8,pk); }
    {auto rr=__builtin_amdgcn_permlane32_swap(__float_as_uint(corr),__float_as_uint(corr),false,false);corr=__uint_as_float(rr[0])+__uint_as_float(rr[1]);}
    if(hi==0)wsf[r32]=corr; asm volatile("s_waitcnt lgkmcnt(0)":::"memory");
    const int vb=(int)(lds0+vbase)+((lane>>4)&1)*32+(lane&3)*8+(4*hi+((lane&15)>>2))*64;
    #pragma unroll
    for(int ch=0;ch<2;++ch){
      f32x16 o[2]; o[0]=f32x16{}; o[1]=f32x16{};
      SBAR(); pv(o,vb+ch*8192,pa[0][0],pa[0][1],pa[0][2],pa[0][3]);
      SBAR(); pv(o,vb+(2+ch)*8192,pa[1][0],pa[1][1],pa[1][2],pa[1][3]);
      #pragma unroll
      for(int d0=0;d0<2;++d0){
        #pragma unroll
        for(int r=0;r<16;++r){const int orow=crow(r,hi); stg[orow*MIX_SROW+r32]=o[d0][r]-wsf[orow];}
        asm volatile("s_waitcnt lgkmcnt(0)":::"memory");
        #pragma unroll
        for(int i=0;i<2;++i){const int row=i*16+(lane>>2),c8=(lane&3)*8; const int p=32*pb+row, e=g*128+ch*64+d0*32+c8;
          const f32x4 m0=*(const f32x4*)(stg+row*MIX_SROW+c8), m1=*(const f32x4*)(stg+row*MIX_SROW+c8+4);
          const f32x4 g0=*(const __attribute__((address_space(1))) f32x4*)(gv+e), g1=*(const __attribute__((address_space(1))) f32x4*)(gv+e+4); const float b=*(const __attribute__((address_space(1))) float*)(bs+g*128+p);
          bf16*up=U+(long)(chunk*128+p)*2048+e; const u32x4 uw=*(const __attribute__((address_space(1))) u32x4*)up;
          u32x4 ow;
          ow.x=cvtpk_s(__uint_as_float(uw.x<<16)*(g0.x*m0.x+b),__uint_as_float(uw.x&0xffff0000u)*(g0.y*m0.y+b));
          ow.y=cvtpk_s(__uint_as_float(uw.y<<16)*(g0.z*m0.z+b),__uint_as_float(uw.y&0xffff0000u)*(g0.w*m0.w+b));
          ow.z=cvtpk_s(__uint_as_float(uw.z<<16)*(g1.x*m1.x+b),__uint_as_float(uw.z&0xffff0000u)*(g1.y*m1.y+b));
          ow.w=cvtpk_s(__uint_as_float(uw.w<<16)*(g1.z*m1.z+b),__uint_as_float(uw.w&0xffff0000u)*(g1.w*m1.w+b));
          *(__attribute__((address_space(1))) u32x4*)up=ow; }
        asm volatile("s_waitcnt lgkmcnt(0)":::"memory"); }
    } }
  asm volatile("s_waitcnt lgkmcnt(0)\n\ts_barrier":::"memory");
}
constexpr int ATTN_LDS_BYTES=LDS_BYTES;
#undef SBAR
#undef WAIT_BAR
}

#ifndef LATUNIT
#define LATUNIT attn_body::attn_unit<8, true>
#endif
__device__ __forceinline__ void attn_fast(const Frame& F, const Args& args) {
    typedef attn_body::bf16 abf;
    unsigned char* ws = wsb(args);
    abf* Q = (abf*)(ws + WS_Q); const abf* K = (const abf*)(ws + WS_K);
    const abf* CKp = (const abf*)(ws + WS_CK); const abf* KCp = (const abf*)(ws + WS_KC); const float* rpb = inp(args, I_RPB);
    char* shm = (char*)(unsigned char*)F.lds + RING_OFF;
    const int vcu = (F.G % 8 == 0) ? (F.bid % 8) * (F.G / 8) + F.bid / 8 : F.bid;
    for (int u = vcu; u < 4 * NH * 4; u += F.G) {
        const int b = u >> 6, h = (u >> 2) & 15, qb = u & 3;
        const int wlo = qb < 2 ? 0 : (qb == 2 ? 4 : 8), nwin = (qb == 0 || qb == 3) ? 8 : 12;
        const long qoff = ((long)(NCTX + b * SEQ_L + qb * 256)) * D + h * HD, woff = ((long)(NCTX + b * SEQ_L + wlo * 64)) * D + h * HD, coff = ((long)(b * PAST)) * D + h * HD;
        LATUNIT(F.tid, Q + qoff, CKp + coff, (long)((WS_CV - WS_CK) / 2), 8, K + woff, (long)((WS_V - WS_K) / 2), 8 + nwin, shm, 4 * qb, wlo, rpb + h * 465);
    }
    for (int u = vcu; u < 32 * NH; u += F.G) {
        const int b = u >> 4, h = u & 15;
        const long qoff = ((long)(b * SEQ_C)) * D + h * HD;
        attn_body::attn_unit<8, false>(F.tid, Q + qoff, KCp + qoff, (long)((WS_VC - WS_KC) / 2), 4, KCp + qoff, (long)((WS_VC - WS_KC) / 2), 4, shm, 0, 0, rpb);
    }
    if (F.G % 4 == 0 && (4 * NH * 4) % F.G == 0) { const int qb = vcu & 3;
        if (qb == 0 || qb == 3) p1_sw_items(F, args, SWI_QKV, SWI_QKV + FF2 / 16, ((vcu >> 2) * 2 + (qb == 3)) * NWAVES + F.wave, (F.G / 2) * NWAVES); }
    else p1_sw_items(F, args, SWI_QKV, SWI_QKV + FF2 / 16, F.bid * NWAVES + F.wave, F.G * NWAVES);
}


__device__ __forceinline__ void mix_fast(const Frame& F, const Args& args) {
    typedef attn_body::bf16 abf;
    unsigned char* ws = wsb(args);
    const abf* VV = (const abf*)(ws + WS_VV); abf* U = (abf*)(ws + WS_U); const abf* WSb = (const abf*)(ws + WS_WSB); const float* LNP = (const float*)(ws + WS_LNP);
    const float* gv = inp(args, I_GV); const float* bs = inp(args, I_BSP);
    char* shm = (char*)(unsigned char*)F.lds + RING_OFF;
    const int vcu = (F.G % 8 == 0) ? (F.bid % 8) * (F.G / 8) + F.bid / 8 : F.bid;
    for (int u = 2 * vcu; u < 96 * 16; u += 2 * F.G) attn_body::mix_pair(F.tid, u, u + 1 < 96 * 16 ? u + 1 : -1, VV, U, WSb, LNP, gv, bs, shm);
}
#ifndef ATTN
#define ATTN attn_fast
#endif
#ifndef MIX
#define MIX mix_fast
#endif
enum Steps { S_P0 = 0, S_QKV, S_ATT, S_WO, S_UP0, S_DN0, S_IN, S_MIX, S_OUT, S_UP1, S_DN1, NSTEPS };

#ifndef STEPMASK
#define STEPMASK 0xffffffffu
#endif
#define ON(s) ((STEPMASK >> (s)) & 1u)
__device__ __forceinline__ void run_step(const Frame& F0, const Args& args, int s) {
    Frame F = F0; asm volatile("" : "+v"(F.tid)); asm volatile("" : "+s"(F.bid)); asm volatile("" : "+s"(F.G)); F.lane = F.tid & 63; F.wave = __builtin_amdgcn_readfirstlane(F.tid >> 6);
    unsigned char* ws = wsb(args);
    const float* MOD0 = (const float*)(ws + WS_MOD); const float* MOD1 = MOD0 + 5 * 6144;
    float* SW = (float*)(ws + WS_SW);
    float* RS0 = (float*)(ws + WS_RS); float* RS1 = RS0 + (size_t)MT * 4; float* RS2 = RS0 + (size_t)MT * 8; float* RS3 = RS0 + (size_t)MT * 12;
    bf16* AN = (bf16*)(ws + WS_AN);
    if (ON(S_P0) && s == S_P0) {
        unsigned* cnt = (unsigned*)ws + CW_CNT + 8192;
        for (int u = F.bid; u < ADA_UNITS; u += F.G) { p0_adaln_unit(F, args, u);
            const int jb = u % 24; if (u < 96 && jb < 8) wave_publish(cnt + (jb < 4 ? 0 : 64)); }
        const int rot = (F.bid + F.G - ADA_UNITS % F.G) % F.G;
        p0_items(F, args, 0, PI_FIRST, rot * NWAVES + F.wave, F.G * NWAVES);
        constexpr int SWU_QKV = (NQKV / 256) * 4;
        if (rot < SWU_QKV) {
            if (F.wave == 0) { wave_wait_ge(cnt, 16 * NWAVES, (unsigned*)ws + CW_TMO); __builtin_amdgcn_fence(__ATOMIC_ACQUIRE, "agent"); }
            __syncthreads();
            for (int u = rot; u < SWU_QKV; u += F.G) sw_unit_f32(F, inp(args, I_WQKV), NQKV, MOD0, SW + SW_QKV, false, u); }
        if (F.wave == 0) { wave_wait_ge(cnt + 64, 16 * NWAVES, (unsigned*)ws + CW_TMO); __builtin_amdgcn_fence(__ATOMIC_ACQUIRE, "agent"); }
        __syncthreads();
        p1_rows(F, args, rot * NWAVES + F.wave, (SWU_QKV < F.G ? SWU_QKV : 0) * NWAVES); }
    else if (ON(S_QKV) && s == S_QKV) { float* out = outb(args);
        EpiQKV E{{RS0, SW + SW_QKV, NQKV}, ws};
        int fw = 0, nfw = 1; const bool fil = filler_slot(F, (MT / 256) * (NQKV / 256), fw, nfw), first = fil && (F.bid & 8);
        if (first) { p0_items(F, args, PI_FIRST, PI_SECOND, fw, nfw); __syncthreads(); }
        gemm_pg8<0>(F, AN, (const bf16*)(ws + WS_WQKV), 0, MT, NQKV, D, E);
        if (fil && !first) p0_items(F, args, PI_FIRST, PI_SECOND, fw, nfw); }
    else if (ON(S_ATT) && s == S_ATT) ATTN(F, args);
    else if (ON(S_WO) && s == S_WO) { float* X = outb(args);
        EpiResT<0> E{inp(args, I_XP), inp(args, I_XS), (bf16*)(ws + WS_XB), nullptr, MOD0 + 2048, AN, inp(args, I_NFFN), MOD0 + 4096, RS1, 1.f};
        gemm_pg8<1, EpiResT<0>, 3>(F, (const bf16*)(ws + WS_Q), (const bf16*)(ws + WS_WO), 0, MT, D, D, E);
    }
    else if (ON(S_UP0) && s == S_UP0) { EpiUpConv E{RS1, SW + SW_UP0, inp(args, I_WCONV), inp(args, I_BCONV), (float*)(ws + WS_HALO), (bf16*)(ws + WS_M), (LAS float*)(F.lds + EPI_OFF), F.skip_epi};
        int fw = 0, nfw = 1; const bool fil = filler_slot(F, (MT / 256) * (FF2 / 256), fw, nfw), first = fil && (F.bid & 8);
        if (first) { p0_items(F, args, PI_SECOND, PI_ALL, fw, nfw); sw_units_f32(F, args, fw / NWAVES, nfw / NWAVES); __syncthreads(); }
        gemm_pg8_raw(F, AN, (const bf16*)(ws + WS_WUP), MT, FF2, D, E);
        if (fil && !first) { p0_items(F, args, PI_SECOND, PI_ALL, fw, nfw); sw_units_f32(F, args, fw / NWAVES, nfw / NWAVES); } }
    else if (ON(S_DN0) && s == S_DN0) { float* X = outb(args);
        { pg8::StaticOrder S0; S0.init(MT, D, F.G, F.bid, 192); pg8::Unit u0; for (int i = 0; S0.next(i, u0); ++i) fix_halo_rows(F, u0.pm * 192, u0.pm * 192 + 224, (const float*)(ws + WS_HALO), inp(args, I_WCONV), inp(args, I_BCONV), (bf16*)(ws + WS_M)); }
        EpiResT<1> E{nullptr, nullptr, (bf16*)(ws + WS_XB), nullptr, MOD0 + 5120, AN, inp(args, I_NMIX) + D, MOD1 + 1024, RS2, F.scale};
        gemm_pg8<1, EpiResT<1>, 3>(F, (const bf16*)(ws + WS_M), (const bf16*)(ws + WS_WDN), 0, MT, D, FF, E);
    }
    else if (ON(S_IN) && s == S_IN) { EpiIn E{{RS2, SW + SW_IN, GE2}, (bf16*)(ws + WS_U), (bf16*)(ws + WS_VV), (float*)(ws + WS_LNP)}; gemm_pg8<2>(F, AN, (const bf16*)(ws + WS_WIN), 0, MT, GE2, D, E); }
    else if (ON(S_MIX) && s == S_MIX) MIX(F, args);
    else if (ON(S_OUT) && s == S_OUT) { float* X = outb(args);
        EpiResT<1> E{nullptr, nullptr, (bf16*)(ws + WS_XB), nullptr, MOD1 + 2048, AN, inp(args, I_NFFN) + D, MOD1 + 4096, RS3, F.scale};
        gemm_pg8<1, EpiResT<1>, 3>(F, (const bf16*)(ws + WS_U), (const bf16*)(ws + WS_WOUT), 0, MT, D, GE, E); }
    else if (ON(S_UP1) && s == S_UP1) { EpiUpConv E{RS3, SW + SW_UP1, inp(args, I_WCONV) + (size_t)3 * FF2, inp(args, I_BCONV) + FF2, (float*)(ws + WS_HALO), (bf16*)(ws + WS_M), (LAS float*)(F.lds + EPI_OFF), F.skip_epi};
        int fw = 0, nfw = 1; const bool fil = filler_slot(F, (MT / 256) * (FF2 / 256), fw, nfw), first = fil && (F.bid & 8);
        if (first) state_items(F, args, fw, nfw);
        gemm_pg8_raw(F, AN, (const bf16*)(ws + WS_WUP) + (size_t)FF2 * D, MT, FF2, D, E);
        if (fil && !first) state_items(F, args, fw, nfw); }
    else if (ON(S_DN1) && s == S_DN1) { float* X = outb(args);
        { pg8::StaticOrder S0; S0.init(MT, D, F.G, F.bid, 192); pg8::Unit u0; for (int i = 0; S0.next(i, u0); ++i) fix_halo_rows(F, u0.pm * 192, u0.pm * 192 + 224, (const float*)(ws + WS_HALO), inp(args, I_WCONV) + (size_t)3 * FF2, inp(args, I_BCONV) + FF2, (bf16*)(ws + WS_M)); }
        EpiFinal E{(const bf16*)(ws + WS_XB), X, MOD1 + 5120, inp(args, I_NFIN), RS0 + (size_t)MT * 16, (unsigned*)ws + CW_CNT, (unsigned*)ws + CW_TMO, F.scale};
        gemm_pg8<1, EpiFinal, 3>(F, (const bf16*)(ws + WS_M), (const bf16*)(ws + WS_WDN) + (size_t)D * FF, 0, MT, D, FF, E); }
}

__global__ void __launch_bounds__(NWAVES * 64, 2) mk_fwd(Args args) {
    extern __shared__ __attribute__((aligned(16))) unsigned char lds[];
    Frame F;
    F.lds = (LAS unsigned char*)lds;
    F.MISC = (volatile LAS unsigned*)(F.lds + MISC_OFF);
    F.tid = threadIdx.x; F.lane = F.tid & 63; F.wave = __builtin_amdgcn_readfirstlane(F.tid >> 6);
    F.G = gridDim.x; F.bid = blockIdx.x; F.scale = 1.f; F.skip_epi = false;
    for (int u = F.tid; u < (LDS_BYTES - LDSCTL_OFF) / 4; u += NWAVES * 64) ((LAS unsigned*)(F.lds + LDSCTL_OFF))[u] = 0u;
    __syncthreads();
    XcdBarrier bar = xcd_barrier_post((unsigned*)(args.ws + WS_CTL) + CW_BAR, F.MISC + 8);
    for (int q = 0; q < args.nseq; ++q) {
        const int sq = args.seq[q]; F.scale = (sq & 32) ? 0.f : 1.f; F.skip_epi = (sq & 64) != 0;
        run_step(F, args, sq & 31);
        if (q + 1 < args.nseq) xcd_barrier(bar);
    }
}

extern "C" void kernel_launch(void* const* d_in, const int* in_sizes, int n_in, void* d_out, int out_size, void* d_ws, size_t ws_size, hipStream_t stream) {
    static int grid = 0;
    if (grid == 0) {
        if (n_in != 23 || ws_size < WS_END) { fprintf(stderr, "kernel_launch: unexpected n_in %d / ws %zu\n", n_in, ws_size); grid = -1; return; }
        int dev = 0, cus = 0, per_cu = 0;
        if (hipGetDevice(&dev) != hipSuccess || hipDeviceGetAttribute(&cus, hipDeviceAttributeMultiprocessorCount, dev) != hipSuccess) { grid = -1; return; }
        if (hipFuncSetAttribute((const void*)mk_fwd, hipFuncAttributeMaxDynamicSharedMemorySize, LDS_BYTES) != hipSuccess) { fprintf(stderr, "kernel_launch: hipFuncSetAttribute failed\n"); grid = -1; return; }
        if (hipOccupancyMaxActiveBlocksPerMultiprocessor(&per_cu, (const void*)mk_fwd, NWAVES * 64, LDS_BYTES) != hipSuccess || per_cu < 1) { fprintf(stderr, "kernel_launch: occupancy query says %d blocks per CU\n", per_cu); per_cu = 1; }
        (void)hipGetLastError();
        grid = cus;
    }
    if (grid < 0) return;
    if (hipMemsetAsync((char*)d_ws + WS_CTL, 0, CTL_ZERO_BYTES, stream) != hipSuccess) { fprintf(stderr, "kernel_launch: memset failed\n"); return; }
    Args a{};
    for (int i = 0; i < 23; ++i) a.in[i] = (const float*)d_in[i];
    a.out = (float*)d_out; a.ws = (unsigned char*)d_ws;
#ifndef DUP_FLAGS
#define DUP_FLAGS 0
#endif
#ifndef DUP_STEP
    a.nseq = NSTEPS; for (int s = 0; s < NSTEPS; ++s) a.seq[s] = (unsigned char)s;
#else
#ifndef DUP_STEP_HI
#define DUP_STEP_HI DUP_STEP
#endif
    a.nseq = 0; for (int s = 0; s < NSTEPS; ++s) { a.seq[a.nseq++] = (unsigned char)s; if (s == DUP_STEP_HI) for (int r = DUP_STEP; r <= DUP_STEP_HI; ++r) a.seq[a.nseq++] = (unsigned char)(r | 32 | DUP_FLAGS); }
#endif
    hipLaunchKernelGGL(mk_fwd, dim3(grid), dim3(NWAVES * 64), LDS_BYTES, stream, a);
    const hipError_t le = hipPeekAtLastError();
    if (le != hipSuccess) fprintf(stderr, "kernel_launch: launch failed: %s\n", hipGetErrorName(le));
}
```

```cpp
#include <hip/hip_runtime.h>
#include <cstdio>
#include <cstdint>
#include <type_traits>


#define GAS __attribute__((address_space(1)))
#define LAS __attribute__((address_space(3)))
typedef unsigned short bf16;
typedef short bf16x8 __attribute__((ext_vector_type(8)));
typedef float f32x4 __attribute__((ext_vector_type(4)));
typedef float f32x2 __attribute__((ext_vector_type(2)));
typedef unsigned u32x4 __attribute__((ext_vector_type(4)));
typedef unsigned u32x2 __attribute__((ext_vector_type(2)));
typedef GAS unsigned gu32;

constexpr int D = 1024, NCTX = 8192, NLAT = 4096, MT = 12288, NH = 16, HD = 64, FF = 2816, FF2 = 5632, GE = 2048, GE2 = 4096, NQKV = 3072;
constexpr int SEQ_C = 256, SEQ_L = 1024, PAST = 512;
constexpr float EPS = 1e-6f, LOG2E = 1.4426950408889634f, C2 = 0.125f * 1.4426950408889634f;
constexpr int NWAVES = 8;

constexpr size_t MiB = 1u << 20;
constexpr size_t WS_CTL = 0, CTL_ZERO_BYTES = 1 * MiB + 512 * 1024;
constexpr size_t WS_MOD = 512 * 1024;
constexpr size_t WS_TS = 800 * 1024;
constexpr size_t WS_SW = 1 * MiB;
constexpr size_t WS_HALO = 1 * MiB + 512 * 1024;
constexpr size_t WS_RS = 3 * MiB;
constexpr size_t WS_LNP = 4 * MiB;
constexpr size_t WS_WQKV = 5 * MiB, WS_WO = 11 * MiB, WS_WIN = 13 * MiB, WS_WOUT = 21 * MiB, WS_WUP = 25 * MiB, WS_WDN = 47 * MiB;
constexpr size_t WUP_BYTES = 11 * MiB, WDN_BYTES = (size_t)1024 * 2816 * 2;
constexpr size_t WS_WSB = 58 * MiB;
constexpr size_t WS_CK = 59 * MiB, WS_CV = 63 * MiB;
constexpr size_t WS_AN = 67 * MiB;
constexpr size_t WS_BIG = 91 * MiB;
constexpr size_t WS_Q = WS_BIG, WS_K = WS_BIG + 24 * MiB, WS_V = WS_BIG + 48 * MiB;
constexpr size_t WS_M = WS_BIG, WS_ARAW = WS_BIG + 66 * MiB;
constexpr size_t WS_U = WS_BIG, WS_VV = WS_BIG + 48 * MiB;
constexpr size_t WS_XB = 200 * MiB;
constexpr size_t WS_KC = 224 * MiB, WS_VC = 240 * MiB;
constexpr size_t WS_END = 256 * MiB;
static_assert(WS_HALO + (size_t)16 * 4 * 5632 * 4 <= WS_RS && WS_SW + 5 * (3072 + 5632 + 4096 + 5632) * 4 <= CTL_ZERO_BYTES, "zeroed region / halo");
static_assert(WS_ARAW + (size_t)4096 * 5632 * 2 <= WS_END && WS_WDN + 2 * WDN_BYTES <= WS_CK && WS_VV + 48 * MiB <= WS_END, "ws map");
constexpr int SW_QKV = 0, SW_UP0 = 5 * NQKV, SW_IN = SW_UP0 + 5 * FF2, SW_UP1 = SW_IN + 5 * GE2;
constexpr int CW_TMO = 0, CW_CODE = 1, CW_BAR = 4096;

#define RLX_AGENT __ATOMIC_RELAXED, __HIP_MEMORY_SCOPE_AGENT
#define LDS_WAIT() asm volatile("s_waitcnt lgkmcnt(0)" ::: "memory")
#define VM_WAIT() asm volatile("s_waitcnt vmcnt(0)" ::: "memory")
__device__ __forceinline__ unsigned cvt_pk_bf16(float lo, float hi) { unsigned r; asm volatile("v_cvt_pk_bf16_f32 %0, %1, %2" : "=v"(r) : "v"(lo), "v"(hi)); return r; }
__device__ __forceinline__ float bf2f(unsigned short u) { return __uint_as_float((unsigned)u << 16); }
__device__ __forceinline__ float bflo(unsigned w) { return __uint_as_float(w << 16); }
__device__ __forceinline__ float bfhi(unsigned w) { return __uint_as_float(w & 0xffff0000u); }
__device__ __forceinline__ u32x4 pack8(f32x4 a, f32x4 b) { u32x4 w; w.x = cvt_pk_bf16(a[0], a[1]); w.y = cvt_pk_bf16(a[2], a[3]); w.z = cvt_pk_bf16(b[0], b[1]); w.w = cvt_pk_bf16(b[2], b[3]); return w; }
__device__ __forceinline__ float wave_sum(float v) {
#pragma unroll
    for (int o = 1; o < 64; o <<= 1) v += __shfl_xor(v, o);
    return v;
}
__device__ __forceinline__ float silu_f(float x) { return x * __builtin_amdgcn_rcpf(1.f + __builtin_amdgcn_exp2f(-x * LOG2E)); }
__device__ __forceinline__ float gelu_tanh_f(float x) { const float u = (-1.5957691216057308f * LOG2E) * (x + 0.044715f * x * x * x); return x * __builtin_amdgcn_rcpf(1.f + __builtin_amdgcn_exp2f(u)); }
__device__ __forceinline__ int ci_of(int row) { return row < NCTX ? 0 : 1 + ((row - NCTX) >> 10); }


__device__ __forceinline__ void st4f_wt(float* p, float v) { __hip_atomic_store((unsigned*)p, __float_as_uint(v), __ATOMIC_RELAXED, __HIP_MEMORY_SCOPE_AGENT); }
__device__ __forceinline__ void wave_publish(unsigned* cnt) {
    asm volatile("s_waitcnt vmcnt(0)" ::: "memory");
    if ((threadIdx.x & 63) == 0) __hip_atomic_fetch_add(cnt, 1u, __ATOMIC_RELAXED, __HIP_MEMORY_SCOPE_AGENT);
}
__device__ __forceinline__ void wave_wait_ge(unsigned* cnt, unsigned need, unsigned* tmo) {
    unsigned sp = 0;
    while ((unsigned)__builtin_amdgcn_readfirstlane(__hip_atomic_load(cnt, __ATOMIC_RELAXED, __HIP_MEMORY_SCOPE_AGENT)) < need) {
        __builtin_amdgcn_s_sleep(2);
        if (++sp > (1u << 22)) { if ((threadIdx.x & 63) == 0) __hip_atomic_store(tmo, 1u, __ATOMIC_RELAXED, __HIP_MEMORY_SCOPE_AGENT); break; } }
}
constexpr int CW_CNT = 16384;
#define XB_TMO      128
#define XB_XCNT(j)  (256  + 64 * (j))
#define XB_XSUB(j)  (1280 + 64 * (j))
#define XB_XGEN(j)  (2304 + 64 * (j))
#define XB_TOP      3328
#define XB_TOPGEN   3392
#define XCD_BAR_WORDS 3456
#define XB_SPIN_CAP (1u << 18)
__device__ __forceinline__ unsigned xb_ld(unsigned* p)              { return __hip_atomic_load(p, __ATOMIC_RELAXED, __HIP_MEMORY_SCOPE_AGENT); }
__device__ __forceinline__ unsigned xb_add(unsigned* p, unsigned v) { return __hip_atomic_fetch_add(p, v, __ATOMIC_RELAXED, __HIP_MEMORY_SCOPE_AGENT); }
__device__ __forceinline__ unsigned xb_xcc_id() { return (unsigned)__builtin_amdgcn_s_getreg((3 << 11) | 20) & 0xFu; }
#define XB_SPIN(cond, bar) do { unsigned _sp = 0; while (cond) { __builtin_amdgcn_s_sleep(1); \
    if ((++_sp & 255u) == 0u) { if (xb_ld(&(bar)[XB_TMO])) break; if (_sp > XB_SPIN_CAP) { atomicAdd(&(bar)[XB_TMO], 1u); break; } } } } while (0)
struct XcdBarrier { unsigned* bar; unsigned x; volatile LAS unsigned* st; };
__device__ __forceinline__ XcdBarrier xcd_barrier_post(unsigned* bar, volatile LAS unsigned* st) {
    XcdBarrier b; b.bar = bar; b.x = xb_xcc_id(); b.st = st;
    if (threadIdx.x == 0) (void)xb_add(&bar[XB_XCNT(b.x)], 1u);
    return b;
}
__device__ __forceinline__ void xcd_barrier_complete(unsigned* bar, unsigned x, unsigned& nloc, unsigned& nx) {
    const unsigned G = gridDim.x * gridDim.y * gridDim.z;
    unsigned sum, cnt, mine, sp = 0u;
    for (;;) {
        sum = 0u; cnt = 0u; mine = 0u;
#pragma unroll
        for (unsigned j = 0; j < 16; ++j) { const unsigned c = xb_ld(&bar[XB_XCNT(j)]); sum += c; cnt += (c > 0u) ? 1u : 0u; mine = (j == x) ? c : mine; }
        if (sum == G) break;
        __builtin_amdgcn_s_sleep(1);
        if ((++sp & 255u) == 0u) { if (xb_ld(&bar[XB_TMO])) break; if (sp > XB_SPIN_CAP) { atomicAdd(&bar[XB_TMO], 1u); break; } }
    }
    nloc = mine > 0u ? mine : 1u; nx = cnt > 0u ? cnt : 1u;
}
__device__ __forceinline__ void xcd_barrier(const XcdBarrier& b) {
    asm volatile("s_waitcnt vmcnt(0)" ::: "memory");
    __syncthreads();
    if (threadIdx.x == 0) {
        unsigned* bar = b.bar;
        __builtin_amdgcn_s_waitcnt(0);
        unsigned nloc = b.st[0], nx = b.st[1];
        if (nloc == 0u) { xcd_barrier_complete(bar, b.x, nloc, nx); b.st[0] = nloc; b.st[1] = nx; }
        const unsigned k = b.st[2] + 1u; b.st[2] = k;
        const unsigned old = xb_add(&bar[XB_XSUB(b.x)], 1u);
        if (old + 1u == k * nloc) {
            __builtin_amdgcn_fence(__ATOMIC_RELEASE, "agent");
            asm volatile("s_waitcnt vmcnt(0)" ::: "memory");
            (void)xb_add(&bar[XB_TOP], 1u);
        }
        XB_SPIN(xb_ld(&bar[XB_TOP]) < k * nx, bar);
        __builtin_amdgcn_fence(__ATOMIC_ACQUIRE, "agent");
        asm volatile("s_waitcnt vmcnt(0)" ::: "memory");
    }
    __syncthreads();
}

constexpr int RING_OFF = 0, RING_BYTES = 131072;
constexpr int LDSCTL_OFF = RING_BYTES, MISC_OFF = LDSCTL_OFF + 320;
constexpr int LDS_BYTES = 147456;

struct Frame {
    LAS unsigned char* lds;
    volatile LAS unsigned* MISC;
    int tid, lane, wave, G, bid;
    bool skip_epi;
    float scale;
};
struct Args { const float* in[23]; float* out; unsigned char* ws; int nseq, pad; unsigned char seq[32]; };
#define ASSUME_GLOBAL(p) __builtin_assume(!__builtin_amdgcn_is_shared((const void*)(p)) && !__builtin_amdgcn_is_private((const void*)(p)))
__device__ __forceinline__ const float* inp(const Args& a, int i) { asm volatile("" : "+s"(i)); const float* p = a.in[i]; return (const float*)(const GAS float*)p; }
__device__ __forceinline__ unsigned char* wsb(const Args& a) { unsigned char* p = a.ws; asm volatile("" : "+s"(p)); return (unsigned char*)(GAS unsigned char*)p; }
__device__ __forceinline__ float* outb(const Args& a) { float* p = a.out; asm volatile("" : "+s"(p)); return (float*)(GAS float*)p; }
enum InIdx { I_XP = 0, I_XS, I_CK, I_CV, I_C, I_CCTX, I_WADA, I_BADA, I_NMIX, I_NFFN, I_NFIN, I_WQKV, I_WO, I_RPB, I_WIN, I_GV, I_WSP, I_BSP, I_WOUT, I_WUP, I_WCONV, I_BCONV, I_WDN };


#define G_LD4(p)   (*(const GAS f32x4*)(p))
#define G_LDU4(p)  (*(const GAS u32x4*)(p))
#define G_ST4(p,v) (*(GAS f32x4*)(p) = (v))
#define G_STU4(p,v) (*(GAS u32x4*)(p) = (v))

__device__ __forceinline__ int upmap(int n) { return n < FF ? ((n >> 7) << 8) + (n & 127) : (((n - FF) >> 7) << 8) + 128 + ((n - FF) & 127); }
constexpr int ADA_UNITS = 2 * 24 * 4;
__device__ __forceinline__ void p0_adaln_unit(const Frame& F, const Args& args, int u) {
    const float* w_ada = inp(args, I_WADA); const float* c_ctx = inp(args, I_CCTX); const float* cc = inp(args, I_C);
    float* MOD = (float*)(wsb(args) + WS_MOD);
    const int jb = u % 24, kq = (u / 24) & 3, l = u / 96;
    const int k0 = kq * 256 + F.wave * 32;
    const float* W = w_ada + ((size_t)l * D + k0) * 6144 + jb * 256 + F.lane * 4;
    f32x4 acc[5];
#pragma unroll
    for (int q = 0; q < 5; ++q) acc[q] = (f32x4){0.f, 0.f, 0.f, 0.f};
    for (int i0 = 0; i0 < 32; i0 += 16) {
        f32x4 w[16];
#pragma unroll
        for (int i = 0; i < 16; ++i) w[i] = G_LD4(W + (size_t)(i0 + i) * 6144);
#pragma unroll
        for (int i = 0; i < 16; ++i) { const int k = k0 + i0 + i;
            acc[0] += silu_f(c_ctx[k]) * w[i];
#pragma unroll
            for (int b = 0; b < 4; ++b) acc[1 + b] += silu_f(cc[b * D + k]) * w[i]; }
    }
    LAS f32x4* red = (LAS f32x4*)(F.lds + RING_OFF);
#pragma unroll
    for (int q = 0; q < 5; ++q) red[(F.wave * 5 + q) * 64 + F.lane] = acc[q];
    __syncthreads();
    const LAS float* redf = (const LAS float*)red;
    for (int o = F.tid; o < 5 * 256; o += NWAVES * 64) { const int q = o >> 8, c = o & 255;
        float s = 0.f;
#pragma unroll
        for (int w = 0; w < NWAVES; ++w) s += redf[(w * 5 + q) * 256 + c];
        if (kq == 0) s += inp(args, I_BADA)[l * 6144 + jb * 256 + c];
        atomicAdd(MOD + (size_t)(l * 5 + q) * 6144 + jb * 256 + c, s * F.scale); }
    __syncthreads();
}
constexpr int PI_QKV = (D / 64) * (NQKV / 32), PI_FIRST = PI_QKV;
constexpr int PI_CACHE = 4096, PI_WSP = 512, PI_O = (D / 64) * (D / 32), PI_IN = (D / 64) * (GE2 / 32), PI_OUT = (GE / 64) * (D / 32), PI_UP = (D / 64) * (FF2 / 32), PI_DN = (FF / 64) * (D / 32);
constexpr int PI_SECOND = PI_FIRST + PI_CACHE + PI_WSP + PI_O + PI_UP + PI_DN, PI_ALL = PI_SECOND + PI_UP + PI_DN + PI_IN + PI_OUT;
__device__ __forceinline__ void p0_transpose_seg(const float* W, int K, int N, bf16* WT, bool upperm, LAS float* scr, int it, int end, int stride, int lane) {
    if (it >= end) return;
    const int nblk = N / 32;
    f32x4 v[8];
    { const int k0 = 64 * (it / nblk), n0 = 32 * (it % nblk);
#pragma unroll
      for (int i = 0; i < 8; ++i) v[i] = G_LD4(W + (size_t)(k0 + 8 * i + (lane >> 3)) * N + n0 + 4 * (lane & 7)); }
    for (; it < end; it += stride) {
        const int k0 = 64 * (it / nblk), n0 = 32 * (it % nblk), nm0 = upperm ? upmap(n0) : n0;
#pragma unroll
        for (int i = 0; i < 8; ++i) { LAS float* d = scr + (8 * i + (lane >> 3)) * 33 + 4 * (lane & 7); d[0] = v[i].x; d[1] = v[i].y; d[2] = v[i].z; d[3] = v[i].w; }
        const int itn = it + stride;
        if (itn < end) { const int k1 = 64 * (itn / nblk), n1 = 32 * (itn % nblk);
#pragma unroll
            for (int i = 0; i < 8; ++i) v[i] = G_LD4(W + (size_t)(k1 + 8 * i + (lane >> 3)) * N + n1 + 4 * (lane & 7)); }
        LDS_WAIT(); asm volatile("" ::: "memory");
        const int c = lane & 7;
#pragma unroll
        for (int j = 0; j < 4; ++j) { const int n = (lane >> 3) + 8 * j; const LAS float* s = scr + (8 * c) * 33 + n;
            u32x4 o; o.x = cvt_pk_bf16(s[0 * 33], s[1 * 33]); o.y = cvt_pk_bf16(s[2 * 33], s[3 * 33]); o.z = cvt_pk_bf16(s[4 * 33], s[5 * 33]); o.w = cvt_pk_bf16(s[6 * 33], s[7 * 33]);
            G_STU4(WT + (size_t)(nm0 + n) * K + k0 + 8 * c, o); }
        LDS_WAIT(); asm volatile("" ::: "memory");
    }
}
__device__ __forceinline__ void p0_cache_seg(const Args& args, int it, int end, int stride, int lane) {
    if (it >= end) return;
    f32x4 a[4];
    { const int which = it >> 11, r = it & 2047, cg = r & 31, h = (r >> 5) & 15, b = r >> 9;
      const float* s = inp(args, which ? I_CV : I_CK) + (((size_t)b * NH + h) * PAST + cg * 16 + (lane >> 2)) * HD + (lane & 3) * 16;
#pragma unroll
      for (int i = 0; i < 4; ++i) a[i] = G_LD4(s + 4 * i); }
    for (; it < end; it += stride) {
        const int which = it >> 11, r = it & 2047, cg = r & 31, h = (r >> 5) & 15, b = r >> 9;
        bf16* d = (bf16*)(wsb(args) + (which ? WS_CV : WS_CK)) + ((size_t)b * PAST + cg * 16 + (lane >> 2)) * D + h * HD + (lane & 3) * 16;
        const u32x4 o0 = pack8(a[0], a[1]), o1 = pack8(a[2], a[3]);
        const int itn = it + stride;
        if (itn < end) { const int w1 = itn >> 11, r1 = itn & 2047, cg1 = r1 & 31, h1 = (r1 >> 5) & 15, b1 = r1 >> 9;
            const float* s = inp(args, w1 ? I_CV : I_CK) + (((size_t)b1 * NH + h1) * PAST + cg1 * 16 + (lane >> 2)) * HD + (lane & 3) * 16;
#pragma unroll
            for (int i = 0; i < 4; ++i) a[i] = G_LD4(s + 4 * i); }
        G_STU4(d, o0); G_STU4(d + 8, o1);
    }
}
__device__ __forceinline__ int first_from(int start, int stride, int s0) { return start >= s0 ? start : start + (s0 - start + stride - 1) / stride * stride; }
__device__ __forceinline__ void p0_items(const Frame& F, const Args& args, int lo, int hi, int fw, int nfw) {
    LAS float* scr = (LAS float*)(F.lds + RING_OFF + F.wave * 16384);
    unsigned char* ws = wsb(args);
    int base = 0;
#define P0_SEG(n, s0v, itv, endv) const int s0v = base; base += (n); const int endv = (hi < base ? hi : base) - s0v, itv = first_from(lo + fw, nfw, s0v) - s0v;
    { P0_SEG(PI_QKV, s0, it, end) p0_transpose_seg(inp(args, I_WQKV), D, NQKV, (bf16*)(ws + WS_WQKV), false, scr, it, end, nfw, F.lane); }
    if (hi <= base) return;
    { P0_SEG(PI_CACHE, s0, it, end) p0_cache_seg(args, it, end, nfw, F.lane); }
    { P0_SEG(PI_WSP, s0, it, end) for (int r = it; r < end; r += nfw) { const float* s = inp(args, I_WSP) + (size_t)r * 512 + F.lane * 8; const f32x4 a0 = *(const f32x4*)s, a1 = *(const f32x4*)(s + 4); *(u32x4*)((bf16*)(ws + WS_WSB) + (size_t)r * 512 + F.lane * 8) = pack8(a0, a1); } }
    { P0_SEG(PI_O, s0, it, end) p0_transpose_seg(inp(args, I_WO), D, D, (bf16*)(ws + WS_WO), false, scr, it, end, nfw, F.lane); }
    { P0_SEG(PI_UP, s0, it, end) p0_transpose_seg(inp(args, I_WUP), D, FF2, (bf16*)(ws + WS_WUP), true, scr, it, end, nfw, F.lane); }
    { P0_SEG(PI_DN, s0, it, end) p0_transpose_seg(inp(args, I_WDN), FF, D, (bf16*)(ws + WS_WDN), false, scr, it, end, nfw, F.lane); }
    if (hi <= base) return;
    { P0_SEG(PI_UP, s0, it, end) p0_transpose_seg(inp(args, I_WUP) + (size_t)D * FF2, D, FF2, (bf16*)(ws + WS_WUP) + (size_t)FF2 * D, true, scr, it, end, nfw, F.lane); }
    { P0_SEG(PI_DN, s0, it, end) p0_transpose_seg(inp(args, I_WDN) + (size_t)FF * D, FF, D, (bf16*)(ws + WS_WDN) + (size_t)D * FF, false, scr, it, end, nfw, F.lane); }
    { P0_SEG(PI_IN, s0, it, end) p0_transpose_seg(inp(args, I_WIN), D, GE2, (bf16*)(ws + WS_WIN), false, scr, it, end, nfw, F.lane); }
    { P0_SEG(PI_OUT, s0, it, end) p0_transpose_seg(inp(args, I_WOUT), GE, D, (bf16*)(ws + WS_WOUT), false, scr, it, end, nfw, F.lane); }
#undef P0_SEG
}
constexpr int ST_ITEMS = 2 * 32 * NH * (SEQ_C / 16);
__device__ __forceinline__ void state_items(const Frame& F, const Args& args, int fw, int nfw) {
    unsigned char* ws = wsb(args); float* out = outb(args);
    for (int it = fw; it < ST_ITEMS; it += nfw) {
        const int tg = it & 15, h = (it >> 4) & 15, b = (it >> 8) & 31, which = it >> 13;
        const bf16* src = (const bf16*)(ws + (which ? WS_VC : WS_KC)) + (size_t)(b * SEQ_C + tg * 16 + (F.lane >> 2)) * D + h * HD + (F.lane & 3) * 16;
        const u32x4 w0 = G_LDU4(src), w1 = G_LDU4(src + 8);
        float* dst = out + (size_t)MT * D + (size_t)which * NCTX * D + (((size_t)b * NH + h) * SEQ_C + tg * 16 + (F.lane >> 2)) * HD + (F.lane & 3) * 16;
        f32x4 o0, o1, o2, o3;
        o0.x = bflo(w0.x); o0.y = bfhi(w0.x); o0.z = bflo(w0.y); o0.w = bfhi(w0.y); o1.x = bflo(w0.z); o1.y = bfhi(w0.z); o1.z = bflo(w0.w); o1.w = bfhi(w0.w);
        o2.x = bflo(w1.x); o2.y = bfhi(w1.x); o2.z = bflo(w1.y); o2.w = bfhi(w1.y); o3.x = bflo(w1.z); o3.y = bfhi(w1.z); o3.z = bflo(w1.w); o3.w = bfhi(w1.w);
        G_ST4(dst, o0); G_ST4(dst + 4, o1); G_ST4(dst + 8, o2); G_ST4(dst + 12, o3);
    }
}
__device__ __forceinline__ bool filler_slot(const Frame& F, int nunits, int& fw, int& nfw) {
    const int rem = nunits % F.G, first = rem, nblk = F.G - rem;
    if (F.bid < first) return false;
    fw = (F.bid - first) * NWAVES + F.wave; nfw = nblk * NWAVES; return true;
}

__device__ __forceinline__ void p1_rows(const Frame& F, const Args& args, const int gw, const int nbusy) {
    const int NGW = F.G * NWAVES, lane = F.lane;
    const float* xp = inp(args, I_XP); const float* xs = inp(args, I_XS); const float* gmix = inp(args, I_NMIX);
    unsigned char* ws = wsb(args);
    const float* MOD = (const float*)(ws + WS_MOD); float* RS = (float*)(ws + WS_RS); bf16* AN = (bf16*)(ws + WS_AN);
    const int nshort = NGW > 2 * nbusy ? nbusy : 0; const bool busy = gw < nshort;
    int m = busy ? gw : 3 * nshort + (gw - nshort); const int mstep = busy ? nshort : NGW - nshort, mend = busy ? 3 * nshort : MT;
    f32x4 g[4], v[4];
#pragma unroll
    for (int j = 0; j < 4; ++j) g[j] = G_LD4(gmix + 4 * lane + 256 * j);
    if (m < mend) { const float* xr = (m < NCTX) ? xp + (size_t)m * D : xs + (size_t)(m - NCTX) * D;
#pragma unroll
        for (int j = 0; j < 4; ++j) v[j] = G_LD4((const f32x4*)xr + lane + 64 * j); }
    for (; m < mend; m += mstep) {
        const float* sc = MOD + (size_t)ci_of(m) * 6144 + 1024;
        f32x4 cs[4], vn[4];
#pragma unroll
        for (int j = 0; j < 4; ++j) cs[j] = G_LD4(sc + 4 * lane + 256 * j);
        const int mn = m + mstep;
        if (mn < mend) { const float* xr = (mn < NCTX) ? xp + (size_t)mn * D : xs + (size_t)(mn - NCTX) * D;
#pragma unroll
            for (int j = 0; j < 4; ++j) vn[j] = G_LD4((const f32x4*)xr + lane + 64 * j); }
        float s = 0.f;
#pragma unroll
        for (int j = 0; j < 4; ++j) s += (v[j].x * v[j].x + v[j].y * v[j].y) + (v[j].z * v[j].z + v[j].w * v[j].w);
        s = wave_sum(s);
        if (lane == 0) G_ST4(RS + (size_t)m * 4, ((f32x4){s, 0.f, 0.f, 0.f}));
#pragma unroll
        for (int j = 0; j < 4; ++j) { const int col = 4 * lane + 256 * j;
            const f32x4 o = v[j] * g[j] * (1.f + cs[j]);
            u32x2 w; w.x = cvt_pk_bf16(o[0], o[1]); w.y = cvt_pk_bf16(o[2], o[3]);
            *(GAS u32x2*)(AN + (size_t)m * D + col) = w; }
#pragma unroll
        for (int j = 0; j < 4; ++j) v[j] = vn[j];
    }
}
namespace pg8 {
#define PG8_LAS __attribute__((address_space(3)))
typedef unsigned short bf16_t;
typedef short bf16x8 __attribute__((ext_vector_type(8)));
typedef float f32x4 __attribute__((ext_vector_type(4)));
typedef unsigned u32x4 __attribute__((ext_vector_type(4)));
constexpr int BM = 256, BK = 64, HALF = 128, HTB = HALF * BK * 2  , STAGE_BYTES = 8 * HTB, NXCD = 8, WGM = 8;

__host__ __device__ __forceinline__ int lds_byte(int r, int c) { const int st = (r >> 4) * 2 + (c >> 5), rr = r & 15, cc = c & 31, ob = rr * 64 + cc * 2; return st * 1024 + (ob ^ (((ob >> 9) & 1) << 5)); }
__host__ __device__ __forceinline__ void stage_rc(int b, int& R, int& C) { const int st = b / 1024, sb = b % 1024, swz = sb ^ (((sb >> 9) & 1) << 5); R = (st >> 1) * 16 + swz / 64; C = (st & 1) * 32 + (swz % 64) / 2; }
__host__ __device__ __forceinline__ int perm32(int rho) { const int n = rho >> 4, i = rho & 15; return 8 * (i >> 2) + 4 * n + (i & 3); }

struct Unit { int pm, pn; };
struct Gemm { const bf16_t* A; const bf16_t* Bt; int M, N, K; };

struct StaticOrder {
    int nM, nN, nwg, G, c;
    __host__ __device__ void init(int M, int N, int G_, int c_, int bmr = BM) { nM = M / bmr; nN = N / BM; nwg = nM * nN; G = G_; c = c_; }
    __host__ __device__ bool next(int i, Unit& u) const {
        const long L = (long)i * G + c; if (L >= nwg) return false;
        int wgid = (int)L; { const int q = nwg / NXCD, r = nwg % NXCD, xcd = wgid % NXCD, off = wgid / NXCD; wgid = (xcd < r ? xcd * (q + 1) : r * (q + 1) + (xcd - r) * q) + off; }
        const int nig = WGM * nN, gid = wgid / nig, fm = gid * WGM, gsz = (nM - fm) < WGM ? (nM - fm) : WGM;
        u.pm = fm + ((wgid % nig) % gsz); u.pn = (wgid % nig) / gsz; return true;
    }
    __device__ __forceinline__ void a_ready(const Unit&) const {}
    __device__ __forceinline__ void done(const Unit&) const {}
};

template <class E> struct epi_is_final { static constexpr bool value = false; };
template <class E, int NRED, int MB = 4> struct EpiAdapt {
    static constexpr bool PERM = true, AFTER_DRAIN = false, HAS_UPF = E::HAS_LIN; static constexpr int BMR = 64 * MB;
    static constexpr int STL_OFF = 2560;
    __device__ __forceinline__ void unit_prefetch(const Unit& u, int wid, int lane) const {
        if constexpr (E::HAS_LIN) {
            if (wid < 4) __builtin_amdgcn_global_load_lds((const unsigned*)(e.L.RS + (size_t)(row0 + u.pm * BMR + wid * 64 + lane) * 4), (PG8_LAS unsigned*)(P + STL_OFF + wid * 256), 16, 0, 0);
            else if (wid == 4) __builtin_amdgcn_global_load_lds((const unsigned*)(e.L.SW + (size_t)ci_of(row0 + u.pm * BMR) * e.L.N + u.pn * BM + lane * 4), (PG8_LAS unsigned*)(P + STL_OFF + 1024), 16, 0, 0);
        }
    }
    __device__ __forceinline__ void fused(f32x4 (&acc)[2][2][MB][2], const Unit& u, int wr, int wc, int fr, int fq, PG8_LAS unsigned char*, int, int) const { (*this)(acc, u, wr, wc, fr, fq); }
    E e; int row0; PG8_LAS float* P; bool skip;
    __device__ __forceinline__ void operator()(f32x4 (&acc)[2][2][MB][2], const Unit& u, int wr, int wc, int fr, int fq) const {
        if (skip) return;
        asm volatile("" : "+v"(fr), "+v"(fq));
        const int rl = wr * 16 * MB + fr, rbase = row0 + u.pm * BMR + rl, cbase = u.pn * BM + wc * 32 + 8 * fq;
        float red[2][MB][NRED > 0 ? NRED : 1];
#pragma unroll
        for (int ai = 0; ai < 2; ++ai)
#pragma unroll
            for (int m = 0; m < MB; ++m)
#pragma unroll
                for (int k = 0; k < (NRED > 0 ? NRED : 1); ++k) red[ai][m][k] = 0.f;
        if constexpr (E::HAS_LIN) {
            static_assert(MB == 4, "HAS_LIN epilogues run on 256-row tiles");
            f32x4 p[2][MB], sw[2][2];
#pragma unroll
            for (int ai = 0; ai < 2; ++ai)
#pragma unroll
                for (int m = 0; m < MB; ++m) p[ai][m] = *(const PG8_LAS f32x4*)(P + STL_OFF + (rl + ai * (BMR / 2) + m * 16) * 4);
            { const PG8_LAS float* s = P + STL_OFF + 1024 + wc * 32 + 8 * fq;
#pragma unroll
              for (int bj = 0; bj < 2; ++bj) { sw[bj][0] = *(const PG8_LAS f32x4*)(s + bj * HALF); sw[bj][1] = *(const PG8_LAS f32x4*)(s + bj * HALF + 4); } }
            asm volatile("s_waitcnt lgkmcnt(0)" ::: "memory"); __builtin_amdgcn_s_barrier(); asm volatile("" ::: "memory");
#pragma unroll
            for (int ai = 0; ai < 2; ++ai)
#pragma unroll
                for (int m = 0; m < MB; ++m) { const f32x4 q = p[ai][m];
                    const float r = __builtin_amdgcn_rsqf(((q.x + q.y) + (q.z + q.w)) * (1.f / D) + EPS);
#pragma unroll
                    for (int bj = 0; bj < 2; ++bj) e.post(rbase + ai * (BMR / 2) + m * 16, cbase + bj * HALF, acc[ai][bj][m][0] * r + sw[bj][0], acc[ai][bj][m][1] * r + sw[bj][1], red[ai][m]); }
        } else if constexpr (E::HAS_PRE) {
            PG8_LAS float* ST = P + 2048;
            const int ci_lo = ci_of(row0 + u.pm * BMR), ci_hi = ci_of(row0 + u.pm * BMR + BMR - 1);
            { const int t = (wr * 4 + wc) * 64 + fq * 16 + fr;
              float sv[2];
#pragma unroll
              for (int k = 0; k < 2; ++k) { const int idx = t + 512 * k; sv[k] = e.stage_val(idx >> 9, ((idx >> 8) & 1) ? ci_hi : ci_lo, u.pn * BM + (idx & 255)); }
#pragma unroll
              for (int k = 0; k < 2; ++k) ST[t + 512 * k] = sv[k]; }
#define PG8_STP(row, col) (ST + (ci_of(row) != ci_lo ? 256 : 0) + ((col) - u.pn * BM))
            if constexpr (E::PRE_HALVES) {
#pragma unroll
                for (int ai = 0; ai < 2; ++ai) {
                    typename E::Pre pre[MB][2];
#pragma unroll
                    for (int m = 0; m < MB; ++m)
#pragma unroll
                        for (int bj = 0; bj < 2; ++bj) pre[m][bj] = e.prefetch(rbase + ai * (BMR / 2) + m * 16, cbase + bj * HALF);
                    __builtin_amdgcn_sched_barrier(0);
                    if (ai == 0) { asm volatile("s_waitcnt lgkmcnt(0)" ::: "memory"); __builtin_amdgcn_s_barrier(); asm volatile("" ::: "memory"); }
#pragma unroll
                    for (int m = 0; m < MB; ++m)
#pragma unroll
                        for (int bj = 0; bj < 2; ++bj) e.apply_pre(rbase + ai * (BMR / 2) + m * 16, cbase + bj * HALF, acc[ai][bj][m][0], acc[ai][bj][m][1], red[ai][m], pre[m][bj], PG8_STP(rbase + ai * (BMR / 2) + m * 16, cbase + bj * HALF));
                    __builtin_amdgcn_sched_barrier(0); }
            } else {
            typename E::Pre pre[2][MB][2];
#pragma unroll
            for (int ai = 0; ai < 2; ++ai)
#pragma unroll
                for (int m = 0; m < MB; ++m)
#pragma unroll
                    for (int bj = 0; bj < 2; ++bj) pre[ai][m][bj] = e.prefetch(rbase + ai * (BMR / 2) + m * 16, cbase + bj * HALF);
            __builtin_amdgcn_sched_barrier(0);
            asm volatile("s_waitcnt lgkmcnt(0)" ::: "memory"); __builtin_amdgcn_s_barrier(); asm volatile("" ::: "memory");
#pragma unroll
            for (int ai = 0; ai < 2; ++ai)
#pragma unroll
                for (int m = 0; m < MB; ++m)
#pragma unroll
                    for (int bj = 0; bj < 2; ++bj) e.apply_pre(rbase + ai * (BMR / 2) + m * 16, cbase + bj * HALF, acc[ai][bj][m][0], acc[ai][bj][m][1], red[ai][m], pre[ai][m][bj], PG8_STP(rbase + ai * (BMR / 2) + m * 16, cbase + bj * HALF));
            }
        } else {
#pragma unroll
        for (int ai = 0; ai < 2; ++ai)
#pragma unroll
            for (int m = 0; m < MB; ++m)
#pragma unroll
                for (int bj = 0; bj < 2; ++bj) e.apply(rbase + ai * (BMR / 2) + m * 16, cbase + bj * HALF, acc[ai][bj][m][0], acc[ai][bj][m][1], red[ai][m]);
        }
        if constexpr (NRED > 0) {
            if (e.want_red(u.pn)) {
#pragma unroll
                for (int ai = 0; ai < 2; ++ai)
#pragma unroll
                    for (int m = 0; m < MB; ++m)
#pragma unroll
                        for (int k = 0; k < NRED; ++k) { float s = red[ai][m][k]; s += __shfl_xor(s, 16); s += __shfl_xor(s, 32); if (fq == 0) P[((ai * (BMR / 2) + rl + m * 16) * 4 + wc) * 2 + k] = s; }
                asm volatile("s_waitcnt lgkmcnt(0)" ::: "memory"); __builtin_amdgcn_s_barrier(); asm volatile("" ::: "memory");
                const int t = (wr * 4 + wc) * 64 + fq * 16 + fr;
                if (t < BMR) { float r[NRED];
#pragma unroll
                    for (int k = 0; k < NRED; ++k) r[k] = (P[(t * 4 + 0) * 2 + k] + P[(t * 4 + 1) * 2 + k]) + (P[(t * 4 + 2) * 2 + k] + P[(t * 4 + 3) * 2 + k]);
                    e.store_red(row0 + u.pm * BMR + t, u.pn, r); }
                if constexpr (epi_is_final<E>::value) {
                    wave_publish(e.cnt + 64 * u.pm);
                    if (wr == 0 && wc == 0) { wave_wait_ge(e.cnt + 64 * u.pm, 4 * 8, e.tmo); __builtin_amdgcn_fence(__ATOMIC_ACQUIRE, "agent"); }
                    asm volatile("s_waitcnt vmcnt(0) lgkmcnt(0)" ::: "memory"); __builtin_amdgcn_s_barrier(); asm volatile("" ::: "memory");
                    if (t < BMR) P[t] = e.row_scale(row0 + u.pm * BMR + t);
                    asm volatile("s_waitcnt lgkmcnt(0)" ::: "memory"); __builtin_amdgcn_s_barrier(); asm volatile("" ::: "memory");
                    f32x4 xq[2][MB][2][2], gf[2][2];
#pragma unroll
                    for (int bj = 0; bj < 2; ++bj) { gf[bj][0] = G_LD4(e.gfin + cbase + bj * HALF); gf[bj][1] = G_LD4(e.gfin + cbase + bj * HALF + 4); }
#pragma unroll
                    for (int ai = 0; ai < 2; ++ai)
#pragma unroll
                        for (int m = 0; m < MB; ++m)
#pragma unroll
                            for (int bj = 0; bj < 2; ++bj) { const float* o = e.Y + (size_t)(rbase + ai * (BMR / 2) + m * 16) * D + cbase + bj * HALF; xq[ai][m][bj][0] = G_LD4(o); xq[ai][m][bj][1] = G_LD4(o + 4); }
                    __builtin_amdgcn_sched_barrier(0);
#pragma unroll
                    for (int ai = 0; ai < 2; ++ai)
#pragma unroll
                        for (int m = 0; m < MB; ++m) { const float rs = P[ai * (BMR / 2) + rl + m * 16];
#pragma unroll
                            for (int bj = 0; bj < 2; ++bj) { float* o = e.Y + (size_t)(rbase + ai * (BMR / 2) + m * 16) * D + cbase + bj * HALF;
                                G_ST4(o, xq[ai][m][bj][0] * rs * gf[bj][0]); G_ST4(o + 4, xq[ai][m][bj][1] * rs * gf[bj][1]); } }
                }
            }
        }
    }
};
template <class Epi, class Sched, bool ALIGN_EPI = false, bool SP2 = false, int MB = 4>
__device__ __forceinline__ void gemm_phase(PG8_LAS unsigned char* lds, const Gemm g, const Sched& S, const Epi& E, const int tid) {
    const int wid = __builtin_amdgcn_readfirstlane(tid >> 6), lane = tid & 63, wr = wid >> 2, wc = wid & 3, fr = lane & 15, fq = lane >> 4;
    const int K = g.K, nt = K / BK;
    unsigned voffA[2], voffB[2];
#pragma unroll
    for (int i = 0; i < 2; ++i) { int R, C; stage_rc(tid * 16 + i * 8192, R, C); const int Rb = Epi::PERM ? ((R & ~31) + perm32(R & 31)) : R;
        voffA[i] = (unsigned)((R < 32 * MB ? R : 0) * K + C) * 2u; voffB[i] = (unsigned)(Rb * K + C) * 2u; }
    const size_t kstep = (size_t)(BK * 2);
    const size_t hstep = (size_t)HALF * K * 2;
    const size_t tstep = 2 * hstep;
    const size_t hstepA = (size_t)(32 * MB) * K * 2, tstepA = 2 * hstepA;
    const unsigned ldsw = (unsigned)wid * 1024u;
    const int aoff = lds_byte(wr * 16 * MB + fr, fq * 8), boff = lds_byte(wc * 32 + fr, fq * 8);
#define PG8_SA(b, h) (((b) * 2 + (h)) * HTB)
#define PG8_SB(b, h) ((4 + (b) * 2 + (h)) * HTB)
#define PG8_STAGE(bufoff, gbase, voff) do { _Pragma("unroll") for (int _i = 0; _i < 2; ++_i) \
        __builtin_amdgcn_global_load_lds((const unsigned*)((const char*)(gbase) + (voff)[_i]), (PG8_LAS unsigned*)(lds + (bufoff) + ldsw + _i * 8192), 16, 0, 0); } while (0)
#define PG8_LDA(dst, b, h) do { _Pragma("unroll") for (int m = 0; m < MB; ++m) _Pragma("unroll") for (int k = 0; k < 2; ++k) dst[m][k] = *(const PG8_LAS bf16x8*)(lds + PG8_SA(b, h) + aoff + m * 2048 + k * 1024); } while (0)
#define PG8_LDB(dst, b, h) do { _Pragma("unroll") for (int n = 0; n < 2; ++n) _Pragma("unroll") for (int k = 0; k < 2; ++k) dst[n][k] = *(const PG8_LAS bf16x8*)(lds + PG8_SB(b, h) + boff + n * 2048 + k * 1024); } while (0)
#define PG8_MMA(ai, bj, At, Bt) do { __builtin_amdgcn_s_setprio(1); _Pragma("unroll") for (int m = 0; m < MB; ++m) _Pragma("unroll") for (int n = 0; n < 2; ++n) _Pragma("unroll") for (int k = 0; k < 2; ++k) \
        acc[ai][bj][m][n] = __builtin_amdgcn_mfma_f32_16x16x32_bf16(Bt[n][k], At[m][k], acc[ai][bj][m][n], 0, 0, 0); __builtin_amdgcn_s_setprio(0); } while (0)
#define PG8_WAIT_V(n) asm volatile("s_waitcnt vmcnt(" #n ")" ::: "memory")
#define PG8_WAIT_L(n) asm volatile("s_waitcnt lgkmcnt(" #n ")" ::: "memory")
#define PG8_BAR __builtin_amdgcn_s_barrier()
#define PG8_SCHED __builtin_amdgcn_sched_barrier(0)
    Unit cur, nxt; int ui = 0;
    if (!S.next(0, cur)) return;
    f32x4 acc[2][2][MB][2];
#pragma unroll
    for (int a = 0; a < 2; ++a)
#pragma unroll
        for (int b = 0; b < 2; ++b)
#pragma unroll
            for (int m = 0; m < MB; ++m)
#pragma unroll
                for (int n = 0; n < 2; ++n) acc[a][b][m][n] = (f32x4){0.f, 0.f, 0.f, 0.f};
    bf16x8 At[MB][2], B0[2][2], B1[2][2];
    const char* cA = (const char*)g.A + (size_t)cur.pm * tstepA; const char* cB = (const char*)g.Bt + (size_t)cur.pn * tstep;
    S.a_ready(cur);
    if constexpr (SP2) {
        PG8_STAGE(PG8_SB(0, 0), cB, voffB); PG8_STAGE(PG8_SB(0, 1), cB + hstep, voffB); PG8_STAGE(PG8_SA(0, 0), cA, voffA); PG8_STAGE(PG8_SA(0, 1), cA + hstepA, voffA);
        if (wr == 1) PG8_BAR;
        PG8_WAIT_V(2); PG8_BAR;
        PG8_STAGE(PG8_SB(1, 0), cB + kstep, voffB); PG8_STAGE(PG8_SA(1, 0), cA + kstep, voffA); PG8_STAGE(PG8_SB(1, 1), cB + hstep + kstep, voffB);
        PG8_WAIT_V(6); PG8_BAR;
    } else {
        PG8_STAGE(PG8_SB(0, 0), cB, voffB); PG8_STAGE(PG8_SA(0, 0), cA, voffA); PG8_STAGE(PG8_SB(0, 1), cB + hstep, voffB); PG8_STAGE(PG8_SA(0, 1), cA + hstepA, voffA);
        if (wr == 1) PG8_BAR;
        PG8_WAIT_V(4); PG8_BAR;
        PG8_STAGE(PG8_SB(1, 0), cB + kstep, voffB); PG8_STAGE(PG8_SA(1, 0), cA + kstep, voffA); PG8_STAGE(PG8_SB(1, 1), cB + hstep + kstep, voffB);
        PG8_WAIT_V(6); PG8_BAR;
    }
    for (;;) {
        const bool has_next = S.next(ui + 1, nxt);
        const char* nA = has_next ? (const char*)g.A + (size_t)nxt.pm * tstepA : cA; const char* nB = has_next ? (const char*)g.Bt + (size_t)nxt.pn * tstep : cB;
        if constexpr (Epi::HAS_UPF) E.unit_prefetch(cur, wid, lane);
        for (int t = 0; t < nt; t += 2) {
            const bool last = (t == nt - 2);
            const char* a1 = cA + (size_t)(t + 1) * kstep;
            const char* a2 = last ? nA : cA + (size_t)(t + 2) * kstep; const char* b2 = last ? nB : cB + (size_t)(t + 2) * kstep;
            const char* a3 = a2 + kstep; const char* b3 = b2 + kstep;
            if (last && has_next) S.a_ready(nxt);
            if constexpr (SP2) {
            PG8_LDB(B0, 0, 0); PG8_LDB(B1, 0, 1); PG8_SCHED; PG8_LDA(At, 0, 0); PG8_STAGE(PG8_SA(1, 1), a1 + hstepA, voffA);
            PG8_WAIT_V(8); PG8_WAIT_L(0); PG8_BAR; PG8_MMA(0, 0, At, B0); PG8_MMA(0, 1, At, B1); PG8_BAR; PG8_SCHED;
            PG8_LDA(At, 0, 1); PG8_STAGE(PG8_SB(0, 0), b2, voffB); PG8_STAGE(PG8_SB(0, 1), b2 + hstep, voffB); PG8_STAGE(PG8_SA(0, 0), a2, voffA);
            PG8_WAIT_V(8); PG8_WAIT_L(0); PG8_BAR; PG8_MMA(1, 0, At, B0); PG8_MMA(1, 1, At, B1); PG8_BAR; PG8_SCHED;
            PG8_LDB(B0, 1, 0); PG8_LDB(B1, 1, 1); PG8_SCHED; PG8_LDA(At, 1, 0); PG8_STAGE(PG8_SA(0, 1), a2 + hstepA, voffA);
            PG8_WAIT_V(8); PG8_WAIT_L(0); PG8_BAR; PG8_MMA(0, 0, At, B0); PG8_MMA(0, 1, At, B1); PG8_BAR; PG8_SCHED;
            PG8_LDA(At, 1, 1); PG8_STAGE(PG8_SB(1, 0), b3, voffB); PG8_STAGE(PG8_SB(1, 1), b3 + hstep, voffB); PG8_STAGE(PG8_SA(1, 0), a3, voffA);
            PG8_WAIT_V(8); PG8_WAIT_L(0); PG8_BAR; PG8_MMA(1, 0, At, B0); PG8_MMA(1, 1, At, B1); PG8_BAR; PG8_SCHED;
            } else {
            PG8_LDB(B0, 0, 0); PG8_SCHED; PG8_LDA(At, 0, 0); PG8_STAGE(PG8_SA(1, 1), a1 + hstepA, voffA);
            PG8_WAIT_L(8); PG8_BAR; PG8_WAIT_L(0); PG8_MMA(0, 0, At, B0); PG8_BAR; PG8_SCHED;
            PG8_LDB(B1, 0, 1); PG8_STAGE(PG8_SB(0, 0), b2, voffB);
            PG8_BAR; PG8_WAIT_L(0); PG8_MMA(0, 1, At, B1); PG8_BAR;
            PG8_LDA(At, 0, 1); PG8_STAGE(PG8_SA(0, 0), a2, voffA);
            PG8_BAR; PG8_WAIT_L(0); PG8_MMA(1, 0, At, B0); PG8_BAR; PG8_SCHED;
            PG8_STAGE(PG8_SB(0, 1), b2 + hstep, voffB);
            PG8_WAIT_V(6); PG8_BAR; PG8_MMA(1, 1, At, B1); PG8_BAR;
            PG8_LDB(B0, 1, 0); PG8_SCHED; PG8_LDA(At, 1, 0); PG8_STAGE(PG8_SA(0, 1), a2 + hstepA, voffA);
            PG8_WAIT_L(8); PG8_BAR; PG8_WAIT_L(0); PG8_MMA(0, 0, At, B0); PG8_BAR; PG8_SCHED;
            PG8_LDB(B1, 1, 1); PG8_STAGE(PG8_SB(1, 0), b3, voffB);
            PG8_BAR; PG8_WAIT_L(0); PG8_MMA(0, 1, At, B1); PG8_BAR;
            PG8_LDA(At, 1, 1); PG8_STAGE(PG8_SA(1, 0), a3, voffA);
            PG8_BAR; PG8_WAIT_L(0); PG8_MMA(1, 0, At, B0); PG8_BAR; PG8_SCHED;
            PG8_STAGE(PG8_SB(1, 1), b3 + hstep, voffB);
            PG8_WAIT_V(6); PG8_BAR; PG8_MMA(1, 1, At, B1); PG8_BAR;
            }
        }
        if constexpr (ALIGN_EPI) { if (wr == 0) PG8_BAR; }
        if constexpr (!Epi::AFTER_DRAIN) { E(acc, cur, wr, wc, fr, fq); S.done(cur); }
        if (!has_next) break;
#pragma unroll
        for (int a = 0; a < 2; ++a)
#pragma unroll
            for (int b = 0; b < 2; ++b)
#pragma unroll
                for (int m = 0; m < 4; ++m)
#pragma unroll
                    for (int n = 0; n < 2; ++n) acc[a][b][m][n] = (f32x4){0.f, 0.f, 0.f, 0.f};
        cur = nxt; cA = nA; cB = nB; ++ui;
        if constexpr (ALIGN_EPI) { if (wr == 1) PG8_BAR; }
    }
    PG8_WAIT_V(0);
    if constexpr (!ALIGN_EPI) { if (wr == 0) PG8_BAR; }
    PG8_BAR;
    if constexpr (Epi::AFTER_DRAIN) { E.fused(acc, cur, wr, wc, fr, fq, lds, wid, lane); S.done(cur); }
#undef PG8_SA
#undef PG8_SB
#undef PG8_STAGE
#undef PG8_LDA
#undef PG8_LDB
#undef PG8_MMA
#undef PG8_WAIT_V
#undef PG8_WAIT_L
#undef PG8_BAR
#undef PG8_SCHED
}
}

__device__ __forceinline__ void p1_sw_item(const bf16* WT, int N, const float* shift  , float* out, int item, int lane, float scale) {
    const int fr = lane & 15, fq = lane >> 4, n0 = (item >> 2) * 64, kq = (item & 3) * 256;
    f32x4 acc[4];
#pragma unroll
    for (int j = 0; j < 4; ++j) acc[j] = (f32x4){0.f, 0.f, 0.f, 0.f};
    const float* sp = shift + (size_t)(fr < 5 ? fr : 0) * 6144 + kq + fq * 8;
    const bf16* bp = WT + (size_t)(n0 + 8 * (fr >> 2) + (fr & 3)) * D + kq + fq * 8;
#pragma unroll
    for (int k0 = 0; k0 < 256; k0 += 128) {
        bf16x8 a[4], b[4][4];
#pragma unroll
        for (int ks = 0; ks < 4; ++ks) { const f32x4 s0 = *(const f32x4*)(sp + k0 + 32 * ks), s1 = *(const f32x4*)(sp + k0 + 32 * ks + 4);
            a[ks] = __builtin_bit_cast(bf16x8, pack8(s0, s1));
#pragma unroll
            for (int nj = 0; nj < 4; ++nj) b[ks][nj] = *(const bf16x8*)(bp + (size_t)(32 * (nj >> 1) + 4 * (nj & 1)) * D + k0 + 32 * ks); }
#pragma unroll
        for (int ks = 0; ks < 4; ++ks)
#pragma unroll
            for (int nj = 0; nj < 4; ++nj) acc[nj] = __builtin_amdgcn_mfma_f32_16x16x32_bf16(b[ks][nj], a[ks], acc[nj], 0, 0, 0);
    }
    if (fr < 5) {
#pragma unroll
        for (int nj = 0; nj < 4; ++nj)
#pragma unroll
            for (int e = 0; e < 4; ++e) atomicAdd(out + (size_t)fr * N + n0 + 32 * (nj >> 1) + 8 * fq + 4 * (nj & 1) + e, acc[nj][e] * scale); }
}
constexpr int SWI_QKV = NQKV / 16, SWI_ALL = NQKV / 16 + FF2 / 16 + GE2 / 16 + FF2 / 16;
__device__ __forceinline__ void p1_sw_items(const Frame& F, const Args& args, int lo, int hi, int fw, int nfw) {
    unsigned char* ws = wsb(args); const float* MOD0 = (const float*)(ws + WS_MOD); const float* MOD1 = MOD0 + 5 * 6144; float* SW = (float*)(ws + WS_SW);
    constexpr int I0 = NQKV / 16, I1 = FF2 / 16, I2 = GE2 / 16;
    for (int it = lo + fw; it < hi; it += nfw) { int r = it;
        if (r < I0) { p1_sw_item((const bf16*)(ws + WS_WQKV), NQKV, MOD0 + 0, SW + SW_QKV, r, F.lane, F.scale); continue; } r -= I0;
        if (r < I1) { p1_sw_item((const bf16*)(ws + WS_WUP), FF2, MOD0 + 3072, SW + SW_UP0, r, F.lane, F.scale); continue; } r -= I1;
        if (r < I2) { p1_sw_item((const bf16*)(ws + WS_WIN), GE2, MOD1 + 0, SW + SW_IN, r, F.lane, F.scale); continue; } r -= I2;
        p1_sw_item((const bf16*)(ws + WS_WUP) + (size_t)FF2 * D, FF2, MOD1 + 3072, SW + SW_UP1, r, F.lane, F.scale); }
}

constexpr int SWU_IN = (GE2 / 256) * 4, SWU_ALL = SWU_IN + (FF2 / 256) * 4;
__device__ __forceinline__ void sw_unit_f32(const Frame& F, const float* W, int N, const float* shift  , float* out, bool upperm, int u) {
    const int nblk = N / 256, nb = u % nblk, kq = u / nblk;
    const int k0 = kq * 256 + F.wave * 32;
    const float* Wp = W + (size_t)k0 * N + nb * 256 + F.lane * 4;
    float sh[5];
#pragma unroll
    for (int q = 0; q < 5; ++q) sh[q] = *(GAS const float*)(shift + (size_t)q * 6144 + k0 + (F.lane & 31));
    f32x4 acc[5];
#pragma unroll
    for (int q = 0; q < 5; ++q) acc[q] = (f32x4){0.f, 0.f, 0.f, 0.f};
#pragma unroll
    for (int i0 = 0; i0 < 32; i0 += 16) {
        f32x4 w[16];
#pragma unroll
        for (int i = 0; i < 16; ++i) w[i] = G_LD4(Wp + (size_t)(i0 + i) * N);
#pragma unroll
        for (int i = 0; i < 16; ++i)
#pragma unroll
            for (int q = 0; q < 5; ++q) acc[q] += __builtin_bit_cast(float, __builtin_amdgcn_readlane(__builtin_bit_cast(int, sh[q]), i0 + i)) * w[i];
    }
    LAS f32x4* red = (LAS f32x4*)(F.lds + RING_OFF);
    __syncthreads();
#pragma unroll
    for (int q = 0; q < 5; ++q) red[(F.wave * 5 + q) * 64 + F.lane] = acc[q];
    __syncthreads();
    const LAS float* redf = (const LAS float*)red;
    for (int o = F.tid; o < 5 * 256; o += NWAVES * 64) { const int q = o >> 8, n = nb * 256 + (o & 255);
        float s = 0.f;
#pragma unroll
        for (int w = 0; w < NWAVES; ++w) s += redf[(w * 5 + q) * 256 + (o & 255)];
        atomicAdd(out + (size_t)q * N + (upperm ? upmap(n) : n), s * F.scale); }
    __syncthreads();
}
__device__ __forceinline__ void sw_units_f32(const Frame& F, const Args& args, int fb, int nfb) {
    const float* MOD1 = (const float*)(wsb(args) + WS_MOD) + 5 * 6144; float* SW = (float*)(wsb(args) + WS_SW);
    for (int u = fb; u < SWU_ALL; u += nfb) {
        if (u < SWU_IN) sw_unit_f32(F, inp(args, I_WIN), GE2, MOD1 + 0, SW + SW_IN, false, u);
        else sw_unit_f32(F, inp(args, I_WUP) + (size_t)D * FF2, FF2, MOD1 + 3072, SW + SW_UP1, true, u - SWU_IN); }
}

constexpr int EPI_OFF = 132096;
template <int NRED, class Epi, int MB = 4>
__device__ __forceinline__ void gemm_pg8(const Frame& F, const bf16* A, const bf16* Bt, int row0, int Mrows, int N, int K, const Epi& E) {
    pg8::Gemm g{A + (size_t)row0 * K, Bt, Mrows, N, K}; pg8::StaticOrder S; S.init(Mrows, N, F.G, F.bid, 64 * MB);
    pg8::EpiAdapt<Epi, NRED, MB> EA{E, row0, (LAS float*)(F.lds + EPI_OFF), F.skip_epi};
    pg8::gemm_phase<pg8::EpiAdapt<Epi, NRED, MB>, pg8::StaticOrder, true, true, MB>(F.lds + RING_OFF, g, S, EA, F.tid);
}


struct RowLin {
    const float* RS; const float* SW; int N;
};
struct EpiQKV { static constexpr bool HAS_PRE = false, HAS_LIN = true;
    RowLin L; unsigned char* ws;
    __device__ __forceinline__ void post(int row, int col, f32x4 v0, f32x4 v1, float*) const {
        const int which = col >> 10, cc = col & 1023;
        if (which == 0) { v0 = v0 * C2; v1 = v1 * C2; }
        const size_t off = which == 0 ? WS_Q : (row < NCTX ? (which == 1 ? WS_KC : WS_VC) : (which == 1 ? WS_K : WS_V));
        G_STU4((bf16*)(ws + off) + (size_t)row * D + cc, pack8(v0, v1));
    }
};
template <int MODE> struct EpiResT {
    const float *base_c, *base_l; bf16* XB; float* Xout; const float* gate; bf16* AN; const float* gn; const float* scn; float* RSout; float gs;
    static constexpr bool HAS_PRE = true, HAS_LIN = false, PRE_HALVES = false;
    struct PreB { u32x4 w; }; struct PreF { f32x4 b0, b1; };
    typedef typename std::conditional<MODE != 0, PreB, PreF>::type Pre;
    __device__ __forceinline__ Pre prefetch(int row, int col) const { Pre p;
        if constexpr (MODE != 0) p.w = G_LDU4(XB + (size_t)row * D + col);
        else { const float* bp = (row < NCTX ? base_c + (size_t)row * D : base_l + (size_t)(row - NCTX) * D) + col; p.b0 = G_LD4(bp); p.b1 = G_LD4(bp + 4); }
        return p; }
    __device__ __forceinline__ float stage_val(int kind, int ci, int col) const {
        return kind == 0 ? *(GAS const float*)(gate + (size_t)ci * 6144 + col) : *(GAS const float*)(gn + col) * (1.f + *(GAS const float*)(scn + (size_t)ci * 6144 + col)); }
    __device__ __forceinline__ void apply_pre(int row, int col, f32x4 v0, f32x4 v1, float* red, const Pre& p, const LAS float* st) const {
        f32x4 b0, b1;
        if constexpr (MODE != 0) { const u32x4 w = p.w; b0 = (f32x4){bflo(w.x), bfhi(w.x), bflo(w.y), bfhi(w.y)}; b1 = (f32x4){bflo(w.z), bfhi(w.z), bflo(w.w), bfhi(w.w)}; }
        else { b0 = p.b0; b1 = p.b1; }
        const f32x4 x0 = b0 + *(const LAS f32x4*)st * (v0 * gs), x1 = b1 + *(const LAS f32x4*)(st + 4) * (v1 * gs);
        if (MODE != 2) G_STU4(XB + (size_t)row * D + col, pack8(x0, x1));
        else { float* xo = Xout + (size_t)row * D + col; G_ST4(xo, x0); G_ST4(xo + 4, x1); }
        if (MODE != 2) { red[0] += ((x0.x * x0.x + x0.y * x0.y) + (x0.z * x0.z + x0.w * x0.w)) + ((x1.x * x1.x + x1.y * x1.y) + (x1.z * x1.z + x1.w * x1.w));
            const f32x4 a0 = x0 * *(const LAS f32x4*)(st + 512), a1 = x1 * *(const LAS f32x4*)(st + 516);
            G_STU4(AN + (size_t)row * D + col, pack8(a0, a1)); }
    }
    __device__ __forceinline__ bool want_red(int) const { return MODE != 2; }
    __device__ __forceinline__ void store_red(int row, int pn, const float* r) const { RSout[(size_t)row * 4 + pn] = r[0]; }
};
struct EpiFinal {
    const bf16* XB; float* Y; const float* gate; const float* gfin; float* RS4; unsigned* cnt; unsigned* tmo; float gs;
    static constexpr bool HAS_PRE = true, HAS_LIN = false, PRE_HALVES = false;
    struct Pre { u32x4 w; };
    __device__ __forceinline__ Pre prefetch(int row, int col) const { Pre p; p.w = G_LDU4(XB + (size_t)row * D + col); return p; }
    __device__ __forceinline__ float stage_val(int kind, int ci, int col) const { return kind == 0 ? *(GAS const float*)(gate + (size_t)ci * 6144 + col) : 0.f; }
    __device__ __forceinline__ void apply_pre(int row, int col, f32x4 v0, f32x4 v1, float* red, const Pre& p, const LAS float* st) const {
        const u32x4 w = p.w;
        v0 = (f32x4){bflo(w.x), bfhi(w.x), bflo(w.y), bfhi(w.y)} + *(const LAS f32x4*)st * (v0 * gs); v1 = (f32x4){bflo(w.z), bfhi(w.z), bflo(w.w), bfhi(w.w)} + *(const LAS f32x4*)(st + 4) * (v1 * gs);
        float* o = Y + (size_t)row * D + col; G_ST4(o, v0); G_ST4(o + 4, v1);
        red[0] += ((v0.x * v0.x + v0.y * v0.y) + (v0.z * v0.z + v0.w * v0.w)) + ((v1.x * v1.x + v1.y * v1.y) + (v1.z * v1.z + v1.w * v1.w));
    }
    __device__ __forceinline__ bool want_red(int) const { return true; }
    __device__ __forceinline__ void store_red(int row, int pn, const float* r) const { st4f_wt(RS4 + (size_t)row * 4 + pn, r[0]); }
    __device__ __forceinline__ float row_scale(int row) const { const f32x4 p = G_LD4(RS4 + (size_t)row * 4); return __builtin_amdgcn_rsqf(((p.x + p.y) + (p.z + p.w)) * (1.f / D) + EPS); }
};
namespace pg8 { template <> struct epi_is_final<EpiFinal> { static constexpr bool value = true; }; }
struct EpiIn { static constexpr bool HAS_PRE = false, HAS_LIN = true;
    RowLin L; bf16 *U, *VV; float* LNP;
    __device__ __forceinline__ void post(int row, int col, f32x4 v0, f32x4 v1, float* red) const {
#pragma unroll
        for (int e = 0; e < 4; ++e) { v0[e] = gelu_tanh_f(v0[e]); v1[e] = gelu_tanh_f(v1[e]); }
        if (col >= GE) { red[0] += ((v0.x + v0.y) + (v0.z + v0.w)) + ((v1.x + v1.y) + (v1.z + v1.w));
            red[1] += ((v0.x * v0.x + v0.y * v0.y) + (v0.z * v0.z + v0.w * v0.w)) + ((v1.x * v1.x + v1.y * v1.y) + (v1.z * v1.z + v1.w * v1.w)); }
        bf16* dst = col < GE ? U + (size_t)row * GE + col : VV + (size_t)row * GE + (col - GE);
        G_STU4(dst, pack8(v0, v1));
    }
    __device__ __forceinline__ bool want_red(int pn) const { return pn >= 8; }
    __device__ __forceinline__ void store_red(int row, int pn, const float* r) const { *(f32x2*)(LNP + (size_t)row * 16 + (pn - 8) * 2) = (f32x2){r[0], r[1]}; }
};


__device__ __forceinline__ float dpp_ror1(float x) { return __builtin_bit_cast(float, __builtin_amdgcn_update_dpp(0, __builtin_bit_cast(int, x), 0x121, 0xf, 0xf, false)); }
__device__ __forceinline__ float dpp_rol1(float x) { return __builtin_bit_cast(float, __builtin_amdgcn_update_dpp(0, __builtin_bit_cast(int, x), 0x12f, 0xf, 0xf, false)); }
__device__ __forceinline__ float bsel(unsigned m, float a, float b) { return __builtin_bit_cast(float, (__builtin_bit_cast(unsigned, a) & m) | (__builtin_bit_cast(unsigned, b) & ~m)); }
__device__ __forceinline__ float dpp_shr1(float old, float x) { return __builtin_bit_cast(float, __builtin_amdgcn_update_dpp(__builtin_bit_cast(int, old), __builtin_bit_cast(int, x), 0x111, 0xf, 0xf, false)); }
__device__ __forceinline__ float dpp_shl1(float old, float x) { return __builtin_bit_cast(float, __builtin_amdgcn_update_dpp(__builtin_bit_cast(int, old), __builtin_bit_cast(int, x), 0x101, 0xf, 0xf, false)); }
struct EpiUpConv {
    static constexpr bool PERM = true, AFTER_DRAIN = false, HAS_UPF = true;
    static constexpr int STL_OFF = 2560;
    const float* RS; const float* SW; const float* wconv; const float* bconv; float* HALO; bf16* M; LAS float* EX; bool skip;
    __device__ __forceinline__ void unit_prefetch(const pg8::Unit& u, int wid, int lane) const {
        const int ci = u.pm < 32 ? 0 : 1 + ((u.pm - 32) >> 2);
        if (wid < 4) __builtin_amdgcn_global_load_lds((const unsigned*)(RS + (size_t)(u.pm * 256 + wid * 64 + lane) * 4), (LAS unsigned*)(EX + STL_OFF + wid * 256), 16, 0, 0);
        else if (wid == 4) __builtin_amdgcn_global_load_lds((const unsigned*)(SW + (size_t)ci * FF2 + u.pn * 256 + lane * 4), (LAS unsigned*)(EX + STL_OFF + 1024), 16, 0, 0);
    }
    __device__ __forceinline__ void operator()(f32x4 (&acc)[2][2][4][2], const pg8::Unit& u, int wr, int wc, int fr, int fq) const {
        if (skip) return;
        const int pm = u.pm, pn = u.pn, ci = pm < 32 ? 0 : 1 + ((pm - 32) >> 2);
        const int c32 = wc * 32 + 8 * fq;
        {   const LAS float* sw = EX + STL_OFF + 1024 + c32;
            f32x4 s[2][2];
#pragma unroll
            for (int bj = 0; bj < 2; ++bj)
#pragma unroll
                for (int n = 0; n < 2; ++n) s[bj][n] = *(const LAS f32x4*)(sw + bj * 128 + 4 * n);
            f32x4 pq[2][4];
#pragma unroll
            for (int ai = 0; ai < 2; ++ai)
#pragma unroll
                for (int m = 0; m < 4; ++m) pq[ai][m] = *(const LAS f32x4*)(EX + STL_OFF + (ai * 128 + wr * 64 + m * 16 + fr) * 4);
#pragma unroll
            for (int ai = 0; ai < 2; ++ai)
#pragma unroll
                for (int m = 0; m < 4; ++m) { const f32x4 p = pq[ai][m];
                    const float r = __builtin_amdgcn_rsqf(((p.x + p.y) + (p.z + p.w)) * (1.f / D) + EPS);
#pragma unroll
                    for (int bj = 0; bj < 2; ++bj)
#pragma unroll
                        for (int n = 0; n < 2; ++n) acc[ai][bj][m][n] = acc[ai][bj][m][n] * r + s[bj][n]; } }
#pragma unroll
        for (int ai = 0; ai < 2; ++ai) { const int sidx = 2 * ai + wr;
#pragma unroll
            for (int bj = 0; bj < 2; ++bj)
#pragma unroll
                for (int n = 0; n < 2; ++n) {
                    if (fr == 0) *(LAS f32x4*)(EX + ((sidx * 2 + 0) * 2 + bj) * 128 + c32 + 4 * n) = acc[ai][bj][0][n];
                    if (fr == 15) *(LAS f32x4*)(EX + ((sidx * 2 + 1) * 2 + bj) * 128 + c32 + 4 * n) = acc[ai][bj][3][n]; } }
        {   const int t = (wr * 4 + wc) * 64 + fq * 16 + fr; EX[8 * 256 + t] = 0.f; }
        if (pm >= 32) { float* hb = HALO + (size_t)(pm - 32) * 4 * FF2 + pn * 256 + c32;
#pragma unroll
            for (int bj = 0; bj < 2; ++bj)
#pragma unroll
                for (int n = 0; n < 2; ++n) {
                    if (wr == 0 && fr < 2) *(f32x4*)(hb + (size_t)fr * FF2 + bj * 128 + 4 * n) = acc[0][bj][0][n];
                    if (wr == 1 && fr >= 14) *(f32x4*)(hb + (size_t)(fr - 12) * FF2 + bj * 128 + 4 * n) = acc[1][bj][3][n]; } }
        const int j0 = pn * 128 + c32;
        f32x4 wq[4];
        { const float* wp = wconv + j0; wq[0] = G_LD4(wp); wq[1] = G_LD4(wp + FF2); wq[2] = G_LD4(wp + 2 * FF2); wq[3] = G_LD4(bconv + j0); }
        asm volatile("s_waitcnt lgkmcnt(0)" ::: "memory"); __builtin_amdgcn_s_barrier(); asm volatile("" ::: "memory");
#pragma unroll
        for (int bj = 0; bj < 2; ++bj)
#pragma unroll
            for (int n = 0; n < 2; ++n) {
                const f32x4 w0 = wq[0], w1 = wq[1], w2 = wq[2], bb = wq[3];
                if (bj * 2 + n < 3) { const int bj1 = (bj * 2 + n + 1) >> 1, n1 = (bj * 2 + n + 1) & 1; const float* wp = wconv + bj1 * FF + j0 + 4 * n1;
                    wq[0] = G_LD4(wp); wq[1] = G_LD4(wp + FF2); wq[2] = G_LD4(wp + 2 * FF2); wq[3] = G_LD4(bconv + bj1 * FF + j0 + 4 * n1); }
#pragma unroll
                for (int ai = 0; ai < 2; ++ai) { const int sidx = 2 * ai + wr;
                    const int xrow = fr == 15 ? (sidx < 3 ? (sidx + 1) * 2 : 9) : (sidx > 0 ? (sidx - 1) * 2 + 1 : 8);
                    const f32x4 X = *(const LAS f32x4*)(EX + (xrow * 2 + bj) * 128 + c32 + 4 * n);
                    f32x4 cur[4];
#pragma unroll
                    for (int m = 0; m < 4; ++m) cur[m] = acc[ai][bj][m][n];
#pragma unroll
                    for (int m = 0; m < 4; ++m) { f32x4 pv_, nx_;
#pragma unroll
                        for (int e = 0; e < 4; ++e) {
                            const float pa_ = m > 0 ? dpp_ror1(cur[m - 1][e]) : X[e], na_ = m < 3 ? dpp_rol1(cur[m + 1][e]) : X[e];
                            pv_[e] = dpp_shr1(pa_, cur[m][e]); nx_[e] = dpp_shl1(na_, cur[m][e]); }
                        acc[ai][bj][m][n] = (w0 * pv_ + w1 * cur[m]) + (w2 * nx_ + bb); }
                    __builtin_amdgcn_sched_barrier(0); } }
#pragma unroll
        for (int ai = 0; ai < 2; ++ai)
#pragma unroll
            for (int m = 0; m < 4; ++m) { const int row = pm * 256 + ai * 128 + wr * 64 + m * 16 + fr;
                f32x4 o0, o1;
#pragma unroll
                for (int e = 0; e < 4; ++e) { o0[e] = silu_f(acc[ai][0][m][0][e]) * acc[ai][1][m][0][e]; o1[e] = silu_f(acc[ai][0][m][1][e]) * acc[ai][1][m][1][e]; }
                G_STU4(M + (size_t)row * FF + j0, pack8(o0, o1)); }
    }
};
__device__ __forceinline__ void fix_halo_rows(const Frame& F, int row_lo, int row_hi, const float* HALO, const float* wconv, const float* bconv, bf16* M) {
    for (int T = row_lo >> 8; T <= (row_hi - 1) >> 8; ++T) {
        if (T < 32) continue;
        const int q = (T - 32) & 3;
#pragma unroll
        for (int which = 0; which < 2; ++which) {
            const int row = T * 256 + (which ? 255 : 0);
            if (!((which == 0 ? (q != 0) : (q != 3)) && row >= row_lo && row < row_hi)) continue;
            const float* own = HALO + (size_t)(T - 32) * 4 * FF2;
            const float* pr = which == 0 ? HALO + ((size_t)(T - 33) * 4 + 3) * FF2 : own + 2 * FF2;
            const float* cu = which == 0 ? own : own + 3 * FF2;
            const float* nx = which == 0 ? own + FF2 : HALO + (size_t)(T - 31) * 4 * FF2;
#pragma unroll
            for (int it = 0; it < 2; ++it) {
                const int j = 4 * (F.tid + it * NWAVES * 64);
                if (j < FF) {
                    const int gc = ((j >> 7) << 8) + (j & 127), vc = gc + 128;
                    const f32x4 g = (G_LD4(wconv + j) * G_LD4(pr + gc) + G_LD4(wconv + FF2 + j) * G_LD4(cu + gc)) + (G_LD4(wconv + 2 * FF2 + j) * G_LD4(nx + gc) + G_LD4(bconv + j));
                    const f32x4 v = (G_LD4(wconv + FF + j) * G_LD4(pr + vc) + G_LD4(wconv + FF2 + FF + j) * G_LD4(cu + vc)) + (G_LD4(wconv + 2 * FF2 + FF + j) * G_LD4(nx + vc) + G_LD4(bconv + FF + j));
                    u32x2 o; o.x = cvt_pk_bf16(silu_f(g.x) * v.x, silu_f(g.y) * v.y); o.y = cvt_pk_bf16(silu_f(g.z) * v.z, silu_f(g.w) * v.w);
                    *(GAS u32x2*)(M + (size_t)row * FF + j) = o; } }
        }
    }
    asm volatile("s_waitcnt vmcnt(0)" ::: "memory"); __syncthreads();
}
template <class Epi>
__device__ __forceinline__ void gemm_pg8_raw(const Frame& F, const bf16* A, const bf16* Bt, int Mrows, int N, int K, const Epi& E) {
    pg8::Gemm g{A, Bt, Mrows, N, K}; pg8::StaticOrder S; S.init(Mrows, N, F.G, F.bid);
    pg8::gemm_phase<Epi, pg8::StaticOrder, true, true>(F.lds + RING_OFF, g, S, E, F.tid);
}

#include <hip/hip_bf16.h>
namespace attn_body {
using bf16=__hip_bfloat16;
using bf16x8=__attribute__((ext_vector_type(8)))short;
using s16x4=__attribute__((ext_vector_type(4)))short;
using f32x16=__attribute__((ext_vector_type(16)))float;
using u32x4=__attribute__((ext_vector_type(4)))unsigned;
constexpr int NHEAD=16,D=64,DM=NHEAD*D;
constexpr int NW=8,QBLK=32,QB=QBLK*NW,KVBLK=64;
__device__ __forceinline__ int crow(int r,int hi){return (r&3)+8*(r>>2)+4*hi;}
#define SBAR() __builtin_amdgcn_sched_barrier(0)
constexpr int NSLOT=3, SLOTB=8192;
constexpr int LDS_K=0, LDS_V=NSLOT*SLOTB, LDS_WS=2*NSLOT*SLOTB, LDS_OST=LDS_WS+NW*64*4, LDS_TAB=LDS_OST+NW*4096, LDS_BYTES=LDS_TAB+(3+15)*128*4;
constexpr float C2=0.125f*1.4426950408889634f;
__device__ __forceinline__ void glds16(const void*gsrc,unsigned lds_dst){unsigned keep;
  asm volatile("s_mov_b32 %0, m0\n\ts_mov_b32 m0, %2\n\ts_nop 0\n\tglobal_load_lds_dwordx4 %1, off\n\ts_mov_b32 m0, %0":"=&s"(keep):"v"(gsrc),"s"(lds_dst):"memory");}
__device__ __forceinline__ float max3f(float a,float b,float c){float r;asm("v_max3_f32 %0, %1, %2, %3":"=v"(r):"v"(a),"v"(b),"v"(c));return r;}
__device__ __forceinline__ float max2f(float a,float b){float r;asm("v_max_f32_e32 %0, %1, %2":"=v"(r):"v"(a),"v"(b));return r;}
__device__ __forceinline__ float fadd_s(float a,float b){float r;asm("v_add_f32_e32 %0, %1, %2":"=v"(r):"v"(a),"v"(b));return r;}
__device__ __forceinline__ float fsub_s(float a,float b){float r;asm("v_sub_f32_e32 %0, %1, %2":"=v"(r):"v"(a),"v"(b));return r;}
typedef float f32x2_t __attribute__((ext_vector_type(2))); typedef __bf16 bf16x2_t __attribute__((ext_vector_type(2)));
__device__ __forceinline__ unsigned cvtpk_s(float lo,float hi){f32x2_t v={lo,hi};bf16x2_t b=__builtin_convertvector(v,bf16x2_t);return __builtin_bit_cast(unsigned,b);}
#define WAIT_BAR(N) asm volatile("s_waitcnt vmcnt(" #N ") lgkmcnt(0)\n\ts_barrier":::"memory")

__device__ __forceinline__ void qkt(f32x16&p0,f32x16&p1,const char*Kslot,const bf16x8*qr,const f32x16&negm,int r32,int hi){
  const char*kb=Kslot+hi*1024+r32*16;
  #pragma unroll
  for(int d0=0;d0<4;++d0){
    const bf16x8 b0=*reinterpret_cast<const bf16x8*>(kb+d0*2048);
    const bf16x8 b1=*reinterpret_cast<const bf16x8*>(kb+d0*2048+512);
    if(d0==0){p0=__builtin_amdgcn_mfma_f32_32x32x16_bf16(b0,qr[0],negm,0,0,0);p1=__builtin_amdgcn_mfma_f32_32x32x16_bf16(b1,qr[0],negm,0,0,0);}
    else{p0=__builtin_amdgcn_mfma_f32_32x32x16_bf16(b0,qr[d0],p0,0,0,0);p1=__builtin_amdgcn_mfma_f32_32x32x16_bf16(b1,qr[d0],p1,0,0,0);}}
}
typedef __attribute__((address_space(3))) const char* lds_cptr;
typedef short v4i16_t __attribute__((ext_vector_type(4)));
__device__ __forceinline__ void kload8(bf16x8*kf,lds_cptr kp){
  kf[0]=*(const __attribute__((address_space(3))) bf16x8*)(kp);      kf[1]=*(const __attribute__((address_space(3))) bf16x8*)(kp+512);
  kf[2]=*(const __attribute__((address_space(3))) bf16x8*)(kp+2048); kf[3]=*(const __attribute__((address_space(3))) bf16x8*)(kp+2560);
  kf[4]=*(const __attribute__((address_space(3))) bf16x8*)(kp+4096); kf[5]=*(const __attribute__((address_space(3))) bf16x8*)(kp+4608);
  kf[6]=*(const __attribute__((address_space(3))) bf16x8*)(kp+6144); kf[7]=*(const __attribute__((address_space(3))) bf16x8*)(kp+6656);
}
__device__ __forceinline__ void kload2(bf16x8*kf,lds_cptr kp,int j){ kf[2*j]=*(const __attribute__((address_space(3))) bf16x8*)(kp+j*2048); kf[2*j+1]=*(const __attribute__((address_space(3))) bf16x8*)(kp+j*2048+512); }
__device__ __forceinline__ s16x4 vtr(lds_cptr p){ return __builtin_bit_cast(s16x4,__builtin_amdgcn_ds_read_tr16_b64_v4i16((__attribute__((address_space(3))) v4i16_t*)p)); }
__device__ __forceinline__ float rowmax(const f32x16&p0,const f32x16&p1){
  float a=max3f(p0[0],p0[1],p1[0]),b=max3f(p0[2],p0[3],p1[1]);a=max3f(a,p1[2],p1[3]);
  #pragma unroll
  for(int r=4;r<16;r+=4){a=max3f(a,p0[r],p0[r+1]);b=max3f(b,p0[r+2],p0[r+3]);a=max3f(a,p1[r],p1[r+1]);b=max3f(b,p1[r+2],p1[r+3]);}
  const float m=max2f(a,b);
  auto rr=__builtin_amdgcn_permlane32_swap(__float_as_uint(m),__float_as_uint(m),false,false);
  return max2f(__uint_as_float(rr[0]),__uint_as_float(rr[1]));
}
__device__ __forceinline__ void pv(f32x16*o,int vb,bf16x8 pa0,bf16x8 pa1,bf16x8 pa2,bf16x8 pa3){
  #pragma unroll
  for(int d0=0;d0<2;++d0){s16x4 lo[4],hi[4];
    #pragma unroll
    for(int ks=0;ks<4;++ks){
      asm volatile("ds_read_b64_tr_b16 %0,%1 offset:%c2":"=&v"(lo[ks]):"v"(vb),"i"(d0*4096+ks*1024):"memory");
      asm volatile("ds_read_b64_tr_b16 %0,%1 offset:%c2":"=&v"(hi[ks]):"v"(vb),"i"(d0*4096+ks*1024+512):"memory");}
    asm volatile("s_waitcnt lgkmcnt(0)":::"memory");SBAR();
    #define PK(k) (bf16x8){lo[k][0],lo[k][1],lo[k][2],lo[k][3],hi[k][0],hi[k][1],hi[k][2],hi[k][3]}
    o[d0]=__builtin_amdgcn_mfma_f32_32x32x16_bf16(pa0,PK(0),o[d0],0,0,0);
    o[d0]=__builtin_amdgcn_mfma_f32_32x32x16_bf16(pa1,PK(1),o[d0],0,0,0);
    o[d0]=__builtin_amdgcn_mfma_f32_32x32x16_bf16(pa2,PK(2),o[d0],0,0,0);
    o[d0]=__builtin_amdgcn_mfma_f32_32x32x16_bf16(pa3,PK(3),o[d0],0,0,0);
    #undef PK
  }
}

#ifndef ATTN_STORE16
#define ATTN_STORE16(p,v) (*(__attribute__((address_space(1))) u32x4*)(p)=(v))
#endif
template<int THRL,bool LAT> __device__ __forceinline__ void attn_unit(const int tid,bf16*Qw0,const bf16*K0,const long dV0,const int n0,const bf16*K1,const long dV1,const int NT,char*shm,const int rq0,const int wlo,const float*rpb_h){
  bf16*const Ow0=Qw0;
  const int lane=tid&63,r32=lane&31,hi=lane>>5; const int wid=__builtin_amdgcn_readfirstlane(tid>>6);
  const bf16*Qw=Qw0+(long)(wid*QBLK)*DM;
  const unsigned lds0=(unsigned)(uintptr_t)shm;
  float*wsf=(float*)(shm+LDS_WS)+wid*64;
  typedef __attribute__((address_space(3))) const float* lds_fptr;
  float*tab=(float*)(shm+LDS_TAB);
  if(LAT){ for(int i=tid;i<15*128;i+=NW*64){const int rr=i>>7,cc=i&127; tab[384+i]=(cc>=48&&cc<79)?rpb_h[rr*31+cc-48]*1.4426950408889634f:0.f;}
    if(tid<384)tab[tid]=(tid<128||(tid>=256+48&&tid<256+64))?0.f:-INFINITY; }
  const int rq=rq0+(wid>>1), rs=min(max(rq-4,0),8);
  lds_fptr tb_=(lds_fptr)tab, tv_=(lds_fptr)tab;
  #define CSEL(t) do{ if(LAT){ const int cq_=32*(wid&1)+r32; const bool w_=(t)>=n0; const int ia_=wlo+((t)-n0); const bool ok_=w_&&(ia_>=rs)&&(ia_<rs+8); \
      tb_=(lds_fptr)tab+(63-cq_+4*hi)+(ok_?384+(ia_-rq+7)*128:0); tv_=(lds_fptr)tab+(48-min(max(cq_-8,0),48)+4*hi)+(w_?(ok_?256:128):0); } }while(0)
  #define CINIT(C,KO) do{ if(LAT){ _Pragma("unroll") for(int r=0;r<16;++r){const int k0_=(r&3)+8*(r>>2)+(KO); C[r]=(tb_[k0_]+tv_[k0_])-mhat;} } }while(0)
  #define CSRC(C) (LAT?C:negm)
  const int koff=lane*DM+wid*8;
  const int voff=(16*(wid&3)+(lane>>2))*DM+(wid>>2)*32+(lane&3)*8;
  const unsigned kdst=lds0+LDS_K+wid*1024, vdst=lds0+LDS_V+wid*1024;
  #define KSRC(t) (((t)<n0?K0+(long)(t)*KVBLK*DM:K1+(long)((t)-n0)*KVBLK*DM)+koff)
  #define VSRC(t) (((t)<n0?K0+dV0+(long)(t)*KVBLK*DM:K1+dV1+(long)((t)-n0)*KVBLK*DM)+voff)
  #define DMA_K(t,slot) glds16(KSRC(t),(unsigned)__builtin_amdgcn_readfirstlane(kdst+(slot)))
  #define DMA_V(t,slot) glds16(VSRC(t),(unsigned)__builtin_amdgcn_readfirstlane(vdst+(slot)))
  const int vb0=(int)(lds0+LDS_V)+((lane>>4)&1)*32+(lane&3)*8+(4*hi+((lane&15)>>2))*64;
  const char*Kbase=shm+LDS_K; bf16x8 kf[8];
  const lds_cptr shm3=(lds_cptr)shm; const lds_cptr kp0=shm3+LDS_K+hi*1024+r32*16; const lds_cptr vp0=shm3+LDS_V+((lane>>4)&1)*32+(lane&3)*8+(4*hi+((lane&15)>>2))*64;

  DMA_K(0,0);DMA_V(0,0);DMA_K(1,SLOTB);
  bf16x8 qr[4];
  #pragma unroll
  for(int d0=0;d0<4;++d0)qr[d0]=*(const __attribute__((address_space(1))) bf16x8*)(&Qw[(long)r32*DM+d0*16+hi*8]);
  float mhat=0.f,l_reg=0.f;f32x16 o[2];o[0]=f32x16{};o[1]=f32x16{};float z_=0.f;asm volatile("":"+v"(z_));f32x16 negm;
  _Pragma("unroll") for(int r=0;r<16;++r)negm[r]=z_;
  if(!LAT)asm volatile("":"+v"(negm));
  #define CMASK(P0,P1,t) do{}while(0)
  bool resc=false;
  #define START(P0,P1) do{ const float rm=rowmax(P0,P1); resc=false; \
    { const float dl=rm; mhat=fadd_s(mhat,dl); \
      _Pragma("unroll") for(int r=0;r<16;++r){P0[r]=fsub_s(P0[r],dl);P1[r]=fsub_s(P1[r],dl);} \
      if(!LAT){ _Pragma("unroll") for(int r=0;r<16;++r)negm[r]=-mhat; asm volatile("":"+v"(negm)); } } \
    _Pragma("unroll") for(int r=0;r<16;++r)P0[r]=__builtin_amdgcn_exp2f(P0[r]); }while(0)
  #define RESC() do{ if(resc){ asm volatile("s_waitcnt lgkmcnt(0)":::"memory"); \
      _Pragma("unroll") for(int d_=0;d_<2;++d_) _Pragma("unroll") for(int r=0;r<16;++r)o[d_][r]*=wsf[crow(r,hi)]; } }while(0)
  f32x16 pA0,pA1,pB0,pB1;
  int sl_prev=0,sl_cur=0,sl_next=SLOTB;
  #define ROT() do{sl_prev=sl_cur;sl_cur=sl_next;sl_next=(sl_next==(NSLOT-1)*SLOTB)?0:sl_next+SLOTB;}while(0)
  DMA_K(2,2*SLOTB);
  WAIT_BAR(3);
  qkt(pA0,pA1,Kbase,qr,negm,r32,hi);asm volatile("s_nop 15\n\ts_nop 7":"+v"(pA0),"+v"(pA1));CMASK(pA0,pA1,0);
  START(pA0,pA1);
  _Pragma("unroll") for(int r=0;r<16;++r)pA1[r]=__builtin_amdgcn_exp2f(pA1[r]);
  WAIT_BAR(0);
  DMA_K(3,0);DMA_V(1,SLOTB);
  ROT();
  kload8(kf,kp0+sl_cur);
  WAIT_BAR(2);
  s16x4 vlo[8],vhi[8]; u32x4 pw0,pw1,pw2,pw3;
  #define PKW(P,B) cvtpk_s(P[B],P[B+1])
  #define PAF(k) __builtin_bit_cast(bf16x8,pw##k)
  #define VFR(i) (bf16x8){vlo[i][0],vlo[i][1],vlo[i][2],vlo[i][3],vhi[i][0],vhi[i][1],vhi[i][2],vhi[i][3]}
  #define PIN(x) asm volatile("":"+v"(x))
  #define MX3(a,b,c) __builtin_fmaxf(__builtin_fmaxf((a),(b)),(c))
  #define GAPA(MF,A0,A1,A2,A3,W0,W1,PW) do{ MF; sacc+=A0; sacc+=A1; sacc+=A2; sacc+=A3; PIN(sacc); W0; W1; PIN(PW); SBAR(); }while(0)
  #define EX(v) __builtin_amdgcn_exp2f(v)
  #define GAPB(MF,X,B,KO) do{ MF; X[B]=EX(X[B]); X[B+1]=EX(X[B+1]); X[B+2]=EX(X[B+2]); X[B+3]=EX(X[B+3]); PIN(X); SBAR(); }while(0)
  #define VRD(i) do{ vlo[i]=vtr(vp_+(((i)>>2)*4096+((i)&3)*1024)); vhi[i]=vtr(vp_+(((i)>>2)*4096+((i)&3)*1024+512)); }while(0)
  #define KRD(G,j) do{ if(G){ kload2(kf,kp0+sl_next,j); SBAR(); } }while(0)
  #define STEP(C0,C1,P0,P1,t,GK,GV,GL) do{ SBAR(); CSEL(t); CINIT(C0,0); SBAR(); \
    const lds_cptr vp_=vp0+sl_prev; \
    VRD(0); SBAR(); float sacc=(P0[0]+P0[1]); \
    GAPA(C0=__builtin_amdgcn_mfma_f32_32x32x16_bf16(kf[0],qr[0],CSRC(C0),0,0,0), P0[2],P0[3],P0[4],P0[5],     pw0[0]=PKW(P0,0), pw0[1]=PKW(P0,2), pw0); \
    CINIT(C1,32); VRD(4); SBAR(); GAPA(C1=__builtin_amdgcn_mfma_f32_32x32x16_bf16(kf[1],qr[0],CSRC(C1),0,0,0), P0[6],P0[7],P0[8],P0[9],     pw0[2]=PKW(P0,4), pw0[3]=PKW(P0,6), pw0); \
    VRD(1); SBAR(); GAPA(C0=__builtin_amdgcn_mfma_f32_32x32x16_bf16(kf[2],qr[1],C0,0,0,0),   P0[10],P0[11],P0[12],P0[13], pw1[0]=PKW(P0,8), pw1[1]=PKW(P0,10), pw1); \
    VRD(5); SBAR(); GAPA(C1=__builtin_amdgcn_mfma_f32_32x32x16_bf16(kf[3],qr[1],C1,0,0,0),   P0[14],P0[15],P1[0],P1[1],   pw1[2]=PKW(P0,12),pw1[3]=PKW(P0,14), pw1); \
    VRD(2); SBAR(); GAPA(C0=__builtin_amdgcn_mfma_f32_32x32x16_bf16(kf[4],qr[2],C0,0,0,0),   P1[2],P1[3],P1[4],P1[5],     pw2[0]=PKW(P1,0), pw2[1]=PKW(P1,2), pw2); \
    VRD(6); SBAR(); GAPA(C1=__builtin_amdgcn_mfma_f32_32x32x16_bf16(kf[5],qr[2],C1,0,0,0),   P1[6],P1[7],P1[8],P1[9],     pw2[2]=PKW(P1,4), pw2[3]=PKW(P1,6), pw2); \
    VRD(3); SBAR(); GAPA(C0=__builtin_amdgcn_mfma_f32_32x32x16_bf16(kf[6],qr[3],C0,0,0,0),   P1[10],P1[11],P1[12],P1[13], pw3[0]=PKW(P1,8), pw3[1]=PKW(P1,10), pw3); \
    VRD(7); SBAR(); GAPA(C1=__builtin_amdgcn_mfma_f32_32x32x16_bf16(kf[7],qr[3],C1,0,0,0),   P1[14],P1[15],0.f,0.f,       pw3[2]=PKW(P1,12),pw3[3]=PKW(P1,14), pw3); \
    l_reg+=sacc; \
    if(GK){DMA_K((t)+3,sl_cur);} if(GV){DMA_V((t)+1,sl_next);} \
    CMASK(C0,C1,t); \
    { float a=MX3(C0[0],C0[1],C1[0]),b=MX3(C0[2],C0[3],C1[1]); a=MX3(a,C1[2],C1[3]); \
      _Pragma("unroll") for(int r=4;r<16;r+=4){a=MX3(a,C0[r],C0[r+1]);b=MX3(b,C0[r+2],C0[r+3]);a=MX3(a,C1[r],C1[r+1]);b=MX3(b,C1[r+2],C1[r+3]);} \
      float rm=__builtin_fmaxf(a,b); { auto rr=__builtin_amdgcn_permlane32_swap(__float_as_uint(rm),__float_as_uint(rm),false,false); rm=__builtin_fmaxf(__uint_as_float(rr[0]),__uint_as_float(rr[1])); } \
      resc=false; \
      if(__builtin_expect(__any(rm>(float)THRL),0)){ const float dl=__builtin_fmaxf(rm,0.f); mhat+=dl; \
        _Pragma("unroll") for(int r=0;r<16;++r){C0[r]-=dl;C1[r]-=dl;} \
        if(!LAT){ _Pragma("unroll") for(int r=0;r<16;++r)negm[r]=-mhat; asm volatile("":"+v"(negm)); } \
        const float f=__builtin_amdgcn_exp2f(-dl); l_reg*=f; if(hi==0)wsf[r32]=f; resc=true; } } \
    SBAR(); \
    GAPB(o[0]=__builtin_amdgcn_mfma_f32_32x32x16_bf16(PAF(0),VFR(0),o[0],0,0,0), C0,0,0); \
    GAPB(o[1]=__builtin_amdgcn_mfma_f32_32x32x16_bf16(PAF(0),VFR(4),o[1],0,0,0), C0,4,0); \
    KRD(GL,0); GAPB(o[0]=__builtin_amdgcn_mfma_f32_32x32x16_bf16(PAF(1),VFR(1),o[0],0,0,0), C0,8,0); \
    KRD(GL,1); GAPB(o[1]=__builtin_amdgcn_mfma_f32_32x32x16_bf16(PAF(1),VFR(5),o[1],0,0,0), C0,12,0); \
    KRD(GL,2); GAPB(o[0]=__builtin_amdgcn_mfma_f32_32x32x16_bf16(PAF(2),VFR(2),o[0],0,0,0), C1,0,32); \
    KRD(GL,3); GAPB(o[1]=__builtin_amdgcn_mfma_f32_32x32x16_bf16(PAF(2),VFR(6),o[1],0,0,0), C1,4,32); \
    GAPB(o[0]=__builtin_amdgcn_mfma_f32_32x32x16_bf16(PAF(3),VFR(3),o[0],0,0,0), C1,8,32); \
    GAPB(o[1]=__builtin_amdgcn_mfma_f32_32x32x16_bf16(PAF(3),VFR(7),o[1],0,0,0), C1,12,32); \
    }while(0)
  int t=1;
  for(;t+5<NT;t+=2){
    STEP(pB0,pB1,pA0,pA1,t,true,true,true);     WAIT_BAR(2); RESC(); ROT();
    STEP(pA0,pA1,pB0,pB1,t+1,true,true,true);   WAIT_BAR(2); RESC(); ROT();
  }
  #define ENDW(tt) do{ if((tt)+3<NT){WAIT_BAR(2);} else if((tt)+2<NT){WAIT_BAR(1);} else {WAIT_BAR(0);} }while(0)
  for(;t+1<NT;t+=2){
    STEP(pB0,pB1,pA0,pA1,t,(t+3<NT),(t+1<NT),(t+1<NT));       ENDW(t);   RESC(); ROT();
    STEP(pA0,pA1,pB0,pB1,t+1,(t+4<NT),(t+2<NT),(t+2<NT));     ENDW(t+1); RESC(); ROT();
  }
  STEP(pB0,pB1,pA0,pA1,NT-1,false,false,false); RESC();
  { float sacc=pB0[0]+pB0[1]; _Pragma("unroll") for(int r=2;r<16;++r)sacc+=pB0[r]; _Pragma("unroll") for(int r=0;r<16;++r)sacc+=pB1[r]; l_reg+=sacc;
    pw0=(u32x4){PKW(pB0,0),PKW(pB0,2),PKW(pB0,4),PKW(pB0,6)};pw1=(u32x4){PKW(pB0,8),PKW(pB0,10),PKW(pB0,12),PKW(pB0,14)};pw2=(u32x4){PKW(pB1,0),PKW(pB1,2),PKW(pB1,4),PKW(pB1,6)};pw3=(u32x4){PKW(pB1,8),PKW(pB1,10),PKW(pB1,12),PKW(pB1,14)};
    SBAR(); pv(o,vb0+sl_cur,PAF(0),PAF(1),PAF(2),PAF(3)); }
  #undef PKW
  #undef PAF
  #undef VFR
  #undef PIN
  #undef MX3
  #undef GAPA
  #undef GAPB
  #undef EX
  #undef VRD
  #undef KRD
  #undef STEP
  #undef ENDW
  {auto rr=__builtin_amdgcn_permlane32_swap(__float_as_uint(l_reg),__float_as_uint(l_reg),false,false);l_reg=__uint_as_float(rr[0])+__uint_as_float(rr[1]);}
  if(hi==0)wsf[32+r32]=l_reg;asm volatile("s_waitcnt lgkmcnt(0)":::"memory");
  float rli[16];
  #pragma unroll
  for(int r=0;r<16;++r)rli[r]=__builtin_amdgcn_rcpf(wsf[32+crow(r,hi)]);
  bf16*Ow=Ow0+(long)(wid*QBLK)*DM;
  { bf16*stg=(bf16*)(shm+LDS_OST)+wid*2048;
    #pragma unroll
    for(int r=0;r<16;++r){const int orow=crow(r,hi);
      #pragma unroll
      for(int d0=0;d0<2;++d0)stg[orow*64+d0*32+r32]=__float2bfloat16(o[d0][r]*rli[r]);}
    asm volatile("s_waitcnt lgkmcnt(0)":::"memory");
    #pragma unroll
    for(int i=0;i<4;++i){const int row=i*8+(lane>>3),ch=lane&7; const u32x4 v=*(const u32x4*)(stg+row*64+ch*8); ATTN_STORE16(Ow+(long)row*DM+ch*8,v);} }
  asm volatile("s_waitcnt lgkmcnt(0)\n\ts_barrier":::"memory");
  #undef DMA_K
  #undef DMA_V
  #undef KSRC
  #undef VSRC
  #undef CMASK
  #undef CSEL
  #undef CINIT
  #undef CSRC
  #undef START
  #undef RESC
  #undef ROT
}

constexpr int MIX_STAT=0, MIX_V=2048, MIX_WS=MIX_V+8*8192, MIX_STG=MIX_WS+NW*64*4, MIX_SROW=36, MIX_LDS_BYTES=MIX_STG+NW*32*MIX_SROW*4;
__device__ __forceinline__ void mix_pair(const int tid,const int uA,const int uB,const bf16*VV,bf16*U,const bf16*WSb,const float*LNP,const float*gv,const float*bs,char*shm){
  const int lane=tid&63,r32=lane&31,hi=lane>>5; const int wid=__builtin_amdgcn_readfirstlane(tid>>6);
  const int grp=wid>>2,pb=wid&3,u=grp?uB:uA; const bool valid=u>=0; const int chunk=u>>4,g=u&15;
  const unsigned lds0=(unsigned)(uintptr_t)shm;
  float*stat=(float*)(shm+MIX_STAT)+grp*256;
  float*wsf=(float*)(shm+MIX_WS)+wid*64;
  float*stg=(float*)(shm+MIX_STG)+wid*32*MIX_SROW;
  const int vbase=MIX_V+grp*32768;
  asm volatile("s_waitcnt vmcnt(0)":::"memory");
  if(valid){
    #pragma unroll
    for(int k=0;k<2;++k){ const int pi=2*pb+k; const bf16*vsrc=VV+(long)(chunk*128+16*(pi&3)+(lane>>2))*2048+g*128+(pi>>2)*32+(lane&3)*8;
      #pragma unroll
      for(int s=0;s<4;++s) glds16(vsrc+(long)((s>>1)*64)*2048+(s&1)*64,(unsigned)__builtin_amdgcn_readfirstlane(lds0+vbase+s*8192+pi*1024)); }
    const int tg=tid&255;
    if(tg<128){ const __attribute__((address_space(1))) float*p=(const __attribute__((address_space(1))) float*)(LNP+(long)(chunk*128+tg)*16); float s=0.f,q=0.f;
      #pragma unroll
      for(int k=0;k<8;++k){s+=p[2*k];q+=p[2*k+1];}
      const float mean=s*(1.f/2048.f),var=q*(1.f/2048.f)-mean*mean; stat[2*tg]=mean; stat[2*tg+1]=__builtin_amdgcn_rsqf(var+1e-6f); } }
  asm volatile("s_waitcnt vmcnt(0) lgkmcnt(0)\n\ts_barrier":::"memory");
  if(valid){
    bf16x8 pa[2][4]; float corr=0.f;
    #pragma unroll
    for(int qt=0;qt<2;++qt)
      #pragma unroll
      for(int ks=0;ks<4;++ks){ const int qa=64*qt+16*ks+4*hi;
        const __attribute__((address_space(1))) unsigned* wp=(const __attribute__((address_space(1))) unsigned*)(WSb+((long)g*128+32*pb+r32)*128+qa);
        const unsigned w0=wp[0],w1=wp[1],w2=wp[4],w3=wp[5];
        const f32x4 s0=*(const f32x4*)(stat+2*qa), s1=*(const f32x4*)(stat+2*qa+4), s2=*(const f32x4*)(stat+2*qa+16), s3=*(const f32x4*)(stat+2*qa+20);
        const float a0=__uint_as_float(w0<<16)*s0.y,a1=__uint_as_float(w0&0xffff0000u)*s0.w,a2=__uint_as_float(w1<<16)*s1.y,a3=__uint_as_float(w1&0xffff0000u)*s1.w;
        const float a4=__uint_as_float(w2<<16)*s2.y,a5=__uint_as_float(w2&0xffff0000u)*s2.w,a6=__uint_as_float(w3<<16)*s3.y,a7=__uint_as_float(w3&0xffff0000u)*s3.w;
        u32x4 pk; pk.x=cvtpk_s(a0,a1); pk.y=cvtpk_s(a2,a3); pk.z=cvtpk_s(a4,a5); pk.w=cvtpk_s(a6,a7);
        corr+=(__uint_as_float(pk.x<<16)*s0.x+__uint_as_float(pk.x&0xffff0000u)*s0.z)+(__uint_as_float(pk.y<<16)*s1.x+__uint_as_float(pk.y&0xffff0000u)*s1.z)
             +(__uint_as_float(pk.z<<16)*s2.x+__uint_as_float(pk.z&0xffff0000u)*s2.z)+(__uint_as_float(pk.w<<16)*s3.x+__uint_as_float(pk.w&0xffff0000u)*s3.z);
        pa[qt][ks]=__builtin_bit_cast(bf16x8,pk); }
    {auto rr=__builtin_amdgcn_permlane32_swap(__float_as_uint(corr),__float_as_uint(corr),false,false);corr=__uint_as_float(rr[0])+__uint_as_float(rr[1]);}
    if(hi==0)wsf[r32]=corr; asm volatile("s_waitcnt lgkmcnt(0)":::"memory");
    const int vb=(int)(lds0+vbase)+((lane>>4)&1)*32+(lane&3)*8+(4*hi+((lane&15)>>2))*64;
    #pragma unroll
    for(int ch=0;ch<2;++ch){
      f32x16 o[2]; o[0]=f32x16{}; o[1]=f32x16{};
      SBAR(); pv(o,vb+ch*8192,pa[0][0],pa[0][1],pa[0][2],pa[0][3]);
      SBAR(); pv(o,vb+(2+ch)*8192,pa[1][0],pa[1][1],pa[1][2],pa[1][3]);
      #pragma unroll
      for(int d0=0;d0<2;++d0){
        #pragma unroll
        for(int r=0;r<16;++r){const int orow=crow(r,hi); stg[orow*MIX_SROW+r32]=o[d0][r]-wsf[orow];}
        asm volatile("s_waitcnt lgkmcnt(0)":::"memory");
        #pragma unroll
        for(int i=0;i<2;++i){const int row=i*16+(lane>>2),c8=(lane&3)*8; const int p=32*pb+row, e=g*128+ch*64+d0*32+c8;
          const f32x4 m0=*(const f32x4*)(stg+row*MIX_SROW+c8), m1=*(const f32x4*)(stg+row*MIX_SROW+c8+4);
          const f32x4 g0=*(const __attribute__((address_space(1))) f32x4*)(gv+e), g1=*(const __attribute__((address_space(1))) f32x4*)(gv+e+4); const float b=*(const __attribute__((address_space(1))) float*)(bs+g*128+p);
          bf16*up=U+(long)(chunk*128+p)*2048+e; const u32x4 uw=*(const __attribute__((address_space(1))) u32x4*)up;
          u32x4 ow;
          ow.x=cvtpk_s(__uint_as_float(uw.x<<16)*(g0.x*m0.x+b),__uint_as_float(uw.x&0xffff0000u)*(g0.y*m0.y+b));
          ow.y=cvtpk_s(__uint_as_float(uw.y<<16)*(g0.z*m0.z+b),__uint_as_float(uw.y&0xffff0000u)*(g0.w*m0.w+b));
          ow.z=cvtpk_s(__uint_as_float(uw.z<<16)*(g1.x*m1.x+b),__uint_as_float(uw.z&0xffff0000u)*(g1.y*m1.y+b));
          ow.w=cvtpk_s(__uint_as_float(uw.w<<16)*(g1.z*m1.z+b),__uint_as_float(uw.w&0xffff0000u)*(g1.w*m1.w+b));
          *(__attribute__((address_space(1))) u32x4*)up=ow; }
        asm volatile("s_waitcnt lgkmcnt(0)":::"memory"); }
    } }
  asm volatile("s_waitcnt lgkmcnt(0)\n\ts_barrier":::"memory");
}
constexpr int ATTN_LDS_BYTES=LDS_BYTES;
#undef SBAR
#undef WAIT_BAR
}

#ifndef LATUNIT
#define LATUNIT attn_body::attn_unit<8, true>
#endif
__device__ __forceinline__ void attn_fast(const Frame& F, const Args& args) {
    typedef attn_body::bf16 abf;
    unsigned char* ws = wsb(args);
    abf* Q = (abf*)(ws + WS_Q); const abf* K = (const abf*)(ws + WS_K);
    const abf* CKp = (const abf*)(ws + WS_CK); const abf* KCp = (const abf*)(ws + WS_KC); const float* rpb = inp(args, I_RPB);
    char* shm = (char*)(unsigned char*)F.lds + RING_OFF;
    const int vcu = (F.G % 8 == 0) ? (F.bid % 8) * (F.G / 8) + F.bid / 8 : F.bid;
    for (int u = vcu; u < 4 * NH * 4; u += F.G) {
        const int b = u >> 6, h = (u >> 2) & 15, qb = u & 3;
        const int wlo = qb < 2 ? 0 : (qb == 2 ? 4 : 8), nwin = (qb == 0 || qb == 3) ? 8 : 12;
        const long qoff = ((long)(NCTX + b * SEQ_L + qb * 256)) * D + h * HD, woff = ((long)(NCTX + b * SEQ_L + wlo * 64)) * D + h * HD, coff = ((long)(b * PAST)) * D + h * HD;
        LATUNIT(F.tid, Q + qoff, CKp + coff, (long)((WS_CV - WS_CK) / 2), 8, K + woff, (long)((WS_V - WS_K) / 2), 8 + nwin, shm, 4 * qb, wlo, rpb + h * 465);
    }
    for (int u = vcu; u < 32 * NH; u += F.G) {
        const int b = u >> 4, h = u & 15;
        const long qoff = ((long)(b * SEQ_C)) * D + h * HD;
        attn_body::attn_unit<8, false>(F.tid, Q + qoff, KCp + qoff, (long)((WS_VC - WS_KC) / 2), 4, KCp + qoff, (long)((WS_VC - WS_KC) / 2), 4, shm, 0, 0, rpb);
    }
    if (F.G % 4 == 0 && (4 * NH * 4) % F.G == 0) { const int qb = vcu & 3;
        if (qb == 0 || qb == 3) p1_sw_items(F, args, SWI_QKV, SWI_QKV + FF2 / 16, ((vcu >> 2) * 2 + (qb == 3)) * NWAVES + F.wave, (F.G / 2) * NWAVES); }
    else p1_sw_items(F, args, SWI_QKV, SWI_QKV + FF2 / 16, F.bid * NWAVES + F.wave, F.G * NWAVES);
}


__device__ __forceinline__ void mix_fast(const Frame& F, const Args& args) {
    typedef attn_body::bf16 abf;
    unsigned char* ws = wsb(args);
    const abf* VV = (const abf*)(ws + WS_VV); abf* U = (abf*)(ws + WS_U); const abf* WSb = (const abf*)(ws + WS_WSB); const float* LNP = (const float*)(ws + WS_LNP);
    const float* gv = inp(args, I_GV); const float* bs = inp(args, I_BSP);
    char* shm = (char*)(unsigned char*)F.lds + RING_OFF;
    const int vcu = (F.G % 8 == 0) ? (F.bid % 8) * (F.G / 8) + F.bid / 8 : F.bid;
    for (int u = 2 * vcu; u < 96 * 16; u += 2 * F.G) attn_body::mix_pair(F.tid, u, u + 1 < 96 * 16 ? u + 1 : -1, VV, U, WSb, LNP, gv, bs, shm);
}
#ifndef ATTN
#define ATTN attn_fast
#endif
#ifndef MIX
#define MIX mix_fast
#endif
enum Steps { S_P0 = 0, S_QKV, S_ATT, S_WO, S_UP0, S_DN0, S_IN, S_MIX, S_OUT, S_UP1, S_DN1, NSTEPS };

#ifndef STEPMASK
#define STEPMASK 0xffffffffu
#endif
#define ON(s) ((STEPMASK >> (s)) & 1u)
__device__ __forceinline__ void run_step(const Frame& F0, const Args& args, int s) {
    Frame F = F0; asm volatile("" : "+v"(F.tid)); asm volatile("" : "+s"(F.bid)); asm volatile("" : "+s"(F.G)); F.lane = F.tid & 63; F.wave = __builtin_amdgcn_readfirstlane(F.tid >> 6);
    unsigned char* ws = wsb(args);
    const float* MOD0 = (const float*)(ws + WS_MOD); const float* MOD1 = MOD0 + 5 * 6144;
    float* SW = (float*)(ws + WS_SW);
    float* RS0 = (float*)(ws + WS_RS); float* RS1 = RS0 + (size_t)MT * 4; float* RS2 = RS0 + (size_t)MT * 8; float* RS3 = RS0 + (size_t)MT * 12;
    bf16* AN = (bf16*)(ws + WS_AN);
    if (ON(S_P0) && s == S_P0) {
        unsigned* cnt = (unsigned*)ws + CW_CNT + 8192;
        for (int u = F.bid; u < ADA_UNITS; u += F.G) { p0_adaln_unit(F, args, u);
            const int jb = u % 24; if (u < 96 && jb < 8) wave_publish(cnt + (jb < 4 ? 0 : 64)); }
        const int rot = (F.bid + F.G - ADA_UNITS % F.G) % F.G;
        p0_items(F, args, 0, PI_FIRST, rot * NWAVES + F.wave, F.G * NWAVES);
        constexpr int SWU_QKV = (NQKV / 256) * 4;
        if (rot < SWU_QKV) {
            if (F.wave == 0) { wave_wait_ge(cnt, 16 * NWAVES, (unsigned*)ws + CW_TMO); __builtin_amdgcn_fence(__ATOMIC_ACQUIRE, "agent"); }
            __syncthreads();
            for (int u = rot; u < SWU_QKV; u += F.G) sw_unit_f32(F, inp(args, I_WQKV), NQKV, MOD0, SW + SW_QKV, false, u); }
        if (F.wave == 0) { wave_wait_ge(cnt + 64, 16 * NWAVES, (unsigned*)ws + CW_TMO); __builtin_amdgcn_fence(__ATOMIC_ACQUIRE, "agent"); }
        __syncthreads();
        p1_rows(F, args, rot * NWAVES + F.wave, (SWU_QKV < F.G ? SWU_QKV : 0) * NWAVES); }
    else if (ON(S_QKV) && s == S_QKV) { float* out = outb(args);
        EpiQKV E{{RS0, SW + SW_QKV, NQKV}, ws};
        int fw = 0, nfw = 1; const bool fil = filler_slot(F, (MT / 256) * (NQKV / 256), fw, nfw), first = fil && (F.bid & 8);
        if (first) { p0_items(F, args, PI_FIRST, PI_SECOND, fw, nfw); __syncthreads(); }
        gemm_pg8<0>(F, AN, (const bf16*)(ws + WS_WQKV), 0, MT, NQKV, D, E);
        if (fil && !first) p0_items(F, args, PI_FIRST, PI_SECOND, fw, nfw); }
    else if (ON(S_ATT) && s == S_ATT) ATTN(F, args);
    else if (ON(S_WO) && s == S_WO) { float* X = outb(args);
        EpiResT<0> E{inp(args, I_XP), inp(args, I_XS), (bf16*)(ws + WS_XB), nullptr, MOD0 + 2048, AN, inp(args, I_NFFN), MOD0 + 4096, RS1, 1.f};
        gemm_pg8<1, EpiResT<0>, 3>(F, (const bf16*)(ws + WS_Q), (const bf16*)(ws + WS_WO), 0, MT, D, D, E);
    }
    else if (ON(S_UP0) && s == S_UP0) { EpiUpConv E{RS1, SW + SW_UP0, inp(args, I_WCONV), inp(args, I_BCONV), (float*)(ws + WS_HALO), (bf16*)(ws + WS_M), (LAS float*)(F.lds + EPI_OFF), F.skip_epi};
        int fw = 0, nfw = 1; const bool fil = filler_slot(F, (MT / 256) * (FF2 / 256), fw, nfw), first = fil && (F.bid & 8);
        if (first) { p0_items(F, args, PI_SECOND, PI_ALL, fw, nfw); sw_units_f32(F, args, fw / NWAVES, nfw / NWAVES); __syncthreads(); }
        gemm_pg8_raw(F, AN, (const bf16*)(ws + WS_WUP), MT, FF2, D, E);
        if (fil && !first) { p0_items(F, args, PI_SECOND, PI_ALL, fw, nfw); sw_units_f32(F, args, fw / NWAVES, nfw / NWAVES); } }
    else if (ON(S_DN0) && s == S_DN0) { float* X = outb(args);
        { pg8::StaticOrder S0; S0.init(MT, D, F.G, F.bid, 192); pg8::Unit u0; for (int i = 0; S0.next(i, u0); ++i) fix_halo_rows(F, u0.pm * 192, u0.pm * 192 + 224, (const float*)(ws + WS_HALO), inp(args, I_WCONV), inp(args, I_BCONV), (bf16*)(ws + WS_M)); }
        EpiResT<1> E{nullptr, nullptr, (bf16*)(ws + WS_XB), nullptr, MOD0 + 5120, AN, inp(args, I_NMIX) + D, MOD1 + 1024, RS2, F.scale};
        gemm_pg8<1, EpiResT<1>, 3>(F, (const bf16*)(ws + WS_M), (const bf16*)(ws + WS_WDN), 0, MT, D, FF, E);
    }
    else if (ON(S_IN) && s == S_IN) { EpiIn E{{RS2, SW + SW_IN, GE2}, (bf16*)(ws + WS_U), (bf16*)(ws + WS_VV), (float*)(ws + WS_LNP)}; gemm_pg8<2>(F, AN, (const bf16*)(ws + WS_WIN), 0, MT, GE2, D, E); }
    else if (ON(S_MIX) && s == S_MIX) MIX(F, args);
    else if (ON(S_OUT) && s == S_OUT) { float* X = outb(args);
        EpiResT<1> E{nullptr, nullptr, (bf16*)(ws + WS_XB), nullptr, MOD1 + 2048, AN, inp(args, I_NFFN) + D, MOD1 + 4096, RS3, F.scale};
        gemm_pg8<1, EpiResT<1>, 3>(F, (const bf16*)(ws + WS_U), (const bf16*)(ws + WS_WOUT), 0, MT, D, GE, E); }
    else if (ON(S_UP1) && s == S_UP1) { EpiUpConv E{RS3, SW + SW_UP1, inp(args, I_WCONV) + (size_t)3 * FF2, inp(args, I_BCONV) + FF2, (float*)(ws + WS_HALO), (bf16*)(ws + WS_M), (LAS float*)(F.lds + EPI_OFF), F.skip_epi};
        int fw = 0, nfw = 1; const bool fil = filler_slot(F, (MT / 256) * (FF2 / 256), fw, nfw), first = fil && (F.bid & 8);
        if (first) state_items(F, args, fw, nfw);
        gemm_pg8_raw(F, AN, (const bf16*)(ws + WS_WUP) + (size_t)FF2 * D, MT, FF2, D, E);
        if (fil && !first) state_items(F, args, fw, nfw); }
    else if (ON(S_DN1) && s == S_DN1) { float* X = outb(args);
        { pg8::StaticOrder S0; S0.init(MT, D, F.G, F.bid, 192); pg8::Unit u0; for (int i = 0; S0.next(i, u0); ++i) fix_halo_rows(F, u0.pm * 192, u0.pm * 192 + 224, (const float*)(ws + WS_HALO), inp(args, I_WCONV) + (size_t)3 * FF2, inp(args, I_BCONV) + FF2, (bf16*)(ws + WS_M)); }
        EpiFinal E{(const bf16*)(ws + WS_XB), X, MOD1 + 5120, inp(args, I_NFIN), RS0 + (size_t)MT * 16, (unsigned*)ws + CW_CNT, (unsigned*)ws + CW_TMO, F.scale};
        gemm_pg8<1, EpiFinal, 3>(F, (const bf16*)(ws + WS_M), (const bf16*)(ws + WS_WDN) + (size_t)D * FF, 0, MT, D, FF, E); }
}

__global__ void __launch_bounds__(NWAVES * 64, 2) mk_fwd(Args args) {
    extern __shared__ __attribute__((aligned(16))) unsigned char lds[];
    Frame F;
    F.lds = (LAS unsigned char*)lds;
    F.MISC = (volatile LAS unsigned*)(F.lds + MISC_OFF);
    F.tid = threadIdx.x; F.lane = F.tid & 63; F.wave = __builtin_amdgcn_readfirstlane(F.tid >> 6);
    F.G = gridDim.x; F.bid = blockIdx.x; F.scale = 1.f; F.skip_epi = false;
    for (int u = F.tid; u < (LDS_BYTES - LDSCTL_OFF) / 4; u += NWAVES * 64) ((LAS unsigned*)(F.lds + LDSCTL_OFF))[u] = 0u;
    __syncthreads();
    XcdBarrier bar = xcd_barrier_post((unsigned*)(args.ws + WS_CTL) + CW_BAR, F.MISC + 8);
    for (int q = 0; q < args.nseq; ++q) {
        const int sq = args.seq[q]; F.scale = (sq & 32) ? 0.f : 1.f; F.skip_epi = (sq & 64) != 0;
        run_step(F, args, sq & 31);
        if (q + 1 < args.nseq) xcd_barrier(bar);
    }
}

extern "C" void kernel_launch(void* const* d_in, const int* in_sizes, int n_in, void* d_out, int out_size, void* d_ws, size_t ws_size, hipStream_t stream) {
    static int grid = 0;
    if (grid == 0) {
        if (n_in != 23 || ws_size < WS_END) { fprintf(stderr, "kernel_launch: unexpected n_in %d / ws %zu\n", n_in, ws_size); grid = -1; return; }
        int dev = 0, cus = 0, per_cu = 0;
        if (hipGetDevice(&dev) != hipSuccess || hipDeviceGetAttribute(&cus, hipDeviceAttributeMultiprocessorCount, dev) != hipSuccess) { grid = -1; return; }
        if (hipFuncSetAttribute((const void*)mk_fwd, hipFuncAttributeMaxDynamicSharedMemorySize, LDS_BYTES) != hipSuccess) { fprintf(stderr, "kernel_launch: hipFuncSetAttribute failed\n"); grid = -1; return; }
        if (hipOccupancyMaxActiveBlocksPerMultiprocessor(&per_cu, (const void*)mk_fwd, NWAVES * 64, LDS_BYTES) != hipSuccess || per_cu < 1) { fprintf(stderr, "kernel_launch: occupancy query says %d blocks per CU\n", per_cu); per_cu = 1; }
        (void)hipGetLastError();
        grid = cus;
    }
    if (grid < 0) return;
    if (hipMemsetAsync((char*)d_ws + WS_CTL, 0, CTL_ZERO_BYTES, stream) != hipSuccess) { fprintf(stderr, "kernel_launch: memset failed\n"); return; }
    Args a{};
    for (int i = 0; i < 23; ++i) a.in[i] = (const float*)d_in[i];
    a.out = (float*)d_out; a.ws = (unsigned char*)d_ws;
#ifndef DUP_FLAGS
#define DUP_FLAGS 0
#endif
#ifndef DUP_STEP
    a.nseq = NSTEPS; for (int s = 0; s < NSTEPS; ++s) a.seq[s] = (unsigned char)s;
#else
#ifndef DUP_STEP_HI
#define DUP_STEP_HI DUP_STEP
#endif
    a.nseq = 0; for (int s = 0; s < NSTEPS; ++s) { a.seq[a.nseq++] = (unsigned char)s; if (s == DUP_STEP_HI) for (int r = DUP_STEP; r <= DUP_STEP_HI; ++r) a.seq[a.nseq++] = (unsigned char)(r | 32 | DUP_FLAGS); }
#endif
    hipLaunchKernelGGL(mk_fwd, dim3(grid), dim3(NWAVES * 64), LDS_BYTES, stream, a);
    const hipError_t le = hipPeekAtLastError();
    if (le != hipSuccess) fprintf(stderr, "kernel_launch: launch failed: %s\n", hipGetErrorName(le));
}
```
